# Optimizing an MI355X kernel written in HIP

```python
import jax
import jax.numpy as jnp
from jax import lax
import numpy as np

D_MODEL = 2048
BATCH = 8
SEQ = 2048
DEPTH = 1

NSA_HEADS = 16
NSA_KV_GROUPS = 4
NSA_HPG = NSA_HEADS // NSA_KV_GROUPS
NSA_DH = 64
NSA_Q = NSA_HEADS * NSA_DH
NSA_KV = NSA_KV_GROUPS * NSA_DH
CMP_STRIDE = 16
CMP_LEN = 2 * CMP_STRIDE
CMP_HID = 256
SEL_LEN = 64
SEL_TOP = 16
WIN = 512
WIN_QBLK = 128
SEL_QBLK = 32
FORCE = 1e3
NEG = -1e9
M_HEADS = 4
M_DQK = 128
M_DV = 256
M_QK = M_HEADS * M_DQK
M_V = M_HEADS * M_DV
M_CHUNK = 64
CONV_W = 4
N_EXPERTS = 64
TOP_K = 8
N_GROUPS = 8
TOP_GROUPS = 4
EXPERT_FF = 512
SHARED_FF = 512
ROUTE_SCALE = 2.5
MOE_BLK = 128
EPS = 1e-6

IN_SIZES = (NSA_Q, 6 * NSA_KV, 3 * NSA_HEADS, 2 * M_QK, M_V, 2 * M_HEADS, M_V, D_MODEL, D_MODEL)
D_IN = sum(IN_SIZES)

kernel_name = 'hybrid_nsa_mlstm_moe_layer'


def rmsnorm(x, g):
    xf = x.astype(jnp.float32)
    y = xf * lax.rsqrt(jnp.mean(xf * xf, axis=-1, keepdims=True) + EPS)
    return (y * g.astype(jnp.float32)).astype(x.dtype)


def masked_softmax(s, mask):
    s = jnp.where(mask, s.astype(jnp.float32), NEG)
    return jax.nn.softmax(s, axis=-1) * mask


def swiglu(x, wg, wu, wd):
    return (jax.nn.silu(x @ wg) * (x @ wu)) @ wd


def causal_conv(x, w, b):
    T = x.shape[1]
    xp = jnp.pad(x, ((0, 0), (CONV_W - 1, 0), (0, 0)))
    y = b
    for i in range(CONV_W):
        y = y + xp[:, i:i + T] * w[i]
    return y


def compress_blocks(kv, pe, w1, w2):
    B, T, G, DH = kv.shape
    s = kv.reshape(B, T // CMP_STRIDE, CMP_STRIDE, G, DH)
    blocks = jnp.concatenate([s[:, :-1], s[:, 1:]], axis=2)
    blocks = blocks + pe[None, None, :, None, :]
    n_cmp = blocks.shape[1]
    flat = blocks.transpose(0, 1, 3, 2, 4).reshape(B, n_cmp, G, CMP_LEN * DH)
    return jax.nn.gelu(flat @ w1) @ w2


def nsa_mixer(q_a, kv_a, g_a, cmp_pe, cmp_w1, cmp_w2):
    B, T, _ = q_a.shape
    G, HPG, DH = NSA_KV_GROUPS, NSA_HPG, NSA_DH
    scale = DH ** -0.5
    q5 = q_a.reshape(B, T, G, HPG, DH)
    kv = kv_a.reshape(B, T, 6, G, DH)
    k_c, v_c, k_s, v_s, k_w, v_w = (kv[:, :, i] for i in range(6))
    t = jnp.arange(T)

    kc = compress_blocks(k_c, cmp_pe[0], cmp_w1[0], cmp_w2[0])
    vc = compress_blocks(v_c, cmp_pe[1], cmp_w1[1], cmp_w2[1])
    n_cmp = kc.shape[1]
    cmp_end = jnp.arange(n_cmp) * CMP_STRIDE + CMP_LEN - 1
    p_cmp = masked_softmax(jnp.einsum('btghd,bngd->bghtn', q5, kc) * scale,
                           cmp_end[None, :] <= t[:, None])
    o_cmp = jnp.einsum('bghtn,bngd->btghd', p_cmp.astype(vc.dtype), vc)

    n_sel = T // SEL_LEN
    top = min(SEL_TOP, n_sel)
    ci = jnp.arange(n_cmp)[:, None]
    sj = jnp.arange(n_sel)[None, :]
    overlap = (jnp.minimum(ci * CMP_STRIDE + CMP_LEN, (sj + 1) * SEL_LEN)
               - jnp.maximum(ci * CMP_STRIDE, sj * SEL_LEN))
    cmp_to_sel = jnp.clip(overlap, 0, None).astype(jnp.float32) / CMP_LEN
    imp = jnp.einsum('bgtn,nj->bgtj', p_cmp.sum(axis=2), cmp_to_sel)
    cur = (t // SEL_LEN)[:, None]
    forced = (sj == 0) | (sj == cur) | (sj == cur - 1)
    score = jnp.where(sj <= cur, imp + jnp.where(forced, FORCE, 0.0), NEG)
    top_s, top_idx = lax.top_k(score, top)
    top_ok = top_s > 0.5 * NEG
    ks_blk = k_s.reshape(B, n_sel, SEL_LEN, G, DH).transpose(0, 3, 1, 2, 4)
    vs_blk = v_s.reshape(B, n_sel, SEL_LEN, G, DH).transpose(0, 3, 1, 2, 4)
    nqs = T // SEL_QBLK
    bi = jnp.arange(B)[:, None, None, None]
    gi = jnp.arange(G)[None, :, None, None]

    def sel_block(args):
        qb, q_blk, idx, ok = args
        k_g = ks_blk[bi, gi, idx]
        v_g = vs_blk[bi, gi, idx].reshape(B, G, SEL_QBLK, top * SEL_LEN, DH)
        s = jnp.einsum('bqghd,bgqjld->bghqjl', q_blk, k_g) * scale
        tq = qb * SEL_QBLK + jnp.arange(SEL_QBLK)
        kpos = idx[..., None] * SEL_LEN + jnp.arange(SEL_LEN)
        mask = ok[..., None] & (kpos <= tq[None, None, :, None, None])
        p = masked_softmax(s.reshape(B, G, HPG, SEL_QBLK, top * SEL_LEN),
                           mask.reshape(B, G, 1, SEL_QBLK, top * SEL_LEN))
        return jnp.einsum('bghqn,bgqnd->bqghd', p.astype(v_g.dtype), v_g)

    o_slc = lax.map(sel_block, (jnp.arange(nqs),
                                jnp.moveaxis(q5.reshape(B, nqs, SEL_QBLK, G, HPG, DH), 1, 0),
                                jnp.moveaxis(top_idx.reshape(B, G, nqs, SEL_QBLK, top), 2, 0),
                                jnp.moveaxis(top_ok.reshape(B, G, nqs, SEL_QBLK, top), 2, 0)))
    o_slc = jnp.moveaxis(o_slc, 0, 1).reshape(B, T, G, HPG, DH)

    kw_pad = jnp.pad(k_w, ((0, 0), (WIN, 0), (0, 0), (0, 0)))
    vw_pad = jnp.pad(v_w, ((0, 0), (WIN, 0), (0, 0), (0, 0)))
    nqw = T // WIN_QBLK

    def win_block(args):
        qb, q_blk = args
        start = qb * WIN_QBLK
        k_b = lax.dynamic_slice_in_dim(kw_pad, start, WIN + WIN_QBLK, axis=1)
        v_b = lax.dynamic_slice_in_dim(vw_pad, start, WIN + WIN_QBLK, axis=1)
        s = jnp.einsum('bqghd,bsgd->bghqs', q_blk, k_b) * scale
        tq = start + jnp.arange(WIN_QBLK)
        kp = start - WIN + jnp.arange(WIN + WIN_QBLK)
        diff = tq[:, None] - kp[None, :]
        p = masked_softmax(s, (kp[None, :] >= 0) & (diff >= 0) & (diff < WIN))
        return jnp.einsum('bghqs,bsgd->bqghd', p.astype(v_b.dtype), v_b)

    o_win = lax.map(win_block, (jnp.arange(nqw),
                                jnp.moveaxis(q5.reshape(B, nqw, WIN_QBLK, G, HPG, DH), 1, 0)))
    o_win = jnp.moveaxis(o_win, 0, 1).reshape(B, T, G, HPG, DH)

    g = jax.nn.sigmoid(g_a).reshape(B, T, G, HPG, 3)
    o = g[..., 0:1] * o_cmp + g[..., 1:2] * o_slc + g[..., 2:3] * o_win
    return o.reshape(B, T, NSA_Q)


def mlstm_chunkwise(q, k, v, logi, logf):
    B, H, T, DQK = q.shape
    DV = v.shape[-1]
    L = M_CHUNK
    nc = T // L

    def chunk(z):
        return jnp.moveaxis(z.reshape((B, H, nc, L) + z.shape[3:]), 2, 0)

    tri = jnp.tril(jnp.ones((L, L), dtype=bool))

    def step(carry, xs):
        C, n, m = carry
        qc, kc, vc, li, lf = xs
        a = jnp.cumsum(lf, axis=-1)
        dlog = jnp.where(tri, a[..., :, None] - a[..., None, :] + li[..., None, :], -jnp.inf)
        inter = a + m[..., None]
        mt = jnp.maximum(inter, dlog.max(axis=-1))
        dmat = jnp.exp(dlog - mt[..., None])
        iw = jnp.exp(inter - mt)
        s = jnp.einsum('bhtd,bhsd->bhts', qc, kc) * dmat
        num = iw[..., None] * jnp.einsum('bhtd,bhde->bhte', qc, C) + jnp.einsum('bhts,bhse->bhte', s, vc)
        den = iw * jnp.einsum('bhtd,bhd->bht', qc, n) + s.sum(axis=-1)
        hc = num / jnp.maximum(jnp.abs(den), jnp.exp(-mt))[..., None]
        a_end = a[..., -1]
        elog = a_end[..., None] - a + li
        m_new = jnp.maximum(a_end + m, elog.max(axis=-1))
        ew = jnp.exp(elog - m_new[..., None])
        decay = jnp.exp(a_end + m - m_new)
        C_new = decay[..., None, None] * C + jnp.einsum('bhs,bhsd,bhse->bhde', ew, kc, vc)
        n_new = decay[..., None] * n + jnp.einsum('bhs,bhsd->bhd', ew, kc)
        return (C_new, n_new, m_new), hc

    init = (jnp.zeros((B, H, DQK, DV), jnp.float32), jnp.zeros((B, H, DQK), jnp.float32),
            jnp.zeros((B, H), jnp.float32))
    _, hs = lax.scan(step, init, (chunk(q), chunk(k), chunk(v), chunk(logi), chunk(logf)))
    return jnp.moveaxis(hs, 0, 2).reshape(B, H, T, DV)


def mlstm_mixer(qk_m, v_m, if_m, o_m, conv_w, conv_b, b_gates_m, mh_norm_g):
    B, T, _ = qk_m.shape
    dt = qk_m.dtype
    qk = jax.nn.silu(causal_conv(qk_m, conv_w, conv_b))
    q, k = jnp.split(qk, 2, axis=-1)

    def heads(z, d):
        return z.reshape(B, T, M_HEADS, d).transpose(0, 2, 1, 3).astype(jnp.float32)

    q = heads(q, M_DQK)
    k = heads(k, M_DQK) * (M_DQK ** -0.5)
    v = heads(v_m, M_DV)
    gates = (if_m + b_gates_m).astype(jnp.float32).transpose(0, 2, 1)
    logi = gates[:, :M_HEADS]
    logf = jax.nn.log_sigmoid(gates[:, M_HEADS:])
    hs = mlstm_chunkwise(q, k, v, logi, logf).transpose(0, 2, 1, 3)
    hn = rmsnorm(hs, mh_norm_g.reshape(M_HEADS, M_DV)).astype(dt)
    return (jax.nn.sigmoid(o_m).reshape(B, T, M_HEADS, M_DV) * hn).reshape(B, T, M_V)


def hybrid_mixer(h, w_in, cmp_pe, cmp_w1, cmp_w2, conv_w, conv_b, b_gates_m, mh_norm_g,
                 w_up_nsa, w_up_mlstm, w_out):
    proj = h @ w_in
    pts = np.cumsum(IN_SIZES)[:-1].tolist()
    q_a, kv_a, g_a, qk_m, v_m, if_m, o_m, gate_a, gate_b = jnp.split(proj, pts, axis=-1)
    o_nsa = nsa_mixer(q_a, kv_a, g_a, cmp_pe, cmp_w1, cmp_w2)
    o_mlstm = mlstm_mixer(qk_m, v_m, if_m, o_m, conv_w, conv_b, b_gates_m, mh_norm_g)
    merged = (jax.nn.sigmoid(gate_a) * (o_nsa @ w_up_nsa)
              + jax.nn.sigmoid(gate_b) * (o_mlstm @ w_up_mlstm))
    return merged @ w_out


def moe_ffn(h, w_router, b_router, w_e_gate, w_e_up, w_e_down, w_sh_gate, w_sh_up, w_sh_down):
    B, T, D = h.shape
    N = B * T
    hf = h.reshape(N, D)
    s = jax.nn.sigmoid((hf @ w_router).astype(jnp.float32))
    sb = s + b_router.astype(jnp.float32)
    gscore = lax.top_k(sb.reshape(N, N_GROUPS, N_EXPERTS // N_GROUPS), 2)[0].sum(axis=-1)
    _, gidx = lax.top_k(gscore, TOP_GROUPS)
    gmask = jax.nn.one_hot(gidx, N_GROUPS, dtype=jnp.float32).sum(axis=-2) > 0
    emask = jnp.repeat(gmask, N_EXPERTS // N_GROUPS, axis=-1)
    _, eidx = lax.top_k(jnp.where(emask, sb, NEG), TOP_K)
    w = jnp.take_along_axis(s, eidx, axis=-1)
    w = (w / w.sum(axis=-1, keepdims=True) * ROUTE_SCALE).astype(h.dtype)

    A = N * TOP_K
    e_flat = eidx.reshape(A)
    tok = jnp.repeat(jnp.arange(N, dtype=jnp.int32), TOP_K)
    w_flat = w.reshape(A)
    order = jnp.argsort(e_flat)
    e_s, tok_s, w_s = e_flat[order], tok[order], w_flat[order]
    counts = jnp.bincount(e_flat, length=N_EXPERTS)
    padded = (counts + MOE_BLK - 1) // MOE_BLK * MOE_BLK
    pad_end = jnp.cumsum(padded)
    pad_start = pad_end - padded
    raw_start = jnp.cumsum(counts) - counts
    dest = pad_start[e_s] + (jnp.arange(A) - raw_start[e_s])
    n_blk = -(-A // MOE_BLK) + N_EXPERTS
    P = n_blk * MOE_BLK
    slot_tok = jnp.full((P,), N, jnp.int32).at[dest].set(tok_s)
    slot_w = jnp.zeros((P,), h.dtype).at[dest].set(w_s)
    blk_exp = jnp.minimum(jnp.searchsorted(pad_end, jnp.arange(n_blk) * MOE_BLK, side='right'),
                          N_EXPERTS - 1)
    hp = jnp.concatenate([hf, jnp.zeros((1, D), hf.dtype)], axis=0)

    def run_block(args):
        e, toks, ws = args
        return swiglu(hp[toks], w_e_gate[e], w_e_up[e], w_e_down[e]) * ws[:, None]

    y = lax.map(run_block, (blk_exp, slot_tok.reshape(n_blk, MOE_BLK), slot_w.reshape(n_blk, MOE_BLK)))
    routed = jnp.zeros((N + 1, D), hf.dtype).at[slot_tok].add(y.reshape(P, D))[:N]
    shared = swiglu(hf, w_sh_gate, w_sh_up, w_sh_down)
    return (routed + shared).reshape(B, T, D)


def setup_inputs(seed: int = 0) -> dict:
    key = jax.random.key(seed)
    ks = iter(jax.random.split(key, 32))

    def nrm(shape, scale):
        return jax.random.normal(next(ks), shape, jnp.float32) * scale

    def gain(shape):
        return 1.0 + nrm(shape, 0.02)

    L = DEPTH
    return {
        'x': nrm((BATCH, SEQ, D_MODEL), 1.0),
        'c': nrm((BATCH, D_MODEL), 1.0),
        'w_ada': nrm((L, D_MODEL, 6 * D_MODEL), 0.2 * D_MODEL ** -0.5),
        'b_ada': nrm((L, 6 * D_MODEL), 0.01),
        'g_pre_mix': gain((L, D_MODEL)),
        'g_post_mix': gain((L, D_MODEL)),
        'w_in': nrm((L, D_MODEL, D_IN), D_MODEL ** -0.5),
        'cmp_pe': nrm((L, 2, CMP_LEN, NSA_DH), 0.02),
        'cmp_w1': nrm((L, 2, CMP_LEN * NSA_DH, CMP_HID), (CMP_LEN * NSA_DH) ** -0.5),
        'cmp_w2': nrm((L, 2, CMP_HID, NSA_DH), CMP_HID ** -0.5),
        'conv_w': nrm((L, CONV_W, 2 * M_QK), CONV_W ** -0.5),
        'conv_b': nrm((L, 2 * M_QK), 0.01),
        'b_gates_m': jnp.concatenate([nrm((L, M_HEADS), 0.1),
                                      jnp.linspace(3.0, 6.0, M_HEADS)[None, :] + nrm((L, M_HEADS), 0.1)],
                                     axis=-1),
        'mh_norm_g': gain((L, M_V)),
        'w_up_nsa': nrm((L, NSA_Q, D_MODEL), NSA_Q ** -0.5),
        'w_up_mlstm': nrm((L, M_V, D_MODEL), M_V ** -0.5),
        'w_out': nrm((L, D_MODEL, D_MODEL), D_MODEL ** -0.5),
        'g_pre_ffn': gain((L, D_MODEL)),
        'g_post_ffn': gain((L, D_MODEL)),
        'w_router': nrm((L, D_MODEL, N_EXPERTS), D_MODEL ** -0.5),
        'b_router': nrm((L, N_EXPERTS), 0.01),
        'w_e_gate': nrm((L, N_EXPERTS, D_MODEL, EXPERT_FF), D_MODEL ** -0.5),
        'w_e_up': nrm((L, N_EXPERTS, D_MODEL, EXPERT_FF), D_MODEL ** -0.5),
        'w_e_down': nrm((L, N_EXPERTS, EXPERT_FF, D_MODEL), EXPERT_FF ** -0.5),
        'w_sh_gate': nrm((L, D_MODEL, SHARED_FF), D_MODEL ** -0.5),
        'w_sh_up': nrm((L, D_MODEL, SHARED_FF), D_MODEL ** -0.5),
        'w_sh_down': nrm((L, SHARED_FF, D_MODEL), SHARED_FF ** -0.5),
    }


def reference(x, c, w_ada, b_ada, g_pre_mix, g_post_mix, w_in, cmp_pe, cmp_w1, cmp_w2, conv_w, conv_b,
              b_gates_m, mh_norm_g, w_up_nsa, w_up_mlstm, w_out, g_pre_ffn, g_post_ffn, w_router, b_router,
              w_e_gate, w_e_up, w_e_down, w_sh_gate, w_sh_up, w_sh_down):
    for l in range(DEPTH):
        mod = jax.nn.silu(c) @ w_ada[l] + b_ada[l]
        sh_m, sc_m, gt_m, sh_f, sc_f, gt_f = (m[:, None, :] for m in jnp.split(mod, 6, axis=-1))
        h = rmsnorm(x, g_pre_mix[l]) * (1.0 + sc_m) + sh_m
        y = hybrid_mixer(h, w_in[l], cmp_pe[l], cmp_w1[l], cmp_w2[l], conv_w[l], conv_b[l], b_gates_m[l],
                         mh_norm_g[l], w_up_nsa[l], w_up_mlstm[l], w_out[l])
        x = x + gt_m * rmsnorm(y, g_post_mix[l])
        h = rmsnorm(x, g_pre_ffn[l]) * (1.0 + sc_f) + sh_f
        y = moe_ffn(h, w_router[l], b_router[l], w_e_gate[l], w_e_up[l], w_e_down[l],
                    w_sh_gate[l], w_sh_up[l], w_sh_down[l])
        x = x + gt_f * rmsnorm(y, g_post_ffn[l])
    return x
```

```cpp
#include <hip/hip_runtime.h>
#include <cstdio>
#include <cstdint>

#define GAS __attribute__((address_space(1)))
#define LAS __attribute__((address_space(3)))
typedef unsigned short bf16;
typedef unsigned v4u __attribute__((ext_vector_type(4)));
typedef unsigned v2u __attribute__((ext_vector_type(2)));
typedef float f32x4 __attribute__((ext_vector_type(4)));
typedef float f32x2 __attribute__((ext_vector_type(2)));
typedef short bf16x8 __attribute__((ext_vector_type(8)));
typedef GAS unsigned gu32;
typedef int v8i __attribute__((ext_vector_type(8)));
typedef int v4i __attribute__((ext_vector_type(4)));

#ifndef PROBE_DUP
#define PROBE_DUP 0x0
#endif
#define PRB(k) (1 + ((PROBE_DUP >> (16 + (k))) & 1))
#define REP(k, ...) do { __VA_ARGS__ if ((PROBE_DUP >> (k)) & 1) { __VA_ARGS__ } } while (0)
#ifndef MK_PER_PHASE
#define MK_PER_PHASE 0
#endif

constexpr int NB = 8, SEQ = 2048, DM = 2048, NTOK = NB * SEQ;
constexpr int PLD = 9984;
constexpr int PC_Q = 0, PC_KC = 1024, PC_KS = 1280, PC_KW = 1536, PC_QKM = 1792, PC_G3 = 2816, PC_IF = 2864, PC_VC = 3072, PC_VS = 3328, PC_VW = 3584, PC_VM = 3840, PC_OM = 4864, PC_GA = 5888, PC_GB = 7936;
constexpr int PN_BF = 3072, PN_F8 = 6912;
constexpr int D_IN = 9784;
constexpr int NEXP = 64, EFF = 512;
constexpr int NSLOT = NTOK * 8;
constexpr int NSLOT_ALL = NSLOT + NTOK;
constexpr float EPS = 1e-6f;
constexpr float QC2 = 0.18033688011112042f;

constexpr size_t MiB = 1u << 20;
constexpr size_t WS_CTL = 0, CTL_ZERO_BYTES = 64 * 1024;
constexpr size_t WS_MOD = 1 * MiB;
constexpr size_t WS_BIAS1 = 1 * MiB + 512 * 1024;
constexpr size_t WS_GA = 2 * MiB, WS_GU = 2 * MiB + 256 * 1024, WS_GM = 2 * MiB + 512 * 1024;
constexpr size_t WS_SELM = 3 * MiB;
constexpr size_t WS_KCV = 4 * MiB;
constexpr size_t WS_HIDC = 6 * MiB;
constexpr size_t WS_TE = 14 * MiB, WS_TP = 14 * MiB + 512 * 1024, WS_TW = 15 * MiB, WS_TOKSLOT = 15 * MiB + 512 * 1024;
constexpr size_t WS_SLOTTOK = 16 * MiB, WS_SLOTW = 17 * MiB, WS_RT = 18 * MiB;
constexpr size_t WS_LOGITS = 19 * MiB;
constexpr size_t WS_WED = 32 * MiB;
constexpr size_t WS_WOUT = 162 * MiB;
constexpr size_t WS_WUP = 170 * MiB;
constexpr size_t WS_CW1 = 178 * MiB;
constexpr size_t WS_CW2 = 181 * MiB;
constexpr size_t WS_WR = 180 * MiB;
constexpr size_t WS_H2 = 182 * MiB;
constexpr size_t WS_HID = 246 * MiB;
constexpr size_t WS_H2Q = 340 * MiB;
constexpr size_t WS_WIN = 392 * MiB;
constexpr size_t WS_WIN8 = 412 * MiB;
constexpr size_t WS_WEGU = 432 * MiB;
constexpr size_t WS_PROJ = 692 * MiB;
constexpr size_t WS_H1 = 1004 * MiB;
constexpr size_t WS_H1Q = 1068 * MiB;
constexpr size_t WS_END = 1100 * MiB;
constexpr size_t WS_OACC = WS_HID;
constexpr size_t WS_OMIX = WS_HID + 64 * MiB;
constexpr size_t WS_T1 = WS_H2;
constexpr size_t WS_QKC = WS_H1;
constexpr size_t WS_MERGED = WS_H1;
constexpr size_t WS_Y = WS_PROJ;
constexpr size_t WS_YSLOT = WS_WEGU;
static_assert(WS_YSLOT + (size_t)NSLOT_ALL * 2048 <= WS_END, "yslot");
static_assert(WS_HID + (size_t)(NSLOT_ALL + 256) * 512 <= WS_H2Q && WS_H2Q + (size_t)NTOK * DM <= WS_WIN, "hid");
constexpr int CW_CNT = 64;
constexpr int CW_MLQ = 200;
constexpr int CW_NTILES = 192;
constexpr int CW_BAR = 4096;

constexpr int RT_LDS_OFF = 131072 + 512 + 4096;
constexpr int RING_BYTES = 131072, LDSCTL_OFF = RING_BYTES, MISC_OFF = LDSCTL_OFF + 320, LDS_BYTES = 147456;

#define LDS_WAIT() asm volatile("s_waitcnt lgkmcnt(0)" ::: "memory")
#define VM_WAIT() asm volatile("s_waitcnt vmcnt(0)" ::: "memory")
#define RLX_AGENT __ATOMIC_RELAXED, __HIP_MEMORY_SCOPE_AGENT
__device__ __forceinline__ unsigned f2bf(float f) { unsigned u = __builtin_bit_cast(unsigned, f); return (u + 0x7fffu + ((u >> 16) & 1u)) >> 16; }
__device__ __forceinline__ unsigned pk2(float lo, float hi) { return f2bf(lo) | (f2bf(hi) << 16); }
__device__ __forceinline__ float bf2f(unsigned h) { return __uint_as_float(h << 16); }
__device__ __forceinline__ float bflo(unsigned w) { return __uint_as_float(w << 16); }
__device__ __forceinline__ float bfhi(unsigned w) { return __uint_as_float(w & 0xffff0000u); }
__device__ __forceinline__ float sigm(float x) { return 1.f / (1.f + __expf(-x)); }
__device__ __forceinline__ float wave_sum(float v) {
#pragma unroll
    for (int o = 1; o < 64; o <<= 1) v += __shfl_xor(v, o);
    return v;
}
__device__ __forceinline__ float wave_max(float v) {
#pragma unroll
    for (int o = 1; o < 64; o <<= 1) v = fmaxf(v, __shfl_xor(v, o));
    return v;
}
__device__ __forceinline__ unsigned long long uaddr(const void* p) {
    const unsigned long long a = (unsigned long long)p; const unsigned lo = __builtin_amdgcn_readfirstlane((unsigned)a), hi = __builtin_amdgcn_readfirstlane((unsigned)(a >> 32));
    return ((unsigned long long)hi << 32) | lo; }
#define UPTR(T, p) ((GAS T*)uaddr(p))
__device__ __forceinline__ int tid_opaque() { int t = threadIdx.x; asm volatile("" : "+v"(t)); return t; }
__device__ __forceinline__ float rdlane(float v, int l) { return __int_as_float(__builtin_amdgcn_readlane(__float_as_int(v), l)); }

namespace pg8 {
constexpr int BM = 256, BK = 64, HALF = 128, HTB = HALF * BK * 2, STAGE_BYTES = 8 * HTB, NXCD = 8, WGM = 8;
__host__ __device__ __forceinline__ int lds_byte(int r, int c) { const int st = (r >> 4) * 2 + (c >> 5), rr = r & 15, cc = c & 31, ob = rr * 64 + cc * 2; return st * 1024 + (ob ^ (((ob >> 9) & 1) << 5)); }
__host__ __device__ __forceinline__ void stage_rc(int b, int& R, int& C) { const int st = b / 1024, sb = b % 1024, swz = sb ^ (((sb >> 9) & 1) << 5); R = (st >> 1) * 16 + swz / 64; C = (st & 1) * 32 + (swz % 64) / 2; }
__host__ __device__ __forceinline__ int perm32(int rho) { const int n = rho >> 4, i = rho & 15; return 8 * (i >> 2) + 4 * n + (i & 3); }

struct Unit { int arow, pn, valid, aux; };
struct Gemm { const void* A; const void* Bt; int K; int kstepA; int scW, scX; };

struct StaticOrder {
    int nM, nN, nwg, G, c, reps;
    __device__ void init(int M, int N, int G_, int c_, int reps_ = 1) { nM = M / BM; nN = N / BM; nwg = nM * nN; G = G_; c = c_; reps = reps_; }
    __device__ bool next(int i, Unit& u) const {
        long L = (long)i * G + c; if (L >= (long)nwg * reps) return false; L %= nwg;
        int wgid = (int)L; { const int q = nwg / NXCD, r = nwg % NXCD, xcd = wgid % NXCD, off = wgid / NXCD; wgid = (xcd < r ? xcd * (q + 1) : r * (q + 1) + (xcd - r) * q) + off; }
        const int nig = WGM * nN, gid = wgid / nig, fm = gid * WGM, gsz = (nM - fm) < WGM ? (nM - fm) : WGM;
        u.arow = (fm + ((wgid % nig) % gsz)) * BM; u.pn = (wgid % nig) / gsz; u.valid = BM; u.aux = u.pn; return true;
    }
    __device__ __forceinline__ unsigned rowkey(const Unit&, int) const { return 0u; }
    __device__ __forceinline__ unsigned keyoff(const Unit&, unsigned) const { return 0u; }
};
struct CmpOrder {
    int G, c;
    __device__ bool next(int i, Unit& u) const { const int L = i * G + c; if (L >= 32) return false; const int kv = L >> 4, pm = L & 15; u.arow = 256 * pm; u.pn = kv; u.valid = (4064 - 256 * pm) < 256 ? (4064 - 256 * pm) : 256; u.aux = kv; return true; }
    __device__ __forceinline__ unsigned rowkey(const Unit& u, int lr) const { int rr = u.arow + lr; rr = (rr < 4064) ? rr : 0; const int b = rr / 508, n = (rr % 508) >> 2, g = rr & 3; return (unsigned)((b * SEQ + 16 * n) | (g << 14)); }
    __device__ __forceinline__ unsigned keyoff(const Unit& u, unsigned key) const { return (unsigned)(((size_t)(key & 0x3fffu) * PLD + (u.aux ? PC_VC : PC_KC) + (key >> 14) * 64) * 2); }
};
struct MoeOrder {
    const LAS int* rt; int ntiles, NCT, G, c; const int* rows; unsigned rbytes; int reps;
    __device__ __forceinline__ unsigned rowkey(const Unit& u, int lr) const { return (unsigned)((lr < u.valid) ? rows[u.arow + lr] : 0); }
    __device__ __forceinline__ unsigned keyoff(const Unit&, unsigned key) const { return key * rbytes; }
    __device__ bool next(int i, Unit& u) const {
        long L = (long)i * G + c; if (L >= (long)ntiles * NCT * reps) return false; L %= (long)ntiles * NCT;
        const int j = (int)(L / NCT), ct = (int)(L % NCT);
        const int e = __builtin_amdgcn_readfirstlane(rt[3 * j]), base = __builtin_amdgcn_readfirstlane(rt[3 * j + 1]), v = __builtin_amdgcn_readfirstlane(rt[3 * j + 2]);
        u.arow = base; u.pn = e * NCT + ct; u.valid = v; u.aux = ct; return true;
    }
};

__device__ __forceinline__ unsigned cvt_pk_bf16(float lo, float hi) { unsigned r; asm volatile("v_cvt_pk_bf16_f32 %0, %1, %2" : "=v"(r) : "v"(lo), "v"(hi)); return r; }

struct EpiBf16 {
    static constexpr bool PERM = true;
    bf16* O; int ldc; int nscaled; float scale0;
    __device__ __forceinline__ void operator()(const f32x4 (&acc)[2][2][4][2], const Unit& u, int wr, int wc, int fr, int fq) const {
        const float sc = (u.aux < nscaled) ? scale0 : 1.f;
#pragma unroll
        for (int ai = 0; ai < 2; ++ai)
#pragma unroll
            for (int m = 0; m < 4; ++m) { const int lr = ai * HALF + wr * 64 + m * 16 + fr; if (lr < u.valid) { bf16* rowp = O + (size_t)(u.arow + lr) * ldc + u.aux * BM + wc * 32 + 8 * fq;
#pragma unroll
                for (int bj = 0; bj < 2; ++bj) { const f32x4 v0 = acc[ai][bj][m][0] * sc, v1 = acc[ai][bj][m][1] * sc; v4u w; w.x = cvt_pk_bf16(v0[0], v0[1]); w.y = cvt_pk_bf16(v0[2], v0[3]); w.z = cvt_pk_bf16(v1[0], v1[1]); w.w = cvt_pk_bf16(v1[2], v1[3]);
                    *(v4u*)(rowp + bj * HALF) = w; } } }
    }
};
struct EpiFp8 {
    static constexpr bool PERM = true;
    unsigned char* O; int ldc; float scale;
    __device__ __forceinline__ void operator()(const f32x4 (&acc)[2][2][4][2], const Unit& u, int wr, int wc, int fr, int fq) const {
#pragma unroll
        for (int ai = 0; ai < 2; ++ai)
#pragma unroll
            for (int m = 0; m < 4; ++m) { const int lr = ai * HALF + wr * 64 + m * 16 + fr; if (lr < u.valid) { unsigned char* rowp = O + (size_t)(u.arow + lr) * ldc + u.aux * BM + wc * 32 + 8 * fq;
#pragma unroll
                for (int bj = 0; bj < 2; ++bj) { float r[8];
#pragma unroll
                    for (int n = 0; n < 2; ++n)
#pragma unroll
                        for (int k = 0; k < 4; ++k) r[4 * n + k] = fminf(fmaxf(acc[ai][bj][m][n][k] * scale, -448.f), 448.f);
                    int o0 = 0, o1 = 0; o0 = __builtin_amdgcn_cvt_pk_fp8_f32(r[0], r[1], o0, false); o0 = __builtin_amdgcn_cvt_pk_fp8_f32(r[2], r[3], o0, true);
                    o1 = __builtin_amdgcn_cvt_pk_fp8_f32(r[4], r[5], o1, false); o1 = __builtin_amdgcn_cvt_pk_fp8_f32(r[6], r[7], o1, true);
                    v2u o; o.x = (unsigned)o0; o.y = (unsigned)o1; *(v2u*)(rowp + bj * HALF) = o; } } }
    }
};
struct EpiGate {
    static constexpr bool PERM = true;
    bf16* O; const bf16* gate; int ldg; const bf16* prev;
    __device__ __forceinline__ void operator()(const f32x4 (&acc)[2][2][4][2], const Unit& u, int wr, int wc, int fr, int fq) const {
#pragma unroll
        for (int ai = 0; ai < 2; ++ai)
#pragma unroll
            for (int m = 0; m < 4; ++m) { const int row = u.arow + ai * HALF + wr * 64 + m * 16 + fr; const int col = u.pn * BM + wc * 32 + 8 * fq;
#pragma unroll
                for (int bj = 0; bj < 2; ++bj) {
                    const v4u gq = *(const v4u*)(gate + (size_t)row * ldg + col + bj * HALF);
                    const f32x4 v0 = acc[ai][bj][m][0], v1 = acc[ai][bj][m][1];
                    float r[8];
                    r[0] = sigm(bflo(gq.x)) * v0[0]; r[1] = sigm(bfhi(gq.x)) * v0[1]; r[2] = sigm(bflo(gq.y)) * v0[2]; r[3] = sigm(bfhi(gq.y)) * v0[3];
                    r[4] = sigm(bflo(gq.z)) * v1[0]; r[5] = sigm(bfhi(gq.z)) * v1[1]; r[6] = sigm(bflo(gq.w)) * v1[2]; r[7] = sigm(bfhi(gq.w)) * v1[3];
                    if (prev) { const v4u pq = *(const v4u*)(prev + (size_t)row * 2048 + col + bj * HALF);
                        r[0] += bflo(pq.x); r[1] += bfhi(pq.x); r[2] += bflo(pq.y); r[3] += bfhi(pq.y); r[4] += bflo(pq.z); r[5] += bfhi(pq.z); r[6] += bflo(pq.w); r[7] += bfhi(pq.w); }
                    v4u w; w.x = cvt_pk_bf16(r[0], r[1]); w.y = cvt_pk_bf16(r[2], r[3]); w.z = cvt_pk_bf16(r[4], r[5]); w.w = cvt_pk_bf16(r[6], r[7]);
                    *(v4u*)(O + (size_t)row * 2048 + col + bj * HALF) = w; } }
    }
};
struct MidGate {
    static constexpr bool ON = true;
    const bf16* ga; const bf16* gb; int ldg;
    __device__ __forceinline__ void operator()(f32x4 (&acc)[2][2][4][2], const Unit& u, int wr, int wc, int fr, int fq) const {
#pragma unroll
        for (int ai = 0; ai < 2; ++ai)
#pragma unroll
            for (int m = 0; m < 4; ++m) { const size_t off = (size_t)(u.arow + ai * HALF + wr * 64 + m * 16 + fr) * ldg + u.pn * BM + wc * 32 + 8 * fq;
#pragma unroll
                for (int bj = 0; bj < 2; ++bj) { const v4u a = *(const v4u*)(ga + off + bj * HALF), b = *(const v4u*)(gb + off + bj * HALF);
#define MG_R(xa, xb) ((1.f + __expf(-(xb))) / (1.f + __expf(-(xa))))
                    acc[ai][bj][m][0][0] *= MG_R(bflo(a.x), bflo(b.x)); acc[ai][bj][m][0][1] *= MG_R(bfhi(a.x), bfhi(b.x)); acc[ai][bj][m][0][2] *= MG_R(bflo(a.y), bflo(b.y)); acc[ai][bj][m][0][3] *= MG_R(bfhi(a.y), bfhi(b.y));
                    acc[ai][bj][m][1][0] *= MG_R(bflo(a.z), bflo(b.z)); acc[ai][bj][m][1][1] *= MG_R(bfhi(a.z), bfhi(b.z)); acc[ai][bj][m][1][2] *= MG_R(bflo(a.w), bflo(b.w)); acc[ai][bj][m][1][3] *= MG_R(bfhi(a.w), bfhi(b.w));
#undef MG_R
                } }
    }
};
struct EpiF32 {
    static constexpr bool PERM = false;
    float* C; int ldc; int ncols;
    __device__ __forceinline__ void operator()(const f32x4 (&acc)[2][2][4][2], const Unit& u, int wr, int wc, int fr, int fq) const {
#pragma unroll
        for (int ai = 0; ai < 2; ++ai)
#pragma unroll
            for (int m = 0; m < 4; ++m) { float* rowp = C + (size_t)(u.arow + ai * HALF + wr * 64 + m * 16 + fr) * ldc; const int col0 = u.pn * BM + wc * 32 + 4 * fq;
#pragma unroll
                for (int bj = 0; bj < 2; ++bj)
#pragma unroll
                    for (int n = 0; n < 2; ++n) { const int col = col0 + bj * HALF + n * 16; if (col < ncols) *(f32x4*)(rowp + col) = acc[ai][bj][m][n]; } }
    }
};
struct EpiCmpHid {
    static constexpr bool PERM = true;
    bf16* H; const float* bias;
    __device__ __forceinline__ void operator()(const f32x4 (&acc)[2][2][4][2], const Unit& u, int wr, int wc, int fr, int fq) const {
        f32x4 bv[2][2];
#pragma unroll
        for (int bj = 0; bj < 2; ++bj)
#pragma unroll
            for (int n = 0; n < 2; ++n) bv[bj][n] = *(const f32x4*)(bias + u.aux * 256 + bj * HALF + wc * 32 + 8 * fq + 4 * n);
#pragma unroll
        for (int ai = 0; ai < 2; ++ai)
#pragma unroll
            for (int m = 0; m < 4; ++m) { const int lr = ai * HALF + wr * 64 + m * 16 + fr; if (lr < u.valid) { bf16* rowp = H + (size_t)(u.aux * 4096 + u.arow + lr) * 256 + wc * 32 + 8 * fq;
#pragma unroll
                for (int bj = 0; bj < 2; ++bj) { float r[8];
#pragma unroll
                    for (int n = 0; n < 2; ++n)
#pragma unroll
                        for (int k = 0; k < 4; ++k) { const float x = acc[ai][bj][m][n][k] + bv[bj][n][k]; const float uu = 0.7978845608028654f * (x + 0.044715f * x * x * x); const float th = 1.f - 2.f / (1.f + __expf(2.f * uu)); r[4 * n + k] = 0.5f * x * (1.f + th); }
                    v4u w; w.x = cvt_pk_bf16(r[0], r[1]); w.y = cvt_pk_bf16(r[2], r[3]); w.z = cvt_pk_bf16(r[4], r[5]); w.w = cvt_pk_bf16(r[6], r[7]);
                    *(v4u*)(rowp + bj * HALF) = w; } } }
    }
};
struct EpiSwiglu {
    static constexpr bool PERM = true;
    unsigned char* H; const float* w;
    __device__ __forceinline__ void operator()(const f32x4 (&acc)[2][2][4][2], const Unit& u, int wr, int wc, int fr, int fq) const {
#pragma unroll
        for (int ai = 0; ai < 2; ++ai)
#pragma unroll
            for (int m = 0; m < 4; ++m) { const int lr = ai * HALF + wr * 64 + m * 16 + fr; if (lr < u.valid) { const int row = u.arow + lr; const float ws = w[row];
                float r[8];
#pragma unroll
                for (int n = 0; n < 2; ++n)
#pragma unroll
                    for (int k = 0; k < 4; ++k) { const float gv = acc[ai][0][m][n][k] * (1.f / 64.f), uv = acc[ai][1][m][n][k] * (1.f / 64.f); r[4 * n + k] = fminf(fmaxf(gv * sigm(gv) * uv * ws * 16.f, -448.f), 448.f); }
                int o0 = 0, o1 = 0; o0 = __builtin_amdgcn_cvt_pk_fp8_f32(r[0], r[1], o0, false); o0 = __builtin_amdgcn_cvt_pk_fp8_f32(r[2], r[3], o0, true);
                o1 = __builtin_amdgcn_cvt_pk_fp8_f32(r[4], r[5], o1, false); o1 = __builtin_amdgcn_cvt_pk_fp8_f32(r[6], r[7], o1, true);
                v2u o; o.x = (unsigned)o0; o.y = (unsigned)o1;
                *(v2u*)(H + (size_t)row * EFF + u.aux * HALF + wc * 32 + 8 * fq) = o; } }
    }
};

struct NoMid { static constexpr bool ON = false; __device__ __forceinline__ void operator()(f32x4 (&)[2][2][4][2], const Unit&, int, int, int, int) const {} };
template <class Epi, class Sched, bool GATHER, bool ALIGN_EPI, bool FP8 = false, bool RD32 = false, class Mid = NoMid>
__device__ __forceinline__ void gemm_phase(LAS unsigned char* lds, const Gemm g, const Sched& S, const Epi& E, const Mid& MH = Mid()) {
    const int tid = tid_opaque(), wid = __builtin_amdgcn_readfirstlane(tid >> 6), lane = tid & 63, wr = wid >> 2, wc = wid & 3, fr = lane & 15, fq = lane >> 4;
    constexpr int EB = FP8 ? 1 : 2;
    const int K = g.K; const size_t rstep = (size_t)K * EB; const int nt = (int)(rstep / 128);
    unsigned voffA[2], voffB[2];
#pragma unroll
    for (int i = 0; i < 2; ++i) { int R, C; stage_rc(tid * 16 + i * 8192, R, C); const int Rb = Epi::PERM ? ((R & ~31) + perm32(R & 31)) : R;
        voffA[i] = (unsigned)(R * rstep + C * 2); voffB[i] = (unsigned)(Rb * rstep + C * 2); }
    const unsigned r64 = (unsigned)(64 * rstep);
    const size_t kstep = (size_t)(BK * 2);
    const size_t kstepA = GATHER ? (size_t)g.kstepA : kstep;
    const size_t hstep = (size_t)HALF * rstep;
    const size_t tstep = 2 * hstep;
    const unsigned ldsw = (unsigned)wid * 1024u;
    const int aoff = lds_byte(wr * 64 + fr, fq * (FP8 ? 16 : 8)), boff = lds_byte(wc * 32 + fr, fq * (FP8 ? 16 : 8));
    unsigned gkey[2];
    LAS v2u* gstash = (LAS v2u*)(lds + STAGE_BYTES + 512 + tid * 8);
    unsigned gcol = 0; { int R_, C_; stage_rc(tid * 16, R_, C_); gcol = (unsigned)C_ * 2u; }
    Unit gu;
#define PG8_SA(b, h) (((b) * 2 + (h)) * HTB)
#define PG8_SB(b, h) ((4 + (b) * 2 + (h)) * HTB)
#define PG8_STG(bufoff, ptr, v0, v1) do { \
        __builtin_amdgcn_global_load_lds((const unsigned*)((const char*)(ptr) + (v0)), (LAS unsigned*)(lds + (bufoff) + ldsw), 16, 0, 0); \
        __builtin_amdgcn_global_load_lds((const unsigned*)((const char*)(ptr) + (v1)), (LAS unsigned*)(lds + (bufoff) + ldsw + 8192), 16, 0, 0); } while (0)
#define PG8_STAGE_B(bufoff, ptr) PG8_STG(bufoff, ptr, voffB[0], voffB[0] + r64)
#define PG8_STAGE_A(bufoff, ptr, h, nx) do { if constexpr (GATHER) { const unsigned o0_ = S.keyoff(gu, gkey[h] & 0xffffu) + gcol, o1_ = S.keyoff(gu, gkey[h] >> 16) + gcol; PG8_STG(bufoff, ptr, o0_, o1_); } \
        else { PG8_STG(bufoff, (const char*)(ptr) + (h) * hstep, voffA[0], voffA[0] + r64); } } while (0)
#define PG8_GLOAD(dst, u) do { int R_, C_; stage_rc(tid * 16, R_, C_); _Pragma("unroll") for (int h_ = 0; h_ < 2; ++h_) \
        dst[h_] = S.rowkey((u), h_ * HALF + R_) | (S.rowkey((u), h_ * HALF + R_ + 64) << 16); } while (0)
#define PG8_RD8(off) (RD32 ? *(const LAS v8i*)(lds + (off)) : __builtin_shufflevector(*(const LAS v4i*)(lds + (off)), *(const LAS v4i*)(lds + (off) + 16), 0, 1, 2, 3, 4, 5, 6, 7))
#define PG8_LDA(dst, b, h) do { if constexpr (FP8) { _Pragma("unroll") for (int m = 0; m < 4; ++m) dst##8[m] = PG8_RD8(PG8_SA(b, h) + aoff + m * 2048); } \
        else { _Pragma("unroll") for (int m = 0; m < 4; ++m) _Pragma("unroll") for (int k = 0; k < 2; ++k) dst[m][k] = *(const LAS bf16x8*)(lds + PG8_SA(b, h) + aoff + m * 2048 + k * 1024); } } while (0)
#define PG8_LDB(dst, b, h) do { if constexpr (FP8) { _Pragma("unroll") for (int n = 0; n < 2; ++n) dst##8[n] = PG8_RD8(PG8_SB(b, h) + boff + n * 2048); } \
        else { _Pragma("unroll") for (int n = 0; n < 2; ++n) _Pragma("unroll") for (int k = 0; k < 2; ++k) dst[n][k] = *(const LAS bf16x8*)(lds + PG8_SB(b, h) + boff + n * 2048 + k * 1024); } } while (0)
#define PG8_MMA(ai, bj, At, Bt) do { __builtin_amdgcn_s_setprio(1); if constexpr (FP8) { _Pragma("unroll") for (int m = 0; m < 4; ++m) _Pragma("unroll") for (int n = 0; n < 2; ++n) \
        asm volatile("v_mfma_f32_16x16x128_f8f6f4 %0, %1, %2, %0" : "+v"(acc[ai][bj][m][n]) : "v"(Bt##8[n]), "v"(At##8[m])); } \
        else { _Pragma("unroll") for (int m = 0; m < 4; ++m) _Pragma("unroll") for (int n = 0; n < 2; ++n) _Pragma("unroll") for (int k = 0; k < 2; ++k) \
        acc[ai][bj][m][n] = __builtin_amdgcn_mfma_f32_16x16x32_bf16(Bt[n][k], At[m][k], acc[ai][bj][m][n], 0, 0, 0); } __builtin_amdgcn_s_setprio(0); } while (0)
#define PG8_WAIT_V(n) asm volatile("s_waitcnt vmcnt(" #n ")" ::: "memory")
#define PG8_WAIT_L(n) asm volatile("s_waitcnt lgkmcnt(" #n ")" ::: "memory")
#define PG8_BAR __builtin_amdgcn_s_barrier()
#define PG8_SCHED __builtin_amdgcn_sched_barrier(0)
    Unit cur, nxt; int ui = 0;
    if (!S.next(0, cur)) return;
    f32x4 acc[2][2][4][2];
#pragma unroll
    for (int a = 0; a < 2; ++a)
#pragma unroll
        for (int b = 0; b < 2; ++b)
#pragma unroll
            for (int m = 0; m < 4; ++m)
#pragma unroll
                for (int n = 0; n < 2; ++n) acc[a][b][m][n] = (f32x4){0.f, 0.f, 0.f, 0.f};
    bf16x8 At[4][2], B0[2][2], B1[2][2]; v8i At8[4], B08[2], B18[2];
    const char* cA = GATHER ? (const char*)g.A : (const char*)g.A + (size_t)cur.arow * rstep; const char* cB = (const char*)g.Bt + (size_t)cur.pn * tstep;
    if constexpr (GATHER) { PG8_GLOAD(gkey, cur); gu = cur; }
    PG8_STAGE_B(PG8_SB(0, 0), cB); PG8_STAGE_B(PG8_SB(0, 1), cB + hstep); PG8_STAGE_A(PG8_SA(0, 0), cA, 0, false); PG8_STAGE_A(PG8_SA(0, 1), cA, 1, false);
    if (wr == 1) PG8_BAR;
    PG8_WAIT_V(2); PG8_BAR;
    PG8_STAGE_B(PG8_SB(1, 0), cB + kstep); PG8_STAGE_A(PG8_SA(1, 0), cA + kstepA, 0, false); PG8_STAGE_B(PG8_SB(1, 1), cB + hstep + kstep);
    PG8_WAIT_V(6); PG8_BAR;
    for (;;) {
        const bool has_next = S.next(ui + 1, nxt);
        if constexpr (GATHER) { if (has_next) { unsigned gt_[2]; PG8_GLOAD(gt_, nxt); *gstash = (v2u){gt_[0], gt_[1]}; } }
        const char* nA = GATHER ? cA : (has_next ? (const char*)g.A + (size_t)nxt.arow * rstep : cA); const char* nB = has_next ? (const char*)g.Bt + (size_t)nxt.pn * tstep : cB;
        for (int t = 0; t < nt; t += 2) {
            const bool last = (t == nt - 2);
            const bool nx = last && has_next;
            if constexpr (Mid::ON) { if (t == nt / 2) { Unit mu; mu.arow = __builtin_amdgcn_readfirstlane(cur.arow); mu.pn = __builtin_amdgcn_readfirstlane(cur.pn); mu.valid = cur.valid; mu.aux = cur.aux;
                int fr_ = fr, fq_ = fq; asm volatile("" : "+s"(mu.arow), "+s"(mu.pn), "+v"(fr_), "+v"(fq_)); MH(acc, mu, wr, wc, fr_, fq_); } }
            const char* a1 = cA + (size_t)(t + 1) * kstepA;
            const char* a2 = last ? nA : cA + (size_t)(t + 2) * kstepA; const char* b2 = last ? nB : cB + (size_t)(t + 2) * kstep;
            const char* a3 = a2 + kstepA; const char* b3 = b2 + kstep;
            PG8_LDB(B0, 0, 0); PG8_LDB(B1, 0, 1); PG8_SCHED; PG8_LDA(At, 0, 0); PG8_STAGE_A(PG8_SA(1, 1), a1, 1, false);
            if constexpr (GATHER) { if (nx) { const v2u s_ = *gstash; gkey[0] = s_.x; gkey[1] = s_.y; gu = nxt; } }
            PG8_WAIT_V(8); PG8_WAIT_L(0); PG8_BAR; PG8_MMA(0, 0, At, B0); PG8_MMA(0, 1, At, B1); PG8_BAR; PG8_SCHED;
            PG8_LDA(At, 0, 1); PG8_STAGE_B(PG8_SB(0, 0), b2); PG8_STAGE_B(PG8_SB(0, 1), b2 + hstep); PG8_STAGE_A(PG8_SA(0, 0), a2, 0, nx);
            PG8_WAIT_V(8); PG8_WAIT_L(0); PG8_BAR; PG8_MMA(1, 0, At, B0); PG8_MMA(1, 1, At, B1); PG8_BAR; PG8_SCHED;
            PG8_LDB(B0, 1, 0); PG8_LDB(B1, 1, 1); PG8_SCHED; PG8_LDA(At, 1, 0); PG8_STAGE_A(PG8_SA(0, 1), a2, 1, nx);
            PG8_WAIT_V(8); PG8_WAIT_L(0); PG8_BAR; PG8_MMA(0, 0, At, B0); PG8_MMA(0, 1, At, B1); PG8_BAR; PG8_SCHED;
            PG8_LDA(At, 1, 1); PG8_STAGE_B(PG8_SB(1, 0), b3); PG8_STAGE_B(PG8_SB(1, 1), b3 + hstep); PG8_STAGE_A(PG8_SA(1, 0), a3, 0, nx);
            PG8_WAIT_V(8); PG8_WAIT_L(0); PG8_BAR; PG8_MMA(1, 0, At, B0); PG8_MMA(1, 1, At, B1); PG8_BAR; PG8_SCHED;
        }
        if constexpr (ALIGN_EPI) { if (wr == 0) PG8_BAR; }
        if constexpr (FP8) asm volatile("s_nop 15\n\ts_nop 7" ::: "memory");
        { Unit eu; eu.arow = __builtin_amdgcn_readfirstlane(cur.arow); eu.pn = __builtin_amdgcn_readfirstlane(cur.pn); eu.valid = __builtin_amdgcn_readfirstlane(cur.valid); eu.aux = __builtin_amdgcn_readfirstlane(cur.aux);
          asm volatile("" : "+s"(eu.arow), "+s"(eu.pn), "+s"(eu.valid), "+s"(eu.aux));
          int fr_ = fr, fq_ = fq; asm volatile("" : "+v"(fr_), "+v"(fq_));
          E(acc, eu, wr, wc, fr_, fq_); }
        if (!has_next) break;
#pragma unroll
        for (int a = 0; a < 2; ++a)
#pragma unroll
            for (int b = 0; b < 2; ++b)
#pragma unroll
                for (int m = 0; m < 4; ++m)
#pragma unroll
                    for (int n = 0; n < 2; ++n) acc[a][b][m][n] = (f32x4){0.f, 0.f, 0.f, 0.f};
        cur = nxt; cA = nA; cB = nB; ++ui;
        if constexpr (ALIGN_EPI) { if (wr == 1) PG8_BAR; }
    }
    PG8_WAIT_V(0);
    if constexpr (!ALIGN_EPI) { if (wr == 0) PG8_BAR; }
    PG8_BAR;
#undef PG8_SA
#undef PG8_SB
#undef PG8_STG
#undef PG8_STAGE_A
#undef PG8_STAGE_B
#undef PG8_GLOAD
#undef PG8_LDA
#undef PG8_RD8
#undef PG8_LDB
#undef PG8_MMA
#undef PG8_WAIT_V
#undef PG8_WAIT_L
#undef PG8_BAR
#undef PG8_SCHED
}
}

#define XB_TMO      128
#define XB_XCNT(j)  (256  + 64 * (j))
#define XB_XSUB(j)  (1280 + 64 * (j))
#define XB_XGEN(j)  (2304 + 64 * (j))
#define XB_TOP      3328
#define XB_TOPGEN   3392
#define XCD_BAR_WORDS 3456
#define XB_SPIN_CAP (1u << 22)

__device__ __forceinline__ unsigned xb_ld(unsigned* p)              { return __hip_atomic_load(p, __ATOMIC_RELAXED, __HIP_MEMORY_SCOPE_AGENT); }
__device__ __forceinline__ unsigned xb_add(unsigned* p, unsigned v) { return __hip_atomic_fetch_add(p, v, __ATOMIC_RELAXED, __HIP_MEMORY_SCOPE_AGENT); }
__device__ __forceinline__ unsigned xb_xcc_id() { return (unsigned)__builtin_amdgcn_s_getreg((3 << 11) | 20) & 0xFu; }
#define XB_SPIN(cond, bar) do { unsigned _sp = 0; while (cond) { __builtin_amdgcn_s_sleep(1); \
    if ((++_sp & 255u) == 0u) { if (xb_ld(&(bar)[XB_TMO])) break; if (_sp > XB_SPIN_CAP) { atomicAdd(&(bar)[XB_TMO], 1u); break; } } } } while (0)

struct XcdBarrier { unsigned* bar; unsigned x; volatile LAS unsigned* st; };

__device__ __forceinline__ XcdBarrier xcd_barrier_post(unsigned* bar, volatile LAS unsigned* st) {
    XcdBarrier b; b.bar = bar; b.x = xb_xcc_id(); b.st = st;
    if (threadIdx.x == 0) (void)xb_add(&bar[XB_XCNT(b.x)], 1u);
    return b;
}
__device__ __forceinline__ void xcd_barrier_complete(unsigned* bar, unsigned x, unsigned& nloc, unsigned& nx) {
    const unsigned G = gridDim.x * gridDim.y * gridDim.z;
    unsigned sum, cnt, mine, sp = 0u;
    for (;;) {
        sum = 0u; cnt = 0u; mine = 0u;
#pragma unroll
        for (unsigned j = 0; j < 16; ++j) { const unsigned c = xb_ld(&bar[XB_XCNT(j)]); sum += c; cnt += (c > 0u) ? 1u : 0u; mine = (j == x) ? c : mine; }
        if (sum == G) break;
        __builtin_amdgcn_s_sleep(1);
        if ((++sp & 255u) == 0u) { if (xb_ld(&bar[XB_TMO])) break; if (sp > XB_SPIN_CAP) { atomicAdd(&bar[XB_TMO], 1u); break; } }
    }
    nloc = mine > 0u ? mine : 1u; nx = cnt > 0u ? cnt : 1u;
}
__device__ __forceinline__ void xcd_barrier(const XcdBarrier& b) {
    asm volatile("s_waitcnt vmcnt(0)" ::: "memory");
    __syncthreads();
    if (threadIdx.x == 0) {
        unsigned* bar = b.bar;
        __builtin_amdgcn_s_waitcnt(0);
        unsigned nloc = b.st[0], nx = b.st[1];
        if (nloc == 0u) { xcd_barrier_complete(bar, b.x, nloc, nx); b.st[0] = nloc; b.st[1] = nx; }
        const unsigned old = xb_add(&bar[XB_XSUB(b.x)], 1u);
        const unsigned gen = old / nloc;
        if (old + 1u == (gen + 1u) * nloc) {
            __builtin_amdgcn_fence(__ATOMIC_RELEASE, "agent");
            asm volatile("s_waitcnt vmcnt(0)" ::: "memory");
            const unsigned og = xb_add(&bar[XB_TOP], 1u);
            const unsigned tg = og / nx;
            if (og + 1u == (tg + 1u) * nx) xb_add(&bar[XB_TOPGEN], 1u);
            else XB_SPIN(xb_ld(&bar[XB_TOPGEN]) == tg, bar);
            __builtin_amdgcn_fence(__ATOMIC_ACQUIRE, "agent");
            xb_add(&bar[XB_XGEN(b.x)], 1u);
            asm volatile("s_waitcnt vmcnt(0)" ::: "memory");
        } else {
            XB_SPIN(xb_ld(&bar[XB_XGEN(b.x)]) == gen, bar);
            __builtin_amdgcn_fence(__ATOMIC_ACQUIRE, "agent");
            asm volatile("s_waitcnt vmcnt(0)" ::: "memory");
        }
    }
    __syncthreads();
}

struct Frame {
    LAS unsigned char* lds;
    unsigned char* ws;
    const float* const* in;
    float* out;
    int tid, lane, wave, G, gw, ngw;
};
#define WSP(T, off) ((T*)(F.ws + (off)))
#define INP(k) (F.in[k])

template <class RowMap>
__device__ __forceinline__ void transpose_item(const float* W, int K, int N, bf16* WT, int ldt, LAS float* scr, int item, int lane, RowMap rm) {
    const int nblk = (N + 31) / 32, kb = item / nblk, nb = item % nblk, k0 = 64 * kb, n0 = 32 * nb;
    const int nn = n0 + (lane & 31);
#pragma unroll 8
    for (int i = 0; i < 32; ++i) { const int kk = 2 * i + (lane >> 5); scr[kk * 33 + (lane & 31)] = (nn < N) ? W[(size_t)(k0 + kk) * N + nn] : 0.f; }
    LDS_WAIT(); asm volatile("" ::: "memory");
    const int c = lane & 7;
#pragma unroll
    for (int j = 0; j < 4; ++j) { const int n = (lane >> 3) + 8 * j; const LAS float* s = scr + (8 * c) * 33 + n;
        v4u o; o.x = pk2(s[0 * 33], s[1 * 33]); o.y = pk2(s[2 * 33], s[3 * 33]); o.z = pk2(s[4 * 33], s[5 * 33]); o.w = pk2(s[6 * 33], s[7 * 33]);
        if (n0 + n < N) *(v4u*)(WT + (size_t)rm(n0 + n) * ldt + k0 + 8 * c) = o; }
    LDS_WAIT(); asm volatile("" ::: "memory");
}
template <class RowMap>
__device__ __forceinline__ void transpose_item8(const float* W, int K, int N, unsigned char* WT, int ldt, LAS float* scr, int item, int lane, RowMap rm) {
    const int nblk = (N + 31) / 32, kb = item / nblk, nb = item % nblk, k0 = 64 * kb, n0 = 32 * nb;
    const int nn = n0 + (lane & 31);
#pragma unroll 8
    for (int i = 0; i < 32; ++i) { const int kk = 2 * i + (lane >> 5); scr[kk * 33 + (lane & 31)] = (nn < N) ? W[(size_t)(k0 + kk) * N + nn] : 0.f; }
    LDS_WAIT(); asm volatile("" ::: "memory");
    const int c = lane & 3;
#pragma unroll
    for (int j = 0; j < 2; ++j) { const int n = (lane >> 2) + 16 * j; const LAS float* s = scr + (16 * c) * 33 + n; int w[4];
#pragma unroll
        for (int q = 0; q < 4; ++q) { int t = 0; t = __builtin_amdgcn_cvt_pk_fp8_f32(s[(4 * q) * 33] * 64.f, s[(4 * q + 1) * 33] * 64.f, t, false); t = __builtin_amdgcn_cvt_pk_fp8_f32(s[(4 * q + 2) * 33] * 64.f, s[(4 * q + 3) * 33] * 64.f, t, true); w[q] = t; }
        if (n0 + n < N) *(v4i*)(WT + (size_t)rm(n0 + n) * ldt + k0 + 16 * c) = (v4i){w[0], w[1], w[2], w[3]}; }
    LDS_WAIT(); asm volatile("" ::: "memory");
}
struct RmId { __device__ __forceinline__ int operator()(int n) const { return n; } };
struct RmWin { __device__ __forceinline__ int operator()(int n) const { return n < 2560 ? n : (n < 2608 ? PC_G3 + (n - 2560) : (n < 4656 ? n - 48 : (n < 4664 ? PC_IF + (n - 4656) : n - 56))); } };
struct RmGU { int up; __device__ __forceinline__ int operator()(int n) const { return 256 * (n >> 7) + (n & 127) + 128 * up; } };

__device__ __forceinline__ void mod_chunks(Frame& F, int first, int last, int stride) {
    const int tid_ = tid_opaque(), lane_ = tid_ & 63; (void)lane_;
    const float* c = INP(1); const float* w_ada = INP(2); const float* b_ada = INP(3);
    float* mod = WSP(float, WS_MOD);
    LAS float* sc = (LAS float*)F.lds; LAS float* red = (LAS float*)(F.lds + 65536);
    __syncthreads();
    { f32x4 cv[8];
#pragma unroll
      for (int j = 0; j < 8; ++j) cv[j] = *(const f32x4*)(c + 4 * tid_ + 2048 * j);
#pragma unroll
      for (int j = 0; j < 8; ++j) { f32x4 o; o.x = cv[j].x * sigm(cv[j].x); o.y = cv[j].y * sigm(cv[j].y); o.z = cv[j].z * sigm(cv[j].z); o.w = cv[j].w * sigm(cv[j].w); *(LAS f32x4*)(sc + 4 * tid_ + 2048 * j) = o; } }
    __syncthreads();
    for (int ci = first; ci < last; ci += stride) {
        const int cq = tid_ % 12, kg = tid_ / 12;
        if (tid_ < 504) {
            float acc[8][4];
#pragma unroll
            for (int b = 0; b < 8; ++b)
#pragma unroll
                for (int j = 0; j < 4; ++j) acc[b][j] = 0.f;
            const float* wp = w_ada + 48 * ci + 4 * cq;
            f32x4 wc[7], wn[7];
#pragma unroll
            for (int u = 0; u < 7; ++u) { wc[u] = __builtin_nontemporal_load((const f32x4*)(wp + (size_t)(kg + 42 * u) * 12288)); wn[u] = wc[u]; }
#pragma unroll 1
            for (int bi = 0; bi < 7; ++bi) {
                if (bi < 6) {
#pragma unroll
                    for (int u = 0; u < 7; ++u) { int k = kg + 42 * (7 * (bi + 1) + u); k = k < DM ? k : DM - 1; wn[u] = __builtin_nontemporal_load((const f32x4*)(wp + (size_t)k * 12288)); } }
#pragma unroll
                for (int u = 0; u < 7; ++u) { const int k = kg + 42 * (7 * bi + u); const bool ok = k < DM; const int kc = ok ? k : DM - 1;
#pragma unroll
                    for (int b = 0; b < 8; ++b) { const float s = ok ? sc[b * DM + kc] : 0.f;
#pragma unroll
                        for (int j = 0; j < 4; ++j) acc[b][j] += s * wc[u][j]; } }
#pragma unroll
                for (int u = 0; u < 7; ++u) wc[u] = wn[u];
            }
#pragma unroll
            for (int b = 0; b < 8; ++b)
#pragma unroll
                for (int j = 0; j < 4; ++j) red[(kg * 12 + cq) * 32 + b * 4 + j] = acc[b][j];
        }
        __syncthreads();
        if (tid_ < 384) { const int b = tid_ / 48, col = tid_ % 48, q = col >> 2, j = col & 3; float s = 0.f;
            for (int k2 = 0; k2 < 42; ++k2) s += red[(k2 * 12 + q) * 32 + b * 4 + j];
            mod[b * 12288 + 48 * ci + col] = s + b_ada[48 * ci + col]; }
        __syncthreads();
    }
}
struct TDesc { const float* W; int K, N; unsigned char* WT; int ldt; int kind; int item; int nblk, nb0; };
__device__ __forceinline__ TDesc p0_decode(Frame& F, int it) {
    constexpr int I_WIN = 32 * 146, I_WIN8 = 32 * 274, I_UP = 16 * 64, I_OUT = 32 * 64, I_SH = 32 * 16, I_SHD = 8 * 64, I_R = 32 * 2, I_EG = 64 * 512, I_C1 = 32 * 8;
    unsigned char* WeGU = WSP(unsigned char, WS_WEGU); unsigned char* WeD = WSP(unsigned char, WS_WED);
    int r = it;
    if (r < I_WIN) return TDesc{INP(6), DM, D_IN, WSP(unsigned char, WS_WIN), DM * 2, 1, r, 146, 0}; r -= I_WIN;
    if (r < I_WIN8) return TDesc{INP(6), DM, D_IN, WSP(unsigned char, WS_WIN8), DM, 5, r, 274, 32}; r -= I_WIN8;
    if (r < I_UP) return TDesc{INP(14), 1024, DM, WSP(unsigned char, WS_WUP), 2048 * 2, 0, r, (DM + 31) / 32, 0}; r -= I_UP;
    if (r < I_UP) return TDesc{INP(15), 1024, DM, WSP(unsigned char, WS_WUP) + 1024 * 2, 2048 * 2, 0, r, (DM + 31) / 32, 0}; r -= I_UP;
    if (r < I_OUT) return TDesc{INP(16), DM, DM, WSP(unsigned char, WS_WOUT), DM * 2, 0, r, (DM + 31) / 32, 0}; r -= I_OUT;
    if (r < I_SH) return TDesc{INP(24), DM, EFF, WeGU + (size_t)64 * 1024 * DM, DM, 3, r, (EFF + 31) / 32, 0}; r -= I_SH;
    if (r < I_SH) return TDesc{INP(25), DM, EFF, WeGU + (size_t)64 * 1024 * DM, DM, 4, r, (EFF + 31) / 32, 0}; r -= I_SH;
    if (r < I_SHD) return TDesc{INP(26), EFF, DM, WeD + (size_t)64 * DM * EFF, EFF, 2, r, (DM + 31) / 32, 0}; r -= I_SHD;
    if (r < I_R) return TDesc{INP(19), DM, NEXP, WSP(unsigned char, WS_WR), DM * 2, 0, r, (NEXP + 31) / 32, 0}; r -= I_R;
    if (r < 16) { const int kv = r >> 3; return TDesc{INP(9) + (size_t)kv * 256 * 64, 256, 64, WSP(unsigned char, WS_CW2) + (size_t)kv * 64 * 256 * 2, 256 * 2, 0, r & 7, 2, 0}; } r -= 16;
    if (r < 2 * I_C1) { const int kv = r >> 8; return TDesc{INP(8) + (size_t)kv * DM * 256, DM, 256, WSP(unsigned char, WS_CW1) + (size_t)kv * 256 * DM * 2, DM * 2, 0, r & 255, (256 + 31) / 32, 0}; } r -= 2 * I_C1;
    if (r < I_EG) { const int e = r >> 9; return TDesc{INP(21) + (size_t)e * DM * EFF, DM, EFF, WeGU + (size_t)e * 1024 * DM, DM, 3, r & 511, (EFF + 31) / 32, 0}; } r -= I_EG;
    if (r < I_EG) { const int e = r >> 9; return TDesc{INP(22) + (size_t)e * DM * EFF, DM, EFF, WeGU + (size_t)e * 1024 * DM, DM, 4, r & 511, (EFF + 31) / 32, 0}; } r -= I_EG;
    { const int e = r >> 9; return TDesc{INP(23) + (size_t)e * EFF * DM, EFF, DM, WeD + (size_t)e * DM * EFF, EFF, 2, r & 511, (DM + 31) / 32, 0}; }
}
__device__ __forceinline__ void t_load(const TDesc& d, int lane, float (&v)[32]) {
    const int nblk = d.nblk, kb = d.item / nblk, nb = d.nb0 + d.item % nblk; int nn = 32 * nb + (lane & 31); nn = nn < d.N ? nn : d.N - 1;
    const float* p = d.W + (size_t)(64 * kb + (lane >> 5)) * d.N + nn;
#pragma unroll
    for (int i = 0; i < 32; ++i) v[i] = __builtin_nontemporal_load(p + (size_t)(2 * i) * d.N);
}
__device__ __forceinline__ int t_rowmap(int kind, int n) {
    if (kind == 1 || kind == 5) { if (n < 1024) return n;
        if (n < 2560) { const int i = (n - 1024) >> 8, c = (n - 1024) & 255; return ((i & 1) ? PC_VC : PC_KC) + (i >> 1) * 256 + c; }
        if (n < 2608) return PC_G3 + (n - 2560); if (n < 3632) return PC_QKM + (n - 2608); if (n < 4656) return PC_VM + (n - 3632); if (n < 4664) return PC_IF + (n - 4656); return n + 200; }
    if (kind == 3 || kind == 4) return 256 * (n >> 7) + (n & 127) + 128 * (kind - 3);
    return n;
}
__device__ __forceinline__ void t_finish(const TDesc& d, int lane, LAS float* scr, const float (&v)[32]) {
    const int nblk = d.nblk, kb = d.item / nblk, nb = d.nb0 + d.item % nblk, k0 = 64 * kb, n0 = 32 * nb;
#pragma unroll
    for (int i = 0; i < 32; ++i) scr[(2 * i + (lane >> 5)) * 33 + (lane & 31)] = v[i];
    LDS_WAIT(); asm volatile("" ::: "memory");
    if (d.kind >= 2) {
        const int c = lane & 3;
#pragma unroll
        for (int j = 0; j < 2; ++j) { const int n = (lane >> 2) + 16 * j; const LAS float* s = scr + (16 * c) * 33 + n; int w[4];
#pragma unroll
            for (int q = 0; q < 4; ++q) { int t = 0; t = __builtin_amdgcn_cvt_pk_fp8_f32(s[(4 * q) * 33] * 64.f, s[(4 * q + 1) * 33] * 64.f, t, false); t = __builtin_amdgcn_cvt_pk_fp8_f32(s[(4 * q + 2) * 33] * 64.f, s[(4 * q + 3) * 33] * 64.f, t, true); w[q] = t; }
            int dr = t_rowmap(d.kind, n0 + n); bool ok = n0 + n < d.N; if (d.kind == 5) { ok = ok && dr >= PN_BF; dr -= PN_BF; }
            if (ok) *(v4i*)(d.WT + (size_t)dr * d.ldt + k0 + 16 * c) = (v4i){w[0], w[1], w[2], w[3]}; }
    } else {
        const int c = lane & 7;
#pragma unroll
        for (int j = 0; j < 4; ++j) { const int n = (lane >> 3) + 8 * j; const LAS float* s = scr + (8 * c) * 33 + n;
            v4u o; o.x = pk2(s[0 * 33], s[1 * 33]); o.y = pk2(s[2 * 33], s[3 * 33]); o.z = pk2(s[4 * 33], s[5 * 33]); o.w = pk2(s[6 * 33], s[7 * 33]);
            const int dr = t_rowmap(d.kind, n0 + n); const bool ok = (n0 + n < d.N) && (d.kind != 1 || dr < PN_BF);
            if (ok) *(v4u*)(d.WT + (size_t)dr * d.ldt + (size_t)(k0 + 8 * c) * 2) = o; }
    }
    LDS_WAIT(); asm volatile("" ::: "memory");
}
constexpr int NIT_ALL = 16 + 32 * 146 + 32 * 274 + 2 * 16 * 64 + 32 * 64 + 2 * 32 * 16 + 8 * 64 + 32 * 2 + 2 * 32 * 8 + 3 * 64 * 512;
constexpr int NIT_LATE = 3 * 64 * 512, NIT_EARLY = NIT_ALL - NIT_LATE;
__device__ __forceinline__ void convert_range(Frame& F, int lo, int hi, int w, int nw) {
    const int tid_ = tid_opaque(), lane_ = tid_ & 63;
    LAS float* scr = (LAS float*)(F.lds + F.wave * 16384);
    int it = lo + w; if (it >= hi) return;
    TDesc d = p0_decode(F, it); float v[32]; t_load(d, lane_, v);
    for (;;) {
        const int itn = it + nw; const bool hn = itn < hi;
        TDesc dn = d; float vn[32];
        if (hn) { dn = p0_decode(F, itn); t_load(dn, lane_, vn); }
        t_finish(d, lane_, scr, v);
        if (!hn) break;
        d = dn; it = itn;
#pragma unroll
        for (int i = 0; i < 32; ++i) v[i] = vn[i];
    }
}
constexpr int MOD_EARLY = 86;
__device__ __forceinline__ void p0_early(Frame& F) {
    const int bx = (int)blockIdx.x;
    if (F.G <= MOD_EARLY + 8) { mod_chunks(F, bx, MOD_EARLY, F.G); convert_range(F, 0, NIT_EARLY, F.gw, F.ngw); return; }
    constexpr int SPLIT = (NIT_EARLY * 7) / 8;
    if (bx < MOD_EARLY) { mod_chunks(F, bx, MOD_EARLY, MOD_EARLY); convert_range(F, SPLIT, NIT_EARLY, bx * 8 + F.wave, MOD_EARLY * 8); }
    else convert_range(F, 0, SPLIT, (bx - MOD_EARLY) * 8 + F.wave, (F.G - MOD_EARLY) * 8);
}
constexpr int NCHUNK = 8;
__device__ __forceinline__ void convert_chunk(Frame& F, int& chunk) {
    if (chunk >= NCHUNK) return;
    const int per = (NIT_LATE + F.G - 1) / F.G, pc = (per + NCHUNK - 1) / NCHUNK;
    int lo = NIT_EARLY + (int)blockIdx.x * per + chunk * pc, hi = lo + pc; const int end = NIT_EARLY + ((int)blockIdx.x + 1) * per;
    hi = hi < end ? hi : end; hi = hi < NIT_ALL ? hi : NIT_ALL;
    __syncthreads();
    if (chunk == 0) { const int nl = 256 - MOD_EARLY; const int per_wg = (nl + F.G - 1) / F.G;
        mod_chunks(F, MOD_EARLY + (int)blockIdx.x * per_wg, (MOD_EARLY + ((int)blockIdx.x + 1) * per_wg) < 256 ? (MOD_EARLY + ((int)blockIdx.x + 1) * per_wg) : 256, 1); }
    convert_range(F, lo, hi, F.wave, 8);
    __syncthreads();
    ++chunk;
}
__device__ __forceinline__ void p0_bias1(Frame& F) {
    const int tid_ = tid_opaque(), lane_ = tid_ & 63;
    for (int o = F.gw; o < 512; o += F.ngw) { const int kv = o >> 8, j = o & 255; const float* pe = INP(7) + kv * 2048; const float* w1 = INP(8) + (size_t)kv * 2048 * 256 + j;
        float s = 0.f;
#pragma unroll 8
        for (int k = lane_; k < 2048; k += 64) s += pe[k] * w1[(size_t)k * 256];
        s = wave_sum(s); if (lane_ == 0) WSP(float, WS_BIAS1)[o] = s; }
}
__device__ __forceinline__ void p1_h1(Frame& F) {
    const int tid_ = tid_opaque(), lane_ = tid_ & 63; (void)lane_;
    const float* x = INP(0); const float* gpm = INP(4); const float* mod = WSP(float, WS_MOD); bf16* H1 = WSP(bf16, WS_H1); unsigned char* H1Q = WSP(unsigned char, WS_H1Q);
    for (int row = F.gw; row < NTOK; row += F.ngw) {
        const int b = row >> 11; const f32x4* xr = (const f32x4*)(x + (size_t)row * DM) + lane_;
        f32x4 v[8]; float s = 0.f;
#pragma unroll
        for (int j = 0; j < 8; ++j) { v[j] = xr[64 * j]; s += (v[j].x * v[j].x + v[j].y * v[j].y) + (v[j].z * v[j].z + v[j].w * v[j].w); }
        const float rstd = rsqrtf(wave_sum(s) * (1.f / DM) + EPS);
        const float* sh = mod + b * 12288; const float* scl = sh + 2048;
        int* o4 = (int*)(H1Q + (size_t)row * DM) + lane_; unsigned long long* o8 = (unsigned long long*)(H1 + (size_t)row * DM) + lane_;
#pragma unroll
        for (int j = 0; j < 8; ++j) { const int col = 4 * lane_ + 256 * j; const f32x4 g = *(const f32x4*)(gpm + col), a = *(const f32x4*)(scl + col), c = *(const f32x4*)(sh + col);
            const float r0 = v[j].x * rstd * g.x * (1.f + a.x) + c.x, r1 = v[j].y * rstd * g.y * (1.f + a.y) + c.y, r2 = v[j].z * rstd * g.z * (1.f + a.z) + c.z, r3 = v[j].w * rstd * g.w * (1.f + a.w) + c.w;
            int q8 = 0; q8 = __builtin_amdgcn_cvt_pk_fp8_f32(fminf(fmaxf(r0, -448.f), 448.f), fminf(fmaxf(r1, -448.f), 448.f), q8, false); q8 = __builtin_amdgcn_cvt_pk_fp8_f32(fminf(fmaxf(r2, -448.f), 448.f), fminf(fmaxf(r3, -448.f), 448.f), q8, true);
            o4[64 * j] = q8; o8[64 * j] = (unsigned long long)pk2(r0, r1) | ((unsigned long long)pk2(r2, r3) << 32); }
    }
}
__device__ __forceinline__ float gelu_tanh(float x) { const float u = 0.7978845608028654f * (x + 0.044715f * x * x * x); const float t = 1.f - 2.f / (1.f + __expf(2.f * u)); return 0.5f * x * (1.f + t); }
__device__ __forceinline__ void p3_conv(Frame& F) {
    const int tid_ = tid_opaque(), lane_ = tid_ & 63; (void)lane_;
    const bf16* PROJ = WSP(bf16, WS_PROJ); bf16* QKC = WSP(bf16, WS_QKC); const float* cw = INP(10); const float* cb = INP(11);
    const int skip = 0;
    if ((int)blockIdx.x < skip) return;
    const int gt = ((int)blockIdx.x - skip) * 512 + tid_, ngt = (F.G - skip) * 512;
    for (int idx = gt; idx < NTOK * 128; idx += ngt) {
        const int row = idx >> 7, c8 = (idx & 127) * 8, t = row & 2047;
        float acc[8];
#pragma unroll
        for (int k = 0; k < 8; ++k) acc[k] = cb[c8 + k];
#pragma unroll
        for (int i = 0; i < 4; ++i) { const int tt = t - 3 + i; if (tt >= 0) { const v4u q = *(const v4u*)(PROJ + (size_t)(row - 3 + i) * PLD + PC_QKM + c8); const float* w = cw + i * 1024 + c8;
            acc[0] += bflo(q.x) * w[0]; acc[1] += bfhi(q.x) * w[1]; acc[2] += bflo(q.y) * w[2]; acc[3] += bfhi(q.y) * w[3]; acc[4] += bflo(q.z) * w[4]; acc[5] += bfhi(q.z) * w[5]; acc[6] += bflo(q.w) * w[6]; acc[7] += bfhi(q.w) * w[7]; } }
        const float sc = (c8 >= 512) ? 0.08838834764831845f : 1.f;
#pragma unroll
        for (int k = 0; k < 8; ++k) acc[k] = acc[k] * sigm(acc[k]) * sc;
        v4u o; o.x = pk2(acc[0], acc[1]); o.y = pk2(acc[2], acc[3]); o.z = pk2(acc[4], acc[5]); o.w = pk2(acc[6], acc[7]);
        *(v4u*)(QKC + (size_t)row * 1024 + c8) = o;
    }
}
__device__ __forceinline__ void p3_gates(Frame& F) {
    const int tid_ = tid_opaque(), lane_ = tid_ & 63;
    const bf16* PROJ = WSP(bf16, WS_PROJ); const float* bg = INP(12); float* GA = WSP(float, WS_GA); float* GU = WSP(float, WS_GU); float* GM = WSP(float, WS_GM);
    LAS float* ex = (LAS float*)F.lds;
    for (int bh = (int)blockIdx.x; bh < 32; bh += F.G) {
        const int b = bh >> 2, h = bh & 3; float carryA = 0.f, cmax = -INFINITY; float Al[4], ul[4], Ml[4];
#pragma unroll
        for (int k = 0; k < 4; ++k) {
            const int t = F.wave * 256 + k * 64 + lane_; const bf16* pr = PROJ + (size_t)(b * SEQ + t) * PLD + PC_IF;
            const float ip = bf2f(pr[h]) + bg[h], fp = bf2f(pr[4 + h]) + bg[4 + h];
            const float lf = fminf(fp, 0.f) - log1pf(__expf(-fabsf(fp)));
            float A = lf;
#pragma unroll
            for (int o = 1; o < 64; o <<= 1) { const float n = __shfl_up(A, o); if (lane_ >= o) A += n; }
            A += carryA;
            const float u = ip - A; float M = u;
#pragma unroll
            for (int o = 1; o < 64; o <<= 1) { const float n = __shfl_up(M, o); if (lane_ >= o) M = fmaxf(M, n); }
            M = fmaxf(M, cmax);
            Al[k] = A; ul[k] = u; Ml[k] = M;
            carryA = rdlane(A, 63); cmax = rdlane(M, 63);
        }
        __syncthreads();
        if (lane_ == 0) { ex[2 * F.wave] = carryA; ex[2 * F.wave + 1] = cmax; }
        __syncthreads();
        float CA = 0.f, CM = 0.f;
        for (int w = 0; w < F.wave; ++w) { CM = fmaxf(CM, ex[2 * w + 1] - CA); CA += ex[2 * w]; }
#pragma unroll
        for (int k = 0; k < 4; ++k) { const int t = F.wave * 256 + k * 64 + lane_;
            GA[bh * SEQ + t] = (Al[k] + CA) * 1.4426950408889634f; GU[bh * SEQ + t] = (ul[k] - CA) * 1.4426950408889634f; GM[bh * SEQ + t] = fmaxf(Ml[k] - CA, CM) * 1.4426950408889634f; }
    }
    __syncthreads();
}
__device__ __forceinline__ void p4_kcv(Frame& F) {
    const int tid_ = tid_opaque(), lane_ = tid_ & 63; (void)lane_;
    const bf16* HIDC = WSP(bf16, WS_HIDC); bf16* KCB = WSP(bf16, WS_KCV); const float* w2 = INP(9);
    const int gt = blockIdx.x * 512 + tid_, ngt = F.G * 512;
    for (int idx = gt; idx < 8128 * 64; idx += ngt) {
        const int r = idx >> 6, d = idx & 63, kv = r / 4064, rr = r % 4064, b = rr / 508, n = (rr % 508) >> 2, g = rr & 3;
        const bf16* hrow = HIDC + ((size_t)kv * 4096 + rr) * 256; const float* w = w2 + kv * 256 * 64 + d; float s = 0.f;
#pragma unroll 8
        for (int j = 0; j < 256; ++j) s += bf2f(hrow[j]) * w[j * 64];
        KCB[((size_t)((kv * 8 + b) * 4 + g) * 128 + n) * 64 + d] = (bf16)f2bf(s);
    }
    for (int idx = gt; idx < 64 * 64; idx += ngt) { const int q = idx >> 6, d = idx & 63; KCB[((size_t)q * 128 + 127) * 64 + d] = 0; }
}
__device__ __forceinline__ void kcv_unit(Frame& F, int kv, int pm) {
    const int tid_ = tid_opaque(), lane_ = tid_ & 63, fr = lane_ & 15, fq = lane_ >> 4;
    const bf16* HIDC = WSP(bf16, WS_HIDC) + ((size_t)kv * 4096 + pm * 256) * 256; const bf16* w2t = WSP(bf16, WS_CW2) + (size_t)kv * 64 * 256; bf16* KCB = WSP(bf16, WS_KCV);
    asm volatile("s_waitcnt vmcnt(0)" ::: "memory"); __syncthreads();
#pragma unroll
    for (int rb = 0; rb < 2; ++rb) {
        const int r0 = F.wave * 32 + rb * 16;
        f32x4 acc[4];
#pragma unroll
        for (int db = 0; db < 4; ++db) acc[db] = (f32x4){0.f, 0.f, 0.f, 0.f};
#pragma unroll
        for (int ks = 0; ks < 8; ++ks) { const bf16x8 a = *(const bf16x8*)(HIDC + (size_t)(r0 + fr) * 256 + ks * 32 + fq * 8);
#pragma unroll
            for (int db = 0; db < 4; ++db) { const bf16x8 bb = *(const bf16x8*)(w2t + (size_t)(db * 16 + fr) * 256 + ks * 32 + fq * 8); acc[db] = __builtin_amdgcn_mfma_f32_16x16x32_bf16(a, bb, acc[db], 0, 0, 0); } }
#pragma unroll
        for (int reg = 0; reg < 4; ++reg) { const int rr = pm * 256 + r0 + 4 * fq + reg; if (rr < 4064) { const int b = rr / 508, n = (rr % 508) >> 2, g = rr & 3;
#pragma unroll
            for (int db = 0; db < 4; ++db) KCB[((size_t)((kv * 8 + b) * 4 + g) * 128 + n) * 64 + db * 16 + fr] = (bf16)f2bf(acc[db][reg]); } }
    }
    if (blockIdx.x == 0) for (int idx = tid_; idx < 64 * 64; idx += 512) { const int q = idx >> 6, d = idx & 63; KCB[((size_t)q * 128 + 127) * 64 + d] = 0; }
}
namespace fa {
typedef float f32x16 __attribute__((ext_vector_type(16)));
typedef short s16x4 __attribute__((ext_vector_type(4)));
typedef float f32x2_t __attribute__((ext_vector_type(2))); typedef __bf16 bf16x2_t __attribute__((ext_vector_type(2)));
constexpr int SLOTB = 8192, NSLOTS = 3, NKS = 4;
constexpr int LDS_K = 0, LDS_V = NKS * SLOTB, LDS_WS = LDS_V + NSLOTS * SLOTB, LDS_OST = LDS_WS + 8 * 1024, LDS_AUX = LDS_OST + 8 * 8192;
static_assert(LDS_AUX <= RING_BYTES, "attention lds");
__device__ __forceinline__ int crow(int r, int hi) { return (r & 3) + 8 * (r >> 2) + 4 * hi; }
__device__ __forceinline__ constexpr int crow0(int r) { return (r & 3) + 8 * (r >> 2); }
#define FA_SBAR() __builtin_amdgcn_sched_barrier(0)
__device__ __forceinline__ void glds16(const void* gsrc, unsigned lds_dst) { unsigned keep;
    asm volatile("s_mov_b32 %0, m0\n\ts_mov_b32 m0, %2\n\ts_nop 0\n\tglobal_load_lds_dwordx4 %1, off\n\ts_mov_b32 m0, %0" : "=&s"(keep) : "v"(gsrc), "s"(lds_dst) : "memory"); }
__device__ __forceinline__ unsigned cvtpk_s(float lo, float hi) { f32x2_t v = {lo, hi}; bf16x2_t b = __builtin_convertvector(v, bf16x2_t); return __builtin_bit_cast(unsigned, b); }
#define FA_WAIT_BAR(N) asm volatile("s_waitcnt vmcnt(" #N ") lgkmcnt(0)\n\ts_barrier" ::: "memory")
__device__ __forceinline__ void qkt(f32x16& p0, f32x16& p1, const LAS char* kb, const bf16x8* qr, const f32x16& c0) {
#pragma unroll
    for (int d0 = 0; d0 < 4; ++d0) {
        const bf16x8 b0 = *(const LAS bf16x8*)(kb + d0 * 2048);
        const bf16x8 b1 = *(const LAS bf16x8*)(kb + d0 * 2048 + 512);
        if (d0 == 0) { p0 = __builtin_amdgcn_mfma_f32_32x32x16_bf16(b0, qr[0], c0, 0, 0, 0); p1 = __builtin_amdgcn_mfma_f32_32x32x16_bf16(b1, qr[0], c0, 0, 0, 0); }
        else { p0 = __builtin_amdgcn_mfma_f32_32x32x16_bf16(b0, qr[d0], p0, 0, 0, 0); p1 = __builtin_amdgcn_mfma_f32_32x32x16_bf16(b1, qr[d0], p1, 0, 0, 0); }
        __builtin_amdgcn_sched_barrier(0xF); }
}
__device__ __forceinline__ float rowmax(const f32x16& p0, const f32x16& p1) {
    float a = fmaxf(fmaxf(p0[0], p0[1]), p1[0]), b = fmaxf(fmaxf(p0[2], p0[3]), p1[1]); a = fmaxf(fmaxf(a, p1[2]), p1[3]);
#pragma unroll
    for (int r = 4; r < 16; r += 4) { a = fmaxf(fmaxf(a, p0[r]), p0[r + 1]); b = fmaxf(fmaxf(b, p0[r + 2]), p0[r + 3]); a = fmaxf(fmaxf(a, p1[r]), p1[r + 1]); b = fmaxf(fmaxf(b, p1[r + 2]), p1[r + 3]); }
    const float m = fmaxf(a, b);
    auto rr = __builtin_amdgcn_permlane32_swap(__float_as_uint(m), __float_as_uint(m), false, false);
    return fmaxf(__uint_as_float(rr[0]), __uint_as_float(rr[1]));
}
__device__ __forceinline__ float swap_add(float v) { auto rr = __builtin_amdgcn_permlane32_swap(__float_as_uint(v), __float_as_uint(v), false, false); return __uint_as_float(rr[0]) + __uint_as_float(rr[1]); }
__device__ __forceinline__ void pv(f32x16* o, int vb, bf16x8 pa0, bf16x8 pa1, bf16x8 pa2, bf16x8 pa3) {
#pragma unroll
    for (int d0 = 0; d0 < 2; ++d0) { s16x4 lo[4], hi[4];
#pragma unroll
        for (int ks = 0; ks < 4; ++ks) {
            asm volatile("ds_read_b64_tr_b16 %0,%1 offset:%c2" : "=&v"(lo[ks]) : "v"(vb), "i"(d0 * 4096 + ks * 1024) : "memory");
            asm volatile("ds_read_b64_tr_b16 %0,%1 offset:%c2" : "=&v"(hi[ks]) : "v"(vb), "i"(d0 * 4096 + ks * 1024 + 512) : "memory"); }
        asm volatile("s_waitcnt lgkmcnt(0)" ::: "memory"); FA_SBAR();
#define FA_PK(k) (bf16x8){lo[k][0], lo[k][1], lo[k][2], lo[k][3], hi[k][0], hi[k][1], hi[k][2], hi[k][3]}
        o[d0] = __builtin_amdgcn_mfma_f32_32x32x16_bf16(pa0, FA_PK(0), o[d0], 0, 0, 0);
        o[d0] = __builtin_amdgcn_mfma_f32_32x32x16_bf16(pa1, FA_PK(1), o[d0], 0, 0, 0);
        o[d0] = __builtin_amdgcn_mfma_f32_32x32x16_bf16(pa2, FA_PK(2), o[d0], 0, 0, 0);
        o[d0] = __builtin_amdgcn_mfma_f32_32x32x16_bf16(pa3, FA_PK(3), o[d0], 0, 0, 0);
#undef FA_PK
    }
}
typedef short v4i16_t __attribute__((ext_vector_type(4)));
__device__ __forceinline__ s16x4 vtr(const LAS char* p) { return __builtin_bit_cast(s16x4, __builtin_amdgcn_ds_read_tr16_b64_v4i16((LAS v4i16_t*)p)); }
__device__ __forceinline__ void pv2(f32x16* o, const LAS char* vp, bf16x8 pa0, bf16x8 pa1, bf16x8 pa2, bf16x8 pa3) {
#pragma unroll
    for (int d0 = 0; d0 < 2; ++d0) {
        s16x4 lo[4], hi[4];
#pragma unroll
        for (int ks = 0; ks < 4; ++ks) { lo[ks] = vtr(vp + d0 * 4096 + ks * 1024); hi[ks] = vtr(vp + d0 * 4096 + ks * 1024 + 512); }
#define FA_PK(k) (bf16x8){lo[k][0], lo[k][1], lo[k][2], lo[k][3], hi[k][0], hi[k][1], hi[k][2], hi[k][3]}
        o[d0] = __builtin_amdgcn_mfma_f32_32x32x16_bf16(pa0, FA_PK(0), o[d0], 0, 0, 0);
        o[d0] = __builtin_amdgcn_mfma_f32_32x32x16_bf16(pa1, FA_PK(1), o[d0], 0, 0, 0);
        o[d0] = __builtin_amdgcn_mfma_f32_32x32x16_bf16(pa2, FA_PK(2), o[d0], 0, 0, 0);
        o[d0] = __builtin_amdgcn_mfma_f32_32x32x16_bf16(pa3, FA_PK(3), o[d0], 0, 0, 0);
#undef FA_PK
        __builtin_amdgcn_sched_barrier(0xF);
    }
}
struct Soft { float mhat, l; f32x16 o[2]; f32x16 negm; };
__device__ __forceinline__ void qk_half(f32x16& p, const LAS char* kbh, const bf16x8* qr) {
    const f32x16 zero = f32x16{};
#pragma unroll
    for (int d0 = 0; d0 < 4; ++d0) { const bf16x8 b = *(const LAS bf16x8*)(kbh + d0 * 2048); p = __builtin_amdgcn_mfma_f32_32x32x16_bf16(b, qr[d0], d0 == 0 ? zero : p, 0, 0, 0); }
}
__device__ __forceinline__ float rowmax16(const f32x16& p) {
    float a = fmaxf(fmaxf(p[0], p[1]), p[2]), b = fmaxf(fmaxf(p[3], p[4]), p[5]);
    a = fmaxf(fmaxf(a, p[6]), p[7]); b = fmaxf(fmaxf(b, p[8]), p[9]); a = fmaxf(fmaxf(a, p[10]), p[11]); b = fmaxf(fmaxf(b, p[12]), p[13]); a = fmaxf(fmaxf(a, p[14]), p[15]);
    const float m = fmaxf(a, b);
    auto rr = __builtin_amdgcn_permlane32_swap(__float_as_uint(m), __float_as_uint(m), false, false);
    return fmaxf(__uint_as_float(rr[0]), __uint_as_float(rr[1]));
}
__device__ __forceinline__ void soft_half(Soft& s, f32x16& p, const LAS char* vph, LAS float* wsf, int r32, int hi) {
    const float rm = rowmax16(p) - s.mhat;
    if (__any(rm > 8.f)) {
        const float dl = fmaxf(rm, 0.f); s.mhat += dl;
        const float f = __builtin_amdgcn_exp2f(-dl); s.l *= f; if (hi == 0) wsf[r32] = f;
        LDS_WAIT(); asm volatile("" ::: "memory");
        const LAS float* wh = wsf + 4 * hi;
#pragma unroll
        for (int d = 0; d < 2; ++d)
#pragma unroll
            for (int r = 0; r < 16; ++r) s.o[d][r] *= wh[crow0(r)];
        LDS_WAIT(); asm volatile("" ::: "memory");
    }
    float sa = 0.f; const float mh = s.mhat;
#pragma unroll
    for (int r = 0; r < 16; ++r) { p[r] = __builtin_amdgcn_exp2f(p[r] - mh); sa += p[r]; }
    s.l += sa;
    const v4u pw0 = (v4u){cvtpk_s(p[0], p[1]), cvtpk_s(p[2], p[3]), cvtpk_s(p[4], p[5]), cvtpk_s(p[6], p[7])};
    const v4u pw1 = (v4u){cvtpk_s(p[8], p[9]), cvtpk_s(p[10], p[11]), cvtpk_s(p[12], p[13]), cvtpk_s(p[14], p[15])};
#pragma unroll
    for (int d0 = 0; d0 < 2; ++d0) {
        const s16x4 l0 = vtr(vph + d0 * 4096), h0 = vtr(vph + d0 * 4096 + 512), l1 = vtr(vph + d0 * 4096 + 1024), h1 = vtr(vph + d0 * 4096 + 1536);
        s.o[d0] = __builtin_amdgcn_mfma_f32_32x32x16_bf16(__builtin_bit_cast(bf16x8, pw0), (bf16x8){l0[0], l0[1], l0[2], l0[3], h0[0], h0[1], h0[2], h0[3]}, s.o[d0], 0, 0, 0);
        s.o[d0] = __builtin_amdgcn_mfma_f32_32x32x16_bf16(__builtin_bit_cast(bf16x8, pw1), (bf16x8){l1[0], l1[1], l1[2], l1[3], h1[0], h1[1], h1[2], h1[3]}, s.o[d0], 0, 0, 0);
    }
}
struct P8 { f32x2 v[8]; };
__device__ __forceinline__ void qk_half_c(f32x16& p, const LAS char* kbh, const bf16x8* qr, const f32x16& negm) {
#pragma unroll
    for (int d0 = 0; d0 < 4; ++d0) { const bf16x8 b = *(const LAS bf16x8*)(kbh + d0 * 2048); p = __builtin_amdgcn_mfma_f32_32x32x16_bf16(b, qr[d0], d0 == 0 ? negm : p, 0, 0, 0); }
}
__device__ __forceinline__ void soft_half_c(Soft& s, f32x16& pin, f32x16& nx, const LAS char* vph, LAS float* wsf, int r32, int hi) {
    P8 p = __builtin_bit_cast(P8, pin);
    const float rm = rowmax16(pin);
    if (__any(rm > 8.f)) {
        const float dl = fmaxf(rm, 0.f); s.mhat += dl; const f32x2 d2 = {dl, dl};
        P8 n = __builtin_bit_cast(P8, nx);
#pragma unroll
        for (int i = 0; i < 8; ++i) { p.v[i] = p.v[i] - d2; n.v[i] = n.v[i] - d2; }
        nx = __builtin_bit_cast(f32x16, n);
#pragma unroll
        for (int r = 0; r < 16; ++r) s.negm[r] = -s.mhat;
        const float f = __builtin_amdgcn_exp2f(-dl); s.l *= f; if (hi == 0) wsf[r32] = f;
        LDS_WAIT(); asm volatile("" ::: "memory");
        const LAS float* wh = wsf + 4 * hi;
#pragma unroll
        for (int d = 0; d < 2; ++d)
#pragma unroll
            for (int r = 0; r < 16; ++r) s.o[d][r] *= wh[crow0(r)];
        LDS_WAIT(); asm volatile("" ::: "memory");
    }
#pragma unroll
    for (int i = 0; i < 8; ++i) { p.v[i].x = __builtin_amdgcn_exp2f(p.v[i].x); p.v[i].y = __builtin_amdgcn_exp2f(p.v[i].y); }
    f32x2 acc = (p.v[0] + p.v[1]) + (p.v[2] + p.v[3]); acc += (p.v[4] + p.v[5]) + (p.v[6] + p.v[7]);
    s.l += acc.x + acc.y;
    const v4u pw0 = (v4u){cvtpk_s(p.v[0].x, p.v[0].y), cvtpk_s(p.v[1].x, p.v[1].y), cvtpk_s(p.v[2].x, p.v[2].y), cvtpk_s(p.v[3].x, p.v[3].y)};
    const v4u pw1 = (v4u){cvtpk_s(p.v[4].x, p.v[4].y), cvtpk_s(p.v[5].x, p.v[5].y), cvtpk_s(p.v[6].x, p.v[6].y), cvtpk_s(p.v[7].x, p.v[7].y)};
#pragma unroll
    for (int d0 = 0; d0 < 2; ++d0) {
        const s16x4 l0 = vtr(vph + d0 * 4096), h0 = vtr(vph + d0 * 4096 + 512), l1 = vtr(vph + d0 * 4096 + 1024), h1 = vtr(vph + d0 * 4096 + 1536);
        s.o[d0] = __builtin_amdgcn_mfma_f32_32x32x16_bf16(__builtin_bit_cast(bf16x8, pw0), (bf16x8){l0[0], l0[1], l0[2], l0[3], h0[0], h0[1], h0[2], h0[3]}, s.o[d0], 0, 0, 0);
        s.o[d0] = __builtin_amdgcn_mfma_f32_32x32x16_bf16(__builtin_bit_cast(bf16x8, pw1), (bf16x8){l1[0], l1[1], l1[2], l1[3], h1[0], h1[1], h1[2], h1[3]}, s.o[d0], 0, 0, 0);
    }
}
__device__ __forceinline__ void mask_causal_h(f32x16& p, int tq, int hi, int half) {
#pragma unroll
    for (int r = 0; r < 16; ++r) { if (32 * half + crow(r, hi) > tq) p[r] = -INFINITY; }
}
__device__ __forceinline__ void mask_anti_h(f32x16& p, int tq, int hi, int half) {
#pragma unroll
    for (int r = 0; r < 16; ++r) { if (32 * half + crow(r, hi) <= tq) p[r] = -INFINITY; }
}
__device__ __forceinline__ void mask_all_h(f32x16& p, bool kill) {
#pragma unroll
    for (int r = 0; r < 16; ++r) p[r] = kill ? -INFINITY : p[r];
}
__device__ __forceinline__ void soft_reset(Soft& s) { s.mhat = 0.f; s.l = 0.f; s.o[0] = f32x16{}; s.o[1] = f32x16{}; s.negm = f32x16{}; asm volatile("" : "+v"(s.negm)); }
__device__ __forceinline__ void soft_step(Soft& s, f32x16& p0, f32x16& p1, int vb, LAS float* wsf, int r32, int hi) {
    const float rm = rowmax(p0, p1);
    if (__any(rm > 8.f)) {
        const float dl = fmaxf(rm, 0.f); s.mhat += dl;
#pragma unroll
        for (int r = 0; r < 16; ++r) { p0[r] -= dl; p1[r] -= dl; }
#pragma unroll
        for (int r = 0; r < 16; ++r) s.negm[r] = -s.mhat;
        asm volatile("" : "+v"(s.negm));
        const float f = exp2f(-dl); s.l *= f; if (hi == 0) wsf[r32] = f;
        LDS_WAIT(); asm volatile("" ::: "memory");
#pragma unroll
        for (int d = 0; d < 2; ++d)
#pragma unroll
            for (int r = 0; r < 16; ++r) s.o[d][r] *= wsf[crow(r, hi)];
        LDS_WAIT(); asm volatile("" ::: "memory");
    }
    float sacc = 0.f;
#pragma unroll
    for (int r = 0; r < 16; ++r) { p0[r] = exp2f(p0[r]); p1[r] = exp2f(p1[r]); sacc += p0[r] + p1[r]; }
    s.l += sacc;
    v4u pw0, pw1, pw2, pw3;
    pw0 = (v4u){cvtpk_s(p0[0], p0[1]), cvtpk_s(p0[2], p0[3]), cvtpk_s(p0[4], p0[5]), cvtpk_s(p0[6], p0[7])};
    pw1 = (v4u){cvtpk_s(p0[8], p0[9]), cvtpk_s(p0[10], p0[11]), cvtpk_s(p0[12], p0[13]), cvtpk_s(p0[14], p0[15])};
    pw2 = (v4u){cvtpk_s(p1[0], p1[1]), cvtpk_s(p1[2], p1[3]), cvtpk_s(p1[4], p1[5]), cvtpk_s(p1[6], p1[7])};
    pw3 = (v4u){cvtpk_s(p1[8], p1[9]), cvtpk_s(p1[10], p1[11]), cvtpk_s(p1[12], p1[13]), cvtpk_s(p1[14], p1[15])};
    pv(s.o, vb, __builtin_bit_cast(bf16x8, pw0), __builtin_bit_cast(bf16x8, pw1), __builtin_bit_cast(bf16x8, pw2), __builtin_bit_cast(bf16x8, pw3));
}
__device__ __forceinline__ void soft_step2(Soft& s, f32x16& p0, f32x16& p1, const LAS char* vp, LAS float* wsf, int r32, int hi) {
    const float rm = rowmax(p0, p1) - s.mhat;
    if (__any(rm > 8.f)) {
        const float dl = fmaxf(rm, 0.f); s.mhat += dl;
        const float f = __builtin_amdgcn_exp2f(-dl); s.l *= f; if (hi == 0) wsf[r32] = f;
        LDS_WAIT(); asm volatile("" ::: "memory");
        const LAS float* wh = wsf + 4 * hi;
#pragma unroll
        for (int d = 0; d < 2; ++d)
#pragma unroll
            for (int r = 0; r < 16; ++r) s.o[d][r] *= wh[crow0(r)];
        LDS_WAIT(); asm volatile("" ::: "memory");
    }
    float sa = 0.f, sb = 0.f; const float mh = s.mhat;
#pragma unroll
    for (int r = 0; r < 16; ++r) { p0[r] = __builtin_amdgcn_exp2f(p0[r] - mh); p1[r] = __builtin_amdgcn_exp2f(p1[r] - mh); sa += p0[r]; sb += p1[r]; }
    s.l += sa + sb;
    v4u pw0, pw1, pw2, pw3;
    pw0 = (v4u){cvtpk_s(p0[0], p0[1]), cvtpk_s(p0[2], p0[3]), cvtpk_s(p0[4], p0[5]), cvtpk_s(p0[6], p0[7])};
    pw1 = (v4u){cvtpk_s(p0[8], p0[9]), cvtpk_s(p0[10], p0[11]), cvtpk_s(p0[12], p0[13]), cvtpk_s(p0[14], p0[15])};
    pw2 = (v4u){cvtpk_s(p1[0], p1[1]), cvtpk_s(p1[2], p1[3]), cvtpk_s(p1[4], p1[5]), cvtpk_s(p1[6], p1[7])};
    pw3 = (v4u){cvtpk_s(p1[8], p1[9]), cvtpk_s(p1[10], p1[11]), cvtpk_s(p1[12], p1[13]), cvtpk_s(p1[14], p1[15])};
    pv2(s.o, vp, __builtin_bit_cast(bf16x8, pw0), __builtin_bit_cast(bf16x8, pw1), __builtin_bit_cast(bf16x8, pw2), __builtin_bit_cast(bf16x8, pw3));
}
__device__ __forceinline__ void soft_finish(Soft& s, f32x16* tot, float gate, LAS float* wsf, int r32, int hi) {
    const float lt = swap_add(s.l); const float fac = (lt > 0.f) ? gate / lt : 0.f;
    if (hi == 0) wsf[32 + r32] = fac;
    LDS_WAIT(); asm volatile("" ::: "memory");
#pragma unroll
    for (int r = 0; r < 16; ++r) { const float f = wsf[32 + crow(r, hi)]; tot[0][r] += s.o[0][r] * f; tot[1][r] += s.o[1][r] * f; }
    LDS_WAIT(); asm volatile("" ::: "memory");
    soft_reset(s);
}
__device__ __forceinline__ void soft_finish_stage(Soft& s, LAS float* stg, bool first, float gate, LAS float* wsf, int r32, int hi) {
    const float lt = swap_add(s.l); const float fac = (lt > 0.f) ? gate / lt : 0.f;
    if (hi == 0) wsf[32 + r32] = fac;
    LDS_WAIT(); asm volatile("" ::: "memory");
#pragma unroll
    for (int r = 0; r < 16; ++r) { const float f = (wsf + 32 + 4 * hi)[crow0(r)]; LAS float* sp = (stg + 4 * hi * 64 + r32) + crow0(r) * 64;
        if (first) { sp[0] = s.o[0][r] * f; sp[32] = s.o[1][r] * f; } else { sp[0] += s.o[0][r] * f; sp[32] += s.o[1][r] * f; } }
    LDS_WAIT(); asm volatile("" ::: "memory");
    soft_reset(s);
}
__device__ __forceinline__ void mask_causal(f32x16& p0, f32x16& p1, int tq, int hi) {
#pragma unroll
    for (int r = 0; r < 16; ++r) { const int kv = crow(r, hi); if (kv > tq) p0[r] = -INFINITY; if (kv + 32 > tq) p1[r] = -INFINITY; }
}
__device__ __forceinline__ void mask_anti(f32x16& p0, f32x16& p1, int tq, int hi) {
#pragma unroll
    for (int r = 0; r < 16; ++r) { const int kv = crow(r, hi); if (kv <= tq) p0[r] = -INFINITY; if (kv + 32 <= tq) p1[r] = -INFINITY; }
}
__device__ __forceinline__ void mask_all(f32x16& p0, f32x16& p1, bool kill) {
#pragma unroll
    for (int r = 0; r < 16; ++r) { p0[r] = kill ? -INFINITY : p0[r]; p1[r] = kill ? -INFINITY : p1[r]; }
}

__device__ __forceinline__ void sel_win_unit(LAS unsigned char* shm, int b, int g, int tb, const bf16* PROJ, const unsigned* SELM, const float* OACC, bf16* ONSA) {
    const int tid = tid_opaque(), lane = tid & 63, r32 = lane & 31, hi = lane >> 5; const int wid = __builtin_amdgcn_readfirstlane(tid >> 6);
    const int hh = wid & 3, th = wid >> 2, head = g * 4 + hh, tq = th * 32 + r32, t = tb * 64 + tq; const size_t row = (size_t)b * SEQ + t;
    const unsigned lds0 = (unsigned)(uintptr_t)shm;
    LAS float* wsf = (LAS float*)(shm + LDS_WS) + wid * 256;
    const bf16* bbase = PROJ + (size_t)b * SEQ * PLD + g * 64;
    const int nsel = tb + 1, jlo = (tb > 8) ? tb - 8 : 0, ntot = nsel + (tb - jlo + 1);
#define FA_KOFF(l_) ((unsigned)((l_) * PLD + wid * 8) * 2u)
#define FA_VOFF(l_) ((unsigned)((16 * (wid & 3) + ((l_) >> 2)) * PLD + (wid >> 2) * 32 + ((l_) & 3) * 8) * 2u)
    const unsigned koff_ = FA_KOFF(lane), voff_ = FA_VOFF(lane);
    const unsigned kdst = lds0 + LDS_K + wid * 1024, vdst = lds0 + LDS_V + wid * 1024;
#define FA_TILE(i) const int i_ = (i); const bool w_ = i_ >= nsel; const int j_ = w_ ? jlo + i_ - nsel : i_; const bf16* tb_ = bbase + (size_t)(j_ * 64) * PLD + (w_ ? PC_KW : PC_KS); const bf16* tv_ = bbase + (size_t)(j_ * 64) * PLD + (w_ ? PC_VW : PC_VS)
#define FA_ISSUE_K(i) do { if ((i) < ntot) { FA_TILE(i); glds16((const char*)tb_ + koff_, (unsigned)__builtin_amdgcn_readfirstlane(kdst + (unsigned)((i_ % NKS) * SLOTB))); } } while (0)
#define FA_ISSUE_V(i) do { if ((i) < ntot) { FA_TILE(i); glds16((const char*)tv_ + voff_, (unsigned)__builtin_amdgcn_readfirstlane(vdst + (unsigned)((i_ % NSLOTS) * SLOTB))); } } while (0)
    const bf16* prow = PROJ + row * PLD;
    bf16x8 qr[4];
#pragma unroll
    for (int d0 = 0; d0 < 4; ++d0) qr[d0] = *(const bf16x8*)(prow + PC_Q + head * 64 + d0 * 16 + hi * 8);
    if (hi == 0) { wsf[64 + r32] = sigm(bf2f(prow[PC_G3 + head * 3 + 1])); wsf[96 + r32] = sigm(bf2f(prow[PC_G3 + head * 3 + 2])); ((LAS unsigned*)wsf)[128 + r32] = __hip_atomic_load(SELM + (size_t)(b * 4 + g) * SEQ + t, RLX_AGENT); }
    FA_ISSUE_K(0); FA_ISSUE_V(0); FA_ISSUE_K(1); FA_ISSUE_K(2); FA_ISSUE_V(1);
    Soft st; soft_reset(st);
    LAS float* stg = (LAS float*)(shm + LDS_OST) + wid * 2048;
    const LAS char* kp0 = (const LAS char*)shm + LDS_K + hi * 1024 + r32 * 16;
    const LAS char* vp0 = (const LAS char*)shm + LDS_V + ((lane >> 4) & 1) * 32 + (lane & 3) * 8 + (4 * hi + ((lane & 15) >> 2)) * 64;
    if (ntot >= 3) { FA_WAIT_BAR(4); } else { FA_WAIT_BAR(3); }
    f32x16 sa_, sb_;
    qk_half_c(sa_, kp0, qr, st.negm); sb_ = sa_;
    for (int i = 0; i < ntot; ++i) {
        if (i + 2 < ntot) { FA_WAIT_BAR(2); } else if (i + 1 < ntot) { FA_WAIT_BAR(1); } else { FA_WAIT_BAR(0); }
        FA_ISSUE_K(i + 3); FA_ISSUE_V(i + 2);
        const bool issel = i < nsel; const int j = issel ? i : jlo + i - nsel;
        const int mcase = (j == tb) ? 1 : ((!issel && j == tb - 8) ? 2 : 0);
        bool kill = false; if (issel) { const unsigned mask = ((const LAS unsigned*)wsf)[128 + r32]; kill = !((mask >> i) & 1u); }
        const bool anyk = __any(kill);
        const LAS char* vpi = vp0 + (i % NSLOTS) * SLOTB;
        qk_half_c(sb_, kp0 + (i % NKS) * SLOTB + 512, qr, st.negm);
        if (anyk) mask_all_h(sa_, kill);
        if (mcase == 1) mask_causal_h(sa_, tq, hi, 0); else if (mcase == 2) mask_anti_h(sa_, tq, hi, 0);
        soft_half_c(st, sa_, sb_, vpi, wsf, r32, hi);
        if (i + 1 < ntot) qk_half_c(sa_, kp0 + ((i + 1) % NKS) * SLOTB, qr, st.negm);
        if (anyk) mask_all_h(sb_, kill);
        if (mcase == 1) mask_causal_h(sb_, tq, hi, 1); else if (mcase == 2) mask_anti_h(sb_, tq, hi, 1);
        soft_half_c(st, sb_, sa_, vpi + 2048, wsf, r32, hi);
        if (i == nsel - 1) { const float mo = st.mhat; soft_finish_stage(st, stg, true, wsf[64 + r32], wsf, r32, hi);
#pragma unroll
            for (int r = 0; r < 16; ++r) sa_[r] += mo; }
    }
    soft_finish_stage(st, stg, false, wsf[96 + r32], wsf, r32, hi);
    const size_t rowbase = (size_t)b * SEQ + tb * 64 + th * 32;
    { float t0[16], t1[16];
#pragma unroll
        for (int r = 0; r < 16; ++r) { const float* oa = OACC + (rowbase + crow(r, hi)) * 1024 + head * 64 + r32; const LAS float* sp = (stg + 4 * hi * 64 + r32) + crow0(r) * 64; t0[r] = sp[0] + oa[0]; t1[r] = sp[32] + oa[32]; }
        LDS_WAIT(); asm volatile("" ::: "memory");
        LAS bf16* sb = (LAS bf16*)stg;
#pragma unroll
        for (int r = 0; r < 16; ++r) { LAS bf16* bp = (sb + 4 * hi * 64 + r32) + crow0(r) * 64; bp[0] = (bf16)f2bf(t0[r]); bp[32] = (bf16)f2bf(t1[r]); }
        LDS_WAIT(); asm volatile("" ::: "memory");
#pragma unroll
        for (int i = 0; i < 4; ++i) { const int rr = i * 8 + (lane >> 3), ch = lane & 7; const v4u v = *(const LAS v4u*)(sb + rr * 64 + ch * 8); *(v4u*)(ONSA + (rowbase + rr) * 2048 + head * 64 + ch * 8) = v; } }
    asm volatile("s_waitcnt lgkmcnt(0)\n\ts_barrier" ::: "memory");
#undef FA_TILE
#undef FA_ISSUE_K
#undef FA_ISSUE_V
#undef FA_KOFF
#undef FA_VOFF
}
}
namespace cs {
using fa::f32x16; using fa::crow; using fa::glds16; using fa::cvtpk_s; using fa::pv; using fa::swap_add; using fa::qkt; using fa::rowmax;
constexpr int C_K = 0, C_V = 16384, C_WS = 32768, C_OWN = 34816, TBW = 32 * 33, C_CAR = C_OWN + 8 * TBW * 4, C_IMP = C_CAR + 8 * TBW * 4, C_END = C_IMP + 64 * 33 * 4;
static_assert(C_END <= RING_BYTES, "cmp lds");
__device__ __forceinline__ void mask_nv(f32x16& p0, f32x16& p1, int base, int nvalid, int hi) {
#pragma unroll
    for (int r = 0; r < 16; ++r) { const int n = base + crow(r, hi); if (n >= nvalid) p0[r] = -INFINITY; if (n + 32 >= nvalid) p1[r] = -INFINITY; }
}
__device__ __forceinline__ void imp_tile(const f32x16& p0, const f32x16& p1, LAS float* own, LAS float* car, int jt, int hi) {
#pragma unroll
    for (int a = 0; a < 4; ++a) {
        const int j0 = jt + 2 * a + hi, j1 = jt + 8 + 2 * a + hi;
        own[j0] = (p0[4 * a] + p0[4 * a + 1]) + (p0[4 * a + 2] + 0.5f * p0[4 * a + 3]); car[j0 + 1] = 0.5f * p0[4 * a + 3];
        own[j1] = (p1[4 * a] + p1[4 * a + 1]) + (p1[4 * a + 2] + 0.5f * p1[4 * a + 3]); if (j1 + 1 < 32) car[j1 + 1] = 0.5f * p1[4 * a + 3];
    }
}
__device__ __forceinline__ bf16x8 pk8(const f32x16& p, int o) { v4u w = (v4u){cvtpk_s(p[o], p[o + 1]), cvtpk_s(p[o + 2], p[o + 3]), cvtpk_s(p[o + 4], p[o + 5]), cvtpk_s(p[o + 6], p[o + 7])}; return __builtin_bit_cast(bf16x8, w); }
__device__ __forceinline__ void cmp_unit(LAS unsigned char* shm, int b, int g, int tb, const bf16* PROJ, const bf16* KCB, float* OACC, unsigned* SELM) {
    const int tid = tid_opaque(), lane = tid & 63, r32 = lane & 31, hi = lane >> 5; const int wid = __builtin_amdgcn_readfirstlane(tid >> 6);
    const int hh = wid & 3, th = wid >> 2, head = g * 4 + hh, tq = th * 32 + r32, t = tb * 64 + tq; const size_t row = (size_t)b * SEQ + t;
    const unsigned lds0 = (unsigned)(uintptr_t)shm;
    LAS float* wsf = (LAS float*)(shm + C_WS) + wid * 64;
    const int ntile = (tb >= 16) ? 2 : 1;
    const bf16* kc = KCB + (size_t)((0 * 8 + b) * 4 + g) * 8192; const bf16* vc = KCB + (size_t)((1 * 8 + b) * 4 + g) * 8192;
    for (int tau = 0; tau < ntile; ++tau) {
        glds16(kc + (size_t)(64 * tau + lane) * 64 + wid * 8, (unsigned)__builtin_amdgcn_readfirstlane(lds0 + C_K + tau * 8192 + wid * 1024));
        glds16(vc + (size_t)(64 * tau + 16 * (wid & 3) + (lane >> 2)) * 64 + (wid >> 2) * 32 + (lane & 3) * 8, (unsigned)__builtin_amdgcn_readfirstlane(lds0 + C_V + tau * 8192 + wid * 1024));
    }
    const bf16* prow = PROJ + row * PLD;
    bf16x8 qr[4];
#pragma unroll
    for (int d0 = 0; d0 < 4; ++d0) qr[d0] = *(const bf16x8*)(prow + PC_Q + head * 64 + d0 * 16 + hi * 8);
    const float g0 = sigm(bf2f(prow[PC_G3 + head * 3 + 0]));
    const int nvalid = (t >= 31) ? (((t - 31) >> 4) + 1) : 0;
    asm volatile("s_waitcnt vmcnt(0) lgkmcnt(0)\n\ts_barrier" ::: "memory");
    const LAS char* kp0 = (const LAS char*)shm + C_K + hi * 1024 + r32 * 16;
    const int vb0 = (int)(lds0 + C_V) + ((lane >> 4) & 1) * 32 + (lane & 3) * 8 + (4 * hi + ((lane & 15) >> 2)) * 64;
    const f32x16 zero = f32x16{};
    f32x16 p0, p1, p2, p3;
    qkt(p0, p1, kp0, qr, zero); mask_nv(p0, p1, 0, nvalid, hi);
    float m = rowmax(p0, p1);
    if (ntile == 2) { qkt(p2, p3, kp0 + 8192, qr, zero); mask_nv(p2, p3, 64, nvalid, hi); m = fmaxf(m, rowmax(p2, p3)); }
    m = fmaxf(m, -1e30f);
    float l = 0.f;
#pragma unroll
    for (int r = 0; r < 16; ++r) { p0[r] = exp2f(p0[r] - m); p1[r] = exp2f(p1[r] - m); l += p0[r] + p1[r]; }
    if (ntile == 2) {
#pragma unroll
        for (int r = 0; r < 16; ++r) { p2[r] = exp2f(p2[r] - m); p3[r] = exp2f(p3[r] - m); l += p2[r] + p3[r]; } }
    const float lt = swap_add(l); const float inv = (lt > 0.f) ? 1.f / lt : 0.f;
#pragma unroll
    for (int r = 0; r < 16; ++r) { p0[r] *= inv; p1[r] *= inv; }
    f32x16 o[2]; o[0] = f32x16{}; o[1] = f32x16{};
    pv(o, vb0, pk8(p0, 0), pk8(p0, 8), pk8(p1, 0), pk8(p1, 8));
    LAS float* own = (LAS float*)(shm + C_OWN) + wid * TBW + r32 * 33; LAS float* car = (LAS float*)(shm + C_CAR) + wid * TBW + r32 * 33;
    imp_tile(p0, p1, own, car, 0, hi);
    if (ntile == 2) {
#pragma unroll
        for (int r = 0; r < 16; ++r) { p2[r] *= inv; p3[r] *= inv; }
        pv(o, vb0 + 8192, pk8(p2, 0), pk8(p2, 8), pk8(p3, 0), pk8(p3, 8));
        imp_tile(p2, p3, own, car, 16, hi);
    }
    if (hi == 0) wsf[r32] = g0;
    LDS_WAIT(); asm volatile("" ::: "memory");
    const size_t rowbase = (size_t)b * SEQ + tb * 64 + th * 32;
#pragma unroll
    for (int r = 0; r < 16; ++r) { const float gq = wsf[crow(r, hi)]; float* oa = OACC + (rowbase + crow(r, hi)) * 1024 + head * 64 + r32; oa[0] = o[0][r] * gq; oa[32] = o[1][r] * gq; }
    asm volatile("s_waitcnt lgkmcnt(0)\n\ts_barrier" ::: "memory");
    LAS float* IMPS = (LAS float*)(shm + C_IMP);
#pragma unroll
    for (int pass = 0; pass < 4; ++pass) { const int tok = pass * 16 + (tid >> 5), j = tid & 31, q = tok & 31, w0 = (tok >> 5) * 4; float v = 0.f;
        if (j < 16 * ntile) {
#pragma unroll
            for (int k = 0; k < 4; ++k) { v += ((LAS float*)(shm + C_OWN))[(w0 + k) * TBW + q * 33 + j]; if (j > 0) v += ((LAS float*)(shm + C_CAR))[(w0 + k) * TBW + q * 33 + j]; } }
        IMPS[tok * 33 + j] = v; }
    asm volatile("s_waitcnt lgkmcnt(0)\n\ts_barrier" ::: "memory");
#pragma unroll
    for (int pass = 0; pass < 4; ++pass) { const int tok = pass * 16 + (tid >> 5), j = tid & 31, cur = tb;
        const bool forced = (j == 0) || (j == cur) || (j == cur - 1);
        const float score = (j <= cur) ? IMPS[tok * 33 + j] + (forced ? 1000.f : 0.f) : -1e9f;
        int rank = 0;
        for (int i = 0; i < 32; ++i) { const bool fi = (i == 0) || (i == cur) || (i == cur - 1); const float si = (i <= cur) ? IMPS[tok * 33 + i] + (fi ? 1000.f : 0.f) : -1e9f; rank += ((si > score) || (si == score && i < j)) ? 1 : 0; }
        const bool sel = (rank < 16) && (score > -5e8f);
        const unsigned long long bal = __ballot(sel);
        if ((lane & 31) == 0) SELM[(size_t)(b * 4 + g) * SEQ + tb * 64 + tok] = (unsigned)(bal >> (lane & 32)); }
    asm volatile("s_waitcnt vmcnt(0) lgkmcnt(0)\n\ts_barrier" ::: "memory");
}
}
__device__ __forceinline__ void p5_cmp_select(Frame& F) {
    const int tid_ = tid_opaque(), lane_ = tid_ & 63; (void)lane_;
    const bf16* PROJ = WSP(bf16, WS_PROJ); const bf16* KCB = WSP(bf16, WS_KCV); float* OACC = WSP(float, WS_OACC); unsigned* SELM = WSP(unsigned, WS_SELM);
    for (int u = blockIdx.x; u < 1024; u += F.G) { const int bg = u >> 5, tb = u & 31; cs::cmp_unit(F.lds, bg >> 2, bg & 3, tb, PROJ, KCB, OACC, SELM); }
}
namespace ml {
using fa::f32x16; using fa::crow; using fa::glds16; using fa::cvtpk_s; using fa::swap_add; using fa::vtr;
constexpr int NR = 4, KSL = 8192, VSL = 16384;
constexpr int L_K = 0, L_V = NR * KSL, L_W = L_V + NR * VSL, L_WS = L_W + 8192, L_UT = L_WS + 8 * 256, L_END = L_UT + 8192;
static_assert(L_END <= RING_BYTES, "mlstm lds");
__device__ __forceinline__ void mlstm_unit(LAS unsigned char* shm, int b, int h, int tb, const bf16* PROJ, const bf16* QKC, const float* GA2, const float* GU2, const float* GM2, const float* mhg, bf16* OML) {
    const int tid = tid_opaque(), lane = tid & 63, r32 = lane & 31, hi = lane >> 5; const int wid = __builtin_amdgcn_readfirstlane(tid >> 6);
    const int vq = wid & 3, th = wid >> 2, tq = th * 32 + r32, t = tb * 64 + tq, bh = b * 4 + h; const size_t row = (size_t)b * SEQ + t;
    const unsigned lds0 = (unsigned)(uintptr_t)shm;
    LAS float* wsf = (LAS float*)(shm + L_WS) + wid * 64;
    LAS float* ut = (LAS float*)(shm + L_UT);
    const int n = 2 * (tb + 1);
    for (int i = tid; i < n * 32; i += 512) ut[i] = GU2[bh * SEQ + i];
    const bf16* kbase = QKC + (size_t)b * SEQ * 1024 + 512 + h * 128 + (size_t)(lane & 31) * 1024 + (2 * wid + (lane >> 5)) * 8;
    const bf16* vb0 = PROJ + (size_t)b * SEQ * PLD + PC_VM + h * 256 + (size_t)(lane >> 2) * PLD + (lane & 3) * 8;
    const int pa = 2 * wid, pb = 2 * wid + 1;
    const bf16* vbaseA = vb0 + (size_t)(16 * (pa & 1)) * PLD + (pa >> 2) * 64 + ((pa >> 1) & 1) * 32;
    const bf16* vbaseB = vb0 + (size_t)(16 * (pb & 1)) * PLD + (pb >> 2) * 64 + ((pb >> 1) & 1) * 32;
    const unsigned kdst = lds0 + L_K + wid * 1024, vdst = lds0 + L_V + wid * 2048;
#define ML_ISSUE_K(i) do { const int i_ = (i); if (i_ < n) glds16(kbase + (size_t)(i_ * 32) * 1024, (unsigned)__builtin_amdgcn_readfirstlane(kdst + (unsigned)((i_ & 3) * KSL))); } while (0)
#define ML_ISSUE_V(i) do { const int i_ = (i); if (i_ >= 0 && i_ < n) { const unsigned d_ = (unsigned)__builtin_amdgcn_readfirstlane(vdst + (unsigned)((i_ & 3) * VSL)); \
        glds16(vbaseA + (size_t)(i_ * 32) * PLD, d_); glds16(vbaseB + (size_t)(i_ * 32) * PLD, d_ + 1024u); } } while (0)
    bf16x8 qr[8];
#pragma unroll
    for (int d0 = 0; d0 < 8; ++d0) qr[d0] = *(const bf16x8*)(QKC + row * 1024 + h * 128 + d0 * 16 + hi * 8);
    const float M2 = GM2[bh * SEQ + t], A2 = GA2[bh * SEQ + t];
    ML_ISSUE_K(0); ML_ISSUE_K(1); ML_ISSUE_V(0); ML_ISSUE_K(2); ML_ISSUE_V(1);
    f32x16 o[2]; o[0] = f32x16{}; o[1] = f32x16{}; float den = 0.f;
    const f32x16 zero = f32x16{};
    const int vbl = ((lane >> 4) & 1) * 32 + (lane & 3) * 8 + (4 * hi + ((lane & 15) >> 2)) * 64;
    LAS unsigned char* wbase = shm + L_W + th * 2048 + lane * 16;
    for (int s = 0; s <= n; ++s) {
        if (s + 2 < n) asm volatile("s_waitcnt vmcnt(6) lgkmcnt(0)\n\ts_barrier" ::: "memory");
        else if (s + 2 == n) asm volatile("s_waitcnt vmcnt(5) lgkmcnt(0)\n\ts_barrier" ::: "memory");
        else if (s + 1 == n) asm volatile("s_waitcnt vmcnt(2) lgkmcnt(0)\n\ts_barrier" ::: "memory");
        else asm volatile("s_waitcnt vmcnt(0) lgkmcnt(0)\n\ts_barrier" ::: "memory");
        ML_ISSUE_K(s + 3); ML_ISSUE_V(s + 2);
        if (s < n && vq == (s & 3)) {
            const LAS char* kb = (const LAS char*)shm + L_K + (s & 3) * KSL + hi * 512 + r32 * 16;
            f32x16 p0;
#pragma unroll
            for (int d0 = 0; d0 < 8; ++d0) { const bf16x8 b0 = *(const LAS bf16x8*)(kb + d0 * 1024); p0 = __builtin_amdgcn_mfma_f32_32x32x16_bf16(b0, qr[d0], d0 == 0 ? zero : p0, 0, 0, 0); }
            const LAS float* up = ut + s * 32 + 4 * hi;
            fa::P8 q0 = __builtin_bit_cast(fa::P8, p0);
            const f32x2 m2 = {M2, M2};
#pragma unroll
            for (int a = 0; a < 4; ++a) { const f32x4 u0 = *(const LAS f32x4*)(up + 8 * a);
                f32x2 e0 = (f32x2){u0.x, u0.y} - m2, e1 = (f32x2){u0.z, u0.w} - m2;
                e0.x = __builtin_amdgcn_exp2f(e0.x); e0.y = __builtin_amdgcn_exp2f(e0.y); e1.x = __builtin_amdgcn_exp2f(e1.x); e1.y = __builtin_amdgcn_exp2f(e1.y);
                q0.v[2 * a] *= e0; q0.v[2 * a + 1] *= e1; }
            if (s >= 2 * tb) {
                const int kb32 = 32 * (s & 1);
#pragma unroll
                for (int r = 0; r < 16; ++r) { if (kb32 + fa::crow(r, hi) > tq) q0.v[r >> 1][r & 1] = 0.f; } }
            { f32x2 d2 = (q0.v[0] + q0.v[1]) + (q0.v[2] + q0.v[3]); d2 += (q0.v[4] + q0.v[5]) + (q0.v[6] + q0.v[7]); den += d2.x + d2.y; }
            LAS unsigned char* wp = wbase + (s & 1) * 4096;
            *(LAS v4u*)(wp) = (v4u){cvtpk_s(q0.v[0].x, q0.v[0].y), cvtpk_s(q0.v[1].x, q0.v[1].y), cvtpk_s(q0.v[2].x, q0.v[2].y), cvtpk_s(q0.v[3].x, q0.v[3].y)};
            *(LAS v4u*)(wp + 1024) = (v4u){cvtpk_s(q0.v[4].x, q0.v[4].y), cvtpk_s(q0.v[5].x, q0.v[5].y), cvtpk_s(q0.v[6].x, q0.v[6].y), cvtpk_s(q0.v[7].x, q0.v[7].y)};
        }
        if (s >= 1) {
            const LAS unsigned char* wp = wbase + ((s - 1) & 1) * 4096;
            const v4u pw0 = *(const LAS v4u*)(wp), pw1 = *(const LAS v4u*)(wp + 1024);
            const LAS char* vp = (const LAS char*)shm + L_V + ((s - 1) & 3) * VSL + vq * 4096 + vbl;
#pragma unroll
            for (int d0 = 0; d0 < 2; ++d0) {
                const fa::s16x4 l0 = vtr(vp + d0 * 2048), h0 = vtr(vp + d0 * 2048 + 512), l1 = vtr(vp + d0 * 2048 + 1024), h1 = vtr(vp + d0 * 2048 + 1536);
                o[d0] = __builtin_amdgcn_mfma_f32_32x32x16_bf16(__builtin_bit_cast(bf16x8, pw0), (bf16x8){l0[0], l0[1], l0[2], l0[3], h0[0], h0[1], h0[2], h0[3]}, o[d0], 0, 0, 0);
                o[d0] = __builtin_amdgcn_mfma_f32_32x32x16_bf16(__builtin_bit_cast(bf16x8, pw1), (bf16x8){l1[0], l1[1], l1[2], l1[3], h1[0], h1[1], h1[2], h1[3]}, o[d0], 0, 0, 0);
            }
        }
    }
    { const float dt = swap_add(den); if (hi == 0) wsf[r32] = dt; }
    asm volatile("s_waitcnt lgkmcnt(0)\n\ts_barrier" ::: "memory");
    { const LAS float* wd = (const LAS float*)(shm + L_WS) + th * 4 * 64; const float dt = (wd[r32] + wd[64 + r32]) + (wd[128 + r32] + wd[192 + r32]);
      const float dd = fmaxf(fabsf(dt), __builtin_amdgcn_exp2f(-(A2 + M2))); if (hi == 0) wsf[32 + r32] = 1.f / dd; }
    LDS_WAIT(); asm volatile("" ::: "memory");
    LAS float* Hst = (LAS float*)shm;
#pragma unroll
    for (int r = 0; r < 16; ++r) { const float f = wsf[32 + crow(r, hi)]; LAS float* hp = Hst + (th * 32 + crow(r, hi)) * 256 + vq * 64 + r32; hp[0] = o[0][r] * f; hp[32] = o[1][r] * f; }
    asm volatile("s_waitcnt lgkmcnt(0)\n\ts_barrier" ::: "memory");
#pragma unroll
    for (int k = 0; k < 8; ++k) { const int tr = wid * 8 + k; const f32x4 hv = *(const LAS f32x4*)(Hst + tr * 256 + 4 * lane);
        const float ssq = wave_sum((hv.x * hv.x + hv.y * hv.y) + (hv.z * hv.z + hv.w * hv.w)); const float rs = rsqrtf(ssq * (1.f / 256.f) + EPS);
        const size_t orow = (size_t)b * SEQ + tb * 64 + tr; const v2u om = *(const v2u*)(PROJ + orow * PLD + PC_OM + h * 256 + 4 * lane); const f32x4 gg = *(const f32x4*)(mhg + h * 256 + 4 * lane);
        v2u ov; ov.x = pk2(sigm(bflo(om.x)) * hv.x * rs * gg.x, sigm(bfhi(om.x)) * hv.y * rs * gg.y); ov.y = pk2(sigm(bflo(om.y)) * hv.z * rs * gg.z, sigm(bfhi(om.y)) * hv.w * rs * gg.w);
        *(v2u*)(OML + orow * 2048 + h * 256 + 4 * lane) = ov; }
    asm volatile("s_waitcnt lgkmcnt(0)\n\ts_barrier" ::: "memory");
#undef ML_ISSUE_K
#undef ML_ISSUE_V
}
}
__device__ __forceinline__ void p5_mlstm(Frame& F, int& chunk) {
    const int tid_ = tid_opaque(), lane_ = tid_ & 63; (void)lane_;
    const bf16* PROJ = WSP(bf16, WS_PROJ); const bf16* QKC = WSP(bf16, WS_QKC); bf16* OML = WSP(bf16, WS_OMIX) + 1024;
    const float* GA = WSP(float, WS_GA); const float* GU = WSP(float, WS_GU); const float* GM = WSP(float, WS_GM); const float* mhg = INP(13);
    unsigned* ctr = WSP(unsigned, WS_CTL) + CW_MLQ; LAS int* tk = (LAS int*)(F.lds + LDSCTL_OFF + 64);
    __syncthreads();
    if (tid_ == 0) tk[0] = (int)__hip_atomic_fetch_add(ctr, 1u, RLX_AGENT);
    __syncthreads();
    int u = tk[0];
    while (u < 1024) {
        int nxt = 0; if (tid_ == 0) nxt = (int)__hip_atomic_fetch_add(ctr, 1u, RLX_AGENT);
        const int bh = u & 31, tb = 31 - (u >> 5);
        ml::mlstm_unit(F.lds, bh >> 2, bh & 3, tb, PROJ, QKC, GA, GU, GM, mhg, OML);
        convert_chunk(F, chunk);
        if (tid_ == 0) tk[0] = nxt;
        __syncthreads();
        u = tk[0];
        __syncthreads();
    }
}
__device__ __forceinline__ void p6_sel_win(Frame& F, int& chunk) {
    const int tid_ = tid_opaque(), lane_ = tid_ & 63; (void)lane_;
    const bf16* PROJ = WSP(bf16, WS_PROJ); float* OACC = WSP(float, WS_OACC); unsigned* SELM = WSP(unsigned, WS_SELM); bf16* ONSA = WSP(bf16, WS_OMIX); const bf16* KCB = WSP(bf16, WS_KCV);
    __syncthreads();
    if (F.G == 256) {
        const int bx = blockIdx.x, xcd = bx % 8, w = bx / 8, s = w & 15;
        for (int i = 0; i < 4; ++i) { const int bg = 4 * xcd + 2 * (i >> 1) + (w >> 4); const int tb = (i & 1) ? 31 - s : s;
            cs::cmp_unit(F.lds, bg >> 2, bg & 3, tb, PROJ, KCB, OACC, SELM); fa::sel_win_unit(F.lds, bg >> 2, bg & 3, tb, PROJ, SELM, OACC, ONSA); convert_chunk(F, chunk); }
    } else {
        for (int u = blockIdx.x; u < 1024; u += F.G) { const int bg = u >> 5, tb = u & 31;
            cs::cmp_unit(F.lds, bg >> 2, bg & 3, tb, PROJ, KCB, OACC, SELM); fa::sel_win_unit(F.lds, bg >> 2, bg & 3, tb, PROJ, SELM, OACC, ONSA); convert_chunk(F, chunk); }
    }
    while (chunk < NCHUNK) convert_chunk(F, chunk);
}
__device__ __forceinline__ void p10_rows(Frame& F) {
    const int tid_ = tid_opaque(), lane_ = tid_ & 63; (void)lane_;
    const float* x = INP(0); const float* gpost = INP(5); const float* gpre = INP(17); const float* mod = WSP(float, WS_MOD); const bf16* Y = WSP(bf16, WS_Y); bf16* H2 = WSP(bf16, WS_H2); unsigned char* H2Q = WSP(unsigned char, WS_H2Q);
    LAS float* A1 = (LAS float*)F.lds; LAS float* A2 = A1 + 2048; LAS float* C2 = A1 + 4096;
    int cur_b = -1;
    for (int blk = blockIdx.x; blk < NTOK / 64; blk += F.G) {
        const int b = blk >> 5;
        if (b != cur_b) { __syncthreads(); const float* mb = mod + b * 12288;
            const f32x4 g = *(const f32x4*)(gpost + 4 * tid_), gt = *(const f32x4*)(mb + 4096 + 4 * tid_), gp = *(const f32x4*)(gpre + 4 * tid_), a = *(const f32x4*)(mb + 8192 + 4 * tid_), c = *(const f32x4*)(mb + 6144 + 4 * tid_);
            *(LAS f32x4*)(A1 + 4 * tid_) = g * gt; *(LAS f32x4*)(A2 + 4 * tid_) = gp * (1.f + a); *(LAS f32x4*)(C2 + 4 * tid_) = c; __syncthreads(); cur_b = b; }
        const int row0 = blk * 64 + F.wave * 8;
        v2u yq[8]; f32x4 xx[8];
        { const GAS v2u* yr = UPTR(const v2u, Y + (size_t)row0 * DM) + lane_; const GAS f32x4* xr = UPTR(const f32x4, x + (size_t)row0 * DM) + lane_;
#pragma unroll
          for (int j = 0; j < 8; ++j) { yq[j] = yr[64 * j]; xx[j] = xr[64 * j]; } }
#pragma unroll
        for (int k = 0; k < 8; ++k) {
            const int row = row0 + k;
            v2u yn[8]; f32x4 xn[8];
            if (k + 1 < 8) { const GAS v2u* yr = UPTR(const v2u, Y + (size_t)(row + 1) * DM) + lane_; const GAS f32x4* xr = UPTR(const f32x4, x + (size_t)(row + 1) * DM) + lane_;
#pragma unroll
                for (int j = 0; j < 8; ++j) { yn[j] = yr[64 * j]; xn[j] = xr[64 * j]; } }
            GAS f32x4* orow = UPTR(f32x4, F.out + (size_t)row * DM) + lane_;
            f32x4 v[8]; float s = 0.f;
#pragma unroll
            for (int j = 0; j < 8; ++j) { const v2u q = yq[j]; v[j] = (f32x4){bflo(q.x), bfhi(q.x), bflo(q.y), bfhi(q.y)}; s += (v[j].x * v[j].x + v[j].y * v[j].y) + (v[j].z * v[j].z + v[j].w * v[j].w); }
            const float rstd = rsqrtf(wave_sum(s) * (1.f / DM) + EPS);
            float s1 = 0.f;
#pragma unroll
            for (int j = 0; j < 8; ++j) { const f32x4 a1 = *(LAS f32x4*)(A1 + 4 * lane_ + 256 * j);
                v[j] = xx[j] + a1 * (v[j] * rstd); orow[64 * j] = v[j]; s1 += (v[j].x * v[j].x + v[j].y * v[j].y) + (v[j].z * v[j].z + v[j].w * v[j].w); }
            const float rstd1 = rsqrtf(wave_sum(s1) * (1.f / DM) + EPS);
            GAS unsigned long long* o8 = UPTR(unsigned long long, H2 + (size_t)row * DM) + lane_; GAS int* o4 = UPTR(int, H2Q + (size_t)row * DM) + lane_;
#pragma unroll
            for (int j = 0; j < 8; ++j) { const int col = 4 * lane_ + 256 * j; const f32x4 a2 = *(LAS f32x4*)(A2 + col), c2 = *(LAS f32x4*)(C2 + col);
                const f32x4 r = v[j] * rstd1 * a2 + c2;
                o8[64 * j] = (unsigned long long)pk2(r.x, r.y) | ((unsigned long long)pk2(r.z, r.w) << 32);
                int q8 = 0; q8 = __builtin_amdgcn_cvt_pk_fp8_f32(fminf(fmaxf(r.x, -448.f), 448.f), fminf(fmaxf(r.y, -448.f), 448.f), q8, false); q8 = __builtin_amdgcn_cvt_pk_fp8_f32(fminf(fmaxf(r.z, -448.f), 448.f), fminf(fmaxf(r.w, -448.f), 448.f), q8, true);
                o4[64 * j] = q8; }
            if (k + 1 < 8) {
#pragma unroll
                for (int j = 0; j < 8; ++j) { yq[j] = yn[j]; xx[j] = xn[j]; } }
        }
    }
    __syncthreads();
}
__device__ __forceinline__ void p12_route(Frame& F, int cbase = CW_CNT) {
    const int tid_ = tid_opaque(), lane_ = tid_ & 63; (void)lane_;
    const float* LG = WSP(float, WS_LOGITS); const float* br = INP(20); unsigned* cnt = WSP(unsigned, WS_CTL) + cbase;
    int* TE = WSP(int, WS_TE); int* TP = WSP(int, WS_TP); float* TW = WSP(float, WS_TW);
    LAS int* cw = (LAS int*)F.lds; LAS int* basee = cw + 512;
    const int lane = lane_; const float brl = br[lane];
    for (int tblk = blockIdx.x; tblk < NTOK / 64; tblk += F.G) {
        __syncthreads();
        int c = 0; unsigned selm = 0u, posb = 0u, kb = 0u; float wv[8];
#pragma unroll
        for (int k = 0; k < 8; ++k) { const int t = tblk * 64 + F.wave * 8 + k;
            const float s = sigm(LG[(size_t)t * 64 + lane]); const float sb = s + brl;
            const int grp = lane >> 3; float m1 = -INFINITY, m2 = -INFINITY;
#pragma unroll
            for (int i = 0; i < 8; ++i) { const float v = __shfl(sb, grp * 8 + i); if (v > m1) { m2 = m1; m1 = v; } else if (v > m2) { m2 = v; } }
            const float gs = m1 + m2; int grank = 0;
#pragma unroll
            for (int gi = 0; gi < 8; ++gi) { const float o = __shfl(gs, gi * 8); grank += ((o > gs) || (o == gs && gi < grp)) ? 1 : 0; }
            const float ms = (grank < 4) ? sb : -1e9f; int rank = 0;
            for (int i = 0; i < 64; ++i) { const float o = rdlane(ms, i); rank += ((o > ms) || (o == ms && i < lane)) ? 1 : 0; }
            const bool sel = rank < 8;
            const float wsum = wave_sum(sel ? s : 0.f);
            const unsigned long long bal = __ballot(sel);
            wv[k] = s / wsum * 2.5f;
            if (sel) { selm |= 1u << k; posb |= (unsigned)c << (3 * k); kb |= (unsigned)(__popcll(bal & ((1ull << lane) - 1ull)) & 7) << (3 * k); ++c; } }
        cw[F.wave * 64 + lane] = c;
        __syncthreads();
        if (F.wave == 0) { int tot = 0;
#pragma unroll
            for (int w = 0; w < 8; ++w) tot += cw[w * 64 + lane];
            basee[lane] = tot ? (int)atomicAdd(&cnt[lane], (unsigned)tot) : 0; }
        __syncthreads();
        int off = basee[lane];
        for (int w = 0; w < F.wave; ++w) off += cw[w * 64 + lane];
#pragma unroll
        for (int k = 0; k < 8; ++k) if ((selm >> k) & 1u) { const int t = tblk * 64 + F.wave * 8 + k; const int idx = t * 8 + (int)((kb >> (3 * k)) & 7u);
            TE[idx] = lane; TP[idx] = off + (int)((posb >> (3 * k)) & 7u); TW[idx] = wv[k]; }
    }
    __syncthreads();
}
__device__ __forceinline__ void p13_slots(Frame& F) {
    const int tid_ = tid_opaque(), lane_ = tid_ & 63; (void)lane_;
    unsigned* cnt = WSP(unsigned, WS_CTL) + CW_CNT; LAS int* rs = (LAS int*)F.lds;
    const int* TE = WSP(int, WS_TE); const int* TP = WSP(int, WS_TP); const float* TW = WSP(float, WS_TW);
    int* TOKSLOT = WSP(int, WS_TOKSLOT); int* SLOTTOK = WSP(int, WS_SLOTTOK); float* SLOTW = WSP(float, WS_SLOTW); int* RT = WSP(int, WS_RT);
    LAS int* ts = rs + 80;
    if (tid_ < 64) { const int c = (int)__hip_atomic_load(cnt + tid_, RLX_AGENT); const int nt_ = (c + 255) >> 8; int a = c, tt = nt_;
#pragma unroll
        for (int o = 1; o < 64; o <<= 1) { const int n = __shfl_up(a, o), n2 = __shfl_up(tt, o); if (lane_ >= o) { a += n; tt += n2; } }
        rs[tid_ + 1] = a; ts[tid_ + 1] = tt; if (tid_ == 0) { rs[0] = 0; ts[0] = 0; } }
    __syncthreads();
    const int gt = blockIdx.x * 512 + tid_, ngt = F.G * 512;
    for (int idx = gt; idx < NSLOT; idx += ngt) { const int e = TE[idx], slot = rs[e] + TP[idx]; SLOTTOK[slot] = idx >> 3; SLOTW[slot] = TW[idx]; TOKSLOT[idx] = slot; }
    for (int idx = gt; idx < NTOK; idx += ngt) { SLOTTOK[NSLOT + idx] = idx; SLOTW[NSLOT + idx] = 1.f; }
    if (blockIdx.x == 0) {
        if (tid_ < 64) { const int e = tid_, c = rs[e + 1] - rs[e]; int j = ts[e]; for (int r = 0; r * 256 < c; ++r, ++j) { RT[3 * j] = e; RT[3 * j + 1] = rs[e] + 256 * r; RT[3 * j + 2] = (c - 256 * r) < 256 ? (c - 256 * r) : 256; } }
        else if (tid_ < 128) { const int r = tid_ - 64, j = ts[64] + r; RT[3 * j] = 64; RT[3 * j + 1] = NSLOT + 256 * r; RT[3 * j + 2] = 256; }
        if (tid_ == 0) __hip_atomic_store(WSP(unsigned, WS_CTL) + CW_NTILES, (unsigned)(ts[64] + 64), RLX_AGENT);
    }
    __syncthreads();
}
__device__ __forceinline__ void p16_final(Frame& F, bool do_store = true) {
    const int tid_ = tid_opaque(), lane_ = tid_ & 63; (void)lane_;
    const unsigned char* YS = WSP(unsigned char, WS_YSLOT); const int* TOKSLOT = WSP(int, WS_TOKSLOT); const float* gpost = INP(18); const float* mod = WSP(float, WS_MOD);
    LAS float* A = (LAS float*)F.lds;
    int cur_b = -1;
    for (int blk = blockIdx.x; blk < NTOK / 64; blk += F.G) {
        const int b = blk >> 5;
        if (b != cur_b) { __syncthreads();
            const f32x4 g = *(const f32x4*)(gpost + 4 * tid_), gt = *(const f32x4*)(mod + b * 12288 + 10240 + 4 * tid_);
            *(LAS f32x4*)(A + 4 * tid_) = g * gt * (1.f / 64.f); __syncthreads(); cur_b = b; }
        const int row0 = blk * 64 + F.wave * 8;
        const int myslot = TOKSLOT[row0 * 8 + lane_];
        int q[3][24]; f32x4 xx[8];
#define P16_ISSUE(kk, gg) do { _Pragma("unroll") for (int r = 0; r < 3; ++r) { const int k9 = 3 * (gg) + r; \
            const int slot = (k9 < 8) ? __builtin_amdgcn_readlane(myslot, (kk) * 8 + k9) : NSLOT + row0 + (kk); \
            const GAS int* yr = UPTR(const int, YS + (size_t)slot * DM) + lane_; \
            _Pragma("unroll") for (int j = 0; j < 8; ++j) q[gg][8 * r + j] = yr[64 * j]; } } while (0)
        P16_ISSUE(0, 0); P16_ISSUE(0, 1); P16_ISSUE(0, 2);
#pragma unroll 1
        for (int k = 0; k < 8; ++k) {
            const int row = row0 + k;
            { const GAS f32x4* xr = UPTR(const f32x4, F.out + (size_t)row * DM) + lane_;
#pragma unroll
              for (int j = 0; j < 8; ++j) xx[j] = xr[64 * j]; }
            f32x4 acc[8];
#pragma unroll
            for (int j = 0; j < 8; ++j) acc[j] = (f32x4){0.f, 0.f, 0.f, 0.f};
#pragma unroll
            for (int g = 0; g < 3; ++g) {
#pragma unroll
                for (int r = 0; r < 3; ++r)
#pragma unroll
                    for (int j = 0; j < 8; ++j) { const int w = q[g][8 * r + j]; const f32x2 lo = __builtin_amdgcn_cvt_pk_f32_fp8(w, false), hi = __builtin_amdgcn_cvt_pk_f32_fp8(w, true);
                        acc[j].x += lo.x; acc[j].y += lo.y; acc[j].z += hi.x; acc[j].w += hi.y; }
                if (k + 1 < 8) P16_ISSUE(k + 1, g);
            }
            float s = 0.f;
#pragma unroll
            for (int j = 0; j < 8; ++j) s += (acc[j].x * acc[j].x + acc[j].y * acc[j].y) + (acc[j].z * acc[j].z + acc[j].w * acc[j].w);
            const float rstd = rsqrtf(wave_sum(s) * (1.f / (4096.f * DM)) + EPS);
            GAS f32x4* orow = UPTR(f32x4, F.out + (size_t)row * DM) + lane_;
            unsigned aoff = 16u * (unsigned)lane_; asm volatile("" : "+v"(aoff));
#pragma unroll
            for (int j = 0; j < 8; ++j) { const f32x4 a = *(LAS f32x4*)((LAS unsigned char*)A + aoff + 1024 * j);
                if (do_store || F.G == 12345) orow[64 * j] = xx[j] + a * (acc[j] * rstd); }
        }
#undef P16_ISSUE
    }
}

constexpr int NPHASE = 17;
struct Args { const float* in[27]; float* out; unsigned char* ws; int ph_lo, ph_hi, li, pad; };
__global__ void __launch_bounds__(512, 2) mega_fwd(Args args) {
    extern __shared__ __attribute__((aligned(16))) unsigned char lds[];
    Frame F;
    F.lds = (LAS unsigned char*)lds; F.ws = args.ws; F.in = args.in; F.out = args.out;
    F.tid = threadIdx.x; F.lane = F.tid & 63; F.wave = __builtin_amdgcn_readfirstlane(F.tid >> 6); F.G = gridDim.x;
    F.gw = blockIdx.x * 8 + F.wave; F.ngw = F.G * 8;
    volatile LAS unsigned* MISC = (volatile LAS unsigned*)(F.lds + MISC_OFF);
    for (int u = F.tid; u < (LDS_BYTES - LDSCTL_OFF) / 4; u += 512) ((LAS unsigned*)(F.lds + LDSCTL_OFF))[u] = 0u;
    __syncthreads();
    unsigned* ctl = (unsigned*)(args.ws + WS_CTL);
    XcdBarrier bar; bar.bar = ctl + CW_BAR; bar.x = 0; bar.st = nullptr;
    if (!MK_PER_PHASE) bar = xcd_barrier_post(ctl + CW_BAR, MISC + 8);
    const int lo = args.ph_lo, hi = args.ph_hi;
#define IN(k) (lo <= (k) && (k) < hi)
#define SEAM(k) do { if (IN(k) && IN((k) + 1)) xcd_barrier(bar); } while (0)
    bf16* PROJ = WSP(bf16, WS_PROJ);
    int chunk = 0;
    const int vcu_ = (F.G % 8 == 0) ? (int)(blockIdx.x % 8) * (F.G / 8) + (int)(blockIdx.x / 8) : (int)blockIdx.x;

    if (IN(0)) { p0_bias1(F); p0_early(F); } SEAM(0);
    if (IN(1)) REP(1, { p1_h1(F); }); SEAM(1);
    if (IN(2)) REP(2, {
        { pg8::Gemm g{WSP(bf16, WS_H1), WSP(bf16, WS_WIN), DM, 128, 0, 0}; pg8::StaticOrder S; S.init(NTOK, PN_BF, F.G, (int)blockIdx.x, PRB(2));
          pg8::EpiBf16 E{PROJ, PLD, 4, QC2};
          pg8::gemm_phase<pg8::EpiBf16, pg8::StaticOrder, false, true>(F.lds, g, S, E); }
        { pg8::Gemm g{WSP(unsigned char, WS_H1Q), WSP(unsigned char, WS_WIN8), DM, 128, 127 - 6, 127}; pg8::StaticOrder S; S.init(NTOK, PN_F8, F.G, (int)blockIdx.x, PRB(3));
          pg8::EpiBf16 E{PROJ + PN_BF, PLD, 1 << 20, 1.f / 64.f};
          pg8::gemm_phase<pg8::EpiBf16, pg8::StaticOrder, false, true, true>(F.lds, g, S, E); }
    }); SEAM(2);
    if (IN(3)) REP(3, { p3_conv(F); p3_gates(F); }); SEAM(3);
    if (IN(4)) {
        { pg8::Gemm g{PROJ, WSP(bf16, WS_CW1), DM, PLD * 2, 0, 0}; pg8::CmpOrder S{F.G, (int)blockIdx.x}; pg8::EpiCmpHid E{WSP(bf16, WS_HIDC), WSP(float, WS_BIAS1)};
          pg8::gemm_phase<pg8::EpiCmpHid, pg8::CmpOrder, true, true>(F.lds, g, S, E);
          if ((int)blockIdx.x < 32) kcv_unit(F, (int)blockIdx.x >> 4, (int)blockIdx.x & 15); }
        p5_mlstm(F, chunk); } SEAM(4);
    if (IN(6)) { p6_sel_win(F, chunk); } SEAM(6);
    if (IN(7)) REP(7, {
        pg8::Gemm g{WSP(bf16, WS_OMIX), WSP(bf16, WS_WUP), DM, 128, 0, 0}; pg8::StaticOrder S; S.init(NTOK, DM, F.G, (int)blockIdx.x);
        pg8::EpiGate E{WSP(bf16, WS_MERGED), PROJ + PC_GB, PLD, nullptr}; pg8::MidGate MH{PROJ + PC_GA, PROJ + PC_GB, PLD};
        pg8::gemm_phase<pg8::EpiGate, pg8::StaticOrder, false, true, false, false, pg8::MidGate>(F.lds, g, S, E, MH);
    }); SEAM(7);
    if (IN(9)) REP(9, {
        pg8::Gemm g{WSP(bf16, WS_MERGED), WSP(bf16, WS_WOUT), DM, 128, 0, 0}; pg8::StaticOrder S; S.init(NTOK, DM, F.G, (int)blockIdx.x);
        pg8::EpiBf16 E{WSP(bf16, WS_Y), DM, 0, 1.f};
        pg8::gemm_phase<pg8::EpiBf16, pg8::StaticOrder, false, true>(F.lds, g, S, E);
    }); SEAM(9);
    if (IN(10)) REP(10, { p10_rows(F); }); SEAM(10);
    if (IN(11)) REP(11, {
        pg8::Gemm g{WSP(bf16, WS_H2), WSP(bf16, WS_WR), DM, 128, 0, 0}; pg8::StaticOrder S; S.init(NTOK, 256, F.G, (int)blockIdx.x);
        pg8::EpiF32 E{WSP(float, WS_LOGITS), 64, 64};
        pg8::gemm_phase<pg8::EpiF32, pg8::StaticOrder, false, true>(F.lds, g, S, E);
    }); SEAM(11);
    if (IN(12)) { if ((PROBE_DUP >> 12) & 1) p12_route(F, 256); p12_route(F); } SEAM(12);
    if (IN(13)) REP(13, { p13_slots(F); }); SEAM(13);
    if (IN(14)) REP(14, {
        const int ntiles = (int)__hip_atomic_load(ctl + CW_NTILES, RLX_AGENT);
        LAS int* rtc = (LAS int*)(F.lds + RT_LDS_OFF); for (int i = threadIdx.x; i < 3 * ntiles; i += 512) rtc[i] = WSP(int, WS_RT)[i]; __syncthreads();
        pg8::Gemm g{WSP(unsigned char, WS_H2Q), WSP(unsigned char, WS_WEGU), DM, 128, 127 - 6, 127}; pg8::MoeOrder S{rtc, ntiles, 4, F.G, vcu_, WSP(int, WS_SLOTTOK), 2048u, PRB(14)};
        pg8::EpiSwiglu E{WSP(unsigned char, WS_HID), WSP(float, WS_SLOTW)};
        pg8::gemm_phase<pg8::EpiSwiglu, pg8::MoeOrder, true, true, true, false>(F.lds, g, S, E);
    }); SEAM(14);
    if (IN(15)) REP(15, {
        const int ntiles = (int)__hip_atomic_load(ctl + CW_NTILES, RLX_AGENT);
        LAS int* rtc = (LAS int*)(F.lds + RT_LDS_OFF); for (int i = threadIdx.x; i < 3 * ntiles; i += 512) rtc[i] = WSP(int, WS_RT)[i]; __syncthreads();
        pg8::Gemm g{WSP(unsigned char, WS_HID), WSP(unsigned char, WS_WED), EFF, 128, 127 - 6, 127 - 4}; pg8::MoeOrder S{rtc, ntiles, 8, F.G, vcu_, nullptr, 512u, PRB(15)};
        pg8::EpiFp8 E{WSP(unsigned char, WS_YSLOT), DM, 64.f / 1024.f};
        pg8::gemm_phase<pg8::EpiFp8, pg8::MoeOrder, false, true, true>(F.lds, g, S, E);
    }); SEAM(15);
    if (IN(16)) { if ((PROBE_DUP >> 16) & 1) p16_final(F, false); p16_final(F); }
#undef IN
#undef SEAM
}

extern "C" void kernel_launch(void* const* d_in, const int* in_sizes, int n_in, void* d_out, int out_size, void* d_ws, size_t ws_size, hipStream_t stream) {
    static int grid = 0;
    if (grid == 0) {
        if (n_in != 27 || out_size != NTOK * DM || ws_size < WS_END) { fprintf(stderr, "kernel_launch: unexpected shapes (n_in %d out %d ws %zu)\n", n_in, out_size, ws_size); grid = -1; return; }
        int dev = 0, cus = 0, per_cu = 0;
        if (hipGetDevice(&dev) != hipSuccess || hipDeviceGetAttribute(&cus, hipDeviceAttributeMultiprocessorCount, dev) != hipSuccess) { grid = -1; return; }
        if (hipFuncSetAttribute((const void*)mega_fwd, hipFuncAttributeMaxDynamicSharedMemorySize, LDS_BYTES) != hipSuccess) { fprintf(stderr, "kernel_launch: hipFuncSetAttribute failed\n"); grid = -1; return; }
        if (hipOccupancyMaxActiveBlocksPerMultiprocessor(&per_cu, (const void*)mega_fwd, 512, LDS_BYTES) != hipSuccess || per_cu < 1) fprintf(stderr, "kernel_launch: occupancy query says %d\n", per_cu);
        (void)hipGetLastError();
        grid = cus;
    }
    if (grid < 0) return;
    (void)hipMemsetAsync((char*)d_ws + WS_CTL, 0, CTL_ZERO_BYTES, stream);
    Args a{};
    for (int i = 0; i < 27; ++i) a.in[i] = (const float*)d_in[i];
    a.out = (float*)d_out; a.ws = (unsigned char*)d_ws;
#if MK_PER_PHASE
    for (int p = 0; p < NPHASE; ++p) { a.ph_lo = p; a.ph_hi = p + 1; a.li = p; hipLaunchKernelGGL(mega_fwd, dim3(grid), dim3(512), LDS_BYTES, stream, a); }
#else
    a.ph_lo = 0; a.ph_hi = NPHASE; a.li = 0;
    hipLaunchKernelGGL(mega_fwd, dim3(grid), dim3(512), LDS_BYTES, stream, a);
#endif
}
```

```cpp
#include <hip/hip_runtime.h>
#include <cstdio>
#include <cstdint>

#define GAS __attribute__((address_space(1)))
#define LAS __attribute__((address_space(3)))
typedef unsigned short bf16;
typedef unsigned v4u __attribute__((ext_vector_type(4)));
typedef unsigned v2u __attribute__((ext_vector_type(2)));
typedef float f32x4 __attribute__((ext_vector_type(4)));
typedef float f32x2 __attribute__((ext_vector_type(2)));
typedef short bf16x8 __attribute__((ext_vector_type(8)));
typedef GAS unsigned gu32;
typedef int v8i __attribute__((ext_vector_type(8)));
typedef int v4i __attribute__((ext_vector_type(4)));

#ifndef PROBE_DUP
#define PROBE_DUP 0x0
#endif
#define PRB(k) (1 + ((PROBE_DUP >> (16 + (k))) & 1))
#define REP(k, ...) do { __VA_ARGS__ if ((PROBE_DUP >> (k)) & 1) { __VA_ARGS__ } } while (0)
#ifndef MK_PER_PHASE
#define MK_PER_PHASE 0
#endif

constexpr int NB = 8, SEQ = 2048, DM = 2048, NTOK = NB * SEQ;
constexpr int PLD = 9984;
constexpr int PC_Q = 0, PC_KC = 1024, PC_KS = 1280, PC_KW = 1536, PC_QKM = 1792, PC_G3 = 2816, PC_IF = 2864, PC_VC = 3072, PC_VS = 3328, PC_VW = 3584, PC_VM = 3840, PC_OM = 4864, PC_GA = 5888, PC_GB = 7936;
constexpr int PN_BF = 3072, PN_F8 = 6912;
constexpr int D_IN = 9784;
constexpr int NEXP = 64, EFF = 512;
constexpr int NSLOT = NTOK * 8;
constexpr int NSLOT_ALL = NSLOT + NTOK;
constexpr float EPS = 1e-6f;
constexpr float QC2 = 0.18033688011112042f;

constexpr size_t MiB = 1u << 20;
constexpr size_t WS_CTL = 0, CTL_ZERO_BYTES = 64 * 1024;
constexpr size_t WS_MOD = 1 * MiB;
constexpr size_t WS_BIAS1 = 1 * MiB + 512 * 1024;
constexpr size_t WS_GA = 2 * MiB, WS_GU = 2 * MiB + 256 * 1024, WS_GM = 2 * MiB + 512 * 1024;
constexpr size_t WS_SELM = 3 * MiB;
constexpr size_t WS_KCV = 4 * MiB;
constexpr size_t WS_HIDC = 6 * MiB;
constexpr size_t WS_TE = 14 * MiB, WS_TP = 14 * MiB + 512 * 1024, WS_TW = 15 * MiB, WS_TOKSLOT = 15 * MiB + 512 * 1024;
constexpr size_t WS_SLOTTOK = 16 * MiB, WS_SLOTW = 17 * MiB, WS_RT = 18 * MiB;
constexpr size_t WS_LOGITS = 19 * MiB;
constexpr size_t WS_WED = 32 * MiB;
constexpr size_t WS_WOUT = 162 * MiB;
constexpr size_t WS_WUP = 170 * MiB;
constexpr size_t WS_CW1 = 178 * MiB;
constexpr size_t WS_CW2 = 181 * MiB;
constexpr size_t WS_WR = 180 * MiB;
constexpr size_t WS_H2 = 182 * MiB;
constexpr size_t WS_HID = 246 * MiB;
constexpr size_t WS_H2Q = 340 * MiB;
constexpr size_t WS_WIN = 392 * MiB;
constexpr size_t WS_WIN8 = 412 * MiB;
constexpr size_t WS_WEGU = 432 * MiB;
constexpr size_t WS_PROJ = 692 * MiB;
constexpr size_t WS_H1 = 1004 * MiB;
constexpr size_t WS_H1Q = 1068 * MiB;
constexpr size_t WS_END = 1100 * MiB;
constexpr size_t WS_OACC = WS_HID;
constexpr size_t WS_OMIX = WS_HID + 64 * MiB;
constexpr size_t WS_T1 = WS_H2;
constexpr size_t WS_QKC = WS_H1;
constexpr size_t WS_MERGED = WS_H1;
constexpr size_t WS_Y = WS_PROJ;
constexpr size_t WS_YSLOT = WS_WEGU;
static_assert(WS_YSLOT + (size_t)NSLOT_ALL * 2048 <= WS_END, "yslot");
static_assert(WS_HID + (size_t)(NSLOT_ALL + 256) * 512 <= WS_H2Q && WS_H2Q + (size_t)NTOK * DM <= WS_WIN, "hid");
constexpr int CW_CNT = 64;
constexpr int CW_MLQ = 200;
constexpr int CW_NTILES = 192;
constexpr int CW_BAR = 4096;

constexpr int RT_LDS_OFF = 131072 + 512 + 4096;
constexpr int RING_BYTES = 131072, LDSCTL_OFF = RING_BYTES, MISC_OFF = LDSCTL_OFF + 320, LDS_BYTES = 147456;

#define LDS_WAIT() asm volatile("s_waitcnt lgkmcnt(0)" ::: "memory")
#define VM_WAIT() asm volatile("s_waitcnt vmcnt(0)" ::: "memory")
#define RLX_AGENT __ATOMIC_RELAXED, __HIP_MEMORY_SCOPE_AGENT
__device__ __forceinline__ unsigned f2bf(float f) { unsigned u = __builtin_bit_cast(unsigned, f); return (u + 0x7fffu + ((u >> 16) & 1u)) >> 16; }
__device__ __forceinline__ unsigned pk2(float lo, float hi) { return f2bf(lo) | (f2bf(hi) << 16); }
__device__ __forceinline__ float bf2f(unsigned h) { return __uint_as_float(h << 16); }
__device__ __forceinline__ float bflo(unsigned w) { return __uint_as_float(w << 16); }
__device__ __forceinline__ float bfhi(unsigned w) { return __uint_as_float(w & 0xffff0000u); }
__device__ __forceinline__ float sigm(float x) { return 1.f / (1.f + __expf(-x)); }
__device__ __forceinline__ float wave_sum(float v) {
#pragma unroll
    for (int o = 1; o < 64; o <<= 1) v += __shfl_xor(v, o);
    return v;
}
__device__ __forceinline__ float wave_max(float v) {
#pragma unroll
    for (int o = 1; o < 64; o <<= 1) v = fmaxf(v, __shfl_xor(v, o));
    return v;
}
__device__ __forceinline__ unsigned long long uaddr(const void* p) {
    const unsigned long long a = (unsigned long long)p; const unsigned lo = __builtin_amdgcn_readfirstlane((unsigned)a), hi = __builtin_amdgcn_readfirstlane((unsigned)(a >> 32));
    return ((unsigned long long)hi << 32) | lo; }
#define UPTR(T, p) ((GAS T*)uaddr(p))
__device__ __forceinline__ int tid_opaque() { int t = threadIdx.x; asm volatile("" : "+v"(t)); return t; }
__device__ __forceinline__ float rdlane(float v, int l) { return __int_as_float(__builtin_amdgcn_readlane(__float_as_int(v), l)); }

namespace pg8 {
constexpr int BM = 256, BK = 64, HALF = 128, HTB = HALF * BK * 2, STAGE_BYTES = 8 * HTB, NXCD = 8, WGM = 8;
__host__ __device__ __forceinline__ int lds_byte(int r, int c) { const int st = (r >> 4) * 2 + (c >> 5), rr = r & 15, cc = c & 31, ob = rr * 64 + cc * 2; return st * 1024 + (ob ^ (((ob >> 9) & 1) << 5)); }
__host__ __device__ __forceinline__ void stage_rc(int b, int& R, int& C) { const int st = b / 1024, sb = b % 1024, swz = sb ^ (((sb >> 9) & 1) << 5); R = (st >> 1) * 16 + swz / 64; C = (st & 1) * 32 + (swz % 64) / 2; }
__host__ __device__ __forceinline__ int perm32(int rho) { const int n = rho >> 4, i = rho & 15; return 8 * (i >> 2) + 4 * n + (i & 3); }

struct Unit { int arow, pn, valid, aux; };
struct Gemm { const void* A; const void* Bt; int K; int kstepA; int scW, scX; };

struct StaticOrder {
    int nM, nN, nwg, G, c, reps;
    __device__ void init(int M, int N, int G_, int c_, int reps_ = 1) { nM = M / BM; nN = N / BM; nwg = nM * nN; G = G_; c = c_; reps = reps_; }
    __device__ bool next(int i, Unit& u) const {
        long L = (long)i * G + c; if (L >= (long)nwg * reps) return false; L %= nwg;
        int wgid = (int)L; { const int q = nwg / NXCD, r = nwg % NXCD, xcd = wgid % NXCD, off = wgid / NXCD; wgid = (xcd < r ? xcd * (q + 1) : r * (q + 1) + (xcd - r) * q) + off; }
        const int nig = WGM * nN, gid = wgid / nig, fm = gid * WGM, gsz = (nM - fm) < WGM ? (nM - fm) : WGM;
        u.arow = (fm + ((wgid % nig) % gsz)) * BM; u.pn = (wgid % nig) / gsz; u.valid = BM; u.aux = u.pn; return true;
    }
    __device__ __forceinline__ unsigned rowkey(const Unit&, int) const { return 0u; }
    __device__ __forceinline__ unsigned keyoff(const Unit&, unsigned) const { return 0u; }
};
struct CmpOrder {
    int G, c;
    __device__ bool next(int i, Unit& u) const { const int L = i * G + c; if (L >= 32) return false; const int kv = L >> 4, pm = L & 15; u.arow = 256 * pm; u.pn = kv; u.valid = (4064 - 256 * pm) < 256 ? (4064 - 256 * pm) : 256; u.aux = kv; return true; }
    __device__ __forceinline__ unsigned rowkey(const Unit& u, int lr) const { int rr = u.arow + lr; rr = (rr < 4064) ? rr : 0; const int b = rr / 508, n = (rr % 508) >> 2, g = rr & 3; return (unsigned)((b * SEQ + 16 * n) | (g << 14)); }
    __device__ __forceinline__ unsigned keyoff(const Unit& u, unsigned key) const { return (unsigned)(((size_t)(key & 0x3fffu) * PLD + (u.aux ? PC_VC : PC_KC) + (key >> 14) * 64) * 2); }
};
struct MoeOrder {
    const LAS int* rt; int ntiles, NCT, G, c; const int* rows; unsigned rbytes; int reps;
    __device__ __forceinline__ unsigned rowkey(const Unit& u, int lr) const { return (unsigned)((lr < u.valid) ? rows[u.arow + lr] : 0); }
    __device__ __forceinline__ unsigned keyoff(const Unit&, unsigned key) const { return key * rbytes; }
    __device__ bool next(int i, Unit& u) const {
        long L = (long)i * G + c; if (L >= (long)ntiles * NCT * reps) return false; L %= (long)ntiles * NCT;
        const int j = (int)(L / NCT), ct = (int)(L % NCT);
        const int e = __builtin_amdgcn_readfirstlane(rt[3 * j]), base = __builtin_amdgcn_readfirstlane(rt[3 * j + 1]), v = __builtin_amdgcn_readfirstlane(rt[3 * j + 2]);
        u.arow = base; u.pn = e * NCT + ct; u.valid = v; u.aux = ct; return true;
    }
};

__device__ __forceinline__ unsigned cvt_pk_bf16(float lo, float hi) { unsigned r; asm volatile("v_cvt_pk_bf16_f32 %0, %1, %2" : "=v"(r) : "v"(lo), "v"(hi)); return r; }

struct EpiBf16 {
    static constexpr bool PERM = true;
    bf16* O; int ldc; int nscaled; float scale0;
    __device__ __forceinline__ void operator()(const f32x4 (&acc)[2][2][4][2], const Unit& u, int wr, int wc, int fr, int fq) const {
        const float sc = (u.aux < nscaled) ? scale0 : 1.f;
#pragma unroll
        for (int ai = 0; ai < 2; ++ai)
#pragma unroll
            for (int m = 0; m < 4; ++m) { const int lr = ai * HALF + wr * 64 + m * 16 + fr; if (lr < u.valid) { bf16* rowp = O + (size_t)(u.arow + lr) * ldc + u.aux * BM + wc * 32 + 8 * fq;
#pragma unroll
                for (int bj = 0; bj < 2; ++bj) { const f32x4 v0 = acc[ai][bj][m][0] * sc, v1 = acc[ai][bj][m][1] * sc; v4u w; w.x = cvt_pk_bf16(v0[0], v0[1]); w.y = cvt_pk_bf16(v0[2], v0[3]); w.z = cvt_pk_bf16(v1[0], v1[1]); w.w = cvt_pk_bf16(v1[2], v1[3]);
                    *(v4u*)(rowp + bj * HALF) = w; } } }
    }
};
struct EpiFp8 {
    static constexpr bool PERM = true;
    unsigned char* O; int ldc; float scale;
    __device__ __forceinline__ void operator()(const f32x4 (&acc)[2][2][4][2], const Unit& u, int wr, int wc, int fr, int fq) const {
#pragma unroll
        for (int ai = 0; ai < 2; ++ai)
#pragma unroll
            for (int m = 0; m < 4; ++m) { const int lr = ai * HALF + wr * 64 + m * 16 + fr; if (lr < u.valid) { unsigned char* rowp = O + (size_t)(u.arow + lr) * ldc + u.aux * BM + wc * 32 + 8 * fq;
#pragma unroll
                for (int bj = 0; bj < 2; ++bj) { float r[8];
#pragma unroll
                    for (int n = 0; n < 2; ++n)
#pragma unroll
                        for (int k = 0; k < 4; ++k) r[4 * n + k] = fminf(fmaxf(acc[ai][bj][m][n][k] * scale, -448.f), 448.f);
                    int o0 = 0, o1 = 0; o0 = __builtin_amdgcn_cvt_pk_fp8_f32(r[0], r[1], o0, false); o0 = __builtin_amdgcn_cvt_pk_fp8_f32(r[2], r[3], o0, true);
                    o1 = __builtin_amdgcn_cvt_pk_fp8_f32(r[4], r[5], o1, false); o1 = __builtin_amdgcn_cvt_pk_fp8_f32(r[6], r[7], o1, true);
                    v2u o; o.x = (unsigned)o0; o.y = (unsigned)o1; *(v2u*)(rowp + bj * HALF) = o; } } }
    }
};
struct EpiGate {
    static constexpr bool PERM = true;
    bf16* O; const bf16* gate; int ldg; const bf16* prev;
    __device__ __forceinline__ void operator()(const f32x4 (&acc)[2][2][4][2], const Unit& u, int wr, int wc, int fr, int fq) const {
#pragma unroll
        for (int ai = 0; ai < 2; ++ai)
#pragma unroll
            for (int m = 0; m < 4; ++m) { const int row = u.arow + ai * HALF + wr * 64 + m * 16 + fr; const int col = u.pn * BM + wc * 32 + 8 * fq;
#pragma unroll
                for (int bj = 0; bj < 2; ++bj) {
                    const v4u gq = *(const v4u*)(gate + (size_t)row * ldg + col + bj * HALF);
                    const f32x4 v0 = acc[ai][bj][m][0], v1 = acc[ai][bj][m][1];
                    float r[8];
                    r[0] = sigm(bflo(gq.x)) * v0[0]; r[1] = sigm(bfhi(gq.x)) * v0[1]; r[2] = sigm(bflo(gq.y)) * v0[2]; r[3] = sigm(bfhi(gq.y)) * v0[3];
                    r[4] = sigm(bflo(gq.z)) * v1[0]; r[5] = sigm(bfhi(gq.z)) * v1[1]; r[6] = sigm(bflo(gq.w)) * v1[2]; r[7] = sigm(bfhi(gq.w)) * v1[3];
                    if (prev) { const v4u pq = *(const v4u*)(prev + (size_t)row * 2048 + col + bj * HALF);
                        r[0] += bflo(pq.x); r[1] += bfhi(pq.x); r[2] += bflo(pq.y); r[3] += bfhi(pq.y); r[4] += bflo(pq.z); r[5] += bfhi(pq.z); r[6] += bflo(pq.w); r[7] += bfhi(pq.w); }
                    v4u w; w.x = cvt_pk_bf16(r[0], r[1]); w.y = cvt_pk_bf16(r[2], r[3]); w.z = cvt_pk_bf16(r[4], r[5]); w.w = cvt_pk_bf16(r[6], r[7]);
                    *(v4u*)(O + (size_t)row * 2048 + col + bj * HALF) = w; } }
    }
};
struct MidGate {
    static constexpr bool ON = true;
    const bf16* ga; const bf16* gb; int ldg;
    __device__ __forceinline__ void operator()(f32x4 (&acc)[2][2][4][2], const Unit& u, int wr, int wc, int fr, int fq) const {
#pragma unroll
        for (int ai = 0; ai < 2; ++ai)
#pragma unroll
            for (int m = 0; m < 4; ++m) { const size_t off = (size_t)(u.arow + ai * HALF + wr * 64 + m * 16 + fr) * ldg + u.pn * BM + wc * 32 + 8 * fq;
#pragma unroll
                for (int bj = 0; bj < 2; ++bj) { const v4u a = *(const v4u*)(ga + off + bj * HALF), b = *(const v4u*)(gb + off + bj * HALF);
#define MG_R(xa, xb) ((1.f + __expf(-(xb))) / (1.f + __expf(-(xa))))
                    acc[ai][bj][m][0][0] *= MG_R(bflo(a.x), bflo(b.x)); acc[ai][bj][m][0][1] *= MG_R(bfhi(a.x), bfhi(b.x)); acc[ai][bj][m][0][2] *= MG_R(bflo(a.y), bflo(b.y)); acc[ai][bj][m][0][3] *= MG_R(bfhi(a.y), bfhi(b.y));
                    acc[ai][bj][m][1][0] *= MG_R(bflo(a.z), bflo(b.z)); acc[ai][bj][m][1][1] *= MG_R(bfhi(a.z), bfhi(b.z)); acc[ai][bj][m][1][2] *= MG_R(bflo(a.w), bflo(b.w)); acc[ai][bj][m][1][3] *= MG_R(bfhi(a.w), bfhi(b.w));
#undef MG_R
                } }
    }
};
struct EpiF32 {
    static constexpr bool PERM = false;
    float* C; int ldc; int ncols;
    __device__ __forceinline__ void operator()(const f32x4 (&acc)[2][2][4][2], const Unit& u, int wr, int wc, int fr, int fq) const {
#pragma unroll
        for (int ai = 0; ai < 2; ++ai)
#pragma unroll
            for (int m = 0; m < 4; ++m) { float* rowp = C + (size_t)(u.arow + ai * HALF + wr * 64 + m * 16 + fr) * ldc; const int col0 = u.pn * BM + wc * 32 + 4 * fq;
#pragma unroll
                for (int bj = 0; bj < 2; ++bj)
#pragma unroll
                    for (int n = 0; n < 2; ++n) { const int col = col0 + bj * HALF + n * 16; if (col < ncols) *(f32x4*)(rowp + col) = acc[ai][bj][m][n]; } }
    }
};
struct EpiCmpHid {
    static constexpr bool PERM = true;
    bf16* H; const float* bias;
    __device__ __forceinline__ void operator()(const f32x4 (&acc)[2][2][4][2], const Unit& u, int wr, int wc, int fr, int fq) const {
        f32x4 bv[2][2];
#pragma unroll
        for (int bj = 0; bj < 2; ++bj)
#pragma unroll
            for (int n = 0; n < 2; ++n) bv[bj][n] = *(const f32x4*)(bias + u.aux * 256 + bj * HALF + wc * 32 + 8 * fq + 4 * n);
#pragma unroll
        for (int ai = 0; ai < 2; ++ai)
#pragma unroll
            for (int m = 0; m < 4; ++m) { const int lr = ai * HALF + wr * 64 + m * 16 + fr; if (lr < u.valid) { bf16* rowp = H + (size_t)(u.aux * 4096 + u.arow + lr) * 256 + wc * 32 + 8 * fq;
#pragma unroll
                for (int bj = 0; bj < 2; ++bj) { float r[8];
#pragma unroll
                    for (int n = 0; n < 2; ++n)
#pragma unroll
                        for (int k = 0; k < 4; ++k) { const float x = acc[ai][bj][m][n][k] + bv[bj][n][k]; const float uu = 0.7978845608028654f * (x + 0.044715f * x * x * x); const float th = 1.f - 2.f / (1.f + __expf(2.f * uu)); r[4 * n + k] = 0.5f * x * (1.f + th); }
                    v4u w; w.x = cvt_pk_bf16(r[0], r[1]); w.y = cvt_pk_bf16(r[2], r[3]); w.z = cvt_pk_bf16(r[4], r[5]); w.w = cvt_pk_bf16(r[6], r[7]);
                    *(v4u*)(rowp + bj * HALF) = w; } } }
    }
};
struct EpiSwiglu {
    static constexpr bool PERM = true;
    unsigned char* H; const float* w;
    __device__ __forceinline__ void operator()(const f32x4 (&acc)[2][2][4][2], const Unit& u, int wr, int wc, int fr, int fq) const {
#pragma unroll
        for (int ai = 0; ai < 2; ++ai)
#pragma unroll
            for (int m = 0; m < 4; ++m) { const int lr = ai * HALF + wr * 64 + m * 16 + fr; if (lr < u.valid) { const int row = u.arow + lr; const float ws = w[row];
                float r[8];
#pragma unroll
                for (int n = 0; n < 2; ++n)
#pragma unroll
                    for (int k = 0; k < 4; ++k) { const float gv = acc[ai][0][m][n][k] * (1.f / 64.f), uv = acc[ai][1][m][n][k] * (1.f / 64.f); r[4 * n + k] = fminf(fmaxf(gv * sigm(gv) * uv * ws * 16.f, -448.f), 448.f); }
                int o0 = 0, o1 = 0; o0 = __builtin_amdgcn_cvt_pk_fp8_f32(r[0], r[1], o0, false); o0 = __builtin_amdgcn_cvt_pk_fp8_f32(r[2], r[3], o0, true);
                o1 = __builtin_amdgcn_cvt_pk_fp8_f32(r[4], r[5], o1, false); o1 = __builtin_amdgcn_cvt_pk_fp8_f32(r[6], r[7], o1, true);
                v2u o; o.x = (unsigned)o0; o.y = (unsigned)o1;
                *(v2u*)(H + (size_t)row * EFF + u.aux * HALF + wc * 32 + 8 * fq) = o; } }
    }
};

struct NoMid { static constexpr bool ON = false; __device__ __forceinline__ void operator()(f32x4 (&)[2][2][4][2], const Unit&, int, int, int, int) const {} };
template <class Epi, class Sched, bool GATHER, bool ALIGN_EPI, bool FP8 = false, bool RD32 = false, class Mid = NoMid>
__device__ __forceinline__ void gemm_phase(LAS unsigned char* lds, const Gemm g, const Sched& S, const Epi& E, const Mid& MH = Mid()) {
    const int tid = tid_opaque(), wid = __builtin_amdgcn_readfirstlane(tid >> 6), lane = tid & 63, wr = wid >> 2, wc = wid & 3, fr = lane & 15, fq = lane >> 4;
    constexpr int EB = FP8 ? 1 : 2;
    const int K = g.K; const size_t rstep = (size_t)K * EB; const int nt = (int)(rstep / 128);
    unsigned voffA[2], voffB[2];
#pragma unroll
    for (int i = 0; i < 2; ++i) { int R, C; stage_rc(tid * 16 + i * 8192, R, C); const int Rb = Epi::PERM ? ((R & ~31) + perm32(R & 31)) : R;
        voffA[i] = (unsigned)(R * rstep + C * 2); voffB[i] = (unsigned)(Rb * rstep + C * 2); }
    const unsigned r64 = (unsigned)(64 * rstep);
    const size_t kstep = (size_t)(BK * 2);
    const size_t kstepA = GATHER ? (size_t)g.kstepA : kstep;
    const size_t hstep = (size_t)HALF * rstep;
    const size_t tstep = 2 * hstep;
    const unsigned ldsw = (unsigned)wid * 1024u;
    const int aoff = lds_byte(wr * 64 + fr, fq * (FP8 ? 16 : 8)), boff = lds_byte(wc * 32 + fr, fq * (FP8 ? 16 : 8));
    unsigned gkey[2];
    LAS v2u* gstash = (LAS v2u*)(lds + STAGE_BYTES + 512 + tid * 8);
    unsigned gcol = 0; { int R_, C_; stage_rc(tid * 16, R_, C_); gcol = (unsigned)C_ * 2u; }
    Unit gu;
#define PG8_SA(b, h) (((b) * 2 + (h)) * HTB)
#define PG8_SB(b, h) ((4 + (b) * 2 + (h)) * HTB)
#define PG8_STG(bufoff, ptr, v0, v1) do { \
        __builtin_amdgcn_global_load_lds((const unsigned*)((const char*)(ptr) + (v0)), (LAS unsigned*)(lds + (bufoff) + ldsw), 16, 0, 0); \
        __builtin_amdgcn_global_load_lds((const unsigned*)((const char*)(ptr) + (v1)), (LAS unsigned*)(lds + (bufoff) + ldsw + 8192), 16, 0, 0); } while (0)
#define PG8_STAGE_B(bufoff, ptr) PG8_STG(bufoff, ptr, voffB[0], voffB[0] + r64)
#define PG8_STAGE_A(bufoff, ptr, h, nx) do { if constexpr (GATHER) { const unsigned o0_ = S.keyoff(gu, gkey[h] & 0xffffu) + gcol, o1_ = S.keyoff(gu, gkey[h] >> 16) + gcol; PG8_STG(bufoff, ptr, o0_, o1_); } \
        else { PG8_STG(bufoff, (const char*)(ptr) + (h) * hstep, voffA[0], voffA[0] + r64); } } while (0)
#define PG8_GLOAD(dst, u) do { int R_, C_; stage_rc(tid * 16, R_, C_); _Pragma("unroll") for (int h_ = 0; h_ < 2; ++h_) \
        dst[h_] = S.rowkey((u), h_ * HALF + R_) | (S.rowkey((u), h_ * HALF + R_ + 64) << 16); } while (0)
#define PG8_RD8(off) (RD32 ? *(const LAS v8i*)(lds + (off)) : __builtin_shufflevector(*(const LAS v4i*)(lds + (off)), *(const LAS v4i*)(lds + (off) + 16), 0, 1, 2, 3, 4, 5, 6, 7))
#define PG8_LDA(dst, b, h) do { if constexpr (FP8) { _Pragma("unroll") for (int m = 0; m < 4; ++m) dst##8[m] = PG8_RD8(PG8_SA(b, h) + aoff + m * 2048); } \
        else { _Pragma("unroll") for (int m = 0; m < 4; ++m) _Pragma("unroll") for (int k = 0; k < 2; ++k) dst[m][k] = *(const LAS bf16x8*)(lds + PG8_SA(b, h) + aoff + m * 2048 + k * 1024); } } while (0)
#define PG8_LDB(dst, b, h) do { if constexpr (FP8) { _Pragma("unroll") for (int n = 0; n < 2; ++n) dst##8[n] = PG8_RD8(PG8_SB(b, h) + boff + n * 2048); } \
        else { _Pragma("unroll") for (int n = 0; n < 2; ++n) _Pragma("unroll") for (int k = 0; k < 2; ++k) dst[n][k] = *(const LAS bf16x8*)(lds + PG8_SB(b, h) + boff + n * 2048 + k * 1024); } } while (0)
#define PG8_MMA(ai, bj, At, Bt) do { __builtin_amdgcn_s_setprio(1); if constexpr (FP8) { _Pragma("unroll") for (int m = 0; m < 4; ++m) _Pragma("unroll") for (int n = 0; n < 2; ++n) \
        asm volatile("v_mfma_f32_16x16x128_f8f6f4 %0, %1, %2, %0" : "+v"(acc[ai][bj][m][n]) : "v"(Bt##8[n]), "v"(At##8[m])); } \
        else { _Pragma("unroll") for (int m = 0; m < 4; ++m) _Pragma("unroll") for (int n = 0; n < 2; ++n) _Pragma("unroll") for (int k = 0; k < 2; ++k) \
        acc[ai][bj][m][n] = __builtin_amdgcn_mfma_f32_16x16x32_bf16(Bt[n][k], At[m][k], acc[ai][bj][m][n], 0, 0, 0); } __builtin_amdgcn_s_setprio(0); } while (0)
#define PG8_WAIT_V(n) asm volatile("s_waitcnt vmcnt(" #n ")" ::: "memory")
#define PG8_WAIT_L(n) asm volatile("s_waitcnt lgkmcnt(" #n ")" ::: "memory")
#define PG8_BAR __builtin_amdgcn_s_barrier()
#define PG8_SCHED __builtin_amdgcn_sched_barrier(0)
    Unit cur, nxt; int ui = 0;
    if (!S.next(0, cur)) return;
    f32x4 acc[2][2][4][2];
#pragma unroll
    for (int a = 0; a < 2; ++a)
#pragma unroll
        for (int b = 0; b < 2; ++b)
#pragma unroll
            for (int m = 0; m < 4; ++m)
#pragma unroll
                for (int n = 0; n < 2; ++n) acc[a][b][m][n] = (f32x4){0.f, 0.f, 0.f, 0.f};
    bf16x8 At[4][2], B0[2][2], B1[2][2]; v8i At8[4], B08[2], B18[2];
    const char* cA = GATHER ? (const char*)g.A : (const char*)g.A + (size_t)cur.arow * rstep; const char* cB = (const char*)g.Bt + (size_t)cur.pn * tstep;
    if constexpr (GATHER) { PG8_GLOAD(gkey, cur); gu = cur; }
    PG8_STAGE_B(PG8_SB(0, 0), cB); PG8_STAGE_B(PG8_SB(0, 1), cB + hstep); PG8_STAGE_A(PG8_SA(0, 0), cA, 0, false); PG8_STAGE_A(PG8_SA(0, 1), cA, 1, false);
    if (wr == 1) PG8_BAR;
    PG8_WAIT_V(2); PG8_BAR;
    PG8_STAGE_B(PG8_SB(1, 0), cB + kstep); PG8_STAGE_A(PG8_SA(1, 0), cA + kstepA, 0, false); PG8_STAGE_B(PG8_SB(1, 1), cB + hstep + kstep);
    PG8_WAIT_V(6); PG8_BAR;
    for (;;) {
        const bool has_next = S.next(ui + 1, nxt);
        if constexpr (GATHER) { if (has_next) { unsigned gt_[2]; PG8_GLOAD(gt_, nxt); *gstash = (v2u){gt_[0], gt_[1]}; } }
        const char* nA = GATHER ? cA : (has_next ? (const char*)g.A + (size_t)nxt.arow * rstep : cA); const char* nB = has_next ? (const char*)g.Bt + (size_t)nxt.pn * tstep : cB;
        for (int t = 0; t < nt; t += 2) {
            const bool last = (t == nt - 2);
            const bool nx = last && has_next;
            if constexpr (Mid::ON) { if (t == nt / 2) { Unit mu; mu.arow = __builtin_amdgcn_readfirstlane(cur.arow); mu.pn = __builtin_amdgcn_readfirstlane(cur.pn); mu.valid = cur.valid; mu.aux = cur.aux;
                int fr_ = fr, fq_ = fq; asm volatile("" : "+s"(mu.arow), "+s"(mu.pn), "+v"(fr_), "+v"(fq_)); MH(acc, mu, wr, wc, fr_, fq_); } }
            const char* a1 = cA + (size_t)(t + 1) * kstepA;
            const char* a2 = last ? nA : cA + (size_t)(t + 2) * kstepA; const char* b2 = last ? nB : cB + (size_t)(t + 2) * kstep;
            const char* a3 = a2 + kstepA; const char* b3 = b2 + kstep;
            PG8_LDB(B0, 0, 0); PG8_LDB(B1, 0, 1); PG8_SCHED; PG8_LDA(At, 0, 0); PG8_STAGE_A(PG8_SA(1, 1), a1, 1, false);
            if constexpr (GATHER) { if (nx) { const v2u s_ = *gstash; gkey[0] = s_.x; gkey[1] = s_.y; gu = nxt; } }
            PG8_WAIT_V(8); PG8_WAIT_L(0); PG8_BAR; PG8_MMA(0, 0, At, B0); PG8_MMA(0, 1, At, B1); PG8_BAR; PG8_SCHED;
            PG8_LDA(At, 0, 1); PG8_STAGE_B(PG8_SB(0, 0), b2); PG8_STAGE_B(PG8_SB(0, 1), b2 + hstep); PG8_STAGE_A(PG8_SA(0, 0), a2, 0, nx);
            PG8_WAIT_V(8); PG8_WAIT_L(0); PG8_BAR; PG8_MMA(1, 0, At, B0); PG8_MMA(1, 1, At, B1); PG8_BAR; PG8_SCHED;
            PG8_LDB(B0, 1, 0); PG8_LDB(B1, 1, 1); PG8_SCHED; PG8_LDA(At, 1, 0); PG8_STAGE_A(PG8_SA(0, 1), a2, 1, nx);
            PG8_WAIT_V(8); PG8_WAIT_L(0); PG8_BAR; PG8_MMA(0, 0, At, B0); PG8_MMA(0, 1, At, B1); PG8_BAR; PG8_SCHED;
            PG8_LDA(At, 1, 1); PG8_STAGE_B(PG8_SB(1, 0), b3); PG8_STAGE_B(PG8_SB(1, 1), b3 + hstep); PG8_STAGE_A(PG8_SA(1, 0), a3, 0, nx);
            PG8_WAIT_V(8); PG8_WAIT_L(0); PG8_BAR; PG8_MMA(1, 0, At, B0); PG8_MMA(1, 1, At, B1); PG8_BAR; PG8_SCHED;
        }
        if constexpr (ALIGN_EPI) { if (wr == 0) PG8_BAR; }
        if constexpr (FP8) asm volatile("s_nop 15\n\ts_nop 7" ::: "memory");
        { Unit eu; eu.arow = __builtin_amdgcn_readfirstlane(cur.arow); eu.pn = __builtin_amdgcn_readfirstlane(cur.pn); eu.valid = __builtin_amdgcn_readfirstlane(cur.valid); eu.aux = __builtin_amdgcn_readfirstlane(cur.aux);
          asm volatile("" : "+s"(eu.arow), "+s"(eu.pn), "+s"(eu.valid), "+s"(eu.aux));
          int fr_ = fr, fq_ = fq; asm volatile("" : "+v"(fr_), "+v"(fq_));
          E(acc, eu, wr, wc, fr_, fq_); }
        if (!has_next) break;
#pragma unroll
        for (int a = 0; a < 2; ++a)
#pragma unroll
            for (int b = 0; b < 2; ++b)
#pragma unroll
                for (int m = 0; m < 4; ++m)
#pragma unroll
                    for (int n = 0; n < 2; ++n) acc[a][b][m][n] = (f32x4){0.f, 0.f, 0.f, 0.f};
        cur = nxt; cA = nA; cB = nB; ++ui;
        if constexpr (ALIGN_EPI) { if (wr == 1) PG8_BAR; }
    }
    PG8_WAIT_V(0);
    if constexpr (!ALIGN_EPI) { if (wr == 0) PG8_BAR; }
    PG8_BAR;
#undef PG8_SA
#undef PG8_SB
#undef PG8_STG
#undef PG8_STAGE_A
#undef PG8_STAGE_B
#undef PG8_GLOAD
#undef PG8_LDA
#undef PG8_RD8
#undef PG8_LDB
#undef PG8_MMA
#undef PG8_WAIT_V
#undef PG8_WAIT_L
#undef PG8_BAR
#undef PG8_SCHED
}
}

#define XB_TMO      128
#define XB_XCNT(j)  (256  + 64 * (j))
#define XB_XSUB(j)  (1280 + 64 * (j))
#define XB_XGEN(j)  (2304 + 64 * (j))
#define XB_TOP      3328
#define XB_TOPGEN   3392
#define XCD_BAR_WORDS 3456
#define XB_SPIN_CAP (1u << 22)

__device__ __forceinline__ unsigned xb_ld(unsigned* p)              { return __hip_atomic_load(p, __ATOMIC_RELAXED, __HIP_MEMORY_SCOPE_AGENT); }
__device__ __forceinline__ unsigned xb_add(unsigned* p, unsigned v) { return __hip_atomic_fetch_add(p, v, __ATOMIC_RELAXED, __HIP_MEMORY_SCOPE_AGENT); }
__device__ __forceinline__ unsigned xb_xcc_id() { return (unsigned)__builtin_amdgcn_s_getreg((3 << 11) | 20) & 0xFu; }
#define XB_SPIN(cond, bar) do { unsigned _sp = 0; while (cond) { __builtin_amdgcn_s_sleep(1); \
    if ((++_sp & 255u) == 0u) { if (xb_ld(&(bar)[XB_TMO])) break; if (_sp > XB_SPIN_CAP) { atomicAdd(&(bar)[XB_TMO], 1u); break; } } } } while (0)

struct XcdBarrier { unsigned* bar; unsigned x; volatile LAS unsigned* st; };

__device__ __forceinline__ XcdBarrier xcd_barrier_post(unsigned* bar, volatile LAS unsigned* st) {
    XcdBarrier b; b.bar = bar; b.x = xb_xcc_id(); b.st = st;
    if (threadIdx.x == 0) (void)xb_add(&bar[XB_XCNT(b.x)], 1u);
    return b;
}
__device__ __forceinline__ void xcd_barrier_complete(unsigned* bar, unsigned x, unsigned& nloc, unsigned& nx) {
    const unsigned G = gridDim.x * gridDim.y * gridDim.z;
    unsigned sum, cnt, mine, sp = 0u;
    for (;;) {
        sum = 0u; cnt = 0u; mine = 0u;
#pragma unroll
        for (unsigned j = 0; j < 16; ++j) { const unsigned c = xb_ld(&bar[XB_XCNT(j)]); sum += c; cnt += (c > 0u) ? 1u : 0u; mine = (j == x) ? c : mine; }
        if (sum == G) break;
        __builtin_amdgcn_s_sleep(1);
        if ((++sp & 255u) == 0u) { if (xb_ld(&bar[XB_TMO])) break; if (sp > XB_SPIN_CAP) { atomicAdd(&bar[XB_TMO], 1u); break; } }
    }
    nloc = mine > 0u ? mine : 1u; nx = cnt > 0u ? cnt : 1u;
}
__device__ __forceinline__ void xcd_barrier(const XcdBarrier& b) {
    asm volatile("s_waitcnt vmcnt(0)" ::: "memory");
    __syncthreads();
    if (threadIdx.x == 0) {
        unsigned* bar = b.bar;
        __builtin_amdgcn_s_waitcnt(0);
        unsigned nloc = b.st[0], nx = b.st[1];
        if (nloc == 0u) { xcd_barrier_complete(bar, b.x, nloc, nx); b.st[0] = nloc; b.st[1] = nx; }
        const unsigned old = xb_add(&bar[XB_XSUB(b.x)], 1u);
        const unsigned gen = old / nloc;
        if (old + 1u == (gen + 1u) * nloc) {
            __builtin_amdgcn_fence(__ATOMIC_RELEASE, "agent");
            asm volatile("s_waitcnt vmcnt(0)" ::: "memory");
            const unsigned og = xb_add(&bar[XB_TOP], 1u);
            const unsigned tg = og / nx;
            if (og + 1u == (tg + 1u) * nx) xb_add(&bar[XB_TOPGEN], 1u);
            else XB_SPIN(xb_ld(&bar[XB_TOPGEN]) == tg, bar);
            __builtin_amdgcn_fence(__ATOMIC_ACQUIRE, "agent");
            xb_add(&bar[XB_XGEN(b.x)], 1u);
            asm volatile("s_waitcnt vmcnt(0)" ::: "memory");
        } else {
            XB_SPIN(xb_ld(&bar[XB_XGEN(b.x)]) == gen, bar);
            __builtin_amdgcn_fence(__ATOMIC_ACQUIRE, "agent");
            asm volatile("s_waitcnt vmcnt(0)" ::: "memory");
        }
    }
    __syncthreads();
}

struct Frame {
    LAS unsigned char* lds;
    unsigned char* ws;
    const float* const* in;
    float* out;
    int tid, lane, wave, G, gw, ngw;
};
#define WSP(T, off) ((T*)(F.ws + (off)))
#define INP(k) (F.in[k])

template <class RowMap>
__device__ __forceinline__ void transpose_item(const float* W, int K, int N, bf16* WT, int ldt, LAS float* scr, int item, int lane, RowMap rm) {
    const int nblk = (N + 31) / 32, kb = item / nblk, nb = item % nblk, k0 = 64 * kb, n0 = 32 * nb;
    const int nn = n0 + (lane & 31);
#pragma unroll 8
    for (int i = 0; i < 32; ++i) { const int kk = 2 * i + (lane >> 5); scr[kk * 33 + (lane & 31)] = (nn < N) ? W[(size_t)(k0 + kk) * N + nn] : 0.f; }
    LDS_WAIT(); asm volatile("" ::: "memory");
    const int c = lane & 7;
#pragma unroll
    for (int j = 0; j < 4; ++j) { const int n = (lane >> 3) + 8 * j; const LAS float* s = scr + (8 * c) * 33 + n;
        v4u o; o.x = pk2(s[0 * 33], s[1 * 33]); o.y = pk2(s[2 * 33], s[3 * 33]); o.z = pk2(s[4 * 33], s[5 * 33]); o.w = pk2(s[6 * 33], s[7 * 33]);
        if (n0 + n < N) *(v4u*)(WT + (size_t)rm(n0 + n) * ldt + k0 + 8 * c) = o; }
    LDS_WAIT(); asm volatile("" ::: "memory");
}
template <class RowMap>
__device__ __forceinline__ void transpose_item8(const float* W, int K, int N, unsigned char* WT, int ldt, LAS float* scr, int item, int lane, RowMap rm) {
    const int nblk = (N + 31) / 32, kb = item / nblk, nb = item % nblk, k0 = 64 * kb, n0 = 32 * nb;
    const int nn = n0 + (lane & 31);
#pragma unroll 8
    for (int i = 0; i < 32; ++i) { const int kk = 2 * i + (lane >> 5); scr[kk * 33 + (lane & 31)] = (nn < N) ? W[(size_t)(k0 + kk) * N + nn] : 0.f; }
    LDS_WAIT(); asm volatile("" ::: "memory");
    const int c = lane & 3;
#pragma unroll
    for (int j = 0; j < 2; ++j) { const int n = (lane >> 2) + 16 * j; const LAS float* s = scr + (16 * c) * 33 + n; int w[4];
#pragma unroll
        for (int q = 0; q < 4; ++q) { int t = 0; t = __builtin_amdgcn_cvt_pk_fp8_f32(s[(4 * q) * 33] * 64.f, s[(4 * q + 1) * 33] * 64.f, t, false); t = __builtin_amdgcn_cvt_pk_fp8_f32(s[(4 * q + 2) * 33] * 64.f, s[(4 * q + 3) * 33] * 64.f, t, true); w[q] = t; }
        if (n0 + n < N) *(v4i*)(WT + (size_t)rm(n0 + n) * ldt + k0 + 16 * c) = (v4i){w[0], w[1], w[2], w[3]}; }
    LDS_WAIT(); asm volatile("" ::: "memory");
}
struct RmId { __device__ __forceinline__ int operator()(int n) const { return n; } };
struct RmWin { __device__ __forceinline__ int operator()(int n) const { return n < 2560 ? n : (n < 2608 ? PC_G3 + (n - 2560) : (n < 4656 ? n - 48 : (n < 4664 ? PC_IF + (n - 4656) : n - 56))); } };
struct RmGU { int up; __device__ __forceinline__ int operator()(int n) const { return 256 * (n >> 7) + (n & 127) + 128 * up; } };

__device__ __forceinline__ void mod_chunks(Frame& F, int first, int last, int stride) {
    const int tid_ = tid_opaque(), lane_ = tid_ & 63; (void)lane_;
    const float* c = INP(1); const float* w_ada = INP(2); const float* b_ada = INP(3);
    float* mod = WSP(float, WS_MOD);
    LAS float* sc = (LAS float*)F.lds; LAS float* red = (LAS float*)(F.lds + 65536);
    __syncthreads();
    { f32x4 cv[8];
#pragma unroll
      for (int j = 0; j < 8; ++j) cv[j] = *(const f32x4*)(c + 4 * tid_ + 2048 * j);
#pragma unroll
      for (int j = 0; j < 8; ++j) { f32x4 o; o.x = cv[j].x * sigm(cv[j].x); o.y = cv[j].y * sigm(cv[j].y); o.z = cv[j].z * sigm(cv[j].z); o.w = cv[j].w * sigm(cv[j].w); *(LAS f32x4*)(sc + 4 * tid_ + 2048 * j) = o; } }
    __syncthreads();
    for (int ci = first; ci < last; ci += stride) {
        const int cq = tid_ % 12, kg = tid_ / 12;
        if (tid_ < 504) {
            float acc[8][4];
#pragma unroll
            for (int b = 0; b < 8; ++b)
#pragma unroll
                for (int j = 0; j < 4; ++j) acc[b][j] = 0.f;
            const float* wp = w_ada + 48 * ci + 4 * cq;
            f32x4 wc[7], wn[7];
#pragma unroll
            for (int u = 0; u < 7; ++u) { wc[u] = __builtin_nontemporal_load((const f32x4*)(wp + (size_t)(kg + 42 * u) * 12288)); wn[u] = wc[u]; }
#pragma unroll 1
            for (int bi = 0; bi < 7; ++bi) {
                if (bi < 6) {
#pragma unroll
                    for (int u = 0; u < 7; ++u) { int k = kg + 42 * (7 * (bi + 1) + u); k = k < DM ? k : DM - 1; wn[u] = __builtin_nontemporal_load((const f32x4*)(wp + (size_t)k * 12288)); } }
#pragma unroll
                for (int u = 0; u < 7; ++u) { const int k = kg + 42 * (7 * bi + u); const bool ok = k < DM; const int kc = ok ? k : DM - 1;
#pragma unroll
                    for (int b = 0; b < 8; ++b) { const float s = ok ? sc[b * DM + kc] : 0.f;
#pragma unroll
                        for (int j = 0; j < 4; ++j) acc[b][j] += s * wc[u][j]; } }
#pragma unroll
                for (int u = 0; u < 7; ++u) wc[u] = wn[u];
            }
#pragma unroll
            for (int b = 0; b < 8; ++b)
#pragma unroll
                for (int j = 0; j < 4; ++j) red[(kg * 12 + cq) * 32 + b * 4 + j] = acc[b][j];
        }
        __syncthreads();
        if (tid_ < 384) { const int b = tid_ / 48, col = tid_ % 48, q = col >> 2, j = col & 3; float s = 0.f;
            for (int k2 = 0; k2 < 42; ++k2) s += red[(k2 * 12 + q) * 32 + b * 4 + j];
            mod[b * 12288 + 48 * ci + col] = s + b_ada[48 * ci + col]; }
        __syncthreads();
    }
}
struct TDesc { const float* W; int K, N; unsigned char* WT; int ldt; int kind; int item; int nblk, nb0; };
__device__ __forceinline__ TDesc p0_decode(Frame& F, int it) {
    constexpr int I_WIN = 32 * 146, I_WIN8 = 32 * 274, I_UP = 16 * 64, I_OUT = 32 * 64, I_SH = 32 * 16, I_SHD = 8 * 64, I_R = 32 * 2, I_EG = 64 * 512, I_C1 = 32 * 8;
    unsigned char* WeGU = WSP(unsigned char, WS_WEGU); unsigned char* WeD = WSP(unsigned char, WS_WED);
    int r = it;
    if (r < I_WIN) return TDesc{INP(6), DM, D_IN, WSP(unsigned char, WS_WIN), DM * 2, 1, r, 146, 0}; r -= I_WIN;
    if (r < I_WIN8) return TDesc{INP(6), DM, D_IN, WSP(unsigned char, WS_WIN8), DM, 5, r, 274, 32}; r -= I_WIN8;
    if (r < I_UP) return TDesc{INP(14), 1024, DM, WSP(unsigned char, WS_WUP), 2048 * 2, 0, r, (DM + 31) / 32, 0}; r -= I_UP;
    if (r < I_UP) return TDesc{INP(15), 1024, DM, WSP(unsigned char, WS_WUP) + 1024 * 2, 2048 * 2, 0, r, (DM + 31) / 32, 0}; r -= I_UP;
    if (r < I_OUT) return TDesc{INP(16), DM, DM, WSP(unsigned char, WS_WOUT), DM * 2, 0, r, (DM + 31) / 32, 0}; r -= I_OUT;
    if (r < I_SH) return TDesc{INP(24), DM, EFF, WeGU + (size_t)64 * 1024 * DM, DM, 3, r, (EFF + 31) / 32, 0}; r -= I_SH;
    if (r < I_SH) return TDesc{INP(25), DM, EFF, WeGU + (size_t)64 * 1024 * DM, DM, 4, r, (EFF + 31) / 32, 0}; r -= I_SH;
    if (r < I_SHD) return TDesc{INP(26), EFF, DM, WeD + (size_t)64 * DM * EFF, EFF, 2, r, (DM + 31) / 32, 0}; r -= I_SHD;
    if (r < I_R) return TDesc{INP(19), DM, NEXP, WSP(unsigned char, WS_WR), DM * 2, 0, r, (NEXP + 31) / 32, 0}; r -= I_R;
    if (r < 16) { const int kv = r >> 3; return TDesc{INP(9) + (size_t)kv * 256 * 64, 256, 64, WSP(unsigned char, WS_CW2) + (size_t)kv * 64 * 256 * 2, 256 * 2, 0, r & 7, 2, 0}; } r -= 16;
    if (r < 2 * I_C1) { const int kv = r >> 8; return TDesc{INP(8) + (size_t)kv * DM * 256, DM, 256, WSP(unsigned char, WS_CW1) + (size_t)kv * 256 * DM * 2, DM * 2, 0, r & 255, (256 + 31) / 32, 0}; } r -= 2 * I_C1;
    if (r < I_EG) { const int e = r >> 9; return TDesc{INP(21) + (size_t)e * DM * EFF, DM, EFF, WeGU + (size_t)e * 1024 * DM, DM, 3, r & 511, (EFF + 31) / 32, 0}; } r -= I_EG;
    if (r < I_EG) { const int e = r >> 9; return TDesc{INP(22) + (size_t)e * DM * EFF, DM, EFF, WeGU + (size_t)e * 1024 * DM, DM, 4, r & 511, (EFF + 31) / 32, 0}; } r -= I_EG;
    { const int e = r >> 9; return TDesc{INP(23) + (size_t)e * EFF * DM, EFF, DM, WeD + (size_t)e * DM * EFF, EFF, 2, r & 511, (DM + 31) / 32, 0}; }
}
__device__ __forceinline__ void t_load(const TDesc& d, int lane, float (&v)[32]) {
    const int nblk = d.nblk, kb = d.item / nblk, nb = d.nb0 + d.item % nblk; int nn = 32 * nb + (lane & 31); nn = nn < d.N ? nn : d.N - 1;
    const float* p = d.W + (size_t)(64 * kb + (lane >> 5)) * d.N + nn;
#pragma unroll
    for (int i = 0; i < 32; ++i) v[i] = __builtin_nontemporal_load(p + (size_t)(2 * i) * d.N);
}
__device__ __forceinline__ int t_rowmap(int kind, int n) {
    if (kind == 1 || kind == 5) { if (n < 1024) return n;
        if (n < 2560) { const int i = (n - 1024) >> 8, c = (n - 1024) & 255; return ((i & 1) ? PC_VC : PC_KC) + (i >> 1) * 256 + c; }
        if (n < 2608) return PC_G3 + (n - 2560); if (n < 3632) return PC_QKM + (n - 2608); if (n < 4656) return PC_VM + (n - 3632); if (n < 4664) return PC_IF + (n - 4656); return n + 200; }
    if (kind == 3 || kind == 4) return 256 * (n >> 7) + (n & 127) + 128 * (kind - 3);
    return n;
}
__device__ __forceinline__ void t_finish(const TDesc& d, int lane, LAS float* scr, const float (&v)[32]) {
    const int nblk = d.nblk, kb = d.item / nblk, nb = d.nb0 + d.item % nblk, k0 = 64 * kb, n0 = 32 * nb;
#pragma unroll
    for (int i = 0; i < 32; ++i) scr[(2 * i + (lane >> 5)) * 33 + (lane & 31)] = v[i];
    LDS_WAIT(); asm volatile("" ::: "memory");
    if (d.kind >= 2) {
        const int c = lane & 3;
#pragma unroll
        for (int j = 0; j < 2; ++j) { const int n = (lane >> 2) + 16 * j; const LAS float* s = scr + (16 * c) * 33 + n; int w[4];
#pragma unroll
            for (int q = 0; q < 4; ++q) { int t = 0; t = __builtin_amdgcn_cvt_pk_fp8_f32(s[(4 * q) * 33] * 64.f, s[(4 * q + 1) * 33] * 64.f, t, false); t = __builtin_amdgcn_cvt_pk_fp8_f32(s[(4 * q + 2) * 33] * 64.f, s[(4 * q + 3) * 33] * 64.f, t, true); w[q] = t; }
            int dr = t_rowmap(d.kind, n0 + n); bool ok = n0 + n < d.N; if (d.kind == 5) { ok = ok && dr >= PN_BF; dr -= PN_BF; }
            if (ok) *(v4i*)(d.WT + (size_t)dr * d.ldt + k0 + 16 * c) = (v4i){w[0], w[1], w[2], w[3]}; }
    } else {
        const int c = lane & 7;
#pragma unroll
        for (int j = 0; j < 4; ++j) { const int n = (lane >> 3) + 8 * j; const LAS float* s = scr + (8 * c) * 33 + n;
            v4u o; o.x = pk2(s[0 * 33], s[1 * 33]); o.y = pk2(s[2 * 33], s[3 * 33]); o.z = pk2(s[4 * 33], s[5 * 33]); o.w = pk2(s[6 * 33], s[7 * 33]);
            const int dr = t_rowmap(d.kind, n0 + n); const bool ok = (n0 + n < d.N) && (d.kind != 1 || dr < PN_BF);
            if (ok) *(v4u*)(d.WT + (size_t)dr * d.ldt + (size_t)(k0 + 8 * c) * 2) = o; }
    }
    LDS_WAIT(); asm volatile("" ::: "memory");
}
constexpr int NIT_ALL = 16 + 32 * 146 + 32 * 274 + 2 * 16 * 64 + 32 * 64 + 2 * 32 * 16 + 8 * 64 + 32 * 2 + 2 * 32 * 8 + 3 * 64 * 512;
constexpr int NIT_LATE = 3 * 64 * 512, NIT_EARLY = NIT_ALL - NIT_LATE;
__device__ __forceinline__ void convert_range(Frame& F, int lo, int hi, int w, int nw) {
    const int tid_ = tid_opaque(), lane_ = tid_ & 63;
    LAS float* scr = (LAS float*)(F.lds + F.wave * 16384);
    int it = lo + w; if (it >= hi) return;
    TDesc d = p0_decode(F, it); float v[32]; t_load(d, lane_, v);
    for (;;) {
        const int itn = it + nw; const bool hn = itn < hi;
        TDesc dn = d; float vn[32];
        if (hn) { dn = p0_decode(F, itn); t_load(dn, lane_, vn); }
        t_finish(d, lane_, scr, v);
        if (!hn) break;
        d = dn; it = itn;
#pragma unroll
        for (int i = 0; i < 32; ++i) v[i] = vn[i];
    }
}
constexpr int MOD_EARLY = 86;
__device__ __forceinline__ void p0_early(Frame& F) {
    const int bx = (int)blockIdx.x;
    if (F.G <= MOD_EARLY + 8) { mod_chunks(F, bx, MOD_EARLY, F.G); convert_range(F, 0, NIT_EARLY, F.gw, F.ngw); return; }
    constexpr int SPLIT = (NIT_EARLY * 7) / 8;
    if (bx < MOD_EARLY) { mod_chunks(F, bx, MOD_EARLY, MOD_EARLY); convert_range(F, SPLIT, NIT_EARLY, bx * 8 + F.wave, MOD_EARLY * 8); }
    else convert_range(F, 0, SPLIT, (bx - MOD_EARLY) * 8 + F.wave, (F.G - MOD_EARLY) * 8);
}
constexpr int NCHUNK = 8;
__device__ __forceinline__ void convert_chunk(Frame& F, int& chunk) {
    if (chunk >= NCHUNK) return;
    const int per = (NIT_LATE + F.G - 1) / F.G, pc = (per + NCHUNK - 1) / NCHUNK;
    int lo = NIT_EARLY + (int)blockIdx.x * per + chunk * pc, hi = lo + pc; const int end = NIT_EARLY + ((int)blockIdx.x + 1) * per;
    hi = hi < end ? hi : end; hi = hi < NIT_ALL ? hi : NIT_ALL;
    __syncthreads();
    if (chunk == 0) { const int nl = 256 - MOD_EARLY; const int per_wg = (nl + F.G - 1) / F.G;
        mod_chunks(F, MOD_EARLY + (int)blockIdx.x * per_wg, (MOD_EARLY + ((int)blockIdx.x + 1) * per_wg) < 256 ? (MOD_EARLY + ((int)blockIdx.x + 1) * per_wg) : 256, 1); }
    convert_range(F, lo, hi, F.wave, 8);
    __syncthreads();
    ++chunk;
}
__device__ __forceinline__ void p0_bias1(Frame& F) {
    const int tid_ = tid_opaque(), lane_ = tid_ & 63;
    for (int o = F.gw; o < 512; o += F.ngw) { const int kv = o >> 8, j = o & 255; const float* pe = INP(7) + kv * 2048; const float* w1 = INP(8) + (size_t)kv * 2048 * 256 + j;
        float s = 0.f;
#pragma unroll 8
        for (int k = lane_; k < 2048; k += 64) s += pe[k] * w1[(size_t)k * 256];
        s = wave_sum(s); if (lane_ == 0) WSP(float, WS_BIAS1)[o] = s; }
}
__device__ __forceinline__ void p1_h1(Frame& F) {
    const int tid_ = tid_opaque(), lane_ = tid_ & 63; (void)lane_;
    const float* x = INP(0); const float* gpm = INP(4); const float* mod = WSP(float, WS_MOD); bf16* H1 = WSP(bf16, WS_H1); unsigned char* H1Q = WSP(unsigned char, WS_H1Q);
    for (int row = F.gw; row < NTOK; row += F.ngw) {
        const int b = row >> 11; const f32x4* xr = (const f32x4*)(x + (size_t)row * DM) + lane_;
        f32x4 v[8]; float s = 0.f;
#pragma unroll
        for (int j = 0; j < 8; ++j) { v[j] = xr[64 * j]; s += (v[j].x * v[j].x + v[j].y * v[j].y) + (v[j].z * v[j].z + v[j].w * v[j].w); }
        const float rstd = rsqrtf(wave_sum(s) * (1.f / DM) + EPS);
        const float* sh = mod + b * 12288; const float* scl = sh + 2048;
        int* o4 = (int*)(H1Q + (size_t)row * DM) + lane_; unsigned long long* o8 = (unsigned long long*)(H1 + (size_t)row * DM) + lane_;
#pragma unroll
        for (int j = 0; j < 8; ++j) { const int col = 4 * lane_ + 256 * j; const f32x4 g = *(const f32x4*)(gpm + col), a = *(const f32x4*)(scl + col), c = *(const f32x4*)(sh + col);
            const float r0 = v[j].x * rstd * g.x * (1.f + a.x) + c.x, r1 = v[j].y * rstd * g.y * (1.f + a.y) + c.y, r2 = v[j].z * rstd * g.z * (1.f + a.z) + c.z, r3 = v[j].w * rstd * g.w * (1.f + a.w) + c.w;
            int q8 = 0; q8 = __builtin_amdgcn_cvt_pk_fp8_f32(fminf(fmaxf(r0, -448.f), 448.f), fminf(fmaxf(r1, -448.f), 448.f), q8, false); q8 = __builtin_amdgcn_cvt_pk_fp8_f32(fminf(fmaxf(r2, -448.f), 448.f), fminf(fmaxf(r3, -448.f), 448.f), q8, true);
            o4[64 * j] = q8; o8[64 * j] = (unsigned long long)pk2(r0, r1) | ((unsigned long long)pk2(r2, r3) << 32); }
    }
}
__device__ __forceinline__ float gelu_tanh(float x) { const float u = 0.7978845608028654f * (x + 0.044715f * x * x * x); const float t = 1.f - 2.f / (1.f + __expf(2.f * u)); return 0.5f * x * (1.f + t); }
__device__ __forceinline__ void p3_conv(Frame& F) {
    const int tid_ = tid_opaque(), lane_ = tid_ & 63; (void)lane_;
    const bf16* PROJ = WSP(bf16, WS_PROJ); bf16* QKC = WSP(bf16, WS_QKC); const float* cw = INP(10); const float* cb = INP(11);
    const int skip = F.G > 64 ? 32 : 0;
    if ((int)blockIdx.x < skip) return;
    const int c8 = (tid_ & 127) * 8, rg = F.wave >> 1;
    f32x4 w[4][2], bias[2];
#pragma unroll
    for (int i = 0; i < 4; ++i) { w[i][0] = *(const f32x4*)(cw + i * 1024 + c8); w[i][1] = *(const f32x4*)(cw + i * 1024 + c8 + 4); }
    bias[0] = *(const f32x4*)(cb + c8); bias[1] = *(const f32x4*)(cb + c8 + 4);
    const float sc = (c8 >= 512) ? 0.08838834764831845f : 1.f;
    for (int blk = (int)blockIdx.x - skip; blk < NTOK / 16; blk += F.G - skip) {
        const int r0 = blk * 16 + rg * 4; const bool head = (r0 & 2047) == 0;
        v4u q[7];
#pragma unroll
        for (int i = 0; i < 7; ++i) { const int row = (i < 3 && head) ? r0 : r0 - 3 + i; const GAS v4u* pr = UPTR(const v4u, PROJ + (size_t)row * PLD + PC_QKM) + (tid_ & 127); q[i] = *pr; }
        if (head) { q[0] = (v4u){0u, 0u, 0u, 0u}; q[1] = q[0]; q[2] = q[0]; }
#pragma unroll
        for (int o = 0; o < 4; ++o) {
            f32x4 a0 = bias[0], a1 = bias[1];
#pragma unroll
            for (int i = 0; i < 4; ++i) { const v4u x = q[o + i];
                a0 += (f32x4){bflo(x.x), bfhi(x.x), bflo(x.y), bfhi(x.y)} * w[i][0]; a1 += (f32x4){bflo(x.z), bfhi(x.z), bflo(x.w), bfhi(x.w)} * w[i][1]; }
            v4u ov; ov.x = pk2(a0.x * sigm(a0.x) * sc, a0.y * sigm(a0.y) * sc); ov.y = pk2(a0.z * sigm(a0.z) * sc, a0.w * sigm(a0.w) * sc);
            ov.z = pk2(a1.x * sigm(a1.x) * sc, a1.y * sigm(a1.y) * sc); ov.w = pk2(a1.z * sigm(a1.z) * sc, a1.w * sigm(a1.w) * sc);
            GAS v4u* po = UPTR(v4u, QKC + (size_t)(r0 + o) * 1024) + (tid_ & 127); *po = ov;
        }
    }
}
__device__ __forceinline__ void p3_gates(Frame& F) {
    const int tid_ = tid_opaque(), lane_ = tid_ & 63;
    const bf16* PROJ = WSP(bf16, WS_PROJ); const float* bg = INP(12); float* GA = WSP(float, WS_GA); float* GU = WSP(float, WS_GU); float* GM = WSP(float, WS_GM);
    LAS float* ex = (LAS float*)F.lds;
    for (int bh = (int)blockIdx.x; bh < 32; bh += F.G) {
        const int b = bh >> 2, h = bh & 3; float carryA = 0.f, cmax = -INFINITY; float Al[4], ul[4], Ml[4];
#pragma unroll
        for (int k = 0; k < 4; ++k) {
            const int t = F.wave * 256 + k * 64 + lane_; const bf16* pr = PROJ + (size_t)(b * SEQ + t) * PLD + PC_IF;
            const float ip = bf2f(pr[h]) + bg[h], fp = bf2f(pr[4 + h]) + bg[4 + h];
            const float lf = fminf(fp, 0.f) - log1pf(__expf(-fabsf(fp)));
            float A = lf;
#pragma unroll
            for (int o = 1; o < 64; o <<= 1) { const float n = __shfl_up(A, o); if (lane_ >= o) A += n; }
            A += carryA;
            const float u = ip - A; float M = u;
#pragma unroll
            for (int o = 1; o < 64; o <<= 1) { const float n = __shfl_up(M, o); if (lane_ >= o) M = fmaxf(M, n); }
            M = fmaxf(M, cmax);
            Al[k] = A; ul[k] = u; Ml[k] = M;
            carryA = rdlane(A, 63); cmax = rdlane(M, 63);
        }
        __syncthreads();
        if (lane_ == 0) { ex[2 * F.wave] = carryA; ex[2 * F.wave + 1] = cmax; }
        __syncthreads();
        float CA = 0.f, CM = 0.f;
        for (int w = 0; w < F.wave; ++w) { CM = fmaxf(CM, ex[2 * w + 1] - CA); CA += ex[2 * w]; }
#pragma unroll
        for (int k = 0; k < 4; ++k) { const int t = F.wave * 256 + k * 64 + lane_;
            GA[bh * SEQ + t] = (Al[k] + CA) * 1.4426950408889634f; GU[bh * SEQ + t] = (ul[k] - CA) * 1.4426950408889634f; GM[bh * SEQ + t] = fmaxf(Ml[k] - CA, CM) * 1.4426950408889634f; }
    }
    __syncthreads();
}
__device__ __forceinline__ void p4_kcv(Frame& F) {
    const int tid_ = tid_opaque(), lane_ = tid_ & 63; (void)lane_;
    const bf16* HIDC = WSP(bf16, WS_HIDC); bf16* KCB = WSP(bf16, WS_KCV); const float* w2 = INP(9);
    const int gt = blockIdx.x * 512 + tid_, ngt = F.G * 512;
    for (int idx = gt; idx < 8128 * 64; idx += ngt) {
        const int r = idx >> 6, d = idx & 63, kv = r / 4064, rr = r % 4064, b = rr / 508, n = (rr % 508) >> 2, g = rr & 3;
        const bf16* hrow = HIDC + ((size_t)kv * 4096 + rr) * 256; const float* w = w2 + kv * 256 * 64 + d; float s = 0.f;
#pragma unroll 8
        for (int j = 0; j < 256; ++j) s += bf2f(hrow[j]) * w[j * 64];
        KCB[((size_t)((kv * 8 + b) * 4 + g) * 128 + n) * 64 + d] = (bf16)f2bf(s);
    }
    for (int idx = gt; idx < 64 * 64; idx += ngt) { const int q = idx >> 6, d = idx & 63; KCB[((size_t)q * 128 + 127) * 64 + d] = 0; }
}
__device__ __forceinline__ void kcv_unit(Frame& F, int kv, int pm) {
    const int tid_ = tid_opaque(), lane_ = tid_ & 63, fr = lane_ & 15, fq = lane_ >> 4;
    const bf16* HIDC = WSP(bf16, WS_HIDC) + ((size_t)kv * 4096 + pm * 256) * 256; const bf16* w2t = WSP(bf16, WS_CW2) + (size_t)kv * 64 * 256; bf16* KCB = WSP(bf16, WS_KCV);
    asm volatile("s_waitcnt vmcnt(0)" ::: "memory"); __syncthreads();
#pragma unroll
    for (int rb = 0; rb < 2; ++rb) {
        const int r0 = F.wave * 32 + rb * 16;
        f32x4 acc[4];
#pragma unroll
        for (int db = 0; db < 4; ++db) acc[db] = (f32x4){0.f, 0.f, 0.f, 0.f};
#pragma unroll
        for (int ks = 0; ks < 8; ++ks) { const bf16x8 a = *(const bf16x8*)(HIDC + (size_t)(r0 + fr) * 256 + ks * 32 + fq * 8);
#pragma unroll
            for (int db = 0; db < 4; ++db) { const bf16x8 bb = *(const bf16x8*)(w2t + (size_t)(db * 16 + fr) * 256 + ks * 32 + fq * 8); acc[db] = __builtin_amdgcn_mfma_f32_16x16x32_bf16(a, bb, acc[db], 0, 0, 0); } }
#pragma unroll
        for (int reg = 0; reg < 4; ++reg) { const int rr = pm * 256 + r0 + 4 * fq + reg; if (rr < 4064) { const int b = rr / 508, n = (rr % 508) >> 2, g = rr & 3;
#pragma unroll
            for (int db = 0; db < 4; ++db) KCB[((size_t)((kv * 8 + b) * 4 + g) * 128 + n) * 64 + db * 16 + fr] = (bf16)f2bf(acc[db][reg]); } }
    }
    if (blockIdx.x == 0) for (int idx = tid_; idx < 64 * 64; idx += 512) { const int q = idx >> 6, d = idx & 63; KCB[((size_t)q * 128 + 127) * 64 + d] = 0; }
}
namespace fa {
typedef float f32x16 __attribute__((ext_vector_type(16)));
typedef short s16x4 __attribute__((ext_vector_type(4)));
typedef float f32x2_t __attribute__((ext_vector_type(2))); typedef __bf16 bf16x2_t __attribute__((ext_vector_type(2)));
constexpr int SLOTB = 8192, NSLOTS = 3, NKS = 4;
constexpr int LDS_K = 0, LDS_V = NKS * SLOTB, LDS_WS = LDS_V + NSLOTS * SLOTB, LDS_OST = LDS_WS + 8 * 1024, LDS_AUX = LDS_OST + 8 * 8192;
static_assert(LDS_AUX <= RING_BYTES, "attention lds");
__device__ __forceinline__ int crow(int r, int hi) { return (r & 3) + 8 * (r >> 2) + 4 * hi; }
__device__ __forceinline__ constexpr int crow0(int r) { return (r & 3) + 8 * (r >> 2); }
#define FA_SBAR() __builtin_amdgcn_sched_barrier(0)
__device__ __forceinline__ void glds16(const void* gsrc, unsigned lds_dst) { unsigned keep;
    asm volatile("s_mov_b32 %0, m0\n\ts_mov_b32 m0, %2\n\ts_nop 0\n\tglobal_load_lds_dwordx4 %1, off\n\ts_mov_b32 m0, %0" : "=&s"(keep) : "v"(gsrc), "s"(lds_dst) : "memory"); }
__device__ __forceinline__ unsigned cvtpk_s(float lo, float hi) { f32x2_t v = {lo, hi}; bf16x2_t b = __builtin_convertvector(v, bf16x2_t); return __builtin_bit_cast(unsigned, b); }
#define FA_WAIT_BAR(N) asm volatile("s_waitcnt vmcnt(" #N ") lgkmcnt(0)\n\ts_barrier" ::: "memory")
__device__ __forceinline__ void qkt(f32x16& p0, f32x16& p1, const LAS char* kb, const bf16x8* qr, const f32x16& c0) {
#pragma unroll
    for (int d0 = 0; d0 < 4; ++d0) {
        const bf16x8 b0 = *(const LAS bf16x8*)(kb + d0 * 2048);
        const bf16x8 b1 = *(const LAS bf16x8*)(kb + d0 * 2048 + 512);
        if (d0 == 0) { p0 = __builtin_amdgcn_mfma_f32_32x32x16_bf16(b0, qr[0], c0, 0, 0, 0); p1 = __builtin_amdgcn_mfma_f32_32x32x16_bf16(b1, qr[0], c0, 0, 0, 0); }
        else { p0 = __builtin_amdgcn_mfma_f32_32x32x16_bf16(b0, qr[d0], p0, 0, 0, 0); p1 = __builtin_amdgcn_mfma_f32_32x32x16_bf16(b1, qr[d0], p1, 0, 0, 0); }
        __builtin_amdgcn_sched_barrier(0xF); }
}
__device__ __forceinline__ float rowmax(const f32x16& p0, const f32x16& p1) {
    float a = fmaxf(fmaxf(p0[0], p0[1]), p1[0]), b = fmaxf(fmaxf(p0[2], p0[3]), p1[1]); a = fmaxf(fmaxf(a, p1[2]), p1[3]);
#pragma unroll
    for (int r = 4; r < 16; r += 4) { a = fmaxf(fmaxf(a, p0[r]), p0[r + 1]); b = fmaxf(fmaxf(b, p0[r + 2]), p0[r + 3]); a = fmaxf(fmaxf(a, p1[r]), p1[r + 1]); b = fmaxf(fmaxf(b, p1[r + 2]), p1[r + 3]); }
    const float m = fmaxf(a, b);
    auto rr = __builtin_amdgcn_permlane32_swap(__float_as_uint(m), __float_as_uint(m), false, false);
    return fmaxf(__uint_as_float(rr[0]), __uint_as_float(rr[1]));
}
__device__ __forceinline__ float swap_add(float v) { auto rr = __builtin_amdgcn_permlane32_swap(__float_as_uint(v), __float_as_uint(v), false, false); return __uint_as_float(rr[0]) + __uint_as_float(rr[1]); }
__device__ __forceinline__ void pv(f32x16* o, int vb, bf16x8 pa0, bf16x8 pa1, bf16x8 pa2, bf16x8 pa3) {
#pragma unroll
    for (int d0 = 0; d0 < 2; ++d0) { s16x4 lo[4], hi[4];
#pragma unroll
        for (int ks = 0; ks < 4; ++ks) {
            asm volatile("ds_read_b64_tr_b16 %0,%1 offset:%c2" : "=&v"(lo[ks]) : "v"(vb), "i"(d0 * 4096 + ks * 1024) : "memory");
            asm volatile("ds_read_b64_tr_b16 %0,%1 offset:%c2" : "=&v"(hi[ks]) : "v"(vb), "i"(d0 * 4096 + ks * 1024 + 512) : "memory"); }
        asm volatile("s_waitcnt lgkmcnt(0)" ::: "memory"); FA_SBAR();
#define FA_PK(k) (bf16x8){lo[k][0], lo[k][1], lo[k][2], lo[k][3], hi[k][0], hi[k][1], hi[k][2], hi[k][3]}
        o[d0] = __builtin_amdgcn_mfma_f32_32x32x16_bf16(pa0, FA_PK(0), o[d0], 0, 0, 0);
        o[d0] = __builtin_amdgcn_mfma_f32_32x32x16_bf16(pa1, FA_PK(1), o[d0], 0, 0, 0);
        o[d0] = __builtin_amdgcn_mfma_f32_32x32x16_bf16(pa2, FA_PK(2), o[d0], 0, 0, 0);
        o[d0] = __builtin_amdgcn_mfma_f32_32x32x16_bf16(pa3, FA_PK(3), o[d0], 0, 0, 0);
#undef FA_PK
    }
}
typedef short v4i16_t __attribute__((ext_vector_type(4)));
__device__ __forceinline__ s16x4 vtr(const LAS char* p) { return __builtin_bit_cast(s16x4, __builtin_amdgcn_ds_read_tr16_b64_v4i16((LAS v4i16_t*)p)); }
__device__ __forceinline__ void pv2(f32x16* o, const LAS char* vp, bf16x8 pa0, bf16x8 pa1, bf16x8 pa2, bf16x8 pa3) {
#pragma unroll
    for (int d0 = 0; d0 < 2; ++d0) {
        s16x4 lo[4], hi[4];
#pragma unroll
        for (int ks = 0; ks < 4; ++ks) { lo[ks] = vtr(vp + d0 * 4096 + ks * 1024); hi[ks] = vtr(vp + d0 * 4096 + ks * 1024 + 512); }
#define FA_PK(k) (bf16x8){lo[k][0], lo[k][1], lo[k][2], lo[k][3], hi[k][0], hi[k][1], hi[k][2], hi[k][3]}
        o[d0] = __builtin_amdgcn_mfma_f32_32x32x16_bf16(pa0, FA_PK(0), o[d0], 0, 0, 0);
        o[d0] = __builtin_amdgcn_mfma_f32_32x32x16_bf16(pa1, FA_PK(1), o[d0], 0, 0, 0);
        o[d0] = __builtin_amdgcn_mfma_f32_32x32x16_bf16(pa2, FA_PK(2), o[d0], 0, 0, 0);
        o[d0] = __builtin_amdgcn_mfma_f32_32x32x16_bf16(pa3, FA_PK(3), o[d0], 0, 0, 0);
#undef FA_PK
        __builtin_amdgcn_sched_barrier(0xF);
    }
}
struct Soft { float mhat, l; f32x16 o[2]; f32x16 negm; };
__device__ __forceinline__ void qk_half(f32x16& p, const LAS char* kbh, const bf16x8* qr) {
    const f32x16 zero = f32x16{};
#pragma unroll
    for (int d0 = 0; d0 < 4; ++d0) { const bf16x8 b = *(const LAS bf16x8*)(kbh + d0 * 2048); p = __builtin_amdgcn_mfma_f32_32x32x16_bf16(b, qr[d0], d0 == 0 ? zero : p, 0, 0, 0); }
}
__device__ __forceinline__ float rowmax16(const f32x16& p) {
    float a = fmaxf(fmaxf(p[0], p[1]), p[2]), b = fmaxf(fmaxf(p[3], p[4]), p[5]);
    a = fmaxf(fmaxf(a, p[6]), p[7]); b = fmaxf(fmaxf(b, p[8]), p[9]); a = fmaxf(fmaxf(a, p[10]), p[11]); b = fmaxf(fmaxf(b, p[12]), p[13]); a = fmaxf(fmaxf(a, p[14]), p[15]);
    const float m = fmaxf(a, b);
    auto rr = __builtin_amdgcn_permlane32_swap(__float_as_uint(m), __float_as_uint(m), false, false);
    return fmaxf(__uint_as_float(rr[0]), __uint_as_float(rr[1]));
}
__device__ __forceinline__ void soft_half(Soft& s, f32x16& p, const LAS char* vph, LAS float* wsf, int r32, int hi) {
    const float rm = rowmax16(p) - s.mhat;
    if (__any(rm > 8.f)) {
        const float dl = fmaxf(rm, 0.f); s.mhat += dl;
        const float f = __builtin_amdgcn_exp2f(-dl); s.l *= f; if (hi == 0) wsf[r32] = f;
        LDS_WAIT(); asm volatile("" ::: "memory");
        const LAS float* wh = wsf + 4 * hi;
#pragma unroll
        for (int d = 0; d < 2; ++d)
#pragma unroll
            for (int r = 0; r < 16; ++r) s.o[d][r] *= wh[crow0(r)];
        LDS_WAIT(); asm volatile("" ::: "memory");
    }
    float sa = 0.f; const float mh = s.mhat;
#pragma unroll
    for (int r = 0; r < 16; ++r) { p[r] = __builtin_amdgcn_exp2f(p[r] - mh); sa += p[r]; }
    s.l += sa;
    const v4u pw0 = (v4u){cvtpk_s(p[0], p[1]), cvtpk_s(p[2], p[3]), cvtpk_s(p[4], p[5]), cvtpk_s(p[6], p[7])};
    const v4u pw1 = (v4u){cvtpk_s(p[8], p[9]), cvtpk_s(p[10], p[11]), cvtpk_s(p[12], p[13]), cvtpk_s(p[14], p[15])};
#pragma unroll
    for (int d0 = 0; d0 < 2; ++d0) {
        const s16x4 l0 = vtr(vph + d0 * 4096), h0 = vtr(vph + d0 * 4096 + 512), l1 = vtr(vph + d0 * 4096 + 1024), h1 = vtr(vph + d0 * 4096 + 1536);
        s.o[d0] = __builtin_amdgcn_mfma_f32_32x32x16_bf16(__builtin_bit_cast(bf16x8, pw0), (bf16x8){l0[0], l0[1], l0[2], l0[3], h0[0], h0[1], h0[2], h0[3]}, s.o[d0], 0, 0, 0);
        s.o[d0] = __builtin_amdgcn_mfma_f32_32x32x16_bf16(__builtin_bit_cast(bf16x8, pw1), (bf16x8){l1[0], l1[1], l1[2], l1[3], h1[0], h1[1], h1[2], h1[3]}, s.o[d0], 0, 0, 0);
    }
}
struct P8 { f32x2 v[8]; };
__device__ __forceinline__ void qk_half_c(f32x16& p, const LAS char* kbh, const bf16x8* qr, const f32x16& negm) {
#pragma unroll
    for (int d0 = 0; d0 < 4; ++d0) { const bf16x8 b = *(const LAS bf16x8*)(kbh + d0 * 2048); p = __builtin_amdgcn_mfma_f32_32x32x16_bf16(b, qr[d0], d0 == 0 ? negm : p, 0, 0, 0); }
}
__device__ __forceinline__ void soft_half_c(Soft& s, f32x16& pin, f32x16& nx, const LAS char* vph, LAS float* wsf, int r32, int hi) {
    P8 p = __builtin_bit_cast(P8, pin);
    const float rm = rowmax16(pin);
    if (__any(rm > 8.f)) {
        const float dl = fmaxf(rm, 0.f); s.mhat += dl; const f32x2 d2 = {dl, dl};
        P8 n = __builtin_bit_cast(P8, nx);
#pragma unroll
        for (int i = 0; i < 8; ++i) { p.v[i] = p.v[i] - d2; n.v[i] = n.v[i] - d2; }
        nx = __builtin_bit_cast(f32x16, n);
#pragma unroll
        for (int r = 0; r < 16; ++r) s.negm[r] = -s.mhat;
        const float f = __builtin_amdgcn_exp2f(-dl); s.l *= f; if (hi == 0) wsf[r32] = f;
        LDS_WAIT(); asm volatile("" ::: "memory");
        const LAS float* wh = wsf + 4 * hi;
#pragma unroll
        for (int d = 0; d < 2; ++d)
#pragma unroll
            for (int r = 0; r < 16; ++r) s.o[d][r] *= wh[crow0(r)];
        LDS_WAIT(); asm volatile("" ::: "memory");
    }
#pragma unroll
    for (int i = 0; i < 8; ++i) { p.v[i].x = __builtin_amdgcn_exp2f(p.v[i].x); p.v[i].y = __builtin_amdgcn_exp2f(p.v[i].y); }
    f32x2 acc = (p.v[0] + p.v[1]) + (p.v[2] + p.v[3]); acc += (p.v[4] + p.v[5]) + (p.v[6] + p.v[7]);
    s.l += acc.x + acc.y;
    const v4u pw0 = (v4u){cvtpk_s(p.v[0].x, p.v[0].y), cvtpk_s(p.v[1].x, p.v[1].y), cvtpk_s(p.v[2].x, p.v[2].y), cvtpk_s(p.v[3].x, p.v[3].y)};
    const v4u pw1 = (v4u){cvtpk_s(p.v[4].x, p.v[4].y), cvtpk_s(p.v[5].x, p.v[5].y), cvtpk_s(p.v[6].x, p.v[6].y), cvtpk_s(p.v[7].x, p.v[7].y)};
#pragma unroll
    for (int d0 = 0; d0 < 2; ++d0) {
        const s16x4 l0 = vtr(vph + d0 * 4096), h0 = vtr(vph + d0 * 4096 + 512), l1 = vtr(vph + d0 * 4096 + 1024), h1 = vtr(vph + d0 * 4096 + 1536);
        s.o[d0] = __builtin_amdgcn_mfma_f32_32x32x16_bf16(__builtin_bit_cast(bf16x8, pw0), (bf16x8){l0[0], l0[1], l0[2], l0[3], h0[0], h0[1], h0[2], h0[3]}, s.o[d0], 0, 0, 0);
        s.o[d0] = __builtin_amdgcn_mfma_f32_32x32x16_bf16(__builtin_bit_cast(bf16x8, pw1), (bf16x8){l1[0], l1[1], l1[2], l1[3], h1[0], h1[1], h1[2], h1[3]}, s.o[d0], 0, 0, 0);
    }
}
__device__ __forceinline__ void mask_causal_h(f32x16& p, int tq, int hi, int half) {
#pragma unroll
    for (int r = 0; r < 16; ++r) { if (32 * half + crow(r, hi) > tq) p[r] = -INFINITY; }
}
__device__ __forceinline__ void mask_anti_h(f32x16& p, int tq, int hi, int half) {
#pragma unroll
    for (int r = 0; r < 16; ++r) { if (32 * half + crow(r, hi) <= tq) p[r] = -INFINITY; }
}
__device__ __forceinline__ void mask_all_h(f32x16& p, bool kill) {
#pragma unroll
    for (int r = 0; r < 16; ++r) p[r] = kill ? -INFINITY : p[r];
}
__device__ __forceinline__ void soft_reset(Soft& s) { s.mhat = 0.f; s.l = 0.f; s.o[0] = f32x16{}; s.o[1] = f32x16{}; s.negm = f32x16{}; asm volatile("" : "+v"(s.negm)); }
__device__ __forceinline__ void soft_step(Soft& s, f32x16& p0, f32x16& p1, int vb, LAS float* wsf, int r32, int hi) {
    const float rm = rowmax(p0, p1);
    if (__any(rm > 8.f)) {
        const float dl = fmaxf(rm, 0.f); s.mhat += dl;
#pragma unroll
        for (int r = 0; r < 16; ++r) { p0[r] -= dl; p1[r] -= dl; }
#pragma unroll
        for (int r = 0; r < 16; ++r) s.negm[r] = -s.mhat;
        asm volatile("" : "+v"(s.negm));
        const float f = exp2f(-dl); s.l *= f; if (hi == 0) wsf[r32] = f;
        LDS_WAIT(); asm volatile("" ::: "memory");
#pragma unroll
        for (int d = 0; d < 2; ++d)
#pragma unroll
            for (int r = 0; r < 16; ++r) s.o[d][r] *= wsf[crow(r, hi)];
        LDS_WAIT(); asm volatile("" ::: "memory");
    }
    float sacc = 0.f;
#pragma unroll
    for (int r = 0; r < 16; ++r) { p0[r] = exp2f(p0[r]); p1[r] = exp2f(p1[r]); sacc += p0[r] + p1[r]; }
    s.l += sacc;
    v4u pw0, pw1, pw2, pw3;
    pw0 = (v4u){cvtpk_s(p0[0], p0[1]), cvtpk_s(p0[2], p0[3]), cvtpk_s(p0[4], p0[5]), cvtpk_s(p0[6], p0[7])};
    pw1 = (v4u){cvtpk_s(p0[8], p0[9]), cvtpk_s(p0[10], p0[11]), cvtpk_s(p0[12], p0[13]), cvtpk_s(p0[14], p0[15])};
    pw2 = (v4u){cvtpk_s(p1[0], p1[1]), cvtpk_s(p1[2], p1[3]), cvtpk_s(p1[4], p1[5]), cvtpk_s(p1[6], p1[7])};
    pw3 = (v4u){cvtpk_s(p1[8], p1[9]), cvtpk_s(p1[10], p1[11]), cvtpk_s(p1[12], p1[13]), cvtpk_s(p1[14], p1[15])};
    pv(s.o, vb, __builtin_bit_cast(bf16x8, pw0), __builtin_bit_cast(bf16x8, pw1), __builtin_bit_cast(bf16x8, pw2), __builtin_bit_cast(bf16x8, pw3));
}
__device__ __forceinline__ void soft_step2(Soft& s, f32x16& p0, f32x16& p1, const LAS char* vp, LAS float* wsf, int r32, int hi) {
    const float rm = rowmax(p0, p1) - s.mhat;
    if (__any(rm > 8.f)) {
        const float dl = fmaxf(rm, 0.f); s.mhat += dl;
        const float f = __builtin_amdgcn_exp2f(-dl); s.l *= f; if (hi == 0) wsf[r32] = f;
        LDS_WAIT(); asm volatile("" ::: "memory");
        const LAS float* wh = wsf + 4 * hi;
#pragma unroll
        for (int d = 0; d < 2; ++d)
#pragma unroll
            for (int r = 0; r < 16; ++r) s.o[d][r] *= wh[crow0(r)];
        LDS_WAIT(); asm volatile("" ::: "memory");
    }
    float sa = 0.f, sb = 0.f; const float mh = s.mhat;
#pragma unroll
    for (int r = 0; r < 16; ++r) { p0[r] = __builtin_amdgcn_exp2f(p0[r] - mh); p1[r] = __builtin_amdgcn_exp2f(p1[r] - mh); sa += p0[r]; sb += p1[r]; }
    s.l += sa + sb;
    v4u pw0, pw1, pw2, pw3;
    pw0 = (v4u){cvtpk_s(p0[0], p0[1]), cvtpk_s(p0[2], p0[3]), cvtpk_s(p0[4], p0[5]), cvtpk_s(p0[6], p0[7])};
    pw1 = (v4u){cvtpk_s(p0[8], p0[9]), cvtpk_s(p0[10], p0[11]), cvtpk_s(p0[12], p0[13]), cvtpk_s(p0[14], p0[15])};
    pw2 = (v4u){cvtpk_s(p1[0], p1[1]), cvtpk_s(p1[2], p1[3]), cvtpk_s(p1[4], p1[5]), cvtpk_s(p1[6], p1[7])};
    pw3 = (v4u){cvtpk_s(p1[8], p1[9]), cvtpk_s(p1[10], p1[11]), cvtpk_s(p1[12], p1[13]), cvtpk_s(p1[14], p1[15])};
    pv2(s.o, vp, __builtin_bit_cast(bf16x8, pw0), __builtin_bit_cast(bf16x8, pw1), __builtin_bit_cast(bf16x8, pw2), __builtin_bit_cast(bf16x8, pw3));
}
__device__ __forceinline__ void soft_finish(Soft& s, f32x16* tot, float gate, LAS float* wsf, int r32, int hi) {
    const float lt = swap_add(s.l); const float fac = (lt > 0.f) ? gate / lt : 0.f;
    if (hi == 0) wsf[32 + r32] = fac;
    LDS_WAIT(); asm volatile("" ::: "memory");
#pragma unroll
    for (int r = 0; r < 16; ++r) { const float f = wsf[32 + crow(r, hi)]; tot[0][r] += s.o[0][r] * f; tot[1][r] += s.o[1][r] * f; }
    LDS_WAIT(); asm volatile("" ::: "memory");
    soft_reset(s);
}
__device__ __forceinline__ void soft_finish_stage(Soft& s, LAS float* stg, bool first, float gate, LAS float* wsf, int r32, int hi) {
    const float lt = swap_add(s.l); const float fac = (lt > 0.f) ? gate / lt : 0.f;
    if (hi == 0) wsf[32 + r32] = fac;
    LDS_WAIT(); asm volatile("" ::: "memory");
#pragma unroll
    for (int r = 0; r < 16; ++r) { const float f = (wsf + 32 + 4 * hi)[crow0(r)]; LAS float* sp = (stg + 4 * hi * 64 + r32) + crow0(r) * 64;
        if (first) { sp[0] = s.o[0][r] * f; sp[32] = s.o[1][r] * f; } else { sp[0] += s.o[0][r] * f; sp[32] += s.o[1][r] * f; } }
    LDS_WAIT(); asm volatile("" ::: "memory");
    soft_reset(s);
}
__device__ __forceinline__ void mask_causal(f32x16& p0, f32x16& p1, int tq, int hi) {
#pragma unroll
    for (int r = 0; r < 16; ++r) { const int kv = crow(r, hi); if (kv > tq) p0[r] = -INFINITY; if (kv + 32 > tq) p1[r] = -INFINITY; }
}
__device__ __forceinline__ void mask_anti(f32x16& p0, f32x16& p1, int tq, int hi) {
#pragma unroll
    for (int r = 0; r < 16; ++r) { const int kv = crow(r, hi); if (kv <= tq) p0[r] = -INFINITY; if (kv + 32 <= tq) p1[r] = -INFINITY; }
}
__device__ __forceinline__ void mask_all(f32x16& p0, f32x16& p1, bool kill) {
#pragma unroll
    for (int r = 0; r < 16; ++r) { p0[r] = kill ? -INFINITY : p0[r]; p1[r] = kill ? -INFINITY : p1[r]; }
}

__device__ __forceinline__ void sel_win_unit(LAS unsigned char* shm, int b, int g, int tb, const bf16* PROJ, const unsigned* SELM, const float* OACC, bf16* ONSA) {
    const int tid = tid_opaque(), lane = tid & 63, r32 = lane & 31, hi = lane >> 5; const int wid = __builtin_amdgcn_readfirstlane(tid >> 6);
    const int hh = wid & 3, th = wid >> 2, head = g * 4 + hh, tq = th * 32 + r32, t = tb * 64 + tq; const size_t row = (size_t)b * SEQ + t;
    const unsigned lds0 = (unsigned)(uintptr_t)shm;
    LAS float* wsf = (LAS float*)(shm + LDS_WS) + wid * 256;
    const bf16* bbase = PROJ + (size_t)b * SEQ * PLD + g * 64;
    const int nsel = tb + 1, jlo = (tb > 8) ? tb - 8 : 0, ntot = nsel + (tb - jlo + 1);
#define FA_KOFF(l_) ((unsigned)((l_) * PLD + wid * 8) * 2u)
#define FA_VOFF(l_) ((unsigned)((16 * (wid & 3) + ((l_) >> 2)) * PLD + (wid >> 2) * 32 + ((l_) & 3) * 8) * 2u)
    const unsigned koff_ = FA_KOFF(lane), voff_ = FA_VOFF(lane);
    const unsigned kdst = lds0 + LDS_K + wid * 1024, vdst = lds0 + LDS_V + wid * 1024;
#define FA_TILE(i) const int i_ = (i); const bool w_ = i_ >= nsel; const int j_ = w_ ? jlo + i_ - nsel : i_; const bf16* tb_ = bbase + (size_t)(j_ * 64) * PLD + (w_ ? PC_KW : PC_KS); const bf16* tv_ = bbase + (size_t)(j_ * 64) * PLD + (w_ ? PC_VW : PC_VS)
#define FA_ISSUE_K(i) do { if ((i) < ntot) { FA_TILE(i); glds16((const char*)tb_ + koff_, (unsigned)__builtin_amdgcn_readfirstlane(kdst + (unsigned)((i_ % NKS) * SLOTB))); } } while (0)
#define FA_ISSUE_V(i) do { if ((i) < ntot) { FA_TILE(i); glds16((const char*)tv_ + voff_, (unsigned)__builtin_amdgcn_readfirstlane(vdst + (unsigned)((i_ % NSLOTS) * SLOTB))); } } while (0)
    const bf16* prow = PROJ + row * PLD;
    bf16x8 qr[4];
#pragma unroll
    for (int d0 = 0; d0 < 4; ++d0) qr[d0] = *(const bf16x8*)(prow + PC_Q + head * 64 + d0 * 16 + hi * 8);
    if (hi == 0) { wsf[64 + r32] = sigm(bf2f(prow[PC_G3 + head * 3 + 1])); wsf[96 + r32] = sigm(bf2f(prow[PC_G3 + head * 3 + 2])); ((LAS unsigned*)wsf)[128 + r32] = __hip_atomic_load(SELM + (size_t)(b * 4 + g) * SEQ + t, RLX_AGENT); }
    FA_ISSUE_K(0); FA_ISSUE_V(0); FA_ISSUE_K(1); FA_ISSUE_K(2); FA_ISSUE_V(1);
    Soft st; soft_reset(st);
    LAS float* stg = (LAS float*)(shm + LDS_OST) + wid * 2048;
    const LAS char* kp0 = (const LAS char*)shm + LDS_K + hi * 1024 + r32 * 16;
    const LAS char* vp0 = (const LAS char*)shm + LDS_V + ((lane >> 4) & 1) * 32 + (lane & 3) * 8 + (4 * hi + ((lane & 15) >> 2)) * 64;
    if (ntot >= 3) { FA_WAIT_BAR(4); } else { FA_WAIT_BAR(3); }
    f32x16 sa_, sb_;
    qk_half_c(sa_, kp0, qr, st.negm); sb_ = sa_;
    for (int i = 0; i < ntot; ++i) {
        if (i + 2 < ntot) { FA_WAIT_BAR(2); } else if (i + 1 < ntot) { FA_WAIT_BAR(1); } else { FA_WAIT_BAR(0); }
        FA_ISSUE_K(i + 3); FA_ISSUE_V(i + 2);
        const bool issel = i < nsel; const int j = issel ? i : jlo + i - nsel;
        const int mcase = (j == tb) ? 1 : ((!issel && j == tb - 8) ? 2 : 0);
        bool kill = false; if (issel) { const unsigned mask = ((const LAS unsigned*)wsf)[128 + r32]; kill = !((mask >> i) & 1u); }
        const bool anyk = __any(kill);
        const LAS char* vpi = vp0 + (i % NSLOTS) * SLOTB;
        qk_half_c(sb_, kp0 + (i % NKS) * SLOTB + 512, qr, st.negm);
        if (anyk) mask_all_h(sa_, kill);
        if (mcase == 1) mask_causal_h(sa_, tq, hi, 0); else if (mcase == 2) mask_anti_h(sa_, tq, hi, 0);
        soft_half_c(st, sa_, sb_, vpi, wsf, r32, hi);
        if (i + 1 < ntot) qk_half_c(sa_, kp0 + ((i + 1) % NKS) * SLOTB, qr, st.negm);
        if (anyk) mask_all_h(sb_, kill);
        if (mcase == 1) mask_causal_h(sb_, tq, hi, 1); else if (mcase == 2) mask_anti_h(sb_, tq, hi, 1);
        soft_half_c(st, sb_, sa_, vpi + 2048, wsf, r32, hi);
        if (i == nsel - 1) { const float mo = st.mhat; soft_finish_stage(st, stg, true, wsf[64 + r32], wsf, r32, hi);
#pragma unroll
            for (int r = 0; r < 16; ++r) sa_[r] += mo; }
    }
    soft_finish_stage(st, stg, false, wsf[96 + r32], wsf, r32, hi);
    const size_t rowbase = (size_t)b * SEQ + tb * 64 + th * 32;
    { float t0[16], t1[16];
#pragma unroll
        for (int r = 0; r < 16; ++r) { const float* oa = OACC + (rowbase + crow(r, hi)) * 1024 + head * 64 + r32; const LAS float* sp = (stg + 4 * hi * 64 + r32) + crow0(r) * 64; t0[r] = sp[0] + oa[0]; t1[r] = sp[32] + oa[32]; }
        LDS_WAIT(); asm volatile("" ::: "memory");
        LAS bf16* sb = (LAS bf16*)stg;
#pragma unroll
        for (int r = 0; r < 16; ++r) { LAS bf16* bp = (sb + 4 * hi * 64 + r32) + crow0(r) * 64; bp[0] = (bf16)f2bf(t0[r]); bp[32] = (bf16)f2bf(t1[r]); }
        LDS_WAIT(); asm volatile("" ::: "memory");
#pragma unroll
        for (int i = 0; i < 4; ++i) { const int rr = i * 8 + (lane >> 3), ch = lane & 7; const v4u v = *(const LAS v4u*)(sb + rr * 64 + ch * 8); *(v4u*)(ONSA + (rowbase + rr) * 2048 + head * 64 + ch * 8) = v; } }
    asm volatile("s_waitcnt lgkmcnt(0)\n\ts_barrier" ::: "memory");
#undef FA_TILE
#undef FA_ISSUE_K
#undef FA_ISSUE_V
#undef FA_KOFF
#undef FA_VOFF
}
}
namespace cs {
using fa::f32x16; using fa::crow; using fa::glds16; using fa::cvtpk_s; using fa::pv; using fa::swap_add; using fa::qkt; using fa::rowmax;
constexpr int C_K = 0, C_V = 16384, C_WS = 32768, C_OWN = 34816, TBW = 32 * 33, C_CAR = C_OWN + 8 * TBW * 4, C_IMP = C_CAR + 8 * TBW * 4, C_END = C_IMP + 64 * 33 * 4;
static_assert(C_END <= RING_BYTES, "cmp lds");
__device__ __forceinline__ void mask_nv(f32x16& p0, f32x16& p1, int base, int nvalid, int hi) {
#pragma unroll
    for (int r = 0; r < 16; ++r) { const int n = base + crow(r, hi); if (n >= nvalid) p0[r] = -INFINITY; if (n + 32 >= nvalid) p1[r] = -INFINITY; }
}
__device__ __forceinline__ void imp_tile(const f32x16& p0, const f32x16& p1, LAS float* own, LAS float* car, int jt, int hi) {
#pragma unroll
    for (int a = 0; a < 4; ++a) {
        const int j0 = jt + 2 * a + hi, j1 = jt + 8 + 2 * a + hi;
        own[j0] = (p0[4 * a] + p0[4 * a + 1]) + (p0[4 * a + 2] + 0.5f * p0[4 * a + 3]); car[j0 + 1] = 0.5f * p0[4 * a + 3];
        own[j1] = (p1[4 * a] + p1[4 * a + 1]) + (p1[4 * a + 2] + 0.5f * p1[4 * a + 3]); if (j1 + 1 < 32) car[j1 + 1] = 0.5f * p1[4 * a + 3];
    }
}
__device__ __forceinline__ bf16x8 pk8(const f32x16& p, int o) { v4u w = (v4u){cvtpk_s(p[o], p[o + 1]), cvtpk_s(p[o + 2], p[o + 3]), cvtpk_s(p[o + 4], p[o + 5]), cvtpk_s(p[o + 6], p[o + 7])}; return __builtin_bit_cast(bf16x8, w); }
__device__ __forceinline__ void cmp_unit(LAS unsigned char* shm, int b, int g, int tb, const bf16* PROJ, const bf16* KCB, float* OACC, unsigned* SELM) {
    const int tid = tid_opaque(), lane = tid & 63, r32 = lane & 31, hi = lane >> 5; const int wid = __builtin_amdgcn_readfirstlane(tid >> 6);
    const int hh = wid & 3, th = wid >> 2, head = g * 4 + hh, tq = th * 32 + r32, t = tb * 64 + tq; const size_t row = (size_t)b * SEQ + t;
    const unsigned lds0 = (unsigned)(uintptr_t)shm;
    LAS float* wsf = (LAS float*)(shm + C_WS) + wid * 64;
    const int ntile = (tb >= 16) ? 2 : 1;
    const bf16* kc = KCB + (size_t)((0 * 8 + b) * 4 + g) * 8192; const bf16* vc = KCB + (size_t)((1 * 8 + b) * 4 + g) * 8192;
    for (int tau = 0; tau < ntile; ++tau) {
        glds16(kc + (size_t)(64 * tau + lane) * 64 + wid * 8, (unsigned)__builtin_amdgcn_readfirstlane(lds0 + C_K + tau * 8192 + wid * 1024));
        glds16(vc + (size_t)(64 * tau + 16 * (wid & 3) + (lane >> 2)) * 64 + (wid >> 2) * 32 + (lane & 3) * 8, (unsigned)__builtin_amdgcn_readfirstlane(lds0 + C_V + tau * 8192 + wid * 1024));
    }
    const bf16* prow = PROJ + row * PLD;
    bf16x8 qr[4];
#pragma unroll
    for (int d0 = 0; d0 < 4; ++d0) qr[d0] = *(const bf16x8*)(prow + PC_Q + head * 64 + d0 * 16 + hi * 8);
    const float g0 = sigm(bf2f(prow[PC_G3 + head * 3 + 0]));
    const int nvalid = (t >= 31) ? (((t - 31) >> 4) + 1) : 0;
    asm volatile("s_waitcnt vmcnt(0) lgkmcnt(0)\n\ts_barrier" ::: "memory");
    const LAS char* kp0 = (const LAS char*)shm + C_K + hi * 1024 + r32 * 16;
    const int vb0 = (int)(lds0 + C_V) + ((lane >> 4) & 1) * 32 + (lane & 3) * 8 + (4 * hi + ((lane & 15) >> 2)) * 64;
    const f32x16 zero = f32x16{};
    f32x16 p0, p1, p2, p3;
    qkt(p0, p1, kp0, qr, zero); mask_nv(p0, p1, 0, nvalid, hi);
    float m = rowmax(p0, p1);
    if (ntile == 2) { qkt(p2, p3, kp0 + 8192, qr, zero); mask_nv(p2, p3, 64, nvalid, hi); m = fmaxf(m, rowmax(p2, p3)); }
    m = fmaxf(m, -1e30f);
    float l = 0.f;
#pragma unroll
    for (int r = 0; r < 16; ++r) { p0[r] = exp2f(p0[r] - m); p1[r] = exp2f(p1[r] - m); l += p0[r] + p1[r]; }
    if (ntile == 2) {
#pragma unroll
        for (int r = 0; r < 16; ++r) { p2[r] = exp2f(p2[r] - m); p3[r] = exp2f(p3[r] - m); l += p2[r] + p3[r]; } }
    const float lt = swap_add(l); const float inv = (lt > 0.f) ? 1.f / lt : 0.f;
#pragma unroll
    for (int r = 0; r < 16; ++r) { p0[r] *= inv; p1[r] *= inv; }
    f32x16 o[2]; o[0] = f32x16{}; o[1] = f32x16{};
    pv(o, vb0, pk8(p0, 0), pk8(p0, 8), pk8(p1, 0), pk8(p1, 8));
    LAS float* own = (LAS float*)(shm + C_OWN) + wid * TBW + r32 * 33; LAS float* car = (LAS float*)(shm + C_CAR) + wid * TBW + r32 * 33;
    imp_tile(p0, p1, own, car, 0, hi);
    if (ntile == 2) {
#pragma unroll
        for (int r = 0; r < 16; ++r) { p2[r] *= inv; p3[r] *= inv; }
        pv(o, vb0 + 8192, pk8(p2, 0), pk8(p2, 8), pk8(p3, 0), pk8(p3, 8));
        imp_tile(p2, p3, own, car, 16, hi);
    }
    if (hi == 0) wsf[r32] = g0;
    LDS_WAIT(); asm volatile("" ::: "memory");
    const size_t rowbase = (size_t)b * SEQ + tb * 64 + th * 32;
#pragma unroll
    for (int r = 0; r < 16; ++r) { const float gq = wsf[crow(r, hi)]; float* oa = OACC + (rowbase + crow(r, hi)) * 1024 + head * 64 + r32; oa[0] = o[0][r] * gq; oa[32] = o[1][r] * gq; }
    asm volatile("s_waitcnt lgkmcnt(0)\n\ts_barrier" ::: "memory");
    LAS float* IMPS = (LAS float*)(shm + C_IMP);
#pragma unroll
    for (int pass = 0; pass < 4; ++pass) { const int tok = pass * 16 + (tid >> 5), j = tid & 31, q = tok & 31, w0 = (tok >> 5) * 4; float v = 0.f;
        if (j < 16 * ntile) {
#pragma unroll
            for (int k = 0; k < 4; ++k) { v += ((LAS float*)(shm + C_OWN))[(w0 + k) * TBW + q * 33 + j]; if (j > 0) v += ((LAS float*)(shm + C_CAR))[(w0 + k) * TBW + q * 33 + j]; } }
        IMPS[tok * 33 + j] = v; }
    asm volatile("s_waitcnt lgkmcnt(0)\n\ts_barrier" ::: "memory");
#pragma unroll
    for (int pass = 0; pass < 4; ++pass) { const int tok = pass * 16 + (tid >> 5), j = tid & 31, cur = tb;
        const bool forced = (j == 0) || (j == cur) || (j == cur - 1);
        const float score = (j <= cur) ? IMPS[tok * 33 + j] + (forced ? 1000.f : 0.f) : -1e9f;
        int rank = 0;
        for (int i = 0; i < 32; ++i) { const bool fi = (i == 0) || (i == cur) || (i == cur - 1); const float si = (i <= cur) ? IMPS[tok * 33 + i] + (fi ? 1000.f : 0.f) : -1e9f; rank += ((si > score) || (si == score && i < j)) ? 1 : 0; }
        const bool sel = (rank < 16) && (score > -5e8f);
        const unsigned long long bal = __ballot(sel);
        if ((lane & 31) == 0) SELM[(size_t)(b * 4 + g) * SEQ + tb * 64 + tok] = (unsigned)(bal >> (lane & 32)); }
    asm volatile("s_waitcnt vmcnt(0) lgkmcnt(0)\n\ts_barrier" ::: "memory");
}
}
__device__ __forceinline__ void p5_cmp_select(Frame& F) {
    const int tid_ = tid_opaque(), lane_ = tid_ & 63; (void)lane_;
    const bf16* PROJ = WSP(bf16, WS_PROJ); const bf16* KCB = WSP(bf16, WS_KCV); float* OACC = WSP(float, WS_OACC); unsigned* SELM = WSP(unsigned, WS_SELM);
    for (int u = blockIdx.x; u < 1024; u += F.G) { const int bg = u >> 5, tb = u & 31; cs::cmp_unit(F.lds, bg >> 2, bg & 3, tb, PROJ, KCB, OACC, SELM); }
}
namespace ml {
using fa::f32x16; using fa::crow; using fa::glds16; using fa::cvtpk_s; using fa::swap_add; using fa::vtr;
constexpr int NR = 4, KSL = 8192, VSL = 16384;
constexpr int L_K = 0, L_V = NR * KSL, L_W = L_V + NR * VSL, L_WS = L_W + 8192, L_UT = L_WS + 8 * 256, L_END = L_UT + 8192;
static_assert(L_END <= RING_BYTES, "mlstm lds");
__device__ __forceinline__ void mlstm_unit(LAS unsigned char* shm, int b, int h, int tb, const bf16* PROJ, const bf16* QKC, const float* GA2, const float* GU2, const float* GM2, const float* mhg, bf16* OML) {
    const int tid = tid_opaque(), lane = tid & 63, r32 = lane & 31, hi = lane >> 5; const int wid = __builtin_amdgcn_readfirstlane(tid >> 6);
    const int vq = wid & 3, th = wid >> 2, tq = th * 32 + r32, t = tb * 64 + tq, bh = b * 4 + h; const size_t row = (size_t)b * SEQ + t;
    const unsigned lds0 = (unsigned)(uintptr_t)shm;
    LAS float* wsf = (LAS float*)(shm + L_WS) + wid * 64;
    LAS float* ut = (LAS float*)(shm + L_UT);
    const int n = 2 * (tb + 1);
    for (int i = tid; i < n * 32; i += 512) ut[i] = GU2[bh * SEQ + i];
    const bf16* kbase = QKC + (size_t)b * SEQ * 1024 + 512 + h * 128 + (size_t)(lane & 31) * 1024 + (2 * wid + (lane >> 5)) * 8;
    const bf16* vb0 = PROJ + (size_t)b * SEQ * PLD + PC_VM + h * 256 + (size_t)(lane >> 2) * PLD + (lane & 3) * 8;
    const int pa = 2 * wid, pb = 2 * wid + 1;
    const bf16* vbaseA = vb0 + (size_t)(16 * (pa & 1)) * PLD + (pa >> 2) * 64 + ((pa >> 1) & 1) * 32;
    const bf16* vbaseB = vb0 + (size_t)(16 * (pb & 1)) * PLD + (pb >> 2) * 64 + ((pb >> 1) & 1) * 32;
    const unsigned kdst = lds0 + L_K + wid * 1024, vdst = lds0 + L_V + wid * 2048;
#define ML_ISSUE_K(i) do { const int i_ = (i); if (i_ < n) glds16(kbase + (size_t)(i_ * 32) * 1024, (unsigned)__builtin_amdgcn_readfirstlane(kdst + (unsigned)((i_ & 3) * KSL))); } while (0)
#define ML_ISSUE_V(i) do { const int i_ = (i); if (i_ >= 0 && i_ < n) { const unsigned d_ = (unsigned)__builtin_amdgcn_readfirstlane(vdst + (unsigned)((i_ & 3) * VSL)); \
        glds16(vbaseA + (size_t)(i_ * 32) * PLD, d_); glds16(vbaseB + (size_t)(i_ * 32) * PLD, d_ + 1024u); } } while (0)
    bf16x8 qr[8];
#pragma unroll
    for (int d0 = 0; d0 < 8; ++d0) qr[d0] = *(const bf16x8*)(QKC + row * 1024 + h * 128 + d0 * 16 + hi * 8);
    const float M2 = GM2[bh * SEQ + t], A2 = GA2[bh * SEQ + t];
    ML_ISSUE_K(0); ML_ISSUE_K(1); ML_ISSUE_V(0); ML_ISSUE_K(2); ML_ISSUE_V(1);
    f32x16 o[2]; o[0] = f32x16{}; o[1] = f32x16{}; float den = 0.f;
    const f32x16 zero = f32x16{};
    const int vbl = ((lane >> 4) & 1) * 32 + (lane & 3) * 8 + (4 * hi + ((lane & 15) >> 2)) * 64;
    LAS unsigned char* wbase = shm + L_W + th * 2048 + lane * 16;
    for (int s = 0; s <= n; ++s) {
        if (s + 2 < n) asm volatile("s_waitcnt vmcnt(6) lgkmcnt(0)\n\ts_barrier" ::: "memory");
        else if (s + 2 == n) asm volatile("s_waitcnt vmcnt(5) lgkmcnt(0)\n\ts_barrier" ::: "memory");
        else if (s + 1 == n) asm volatile("s_waitcnt vmcnt(2) lgkmcnt(0)\n\ts_barrier" ::: "memory");
        else asm volatile("s_waitcnt vmcnt(0) lgkmcnt(0)\n\ts_barrier" ::: "memory");
        ML_ISSUE_K(s + 3); ML_ISSUE_V(s + 2);
        if (s < n && vq == (s & 3)) {
            const LAS char* kb = (const LAS char*)shm + L_K + (s & 3) * KSL + hi * 512 + r32 * 16;
            f32x16 p0;
#pragma unroll
            for (int d0 = 0; d0 < 8; ++d0) { const bf16x8 b0 = *(const LAS bf16x8*)(kb + d0 * 1024); p0 = __builtin_amdgcn_mfma_f32_32x32x16_bf16(b0, qr[d0], d0 == 0 ? zero : p0, 0, 0, 0); }
            const LAS float* up = ut + s * 32 + 4 * hi;
            fa::P8 q0 = __builtin_bit_cast(fa::P8, p0);
            const f32x2 m2 = {M2, M2};
#pragma unroll
            for (int a = 0; a < 4; ++a) { const f32x4 u0 = *(const LAS f32x4*)(up + 8 * a);
                f32x2 e0 = (f32x2){u0.x, u0.y} - m2, e1 = (f32x2){u0.z, u0.w} - m2;
                e0.x = __builtin_amdgcn_exp2f(e0.x); e0.y = __builtin_amdgcn_exp2f(e0.y); e1.x = __builtin_amdgcn_exp2f(e1.x); e1.y = __builtin_amdgcn_exp2f(e1.y);
                q0.v[2 * a] *= e0; q0.v[2 * a + 1] *= e1; }
            if (s >= 2 * tb) {
                const int kb32 = 32 * (s & 1);
#pragma unroll
                for (int r = 0; r < 16; ++r) { if (kb32 + fa::crow(r, hi) > tq) q0.v[r >> 1][r & 1] = 0.f; } }
            { f32x2 d2 = (q0.v[0] + q0.v[1]) + (q0.v[2] + q0.v[3]); d2 += (q0.v[4] + q0.v[5]) + (q0.v[6] + q0.v[7]); den += d2.x + d2.y; }
            LAS unsigned char* wp = wbase + (s & 1) * 4096;
            *(LAS v4u*)(wp) = (v4u){cvtpk_s(q0.v[0].x, q0.v[0].y), cvtpk_s(q0.v[1].x, q0.v[1].y), cvtpk_s(q0.v[2].x, q0.v[2].y), cvtpk_s(q0.v[3].x, q0.v[3].y)};
            *(LAS v4u*)(wp + 1024) = (v4u){cvtpk_s(q0.v[4].x, q0.v[4].y), cvtpk_s(q0.v[5].x, q0.v[5].y), cvtpk_s(q0.v[6].x, q0.v[6].y), cvtpk_s(q0.v[7].x, q0.v[7].y)};
        }
        if (s >= 1) {
            const LAS unsigned char* wp = wbase + ((s - 1) & 1) * 4096;
            const v4u pw0 = *(const LAS v4u*)(wp), pw1 = *(const LAS v4u*)(wp + 1024);
            const LAS char* vp = (const LAS char*)shm + L_V + ((s - 1) & 3) * VSL + vq * 4096 + vbl;
#pragma unroll
            for (int d0 = 0; d0 < 2; ++d0) {
                const fa::s16x4 l0 = vtr(vp + d0 * 2048), h0 = vtr(vp + d0 * 2048 + 512), l1 = vtr(vp + d0 * 2048 + 1024), h1 = vtr(vp + d0 * 2048 + 1536);
                o[d0] = __builtin_amdgcn_mfma_f32_32x32x16_bf16(__builtin_bit_cast(bf16x8, pw0), (bf16x8){l0[0], l0[1], l0[2], l0[3], h0[0], h0[1], h0[2], h0[3]}, o[d0], 0, 0, 0);
                o[d0] = __builtin_amdgcn_mfma_f32_32x32x16_bf16(__builtin_bit_cast(bf16x8, pw1), (bf16x8){l1[0], l1[1], l1[2], l1[3], h1[0], h1[1], h1[2], h1[3]}, o[d0], 0, 0, 0);
            }
        }
    }
    { const float dt = swap_add(den); if (hi == 0) wsf[r32] = dt; }
    asm volatile("s_waitcnt lgkmcnt(0)\n\ts_barrier" ::: "memory");
    { const LAS float* wd = (const LAS float*)(shm + L_WS) + th * 4 * 64; const float dt = (wd[r32] + wd[64 + r32]) + (wd[128 + r32] + wd[192 + r32]);
      const float dd = fmaxf(fabsf(dt), __builtin_amdgcn_exp2f(-(A2 + M2))); if (hi == 0) wsf[32 + r32] = 1.f / dd; }
    LDS_WAIT(); asm volatile("" ::: "memory");
    LAS float* Hst = (LAS float*)shm;
#pragma unroll
    for (int r = 0; r < 16; ++r) { const float f = wsf[32 + crow(r, hi)]; LAS float* hp = Hst + (th * 32 + crow(r, hi)) * 256 + vq * 64 + r32; hp[0] = o[0][r] * f; hp[32] = o[1][r] * f; }
    asm volatile("s_waitcnt lgkmcnt(0)\n\ts_barrier" ::: "memory");
#pragma unroll
    for (int k = 0; k < 8; ++k) { const int tr = wid * 8 + k; const f32x4 hv = *(const LAS f32x4*)(Hst + tr * 256 + 4 * lane);
        const float ssq = wave_sum((hv.x * hv.x + hv.y * hv.y) + (hv.z * hv.z + hv.w * hv.w)); const float rs = rsqrtf(ssq * (1.f / 256.f) + EPS);
        const size_t orow = (size_t)b * SEQ + tb * 64 + tr; const v2u om = *(const v2u*)(PROJ + orow * PLD + PC_OM + h * 256 + 4 * lane); const f32x4 gg = *(const f32x4*)(mhg + h * 256 + 4 * lane);
        v2u ov; ov.x = pk2(sigm(bflo(om.x)) * hv.x * rs * gg.x, sigm(bfhi(om.x)) * hv.y * rs * gg.y); ov.y = pk2(sigm(bflo(om.y)) * hv.z * rs * gg.z, sigm(bfhi(om.y)) * hv.w * rs * gg.w);
        *(v2u*)(OML + orow * 2048 + h * 256 + 4 * lane) = ov; }
    asm volatile("s_waitcnt lgkmcnt(0)\n\ts_barrier" ::: "memory");
#undef ML_ISSUE_K
#undef ML_ISSUE_V
}
}
__device__ __forceinline__ void p5_mlstm(Frame& F, int& chunk) {
    const int tid_ = tid_opaque(), lane_ = tid_ & 63; (void)lane_;
    const bf16* PROJ = WSP(bf16, WS_PROJ); const bf16* QKC = WSP(bf16, WS_QKC); bf16* OML = WSP(bf16, WS_OMIX) + 1024;
    const float* GA = WSP(float, WS_GA); const float* GU = WSP(float, WS_GU); const float* GM = WSP(float, WS_GM); const float* mhg = INP(13);
    unsigned* ctr = WSP(unsigned, WS_CTL) + CW_MLQ; LAS int* tk = (LAS int*)(F.lds + LDSCTL_OFF + 64);
    __syncthreads();
    if (tid_ == 0) tk[0] = (int)__hip_atomic_fetch_add(ctr, 1u, RLX_AGENT);
    __syncthreads();
    int u = tk[0];
    while (u < 1024) {
        int nxt = 0; if (tid_ == 0) nxt = (int)__hip_atomic_fetch_add(ctr, 1u, RLX_AGENT);
        const int bh = u & 31, tb = 31 - (u >> 5);
        ml::mlstm_unit(F.lds, bh >> 2, bh & 3, tb, PROJ, QKC, GA, GU, GM, mhg, OML);
        convert_chunk(F, chunk);
        if (tid_ == 0) tk[0] = nxt;
        __syncthreads();
        u = tk[0];
        __syncthreads();
    }
}
__device__ __forceinline__ void p6_sel_win(Frame& F, int& chunk) {
    const int tid_ = tid_opaque(), lane_ = tid_ & 63; (void)lane_;
    const bf16* PROJ = WSP(bf16, WS_PROJ); float* OACC = WSP(float, WS_OACC); unsigned* SELM = WSP(unsigned, WS_SELM); bf16* ONSA = WSP(bf16, WS_OMIX); const bf16* KCB = WSP(bf16, WS_KCV);
    __syncthreads();
    if (F.G == 256) {
        const int bx = blockIdx.x, xcd = bx % 8, w = bx / 8, s = w & 15;
        for (int i = 0; i < 4; ++i) { const int bg = 4 * xcd + 2 * (i >> 1) + (w >> 4); const int tb = (i & 1) ? 31 - s : s;
            cs::cmp_unit(F.lds, bg >> 2, bg & 3, tb, PROJ, KCB, OACC, SELM); fa::sel_win_unit(F.lds, bg >> 2, bg & 3, tb, PROJ, SELM, OACC, ONSA); convert_chunk(F, chunk); }
    } else {
        for (int u = blockIdx.x; u < 1024; u += F.G) { const int bg = u >> 5, tb = u & 31;
            cs::cmp_unit(F.lds, bg >> 2, bg & 3, tb, PROJ, KCB, OACC, SELM); fa::sel_win_unit(F.lds, bg >> 2, bg & 3, tb, PROJ, SELM, OACC, ONSA); convert_chunk(F, chunk); }
    }
    while (chunk < NCHUNK) convert_chunk(F, chunk);
}
__device__ __forceinline__ void p10_rows(Frame& F) {
    const int tid_ = tid_opaque(), lane_ = tid_ & 63; (void)lane_;
    const float* x = INP(0); const float* gpost = INP(5); const float* gpre = INP(17); const float* mod = WSP(float, WS_MOD); const bf16* Y = WSP(bf16, WS_Y); bf16* H2 = WSP(bf16, WS_H2); unsigned char* H2Q = WSP(unsigned char, WS_H2Q);
    LAS float* A1 = (LAS float*)F.lds; LAS float* A2 = A1 + 2048; LAS float* C2 = A1 + 4096;
    int cur_b = -1;
    for (int blk = blockIdx.x; blk < NTOK / 64; blk += F.G) {
        const int b = blk >> 5;
        if (b != cur_b) { __syncthreads(); const float* mb = mod + b * 12288;
            const f32x4 g = *(const f32x4*)(gpost + 4 * tid_), gt = *(const f32x4*)(mb + 4096 + 4 * tid_), gp = *(const f32x4*)(gpre + 4 * tid_), a = *(const f32x4*)(mb + 8192 + 4 * tid_), c = *(const f32x4*)(mb + 6144 + 4 * tid_);
            *(LAS f32x4*)(A1 + 4 * tid_) = g * gt; *(LAS f32x4*)(A2 + 4 * tid_) = gp * (1.f + a); *(LAS f32x4*)(C2 + 4 * tid_) = c; __syncthreads(); cur_b = b; }
        const int row0 = blk * 64 + F.wave * 8;
        v2u yq[8]; f32x4 xx[8];
        { const GAS v2u* yr = UPTR(const v2u, Y + (size_t)row0 * DM) + lane_; const GAS f32x4* xr = UPTR(const f32x4, x + (size_t)row0 * DM) + lane_;
#pragma unroll
          for (int j = 0; j < 8; ++j) { yq[j] = yr[64 * j]; xx[j] = xr[64 * j]; } }
#pragma unroll
        for (int k = 0; k < 8; ++k) {
            const int row = row0 + k;
            v2u yn[8]; f32x4 xn[8];
            if (k + 1 < 8) { const GAS v2u* yr = UPTR(const v2u, Y + (size_t)(row + 1) * DM) + lane_; const GAS f32x4* xr = UPTR(const f32x4, x + (size_t)(row + 1) * DM) + lane_;
#pragma unroll
                for (int j = 0; j < 8; ++j) { yn[j] = yr[64 * j]; xn[j] = xr[64 * j]; } }
            GAS f32x4* orow = UPTR(f32x4, F.out + (size_t)row * DM) + lane_;
            f32x4 v[8]; float s = 0.f;
#pragma unroll
            for (int j = 0; j < 8; ++j) { const v2u q = yq[j]; v[j] = (f32x4){bflo(q.x), bfhi(q.x), bflo(q.y), bfhi(q.y)}; s += (v[j].x * v[j].x + v[j].y * v[j].y) + (v[j].z * v[j].z + v[j].w * v[j].w); }
            const float rstd = rsqrtf(wave_sum(s) * (1.f / DM) + EPS);
            float s1 = 0.f;
#pragma unroll
            for (int j = 0; j < 8; ++j) { const f32x4 a1 = *(LAS f32x4*)(A1 + 4 * lane_ + 256 * j);
                v[j] = xx[j] + a1 * (v[j] * rstd); orow[64 * j] = v[j]; s1 += (v[j].x * v[j].x + v[j].y * v[j].y) + (v[j].z * v[j].z + v[j].w * v[j].w); }
            const float rstd1 = rsqrtf(wave_sum(s1) * (1.f / DM) + EPS);
            GAS unsigned long long* o8 = UPTR(unsigned long long, H2 + (size_t)row * DM) + lane_; GAS int* o4 = UPTR(int, H2Q + (size_t)row * DM) + lane_;
#pragma unroll
            for (int j = 0; j < 8; ++j) { const int col = 4 * lane_ + 256 * j; const f32x4 a2 = *(LAS f32x4*)(A2 + col), c2 = *(LAS f32x4*)(C2 + col);
                const f32x4 r = v[j] * rstd1 * a2 + c2;
                o8[64 * j] = (unsigned long long)pk2(r.x, r.y) | ((unsigned long long)pk2(r.z, r.w) << 32);
                int q8 = 0; q8 = __builtin_amdgcn_cvt_pk_fp8_f32(fminf(fmaxf(r.x, -448.f), 448.f), fminf(fmaxf(r.y, -448.f), 448.f), q8, false); q8 = __builtin_amdgcn_cvt_pk_fp8_f32(fminf(fmaxf(r.z, -448.f), 448.f), fminf(fmaxf(r.w, -448.f), 448.f), q8, true);
                o4[64 * j] = q8; }
            if (k + 1 < 8) {
#pragma unroll
                for (int j = 0; j < 8; ++j) { yq[j] = yn[j]; xx[j] = xn[j]; } }
        }
    }
    __syncthreads();
}
__device__ __forceinline__ void p12_route(Frame& F, int cbase = CW_CNT) {
    const int tid_ = tid_opaque(), lane_ = tid_ & 63; (void)lane_;
    const float* LG = WSP(float, WS_LOGITS); const float* br = INP(20); unsigned* cnt = WSP(unsigned, WS_CTL) + cbase;
    int* TE = WSP(int, WS_TE); int* TP = WSP(int, WS_TP); float* TW = WSP(float, WS_TW);
    LAS int* cw = (LAS int*)F.lds; LAS int* basee = cw + 512;
    const int lane = lane_; const float brl = br[lane];
    for (int tblk = blockIdx.x; tblk < NTOK / 64; tblk += F.G) {
        __syncthreads();
        int c = 0; unsigned selm = 0u, posb = 0u, kb = 0u; float wv[8];
#pragma unroll
        for (int k = 0; k < 8; ++k) { const int t = tblk * 64 + F.wave * 8 + k;
            const float s = sigm(LG[(size_t)t * 64 + lane]); const float sb = s + brl;
            const int grp = lane >> 3; float m1 = -INFINITY, m2 = -INFINITY;
#pragma unroll
            for (int i = 0; i < 8; ++i) { const float v = __shfl(sb, grp * 8 + i); if (v > m1) { m2 = m1; m1 = v; } else if (v > m2) { m2 = v; } }
            const float gs = m1 + m2; int grank = 0;
#pragma unroll
            for (int gi = 0; gi < 8; ++gi) { const float o = __shfl(gs, gi * 8); grank += ((o > gs) || (o == gs && gi < grp)) ? 1 : 0; }
            const float ms = (grank < 4) ? sb : -1e9f; int rank = 0;
            for (int i = 0; i < 64; ++i) { const float o = rdlane(ms, i); rank += ((o > ms) || (o == ms && i < lane)) ? 1 : 0; }
            const bool sel = rank < 8;
            const float wsum = wave_sum(sel ? s : 0.f);
            const unsigned long long bal = __ballot(sel);
            wv[k] = s / wsum * 2.5f;
            if (sel) { selm |= 1u << k; posb |= (unsigned)c << (3 * k); kb |= (unsigned)(__popcll(bal & ((1ull << lane) - 1ull)) & 7) << (3 * k); ++c; } }
        cw[F.wave * 64 + lane] = c;
        __syncthreads();
        if (F.wave == 0) { int tot = 0;
#pragma unroll
            for (int w = 0; w < 8; ++w) tot += cw[w * 64 + lane];
            basee[lane] = tot ? (int)atomicAdd(&cnt[lane], (unsigned)tot) : 0; }
        __syncthreads();
        int off = basee[lane];
        for (int w = 0; w < F.wave; ++w) off += cw[w * 64 + lane];
#pragma unroll
        for (int k = 0; k < 8; ++k) if ((selm >> k) & 1u) { const int t = tblk * 64 + F.wave * 8 + k; const int idx = t * 8 + (int)((kb >> (3 * k)) & 7u);
            TE[idx] = lane; TP[idx] = off + (int)((posb >> (3 * k)) & 7u); TW[idx] = wv[k]; }
    }
    __syncthreads();
}
__device__ __forceinline__ void p13_slots(Frame& F) {
    const int tid_ = tid_opaque(), lane_ = tid_ & 63; (void)lane_;
    unsigned* cnt = WSP(unsigned, WS_CTL) + CW_CNT; LAS int* rs = (LAS int*)F.lds;
    const int* TE = WSP(int, WS_TE); const int* TP = WSP(int, WS_TP); const float* TW = WSP(float, WS_TW);
    int* TOKSLOT = WSP(int, WS_TOKSLOT); int* SLOTTOK = WSP(int, WS_SLOTTOK); float* SLOTW = WSP(float, WS_SLOTW); int* RT = WSP(int, WS_RT);
    LAS int* ts = rs + 80;
    if (tid_ < 64) { const int c = (int)__hip_atomic_load(cnt + tid_, RLX_AGENT); const int nt_ = (c + 255) >> 8; int a = c, tt = nt_;
#pragma unroll
        for (int o = 1; o < 64; o <<= 1) { const int n = __shfl_up(a, o), n2 = __shfl_up(tt, o); if (lane_ >= o) { a += n; tt += n2; } }
        rs[tid_ + 1] = a; ts[tid_ + 1] = tt; if (tid_ == 0) { rs[0] = 0; ts[0] = 0; } }
    __syncthreads();
    const int gt = blockIdx.x * 512 + tid_, ngt = F.G * 512;
    for (int idx = gt; idx < NSLOT; idx += ngt) { const int e = TE[idx], slot = rs[e] + TP[idx]; SLOTTOK[slot] = idx >> 3; SLOTW[slot] = TW[idx]; TOKSLOT[idx] = slot; }
    for (int idx = gt; idx < NTOK; idx += ngt) { SLOTTOK[NSLOT + idx] = idx; SLOTW[NSLOT + idx] = 1.f; }
    if (blockIdx.x == 0) {
        if (tid_ < 64) { const int e = tid_, c = rs[e + 1] - rs[e]; int j = ts[e]; for (int r = 0; r * 256 < c; ++r, ++j) { RT[3 * j] = e; RT[3 * j + 1] = rs[e] + 256 * r; RT[3 * j + 2] = (c - 256 * r) < 256 ? (c - 256 * r) : 256; } }
        else if (tid_ < 128) { const int r = tid_ - 64, j = ts[64] + r; RT[3 * j] = 64; RT[3 * j + 1] = NSLOT + 256 * r; RT[3 * j + 2] = 256; }
        if (tid_ == 0) __hip_atomic_store(WSP(unsigned, WS_CTL) + CW_NTILES, (unsigned)(ts[64] + 64), RLX_AGENT);
    }
    __syncthreads();
}
__device__ __forceinline__ void p16_final(Frame& F, bool do_store = true) {
    const int tid_ = tid_opaque(), lane_ = tid_ & 63; (void)lane_;
    const unsigned char* YS = WSP(unsigned char, WS_YSLOT); const int* TOKSLOT = WSP(int, WS_TOKSLOT); const float* gpost = INP(18); const float* mod = WSP(float, WS_MOD);
    LAS float* A = (LAS float*)F.lds;
    int cur_b = -1;
    for (int blk = blockIdx.x; blk < NTOK / 64; blk += F.G) {
        const int b = blk >> 5;
        if (b != cur_b) { __syncthreads();
            const f32x4 g = *(const f32x4*)(gpost + 4 * tid_), gt = *(const f32x4*)(mod + b * 12288 + 10240 + 4 * tid_);
            *(LAS f32x4*)(A + 4 * tid_) = g * gt * (1.f / 64.f); __syncthreads(); cur_b = b; }
        const int row0 = blk * 64 + F.wave * 8;
        const int myslot = TOKSLOT[row0 * 8 + lane_];
        int q[3][24]; f32x4 xx[8];
#define P16_ISSUE(kk, gg) do { _Pragma("unroll") for (int r = 0; r < 3; ++r) { const int k9 = 3 * (gg) + r; \
            const int slot = (k9 < 8) ? __builtin_amdgcn_readlane(myslot, (kk) * 8 + k9) : NSLOT + row0 + (kk); \
            const GAS int* yr = UPTR(const int, YS + (size_t)slot * DM) + lane_; \
            _Pragma("unroll") for (int j = 0; j < 8; ++j) q[gg][8 * r + j] = yr[64 * j]; } } while (0)
        P16_ISSUE(0, 0); P16_ISSUE(0, 1); P16_ISSUE(0, 2);
#pragma unroll 1
        for (int k = 0; k < 8; ++k) {
            const int row = row0 + k;
            { const GAS f32x4* xr = UPTR(const f32x4, F.out + (size_t)row * DM) + lane_;
#pragma unroll
              for (int j = 0; j < 8; ++j) xx[j] = xr[64 * j]; }
            f32x4 acc[8];
#pragma unroll
            for (int j = 0; j < 8; ++j) acc[j] = (f32x4){0.f, 0.f, 0.f, 0.f};
#pragma unroll
            for (int g = 0; g < 3; ++g) {
#pragma unroll
                for (int r = 0; r < 3; ++r)
#pragma unroll
                    for (int j = 0; j < 8; ++j) { const int w = q[g][8 * r + j]; const f32x2 lo = __builtin_amdgcn_cvt_pk_f32_fp8(w, false), hi = __builtin_amdgcn_cvt_pk_f32_fp8(w, true);
                        acc[j].x += lo.x; acc[j].y += lo.y; acc[j].z += hi.x; acc[j].w += hi.y; }
                if (k + 1 < 8) P16_ISSUE(k + 1, g);
            }
            float s = 0.f;
#pragma unroll
            for (int j = 0; j < 8; ++j) s += (acc[j].x * acc[j].x + acc[j].y * acc[j].y) + (acc[j].z * acc[j].z + acc[j].w * acc[j].w);
            const float rstd = rsqrtf(wave_sum(s) * (1.f / (4096.f * DM)) + EPS);
            GAS f32x4* orow = UPTR(f32x4, F.out + (size_t)row * DM) + lane_;
            unsigned aoff = 16u * (unsigned)lane_; asm volatile("" : "+v"(aoff));
#pragma unroll
            for (int j = 0; j < 8; ++j) { const f32x4 a = *(LAS f32x4*)((LAS unsigned char*)A + aoff + 1024 * j);
                if (do_store || F.G == 12345) orow[64 * j] = xx[j] + a * (acc[j] * rstd); }
        }
#undef P16_ISSUE
    }
}

constexpr int NPHASE = 17;
struct Args { const float* in[27]; float* out; unsigned char* ws; int ph_lo, ph_hi, li, pad; };
__global__ void __launch_bounds__(512, 2) mega_fwd(Args args) {
    extern __shared__ __attribute__((aligned(16))) unsigned char lds[];
    Frame F;
    F.lds = (LAS unsigned char*)lds; F.ws = args.ws; F.in = args.in; F.out = args.out;
    F.tid = threadIdx.x; F.lane = F.tid & 63; F.wave = __builtin_amdgcn_readfirstlane(F.tid >> 6); F.G = gridDim.x;
    F.gw = blockIdx.x * 8 + F.wave; F.ngw = F.G * 8;
    volatile LAS unsigned* MISC = (volatile LAS unsigned*)(F.lds + MISC_OFF);
    for (int u = F.tid; u < (LDS_BYTES - LDSCTL_OFF) / 4; u += 512) ((LAS unsigned*)(F.lds + LDSCTL_OFF))[u] = 0u;
    __syncthreads();
    unsigned* ctl = (unsigned*)(args.ws + WS_CTL);
    XcdBarrier bar; bar.bar = ctl + CW_BAR; bar.x = 0; bar.st = nullptr;
    if (!MK_PER_PHASE) bar = xcd_barrier_post(ctl + CW_BAR, MISC + 8);
    const int lo = args.ph_lo, hi = args.ph_hi;
#define IN(k) (lo <= (k) && (k) < hi)
#define SEAM(k) do { if (IN(k) && IN((k) + 1)) xcd_barrier(bar); } while (0)
    bf16* PROJ = WSP(bf16, WS_PROJ);
    int chunk = 0;
    const int vcu_ = (F.G % 8 == 0) ? (int)(blockIdx.x % 8) * (F.G / 8) + (int)(blockIdx.x / 8) : (int)blockIdx.x;

    if (IN(0)) { p0_bias1(F); p0_early(F); } SEAM(0);
    if (IN(1)) REP(1, { p1_h1(F); }); SEAM(1);
    if (IN(2)) REP(2, {
        { pg8::Gemm g{WSP(bf16, WS_H1), WSP(bf16, WS_WIN), DM, 128, 0, 0}; pg8::StaticOrder S; S.init(NTOK, PN_BF, F.G, (int)blockIdx.x, PRB(2));
          pg8::EpiBf16 E{PROJ, PLD, 4, QC2};
          pg8::gemm_phase<pg8::EpiBf16, pg8::StaticOrder, false, true>(F.lds, g, S, E); }
        { pg8::Gemm g{WSP(unsigned char, WS_H1Q), WSP(unsigned char, WS_WIN8), DM, 128, 127 - 6, 127}; pg8::StaticOrder S; S.init(NTOK, PN_F8, F.G, (int)blockIdx.x, PRB(3));
          pg8::EpiBf16 E{PROJ + PN_BF, PLD, 1 << 20, 1.f / 64.f};
          pg8::gemm_phase<pg8::EpiBf16, pg8::StaticOrder, false, true, true>(F.lds, g, S, E); }
    }); SEAM(2);
    if (IN(3)) REP(3, { p3_conv(F); p3_gates(F); }); SEAM(3);
    if (IN(4)) {
        { pg8::Gemm g{PROJ, WSP(bf16, WS_CW1), DM, PLD * 2, 0, 0}; pg8::CmpOrder S{F.G, (int)blockIdx.x}; pg8::EpiCmpHid E{WSP(bf16, WS_HIDC), WSP(float, WS_BIAS1)};
          pg8::gemm_phase<pg8::EpiCmpHid, pg8::CmpOrder, true, true>(F.lds, g, S, E);
          if ((int)blockIdx.x < 32) kcv_unit(F, (int)blockIdx.x >> 4, (int)blockIdx.x & 15); }
        p5_mlstm(F, chunk); } SEAM(4);
    if (IN(6)) { p6_sel_win(F, chunk); } SEAM(6);
    if (IN(7)) REP(7, {
        pg8::Gemm g{WSP(bf16, WS_OMIX), WSP(bf16, WS_WUP), DM, 128, 0, 0}; pg8::StaticOrder S; S.init(NTOK, DM, F.G, (int)blockIdx.x);
        pg8::EpiGate E{WSP(bf16, WS_MERGED), PROJ + PC_GB, PLD, nullptr}; pg8::MidGate MH{PROJ + PC_GA, PROJ + PC_GB, PLD};
        pg8::gemm_phase<pg8::EpiGate, pg8::StaticOrder, false, true, false, false, pg8::MidGate>(F.lds, g, S, E, MH);
    }); SEAM(7);
    if (IN(9)) REP(9, {
        pg8::Gemm g{WSP(bf16, WS_MERGED), WSP(bf16, WS_WOUT), DM, 128, 0, 0}; pg8::StaticOrder S; S.init(NTOK, DM, F.G, (int)blockIdx.x);
        pg8::EpiBf16 E{WSP(bf16, WS_Y), DM, 0, 1.f};
        pg8::gemm_phase<pg8::EpiBf16, pg8::StaticOrder, false, true>(F.lds, g, S, E);
    }); SEAM(9);
    if (IN(10)) REP(10, { p10_rows(F); }); SEAM(10);
    if (IN(11)) REP(11, {
        pg8::Gemm g{WSP(bf16, WS_H2), WSP(bf16, WS_WR), DM, 128, 0, 0}; pg8::StaticOrder S; S.init(NTOK, 256, F.G, (int)blockIdx.x);
        pg8::EpiF32 E{WSP(float, WS_LOGITS), 64, 64};
        pg8::gemm_phase<pg8::EpiF32, pg8::StaticOrder, false, true>(F.lds, g, S, E);
    }); SEAM(11);
    if (IN(12)) { if ((PROBE_DUP >> 12) & 1) p12_route(F, 256); p12_route(F); } SEAM(12);
    if (IN(13)) REP(13, { p13_slots(F); }); SEAM(13);
    if (IN(14)) REP(14, {
        const int ntiles = (int)__hip_atomic_load(ctl + CW_NTILES, RLX_AGENT);
        LAS int* rtc = (LAS int*)(F.lds + RT_LDS_OFF); for (int i = threadIdx.x; i < 3 * ntiles; i += 512) rtc[i] = WSP(int, WS_RT)[i]; __syncthreads();
        pg8::Gemm g{WSP(unsigned char, WS_H2Q), WSP(unsigned char, WS_WEGU), DM, 128, 127 - 6, 127}; pg8::MoeOrder S{rtc, ntiles, 4, F.G, vcu_, WSP(int, WS_SLOTTOK), 2048u, PRB(14)};
        pg8::EpiSwiglu E{WSP(unsigned char, WS_HID), WSP(float, WS_SLOTW)};
        pg8::gemm_phase<pg8::EpiSwiglu, pg8::MoeOrder, true, true, true, false>(F.lds, g, S, E);
    }); SEAM(14);
    if (IN(15)) REP(15, {
        const int ntiles = (int)__hip_atomic_load(ctl + CW_NTILES, RLX_AGENT);
        LAS int* rtc = (LAS int*)(F.lds + RT_LDS_OFF); for (int i = threadIdx.x; i < 3 * ntiles; i += 512) rtc[i] = WSP(int, WS_RT)[i]; __syncthreads();
        pg8::Gemm g{WSP(unsigned char, WS_HID), WSP(unsigned char, WS_WED), EFF, 128, 127 - 6, 127 - 4}; pg8::MoeOrder S{rtc, ntiles, 8, F.G, vcu_, nullptr, 512u, PRB(15)};
        pg8::EpiFp8 E{WSP(unsigned char, WS_YSLOT), DM, 64.f / 1024.f};
        pg8::gemm_phase<pg8::EpiFp8, pg8::MoeOrder, false, true, true>(F.lds, g, S, E);
    }); SEAM(15);
    if (IN(16)) { if ((PROBE_DUP >> 16) & 1) p16_final(F, false); p16_final(F); }
#undef IN
#undef SEAM
}

extern "C" void kernel_launch(void* const* d_in, const int* in_sizes, int n_in, void* d_out, int out_size, void* d_ws, size_t ws_size, hipStream_t stream) {
    static int grid = 0;
    if (grid == 0) {
        if (n_in != 27 || out_size != NTOK * DM || ws_size < WS_END) { fprintf(stderr, "kernel_launch: unexpected shapes (n_in %d out %d ws %zu)\n", n_in, out_size, ws_size); grid = -1; return; }
        int dev = 0, cus = 0, per_cu = 0;
        if (hipGetDevice(&dev) != hipSuccess || hipDeviceGetAttribute(&cus, hipDeviceAttributeMultiprocessorCount, dev) != hipSuccess) { grid = -1; return; }
        if (hipFuncSetAttribute((const void*)mega_fwd, hipFuncAttributeMaxDynamicSharedMemorySize, LDS_BYTES) != hipSuccess) { fprintf(stderr, "kernel_launch: hipFuncSetAttribute failed\n"); grid = -1; return; }
        if (hipOccupancyMaxActiveBlocksPerMultiprocessor(&per_cu, (const void*)mega_fwd, 512, LDS_BYTES) != hipSuccess || per_cu < 1) fprintf(stderr, "kernel_launch: occupancy query says %d\n", per_cu);
        (void)hipGetLastError();
        grid = cus;
    }
    if (grid < 0) return;
    (void)hipMemsetAsync((char*)d_ws + WS_CTL, 0, CTL_ZERO_BYTES, stream);
    Args a{};
    for (int i = 0; i < 27; ++i) a.in[i] = (const float*)d_in[i];
    a.out = (float*)d_out; a.ws = (unsigned char*)d_ws;
#if MK_PER_PHASE
    for (int p = 0; p < NPHASE; ++p) { a.ph_lo = p; a.ph_hi = p + 1; a.li = p; hipLaunchKernelGGL(mega_fwd, dim3(grid), dim3(512), LDS_BYTES, stream, a); }
#else
    a.ph_lo = 0; a.ph_hi = NPHASE; a.li = 0;
    hipLaunchKernelGGL(mega_fwd, dim3(grid), dim3(512), LDS_BYTES, stream, a);
#endif
}
```

```cpp
#include <hip/hip_runtime.h>
#include <cstdio>
#include <cstdint>

#define GAS __attribute__((address_space(1)))
#define LAS __attribute__((address_space(3)))
typedef unsigned short bf16;
typedef unsigned v4u __attribute__((ext_vector_type(4)));
typedef unsigned v2u __attribute__((ext_vector_type(2)));
typedef float f32x4 __attribute__((ext_vector_type(4)));
typedef float f32x2 __attribute__((ext_vector_type(2)));
typedef short bf16x8 __attribute__((ext_vector_type(8)));
typedef GAS unsigned gu32;
typedef int v8i __attribute__((ext_vector_type(8)));
typedef int v4i __attribute__((ext_vector_type(4)));

#ifndef PROBE_DUP
#define PROBE_DUP 0x0
#endif
#define PRB(k) (1 + ((PROBE_DUP >> (16 + (k))) & 1))
#define REP(k, ...) do { __VA_ARGS__ if ((PROBE_DUP >> (k)) & 1) { __VA_ARGS__ } } while (0)
#ifndef MK_PER_PHASE
#define MK_PER_PHASE 0
#endif

constexpr int NB = 8, SEQ = 2048, DM = 2048, NTOK = NB * SEQ;
constexpr int PLD = 9984;
constexpr int PC_Q = 0, PC_KC = 1024, PC_KS = 1280, PC_KW = 1536, PC_QKM = 1792, PC_G3 = 2816, PC_IF = 2864, PC_VC = 3072, PC_VS = 3328, PC_VW = 3584, PC_VM = 3840, PC_OM = 4864, PC_GA = 5888, PC_GB = 7936;
constexpr int PN_BF = 3072, PN_F8 = 6912;
constexpr int D_IN = 9784;
constexpr int NEXP = 64, EFF = 512;
constexpr int NSLOT = NTOK * 8;
constexpr int NSLOT_ALL = NSLOT + NTOK;
constexpr float EPS = 1e-6f;
constexpr float QC2 = 0.18033688011112042f;

constexpr size_t MiB = 1u << 20;
constexpr size_t WS_CTL = 0, CTL_ZERO_BYTES = 64 * 1024;
constexpr size_t WS_MOD = 1 * MiB;
constexpr size_t WS_BIAS1 = 1 * MiB + 512 * 1024;
constexpr size_t WS_GA = 2 * MiB, WS_GU = 2 * MiB + 256 * 1024, WS_GM = 2 * MiB + 512 * 1024;
constexpr size_t WS_SELM = 3 * MiB;
constexpr size_t WS_KCV = 4 * MiB;
constexpr size_t WS_HIDC = 6 * MiB;
constexpr size_t WS_TE = 14 * MiB, WS_TP = 14 * MiB + 512 * 1024, WS_TW = 15 * MiB, WS_TOKSLOT = 15 * MiB + 512 * 1024;
constexpr size_t WS_SLOTTOK = 16 * MiB, WS_SLOTW = 17 * MiB, WS_RT = 18 * MiB;
constexpr size_t WS_LOGITS = 19 * MiB;
constexpr size_t WS_WED = 32 * MiB;
constexpr size_t WS_WOUT = 162 * MiB;
constexpr size_t WS_WUP = 170 * MiB;
constexpr size_t WS_CW1 = 178 * MiB;
constexpr size_t WS_CW2 = 181 * MiB;
constexpr size_t WS_WR = 180 * MiB;
constexpr size_t WS_H2 = 182 * MiB;
constexpr size_t WS_HID = 246 * MiB;
constexpr size_t WS_H2Q = 340 * MiB;
constexpr size_t WS_WIN = 392 * MiB;
constexpr size_t WS_WIN8 = 412 * MiB;
constexpr size_t WS_WEGU = 432 * MiB;
constexpr size_t WS_PROJ = 692 * MiB;
constexpr size_t WS_H1 = 1004 * MiB;
constexpr size_t WS_H1Q = 1068 * MiB;
constexpr size_t WS_END = 1100 * MiB;
constexpr size_t WS_OACC = WS_HID;
constexpr size_t WS_OMIX = WS_HID + 64 * MiB;
constexpr size_t WS_T1 = WS_H2;
constexpr size_t WS_QKC = WS_H1;
constexpr size_t WS_MERGED = WS_H1;
constexpr size_t WS_Y = WS_PROJ;
constexpr size_t WS_YSLOT = WS_WEGU;
static_assert(WS_YSLOT + (size_t)NSLOT_ALL * 2048 <= WS_END, "yslot");
static_assert(WS_HID + (size_t)(NSLOT_ALL + 256) * 512 <= WS_H2Q && WS_H2Q + (size_t)NTOK * DM <= WS_WIN, "hid");
constexpr int CW_CNT = 64;
constexpr int CW_MLQ = 200;
constexpr int CW_NTILES = 192;
constexpr int CW_BAR = 4096;

constexpr int RT_LDS_OFF = 131072 + 512 + 4096;
constexpr int RING_BYTES = 131072, LDSCTL_OFF = RING_BYTES, MISC_OFF = LDSCTL_OFF + 320, LDS_BYTES = 147456;

#define LDS_WAIT() asm volatile("s_waitcnt lgkmcnt(0)" ::: "memory")
#define VM_WAIT() asm volatile("s_waitcnt vmcnt(0)" ::: "memory")
#define RLX_AGENT __ATOMIC_RELAXED, __HIP_MEMORY_SCOPE_AGENT
__device__ __forceinline__ unsigned f2bf(float f) { unsigned u = __builtin_bit_cast(unsigned, f); return (u + 0x7fffu + ((u >> 16) & 1u)) >> 16; }
__device__ __forceinline__ unsigned pk2(float lo, float hi) { return f2bf(lo) | (f2bf(hi) << 16); }
__device__ __forceinline__ float bf2f(unsigned h) { return __uint_as_float(h << 16); }
__device__ __forceinline__ float bflo(unsigned w) { return __uint_as_float(w << 16); }
__device__ __forceinline__ float bfhi(unsigned w) { return __uint_as_float(w & 0xffff0000u); }
__device__ __forceinline__ float frcp(float x) { return __builtin_amdgcn_rcpf(x); }
__device__ __forceinline__ float sigm(float x) { return frcp(1.f + __expf(-x)); }
__device__ __forceinline__ float sigm_ieee(float x) { return 1.f / (1.f + __expf(-x)); }
__device__ __forceinline__ float wave_sum(float v) {
#pragma unroll
    for (int o = 1; o < 64; o <<= 1) v += __shfl_xor(v, o);
    return v;
}
__device__ __forceinline__ float wave_max(float v) {
#pragma unroll
    for (int o = 1; o < 64; o <<= 1) v = fmaxf(v, __shfl_xor(v, o));
    return v;
}
__device__ __forceinline__ unsigned long long uaddr(const void* p) {
    const unsigned long long a = (unsigned long long)p; const unsigned lo = __builtin_amdgcn_readfirstlane((unsigned)a), hi = __builtin_amdgcn_readfirstlane((unsigned)(a >> 32));
    return ((unsigned long long)hi << 32) | lo; }
#define UPTR(T, p) ((GAS T*)uaddr(p))
__device__ __forceinline__ int tid_opaque() { int t = threadIdx.x; asm volatile("" : "+v"(t)); return t; }
__device__ __forceinline__ float rdlane(float v, int l) { return __int_as_float(__builtin_amdgcn_readlane(__float_as_int(v), l)); }

namespace pg8 {
constexpr int BM = 256, BK = 64, HALF = 128, HTB = HALF * BK * 2, STAGE_BYTES = 8 * HTB, NXCD = 8, WGM = 8;
__host__ __device__ __forceinline__ int lds_byte(int r, int c) { const int st = (r >> 4) * 2 + (c >> 5), rr = r & 15, cc = c & 31, ob = rr * 64 + cc * 2; return st * 1024 + (ob ^ (((ob >> 9) & 1) << 5)); }
__host__ __device__ __forceinline__ void stage_rc(int b, int& R, int& C) { const int st = b / 1024, sb = b % 1024, swz = sb ^ (((sb >> 9) & 1) << 5); R = (st >> 1) * 16 + swz / 64; C = (st & 1) * 32 + (swz % 64) / 2; }
__host__ __device__ __forceinline__ int perm32(int rho) { const int n = rho >> 4, i = rho & 15; return 8 * (i >> 2) + 4 * n + (i & 3); }

struct Unit { int arow, pn, valid, aux; };
struct Gemm { const void* A; const void* Bt; int K; int kstepA; int scW, scX; };

struct StaticOrder {
    int nM, nN, nwg, G, c, reps;
    __device__ void init(int M, int N, int G_, int c_, int reps_ = 1) { nM = M / BM; nN = N / BM; nwg = nM * nN; G = G_; c = c_; reps = reps_; }
    __device__ bool next(int i, Unit& u) const {
        long L = (long)i * G + c; if (L >= (long)nwg * reps) return false; L %= nwg;
        int wgid = (int)L; { const int q = nwg / NXCD, r = nwg % NXCD, xcd = wgid % NXCD, off = wgid / NXCD; wgid = (xcd < r ? xcd * (q + 1) : r * (q + 1) + (xcd - r) * q) + off; }
        const int nig = WGM * nN, gid = wgid / nig, fm = gid * WGM, gsz = (nM - fm) < WGM ? (nM - fm) : WGM;
        u.arow = (fm + ((wgid % nig) % gsz)) * BM; u.pn = (wgid % nig) / gsz; u.valid = BM; u.aux = u.pn; return true;
    }
    __device__ __forceinline__ unsigned rowkey(const Unit&, int) const { return 0u; }
    __device__ __forceinline__ unsigned keyoff(const Unit&, unsigned) const { return 0u; }
};
struct CmpOrder {
    int G, c;
    __device__ bool next(int i, Unit& u) const { const int L = i * G + c; if (L >= 32) return false; const int kv = L >> 4, pm = L & 15; u.arow = 256 * pm; u.pn = kv; u.valid = (4064 - 256 * pm) < 256 ? (4064 - 256 * pm) : 256; u.aux = kv; return true; }
    __device__ __forceinline__ unsigned rowkey(const Unit& u, int lr) const { int rr = u.arow + lr; rr = (rr < 4064) ? rr : 0; const int b = rr / 508, n = (rr % 508) >> 2, g = rr & 3; return (unsigned)((b * SEQ + 16 * n) | (g << 14)); }
    __device__ __forceinline__ unsigned keyoff(const Unit& u, unsigned key) const { return (unsigned)(((size_t)(key & 0x3fffu) * PLD + (u.aux ? PC_VC : PC_KC) + (key >> 14) * 64) * 2); }
};
struct MoeOrder {
    const LAS int* rt; int ntiles, NCT, G, c; const int* rows; unsigned rbytes; int reps;
    __device__ __forceinline__ unsigned rowkey(const Unit& u, int lr) const { return (unsigned)((lr < u.valid) ? rows[u.arow + lr] : 0); }
    __device__ __forceinline__ unsigned keyoff(const Unit&, unsigned key) const { return key * rbytes; }
    __device__ bool next(int i, Unit& u) const {
        long L = (long)i * G + c; if (L >= (long)ntiles * NCT * reps) return false; L %= (long)ntiles * NCT;
        const int j = (int)(L / NCT), ct = (int)(L % NCT);
        const int e = __builtin_amdgcn_readfirstlane(rt[3 * j]), base = __builtin_amdgcn_readfirstlane(rt[3 * j + 1]), v = __builtin_amdgcn_readfirstlane(rt[3 * j + 2]);
        u.arow = base; u.pn = e * NCT + ct; u.valid = v; u.aux = ct; return true;
    }
};

__device__ __forceinline__ unsigned cvt_pk_bf16(float lo, float hi) { unsigned r; asm volatile("v_cvt_pk_bf16_f32 %0, %1, %2" : "=v"(r) : "v"(lo), "v"(hi)); return r; }

struct EpiBf16 {
    static constexpr bool PERM = true;
    bf16* O; int ldc; int nscaled; float scale0;
    __device__ __forceinline__ void operator()(const f32x4 (&acc)[2][2][4][2], const Unit& u, int wr, int wc, int fr, int fq) const {
        const float sc = (u.aux < nscaled) ? scale0 : 1.f;
#pragma unroll
        for (int ai = 0; ai < 2; ++ai)
#pragma unroll
            for (int m = 0; m < 4; ++m) { const int lr = ai * HALF + wr * 64 + m * 16 + fr; if (lr < u.valid) { bf16* rowp = O + (size_t)(u.arow + lr) * ldc + u.aux * BM + wc * 32 + 8 * fq;
#pragma unroll
                for (int bj = 0; bj < 2; ++bj) { const f32x4 v0 = acc[ai][bj][m][0] * sc, v1 = acc[ai][bj][m][1] * sc; v4u w; w.x = cvt_pk_bf16(v0[0], v0[1]); w.y = cvt_pk_bf16(v0[2], v0[3]); w.z = cvt_pk_bf16(v1[0], v1[1]); w.w = cvt_pk_bf16(v1[2], v1[3]);
                    *(v4u*)(rowp + bj * HALF) = w; } } }
    }
};
struct EpiFp8 {
    static constexpr bool PERM = true;
    unsigned char* O; int ldc; float scale;
    __device__ __forceinline__ void operator()(const f32x4 (&acc)[2][2][4][2], const Unit& u, int wr, int wc, int fr, int fq) const {
#pragma unroll
        for (int ai = 0; ai < 2; ++ai)
#pragma unroll
            for (int m = 0; m < 4; ++m) { const int lr = ai * HALF + wr * 64 + m * 16 + fr; if (lr < u.valid) { unsigned char* rowp = O + (size_t)(u.arow + lr) * ldc + u.aux * BM + wc * 32 + 8 * fq;
#pragma unroll
                for (int bj = 0; bj < 2; ++bj) { float r[8];
#pragma unroll
                    for (int n = 0; n < 2; ++n)
#pragma unroll
                        for (int k = 0; k < 4; ++k) r[4 * n + k] = fminf(fmaxf(acc[ai][bj][m][n][k] * scale, -448.f), 448.f);
                    int o0 = 0, o1 = 0; o0 = __builtin_amdgcn_cvt_pk_fp8_f32(r[0], r[1], o0, false); o0 = __builtin_amdgcn_cvt_pk_fp8_f32(r[2], r[3], o0, true);
                    o1 = __builtin_amdgcn_cvt_pk_fp8_f32(r[4], r[5], o1, false); o1 = __builtin_amdgcn_cvt_pk_fp8_f32(r[6], r[7], o1, true);
                    v2u o; o.x = (unsigned)o0; o.y = (unsigned)o1; *(v2u*)(rowp + bj * HALF) = o; } } }
    }
};
struct EpiGate {
    static constexpr bool PERM = true;
    bf16* O; const bf16* gate; int ldg; const bf16* prev;
    __device__ __forceinline__ void operator()(const f32x4 (&acc)[2][2][4][2], const Unit& u, int wr, int wc, int fr, int fq) const {
#pragma unroll
        for (int ai = 0; ai < 2; ++ai)
#pragma unroll
            for (int m = 0; m < 4; ++m) { const int row = u.arow + ai * HALF + wr * 64 + m * 16 + fr; const int col = u.pn * BM + wc * 32 + 8 * fq;
#pragma unroll
                for (int bj = 0; bj < 2; ++bj) {
                    const v4u gq = *(const v4u*)(gate + (size_t)row * ldg + col + bj * HALF);
                    const f32x4 v0 = acc[ai][bj][m][0], v1 = acc[ai][bj][m][1];
                    float r[8];
                    r[0] = sigm(bflo(gq.x)) * v0[0]; r[1] = sigm(bfhi(gq.x)) * v0[1]; r[2] = sigm(bflo(gq.y)) * v0[2]; r[3] = sigm(bfhi(gq.y)) * v0[3];
                    r[4] = sigm(bflo(gq.z)) * v1[0]; r[5] = sigm(bfhi(gq.z)) * v1[1]; r[6] = sigm(bflo(gq.w)) * v1[2]; r[7] = sigm(bfhi(gq.w)) * v1[3];
                    if (prev) { const v4u pq = *(const v4u*)(prev + (size_t)row * 2048 + col + bj * HALF);
                        r[0] += bflo(pq.x); r[1] += bfhi(pq.x); r[2] += bflo(pq.y); r[3] += bfhi(pq.y); r[4] += bflo(pq.z); r[5] += bfhi(pq.z); r[6] += bflo(pq.w); r[7] += bfhi(pq.w); }
                    v4u w; w.x = cvt_pk_bf16(r[0], r[1]); w.y = cvt_pk_bf16(r[2], r[3]); w.z = cvt_pk_bf16(r[4], r[5]); w.w = cvt_pk_bf16(r[6], r[7]);
                    *(v4u*)(O + (size_t)row * 2048 + col + bj * HALF) = w; } }
    }
};
struct MidGate {
    static constexpr bool ON = true;
    const bf16* ga; const bf16* gb; int ldg;
    __device__ __forceinline__ void operator()(f32x4 (&acc)[2][2][4][2], const Unit& u, int wr, int wc, int fr, int fq) const {
#pragma unroll
        for (int ai = 0; ai < 2; ++ai)
#pragma unroll
            for (int m = 0; m < 4; ++m) { const size_t off = (size_t)(u.arow + ai * HALF + wr * 64 + m * 16 + fr) * ldg + u.pn * BM + wc * 32 + 8 * fq;
#pragma unroll
                for (int bj = 0; bj < 2; ++bj) { const v4u a = *(const v4u*)(ga + off + bj * HALF), b = *(const v4u*)(gb + off + bj * HALF);
#define MG_R(xa, xb) ((1.f + __expf(-(xb))) * frcp(1.f + __expf(-(xa))))
                    acc[ai][bj][m][0][0] *= MG_R(bflo(a.x), bflo(b.x)); acc[ai][bj][m][0][1] *= MG_R(bfhi(a.x), bfhi(b.x)); acc[ai][bj][m][0][2] *= MG_R(bflo(a.y), bflo(b.y)); acc[ai][bj][m][0][3] *= MG_R(bfhi(a.y), bfhi(b.y));
                    acc[ai][bj][m][1][0] *= MG_R(bflo(a.z), bflo(b.z)); acc[ai][bj][m][1][1] *= MG_R(bfhi(a.z), bfhi(b.z)); acc[ai][bj][m][1][2] *= MG_R(bflo(a.w), bflo(b.w)); acc[ai][bj][m][1][3] *= MG_R(bfhi(a.w), bfhi(b.w));
#undef MG_R
                } }
    }
};
struct EpiF32 {
    static constexpr bool PERM = false;
    float* C; int ldc; int ncols;
    __device__ __forceinline__ void operator()(const f32x4 (&acc)[2][2][4][2], const Unit& u, int wr, int wc, int fr, int fq) const {
#pragma unroll
        for (int ai = 0; ai < 2; ++ai)
#pragma unroll
            for (int m = 0; m < 4; ++m) { float* rowp = C + (size_t)(u.arow + ai * HALF + wr * 64 + m * 16 + fr) * ldc; const int col0 = u.pn * BM + wc * 32 + 4 * fq;
#pragma unroll
                for (int bj = 0; bj < 2; ++bj)
#pragma unroll
                    for (int n = 0; n < 2; ++n) { const int col = col0 + bj * HALF + n * 16; if (col < ncols) *(f32x4*)(rowp + col) = acc[ai][bj][m][n]; } }
    }
};
struct EpiCmpHid {
    static constexpr bool PERM = true;
    bf16* H; const float* bias;
    __device__ __forceinline__ void operator()(const f32x4 (&acc)[2][2][4][2], const Unit& u, int wr, int wc, int fr, int fq) const {
        f32x4 bv[2][2];
#pragma unroll
        for (int bj = 0; bj < 2; ++bj)
#pragma unroll
            for (int n = 0; n < 2; ++n) bv[bj][n] = *(const f32x4*)(bias + u.aux * 256 + bj * HALF + wc * 32 + 8 * fq + 4 * n);
#pragma unroll
        for (int ai = 0; ai < 2; ++ai)
#pragma unroll
            for (int m = 0; m < 4; ++m) { const int lr = ai * HALF + wr * 64 + m * 16 + fr; if (lr < u.valid) { bf16* rowp = H + (size_t)(u.aux * 4096 + u.arow + lr) * 256 + wc * 32 + 8 * fq;
#pragma unroll
                for (int bj = 0; bj < 2; ++bj) { float r[8];
#pragma unroll
                    for (int n = 0; n < 2; ++n)
#pragma unroll
                        for (int k = 0; k < 4; ++k) { const float x = acc[ai][bj][m][n][k] + bv[bj][n][k]; const float uu = 0.7978845608028654f * (x + 0.044715f * x * x * x); const float th = 1.f - 2.f * frcp(1.f + __expf(2.f * uu)); r[4 * n + k] = 0.5f * x * (1.f + th); }
                    v4u w; w.x = cvt_pk_bf16(r[0], r[1]); w.y = cvt_pk_bf16(r[2], r[3]); w.z = cvt_pk_bf16(r[4], r[5]); w.w = cvt_pk_bf16(r[6], r[7]);
                    *(v4u*)(rowp + bj * HALF) = w; } } }
    }
};
struct EpiSwiglu {
    static constexpr bool PERM = true;
    unsigned char* H; const float* w;
    __device__ __forceinline__ void operator()(const f32x4 (&acc)[2][2][4][2], const Unit& u, int wr, int wc, int fr, int fq) const {
#pragma unroll
        for (int ai = 0; ai < 2; ++ai)
#pragma unroll
            for (int m = 0; m < 4; ++m) { const int lr = ai * HALF + wr * 64 + m * 16 + fr; if (lr < u.valid) { const int row = u.arow + lr; const float ws = w[row];
                float r[8];
#pragma unroll
                for (int n = 0; n < 2; ++n)
#pragma unroll
                    for (int k = 0; k < 4; ++k) { const float gv = acc[ai][0][m][n][k] * (1.f / 64.f), uv = acc[ai][1][m][n][k] * (1.f / 64.f); r[4 * n + k] = fminf(fmaxf(gv * sigm(gv) * uv * ws * 16.f, -448.f), 448.f); }
                int o0 = 0, o1 = 0; o0 = __builtin_amdgcn_cvt_pk_fp8_f32(r[0], r[1], o0, false); o0 = __builtin_amdgcn_cvt_pk_fp8_f32(r[2], r[3], o0, true);
                o1 = __builtin_amdgcn_cvt_pk_fp8_f32(r[4], r[5], o1, false); o1 = __builtin_amdgcn_cvt_pk_fp8_f32(r[6], r[7], o1, true);
                v2u o; o.x = (unsigned)o0; o.y = (unsigned)o1;
                *(v2u*)(H + (size_t)row * EFF + u.aux * HALF + wc * 32 + 8 * fq) = o; } }
    }
};

struct NoMid { static constexpr bool ON = false; __device__ __forceinline__ void operator()(f32x4 (&)[2][2][4][2], const Unit&, int, int, int, int) const {} };
template <class Epi, class Sched, bool GATHER, bool ALIGN_EPI, bool FP8 = false, bool RD32 = false, class Mid = NoMid>
__device__ __forceinline__ void gemm_phase(LAS unsigned char* lds, const Gemm g, const Sched& S, const Epi& E, const Mid& MH = Mid()) {
    const int tid = tid_opaque(), wid = __builtin_amdgcn_readfirstlane(tid >> 6), lane = tid & 63, wr = wid >> 2, wc = wid & 3, fr = lane & 15, fq = lane >> 4;
    constexpr int EB = FP8 ? 1 : 2;
    const int K = g.K; const size_t rstep = (size_t)K * EB; const int nt = (int)(rstep / 128);
    unsigned voffA[2], voffB[2];
#pragma unroll
    for (int i = 0; i < 2; ++i) { int R, C; stage_rc(tid * 16 + i * 8192, R, C); const int Rb = Epi::PERM ? ((R & ~31) + perm32(R & 31)) : R;
        voffA[i] = (unsigned)(R * rstep + C * 2); voffB[i] = (unsigned)(Rb * rstep + C * 2); }
    const unsigned r64 = (unsigned)(64 * rstep);
    const size_t kstep = (size_t)(BK * 2);
    const size_t kstepA = GATHER ? (size_t)g.kstepA : kstep;
    const size_t hstep = (size_t)HALF * rstep;
    const size_t tstep = 2 * hstep;
    const unsigned ldsw = (unsigned)wid * 1024u;
    const int aoff = lds_byte(wr * 64 + fr, fq * (FP8 ? 16 : 8)), boff = lds_byte(wc * 32 + fr, fq * (FP8 ? 16 : 8));
    unsigned gkey[2];
    LAS v2u* gstash = (LAS v2u*)(lds + STAGE_BYTES + 512 + tid * 8);
    unsigned gcol = 0; { int R_, C_; stage_rc(tid * 16, R_, C_); gcol = (unsigned)C_ * 2u; }
    Unit gu;
#define PG8_SA(b, h) (((b) * 2 + (h)) * HTB)
#define PG8_SB(b, h) ((4 + (b) * 2 + (h)) * HTB)
#define PG8_STG(bufoff, ptr, v0, v1) do { \
        __builtin_amdgcn_global_load_lds((const unsigned*)((const char*)(ptr) + (v0)), (LAS unsigned*)(lds + (bufoff) + ldsw), 16, 0, 0); \
        __builtin_amdgcn_global_load_lds((const unsigned*)((const char*)(ptr) + (v1)), (LAS unsigned*)(lds + (bufoff) + ldsw + 8192), 16, 0, 0); } while (0)
#define PG8_STAGE_B(bufoff, ptr) PG8_STG(bufoff, ptr, voffB[0], voffB[0] + r64)
#define PG8_STAGE_A(bufoff, ptr, h, nx) do { if constexpr (GATHER) { const unsigned o0_ = S.keyoff(gu, gkey[h] & 0xffffu) + gcol, o1_ = S.keyoff(gu, gkey[h] >> 16) + gcol; PG8_STG(bufoff, ptr, o0_, o1_); } \
        else { PG8_STG(bufoff, (const char*)(ptr) + (h) * hstep, voffA[0], voffA[0] + r64); } } while (0)
#define PG8_GLOAD(dst, u) do { int R_, C_; stage_rc(tid * 16, R_, C_); _Pragma("unroll") for (int h_ = 0; h_ < 2; ++h_) \
        dst[h_] = S.rowkey((u), h_ * HALF + R_) | (S.rowkey((u), h_ * HALF + R_ + 64) << 16); } while (0)
#define PG8_RD8(off) (RD32 ? *(const LAS v8i*)(lds + (off)) : __builtin_shufflevector(*(const LAS v4i*)(lds + (off)), *(const LAS v4i*)(lds + (off) + 16), 0, 1, 2, 3, 4, 5, 6, 7))
#define PG8_LDA(dst, b, h) do { if constexpr (FP8) { _Pragma("unroll") for (int m = 0; m < 4; ++m) dst##8[m] = PG8_RD8(PG8_SA(b, h) + aoff + m * 2048); } \
        else { _Pragma("unroll") for (int m = 0; m < 4; ++m) _Pragma("unroll") for (int k = 0; k < 2; ++k) dst[m][k] = *(const LAS bf16x8*)(lds + PG8_SA(b, h) + aoff + m * 2048 + k * 1024); } } while (0)
#define PG8_LDB(dst, b, h) do { if constexpr (FP8) { _Pragma("unroll") for (int n = 0; n < 2; ++n) dst##8[n] = PG8_RD8(PG8_SB(b, h) + boff + n * 2048); } \
        else { _Pragma("unroll") for (int n = 0; n < 2; ++n) _Pragma("unroll") for (int k = 0; k < 2; ++k) dst[n][k] = *(const LAS bf16x8*)(lds + PG8_SB(b, h) + boff + n * 2048 + k * 1024); } } while (0)
#define PG8_MMA(ai, bj, At, Bt) do { __builtin_amdgcn_s_setprio(1); if constexpr (FP8) { _Pragma("unroll") for (int m = 0; m < 4; ++m) _Pragma("unroll") for (int n = 0; n < 2; ++n) \
        asm volatile("v_mfma_f32_16x16x128_f8f6f4 %0, %1, %2, %0" : "+v"(acc[ai][bj][m][n]) : "v"(Bt##8[n]), "v"(At##8[m])); } \
        else { _Pragma("unroll") for (int m = 0; m < 4; ++m) _Pragma("unroll") for (int n = 0; n < 2; ++n) _Pragma("unroll") for (int k = 0; k < 2; ++k) \
        acc[ai][bj][m][n] = __builtin_amdgcn_mfma_f32_16x16x32_bf16(Bt[n][k], At[m][k], acc[ai][bj][m][n], 0, 0, 0); } __builtin_amdgcn_s_setprio(0); } while (0)
#define PG8_WAIT_V(n) asm volatile("s_waitcnt vmcnt(" #n ")" ::: "memory")
#define PG8_WAIT_L(n) asm volatile("s_waitcnt lgkmcnt(" #n ")" ::: "memory")
#define PG8_BAR __builtin_amdgcn_s_barrier()
#define PG8_SCHED __builtin_amdgcn_sched_barrier(0)
    Unit cur, nxt; int ui = 0;
    if (!S.next(0, cur)) return;
    f32x4 acc[2][2][4][2];
#pragma unroll
    for (int a = 0; a < 2; ++a)
#pragma unroll
        for (int b = 0; b < 2; ++b)
#pragma unroll
            for (int m = 0; m < 4; ++m)
#pragma unroll
                for (int n = 0; n < 2; ++n) acc[a][b][m][n] = (f32x4){0.f, 0.f, 0.f, 0.f};
    bf16x8 At[4][2], B0[2][2], B1[2][2]; v8i At8[4], B08[2], B18[2];
    const char* cA = GATHER ? (const char*)g.A : (const char*)g.A + (size_t)cur.arow * rstep; const char* cB = (const char*)g.Bt + (size_t)cur.pn * tstep;
    if constexpr (GATHER) { PG8_GLOAD(gkey, cur); gu = cur; }
    PG8_STAGE_B(PG8_SB(0, 0), cB); PG8_STAGE_B(PG8_SB(0, 1), cB + hstep); PG8_STAGE_A(PG8_SA(0, 0), cA, 0, false); PG8_STAGE_A(PG8_SA(0, 1), cA, 1, false);
    if (wr == 1) PG8_BAR;
    PG8_WAIT_V(2); PG8_BAR;
    PG8_STAGE_B(PG8_SB(1, 0), cB + kstep); PG8_STAGE_A(PG8_SA(1, 0), cA + kstepA, 0, false); PG8_STAGE_B(PG8_SB(1, 1), cB + hstep + kstep);
    PG8_WAIT_V(6); PG8_BAR;
    for (;;) {
        const bool has_next = S.next(ui + 1, nxt);
        if constexpr (GATHER) { if (has_next) { unsigned gt_[2]; PG8_GLOAD(gt_, nxt); *gstash = (v2u){gt_[0], gt_[1]}; } }
        const char* nA = GATHER ? cA : (has_next ? (const char*)g.A + (size_t)nxt.arow * rstep : cA); const char* nB = has_next ? (const char*)g.Bt + (size_t)nxt.pn * tstep : cB;
        for (int t = 0; t < nt; t += 2) {
            const bool last = (t == nt - 2);
            const bool nx = last && has_next;
            if constexpr (Mid::ON) { if (t == nt / 2) { Unit mu; mu.arow = __builtin_amdgcn_readfirstlane(cur.arow); mu.pn = __builtin_amdgcn_readfirstlane(cur.pn); mu.valid = cur.valid; mu.aux = cur.aux;
                int fr_ = fr, fq_ = fq; asm volatile("" : "+s"(mu.arow), "+s"(mu.pn), "+v"(fr_), "+v"(fq_)); MH(acc, mu, wr, wc, fr_, fq_); } }
            const char* a1 = cA + (size_t)(t + 1) * kstepA;
            const char* a2 = last ? nA : cA + (size_t)(t + 2) * kstepA; const char* b2 = last ? nB : cB + (size_t)(t + 2) * kstep;
            const char* a3 = a2 + kstepA; const char* b3 = b2 + kstep;
            PG8_LDB(B0, 0, 0); PG8_LDB(B1, 0, 1); PG8_SCHED; PG8_LDA(At, 0, 0); PG8_STAGE_A(PG8_SA(1, 1), a1, 1, false);
            if constexpr (GATHER) { if (nx) { const v2u s_ = *gstash; gkey[0] = s_.x; gkey[1] = s_.y; gu = nxt; } }
            PG8_WAIT_V(8); PG8_WAIT_L(0); PG8_BAR; PG8_MMA(0, 0, At, B0); PG8_MMA(0, 1, At, B1); PG8_BAR; PG8_SCHED;
            PG8_LDA(At, 0, 1); PG8_STAGE_B(PG8_SB(0, 0), b2); PG8_STAGE_B(PG8_SB(0, 1), b2 + hstep); PG8_STAGE_A(PG8_SA(0, 0), a2, 0, nx);
            PG8_WAIT_V(8); PG8_WAIT_L(0); PG8_BAR; PG8_MMA(1, 0, At, B0); PG8_MMA(1, 1, At, B1); PG8_BAR; PG8_SCHED;
            PG8_LDB(B0, 1, 0); PG8_LDB(B1, 1, 1); PG8_SCHED; PG8_LDA(At, 1, 0); PG8_STAGE_A(PG8_SA(0, 1), a2, 1, nx);
            PG8_WAIT_V(8); PG8_WAIT_L(0); PG8_BAR; PG8_MMA(0, 0, At, B0); PG8_MMA(0, 1, At, B1); PG8_BAR; PG8_SCHED;
            PG8_LDA(At, 1, 1); PG8_STAGE_B(PG8_SB(1, 0), b3); PG8_STAGE_B(PG8_SB(1, 1), b3 + hstep); PG8_STAGE_A(PG8_SA(1, 0), a3, 0, nx);
            PG8_WAIT_V(8); PG8_WAIT_L(0); PG8_BAR; PG8_MMA(1, 0, At, B0); PG8_MMA(1, 1, At, B1); PG8_BAR; PG8_SCHED;
        }
        if constexpr (ALIGN_EPI) { if (wr == 0) PG8_BAR; }
        if constexpr (FP8) asm volatile("s_nop 15\n\ts_nop 7" ::: "memory");
        { Unit eu; eu.arow = __builtin_amdgcn_readfirstlane(cur.arow); eu.pn = __builtin_amdgcn_readfirstlane(cur.pn); eu.valid = __builtin_amdgcn_readfirstlane(cur.valid); eu.aux = __builtin_amdgcn_readfirstlane(cur.aux);
          asm volatile("" : "+s"(eu.arow), "+s"(eu.pn), "+s"(eu.valid), "+s"(eu.aux));
          int fr_ = fr, fq_ = fq; asm volatile("" : "+v"(fr_), "+v"(fq_));
          E(acc, eu, wr, wc, fr_, fq_); }
        if (!has_next) break;
#pragma unroll
        for (int a = 0; a < 2; ++a)
#pragma unroll
            for (int b = 0; b < 2; ++b)
#pragma unroll
                for (int m = 0; m < 4; ++m)
#pragma unroll
                    for (int n = 0; n < 2; ++n) acc[a][b][m][n] = (f32x4){0.f, 0.f, 0.f, 0.f};
        cur = nxt; cA = nA; cB = nB; ++ui;
        if constexpr (ALIGN_EPI) { if (wr == 1) PG8_BAR; }
    }
    PG8_WAIT_V(0);
    if constexpr (!ALIGN_EPI) { if (wr == 0) PG8_BAR; }
    PG8_BAR;
#undef PG8_SA
#undef PG8_SB
#undef PG8_STG
#undef PG8_STAGE_A
#undef PG8_STAGE_B
#undef PG8_GLOAD
#undef PG8_LDA
#undef PG8_RD8
#undef PG8_LDB
#undef PG8_MMA
#undef PG8_WAIT_V
#undef PG8_WAIT_L
#undef PG8_BAR
#undef PG8_SCHED
}
}

#define XB_TMO      128
#define XB_XCNT(j)  (256  + 64 * (j))
#define XB_XSUB(j)  (1280 + 64 * (j))
#define XB_XGEN(j)  (2304 + 64 * (j))
#define XB_TOP      3328
#define XB_TOPGEN   3392
#define XCD_BAR_WORDS 3456
#define XB_SPIN_CAP (1u << 22)

__device__ __forceinline__ unsigned xb_ld(unsigned* p)              { return __hip_atomic_load(p, __ATOMIC_RELAXED, __HIP_MEMORY_SCOPE_AGENT); }
__device__ __forceinline__ unsigned xb_add(unsigned* p, unsigned v) { return __hip_atomic_fetch_add(p, v, __ATOMIC_RELAXED, __HIP_MEMORY_SCOPE_AGENT); }
__device__ __forceinline__ unsigned xb_xcc_id() { return (unsigned)__builtin_amdgcn_s_getreg((3 << 11) | 20) & 0xFu; }
#define XB_SPIN(cond, bar) do { unsigned _sp = 0; while (cond) { __builtin_amdgcn_s_sleep(1); \
    if ((++_sp & 255u) == 0u) { if (xb_ld(&(bar)[XB_TMO])) break; if (_sp > XB_SPIN_CAP) { atomicAdd(&(bar)[XB_TMO], 1u); break; } } } } while (0)

struct XcdBarrier { unsigned* bar; unsigned x; volatile LAS unsigned* st; };

__device__ __forceinline__ XcdBarrier xcd_barrier_post(unsigned* bar, volatile LAS unsigned* st) {
    XcdBarrier b; b.bar = bar; b.x = xb_xcc_id(); b.st = st;
    if (threadIdx.x == 0) (void)xb_add(&bar[XB_XCNT(b.x)], 1u);
    return b;
}
__device__ __forceinline__ void xcd_barrier_complete(unsigned* bar, unsigned x, unsigned& nloc, unsigned& nx) {
    const unsigned G = gridDim.x * gridDim.y * gridDim.z;
    unsigned sum, cnt, mine, sp = 0u;
    for (;;) {
        sum = 0u; cnt = 0u; mine = 0u;
#pragma unroll
        for (unsigned j = 0; j < 16; ++j) { const unsigned c = xb_ld(&bar[XB_XCNT(j)]); sum += c; cnt += (c > 0u) ? 1u : 0u; mine = (j == x) ? c : mine; }
        if (sum == G) break;
        __builtin_amdgcn_s_sleep(1);
        if ((++sp & 255u) == 0u) { if (xb_ld(&bar[XB_TMO])) break; if (sp > XB_SPIN_CAP) { atomicAdd(&bar[XB_TMO], 1u); break; } }
    }
    nloc = mine > 0u ? mine : 1u; nx = cnt > 0u ? cnt : 1u;
}
__device__ __forceinline__ void xcd_barrier(const XcdBarrier& b) {
    asm volatile("s_waitcnt vmcnt(0)" ::: "memory");
    __syncthreads();
    if (threadIdx.x == 0) {
        unsigned* bar = b.bar;
        __builtin_amdgcn_s_waitcnt(0);
        unsigned nloc = b.st[0], nx = b.st[1];
        if (nloc == 0u) { xcd_barrier_complete(bar, b.x, nloc, nx); b.st[0] = nloc; b.st[1] = nx; }
        const unsigned old = xb_add(&bar[XB_XSUB(b.x)], 1u);
        const unsigned gen = old / nloc;
        if (old + 1u == (gen + 1u) * nloc) {
            __builtin_amdgcn_fence(__ATOMIC_RELEASE, "agent");
            asm volatile("s_waitcnt vmcnt(0)" ::: "memory");
            const unsigned og = xb_add(&bar[XB_TOP], 1u);
            const unsigned tg = og / nx;
            if (og + 1u == (tg + 1u) * nx) xb_add(&bar[XB_TOPGEN], 1u);
            else XB_SPIN(xb_ld(&bar[XB_TOPGEN]) == tg, bar);
            __builtin_amdgcn_fence(__ATOMIC_ACQUIRE, "agent");
            xb_add(&bar[XB_XGEN(b.x)], 1u);
            asm volatile("s_waitcnt vmcnt(0)" ::: "memory");
        } else {
            XB_SPIN(xb_ld(&bar[XB_XGEN(b.x)]) == gen, bar);
            __builtin_amdgcn_fence(__ATOMIC_ACQUIRE, "agent");
            asm volatile("s_waitcnt vmcnt(0)" ::: "memory");
        }
    }
    __syncthreads();
}

struct Frame {
    LAS unsigned char* lds;
    unsigned char* ws;
    const float* const* in;
    float* out;
    int tid, lane, wave, G, gw, ngw;
};
#define WSP(T, off) ((T*)(F.ws + (off)))
#define INP(k) (F.in[k])

template <class RowMap>
__device__ __forceinline__ void transpose_item(const float* W, int K, int N, bf16* WT, int ldt, LAS float* scr, int item, int lane, RowMap rm) {
    const int nblk = (N + 31) / 32, kb = item / nblk, nb = item % nblk, k0 = 64 * kb, n0 = 32 * nb;
    const int nn = n0 + (lane & 31);
#pragma unroll 8
    for (int i = 0; i < 32; ++i) { const int kk = 2 * i + (lane >> 5); scr[kk * 33 + (lane & 31)] = (nn < N) ? W[(size_t)(k0 + kk) * N + nn] : 0.f; }
    LDS_WAIT(); asm volatile("" ::: "memory");
    const int c = lane & 7;
#pragma unroll
    for (int j = 0; j < 4; ++j) { const int n = (lane >> 3) + 8 * j; const LAS float* s = scr + (8 * c) * 33 + n;
        v4u o; o.x = pk2(s[0 * 33], s[1 * 33]); o.y = pk2(s[2 * 33], s[3 * 33]); o.z = pk2(s[4 * 33], s[5 * 33]); o.w = pk2(s[6 * 33], s[7 * 33]);
        if (n0 + n < N) *(v4u*)(WT + (size_t)rm(n0 + n) * ldt + k0 + 8 * c) = o; }
    LDS_WAIT(); asm volatile("" ::: "memory");
}
template <class RowMap>
__device__ __forceinline__ void transpose_item8(const float* W, int K, int N, unsigned char* WT, int ldt, LAS float* scr, int item, int lane, RowMap rm) {
    const int nblk = (N + 31) / 32, kb = item / nblk, nb = item % nblk, k0 = 64 * kb, n0 = 32 * nb;
    const int nn = n0 + (lane & 31);
#pragma unroll 8
    for (int i = 0; i < 32; ++i) { const int kk = 2 * i + (lane >> 5); scr[kk * 33 + (lane & 31)] = (nn < N) ? W[(size_t)(k0 + kk) * N + nn] : 0.f; }
    LDS_WAIT(); asm volatile("" ::: "memory");
    const int c = lane & 3;
#pragma unroll
    for (int j = 0; j < 2; ++j) { const int n = (lane >> 2) + 16 * j; const LAS float* s = scr + (16 * c) * 33 + n; int w[4];
#pragma unroll
        for (int q = 0; q < 4; ++q) { int t = 0; t = __builtin_amdgcn_cvt_pk_fp8_f32(s[(4 * q) * 33] * 64.f, s[(4 * q + 1) * 33] * 64.f, t, false); t = __builtin_amdgcn_cvt_pk_fp8_f32(s[(4 * q + 2) * 33] * 64.f, s[(4 * q + 3) * 33] * 64.f, t, true); w[q] = t; }
        if (n0 + n < N) *(v4i*)(WT + (size_t)rm(n0 + n) * ldt + k0 + 16 * c) = (v4i){w[0], w[1], w[2], w[3]}; }
    LDS_WAIT(); asm volatile("" ::: "memory");
}
struct RmId { __device__ __forceinline__ int operator()(int n) const { return n; } };
struct RmWin { __device__ __forceinline__ int operator()(int n) const { return n < 2560 ? n : (n < 2608 ? PC_G3 + (n - 2560) : (n < 4656 ? n - 48 : (n < 4664 ? PC_IF + (n - 4656) : n - 56))); } };
struct RmGU { int up; __device__ __forceinline__ int operator()(int n) const { return 256 * (n >> 7) + (n & 127) + 128 * up; } };

__device__ __forceinline__ void mod_chunks(Frame& F, int first, int last, int stride) {
    const int tid_ = tid_opaque(), lane_ = tid_ & 63; (void)lane_;
    const float* c = INP(1); const float* w_ada = INP(2); const float* b_ada = INP(3);
    float* mod = WSP(float, WS_MOD);
    LAS float* sc = (LAS float*)F.lds; LAS float* red = (LAS float*)(F.lds + 65536);
    __syncthreads();
    { f32x4 cv[8];
#pragma unroll
      for (int j = 0; j < 8; ++j) cv[j] = *(const f32x4*)(c + 4 * tid_ + 2048 * j);
#pragma unroll
      for (int j = 0; j < 8; ++j) { f32x4 o; o.x = cv[j].x * sigm(cv[j].x); o.y = cv[j].y * sigm(cv[j].y); o.z = cv[j].z * sigm(cv[j].z); o.w = cv[j].w * sigm(cv[j].w); *(LAS f32x4*)(sc + 4 * tid_ + 2048 * j) = o; } }
    __syncthreads();
    for (int ci = first; ci < last; ci += stride) {
        const int cq = tid_ % 12, kg = tid_ / 12;
        if (tid_ < 504) {
            float acc[8][4];
#pragma unroll
            for (int b = 0; b < 8; ++b)
#pragma unroll
                for (int j = 0; j < 4; ++j) acc[b][j] = 0.f;
            const float* wp = w_ada + 48 * ci + 4 * cq;
            f32x4 wc[7], wn[7];
#pragma unroll
            for (int u = 0; u < 7; ++u) { wc[u] = __builtin_nontemporal_load((const f32x4*)(wp + (size_t)(kg + 42 * u) * 12288)); wn[u] = wc[u]; }
#pragma unroll 1
            for (int bi = 0; bi < 7; ++bi) {
                if (bi < 6) {
#pragma unroll
                    for (int u = 0; u < 7; ++u) { int k = kg + 42 * (7 * (bi + 1) + u); k = k < DM ? k : DM - 1; wn[u] = __builtin_nontemporal_load((const f32x4*)(wp + (size_t)k * 12288)); } }
#pragma unroll
                for (int u = 0; u < 7; ++u) { const int k = kg + 42 * (7 * bi + u); const bool ok = k < DM; const int kc = ok ? k : DM - 1;
#pragma unroll
                    for (int b = 0; b < 8; ++b) { const float s = ok ? sc[b * DM + kc] : 0.f;
#pragma unroll
                        for (int j = 0; j < 4; ++j) acc[b][j] += s * wc[u][j]; } }
#pragma unroll
                for (int u = 0; u < 7; ++u) wc[u] = wn[u];
            }
#pragma unroll
            for (int b = 0; b < 8; ++b)
#pragma unroll
                for (int j = 0; j < 4; ++j) red[(kg * 12 + cq) * 32 + b * 4 + j] = acc[b][j];
        }
        __syncthreads();
        if (tid_ < 384) { const int b = tid_ / 48, col = tid_ % 48, q = col >> 2, j = col & 3; float s = 0.f;
            for (int k2 = 0; k2 < 42; ++k2) s += red[(k2 * 12 + q) * 32 + b * 4 + j];
            mod[b * 12288 + 48 * ci + col] = s + b_ada[48 * ci + col]; }
        __syncthreads();
    }
}
struct TDesc { const float* W; int K, N; unsigned char* WT; int ldt; int kind; int item; int nblk, nb0; };
__device__ __forceinline__ TDesc p0_decode(Frame& F, int it) {
    constexpr int I_WIN = 32 * 146, I_WIN8 = 32 * 274, I_UP = 16 * 64, I_OUT = 32 * 64, I_SH = 32 * 16, I_SHD = 8 * 64, I_R = 32 * 2, I_EG = 64 * 512, I_C1 = 32 * 8;
    unsigned char* WeGU = WSP(unsigned char, WS_WEGU); unsigned char* WeD = WSP(unsigned char, WS_WED);
    int r = it;
    if (r < I_WIN) return TDesc{INP(6), DM, D_IN, WSP(unsigned char, WS_WIN), DM * 2, 1, r, 146, 0}; r -= I_WIN;
    if (r < I_WIN8) return TDesc{INP(6), DM, D_IN, WSP(unsigned char, WS_WIN8), DM, 5, r, 274, 32}; r -= I_WIN8;
    if (r < I_UP) return TDesc{INP(14), 1024, DM, WSP(unsigned char, WS_WUP), 2048 * 2, 0, r, (DM + 31) / 32, 0}; r -= I_UP;
    if (r < I_UP) return TDesc{INP(15), 1024, DM, WSP(unsigned char, WS_WUP) + 1024 * 2, 2048 * 2, 0, r, (DM + 31) / 32, 0}; r -= I_UP;
    if (r < I_OUT) return TDesc{INP(16), DM, DM, WSP(unsigned char, WS_WOUT), DM * 2, 0, r, (DM + 31) / 32, 0}; r -= I_OUT;
    if (r < I_SH) return TDesc{INP(24), DM, EFF, WeGU + (size_t)64 * 1024 * DM, DM, 3, r, (EFF + 31) / 32, 0}; r -= I_SH;
    if (r < I_SH) return TDesc{INP(25), DM, EFF, WeGU + (size_t)64 * 1024 * DM, DM, 4, r, (EFF + 31) / 32, 0}; r -= I_SH;
    if (r < I_SHD) return TDesc{INP(26), EFF, DM, WeD + (size_t)64 * DM * EFF, EFF, 2, r, (DM + 31) / 32, 0}; r -= I_SHD;
    if (r < I_R) return TDesc{INP(19), DM, NEXP, WSP(unsigned char, WS_WR), DM * 2, 0, r, (NEXP + 31) / 32, 0}; r -= I_R;
    if (r < 16) { const int kv = r >> 3; return TDesc{INP(9) + (size_t)kv * 256 * 64, 256, 64, WSP(unsigned char, WS_CW2) + (size_t)kv * 64 * 256 * 2, 256 * 2, 0, r & 7, 2, 0}; } r -= 16;
    if (r < 2 * I_C1) { const int kv = r >> 8; return TDesc{INP(8) + (size_t)kv * DM * 256, DM, 256, WSP(unsigned char, WS_CW1) + (size_t)kv * 256 * DM * 2, DM * 2, 0, r & 255, (256 + 31) / 32, 0}; } r -= 2 * I_C1;
    if (r < I_EG) { const int e = r >> 9; return TDesc{INP(21) + (size_t)e * DM * EFF, DM, EFF, WeGU + (size_t)e * 1024 * DM, DM, 3, r & 511, (EFF + 31) / 32, 0}; } r -= I_EG;
    if (r < I_EG) { const int e = r >> 9; return TDesc{INP(22) + (size_t)e * DM * EFF, DM, EFF, WeGU + (size_t)e * 1024 * DM, DM, 4, r & 511, (EFF + 31) / 32, 0}; } r -= I_EG;
    { const int e = r >> 9; return TDesc{INP(23) + (size_t)e * EFF * DM, EFF, DM, WeD + (size_t)e * DM * EFF, EFF, 2, r & 511, (DM + 31) / 32, 0}; }
}
__device__ __forceinline__ void t_load(const TDesc& d, int lane, float (&v)[32]) {
    const int nblk = d.nblk, kb = d.item / nblk, nb = d.nb0 + d.item % nblk; int nn = 32 * nb + (lane & 31); nn = nn < d.N ? nn : d.N - 1;
    const float* p = d.W + (size_t)(64 * kb + (lane >> 5)) * d.N + nn;
#pragma unroll
    for (int i = 0; i < 32; ++i) v[i] = __builtin_nontemporal_load(p + (size_t)(2 * i) * d.N);
}
__device__ __forceinline__ int t_rowmap(int kind, int n) {
    if (kind == 1 || kind == 5) { if (n < 1024) return n;
        if (n < 2560) { const int i = (n - 1024) >> 8, c = (n - 1024) & 255; return ((i & 1) ? PC_VC : PC_KC) + (i >> 1) * 256 + c; }
        if (n < 2608) return PC_G3 + (n - 2560); if (n < 3632) return PC_QKM + (n - 2608); if (n < 4656) return PC_VM + (n - 3632); if (n < 4664) return PC_IF + (n - 4656); return n + 200; }
    if (kind == 3 || kind == 4) return 256 * (n >> 7) + (n & 127) + 128 * (kind - 3);
    return n;
}
__device__ __forceinline__ void t_finish(const TDesc& d, int lane, LAS float* scr, const float (&v)[32]) {
    const int nblk = d.nblk, kb = d.item / nblk, nb = d.nb0 + d.item % nblk, k0 = 64 * kb, n0 = 32 * nb;
#pragma unroll
    for (int i = 0; i < 32; ++i) scr[(2 * i + (lane >> 5)) * 33 + (lane & 31)] = v[i];
    LDS_WAIT(); asm volatile("" ::: "memory");
    if (d.kind >= 2) {
        const int c = lane & 3;
#pragma unroll
        for (int j = 0; j < 2; ++j) { const int n = (lane >> 2) + 16 * j; const LAS float* s = scr + (16 * c) * 33 + n; int w[4];
#pragma unroll
            for (int q = 0; q < 4; ++q) { int t = 0; t = __builtin_amdgcn_cvt_pk_fp8_f32(s[(4 * q) * 33] * 64.f, s[(4 * q + 1) * 33] * 64.f, t, false); t = __builtin_amdgcn_cvt_pk_fp8_f32(s[(4 * q + 2) * 33] * 64.f, s[(4 * q + 3) * 33] * 64.f, t, true); w[q] = t; }
            int dr = t_rowmap(d.kind, n0 + n); bool ok = n0 + n < d.N; if (d.kind == 5) { ok = ok && dr >= PN_BF; dr -= PN_BF; }
            if (ok) *(v4i*)(d.WT + (size_t)dr * d.ldt + k0 + 16 * c) = (v4i){w[0], w[1], w[2], w[3]}; }
    } else {
        const int c = lane & 7;
#pragma unroll
        for (int j = 0; j < 4; ++j) { const int n = (lane >> 3) + 8 * j; const LAS float* s = scr + (8 * c) * 33 + n;
            v4u o; o.x = pk2(s[0 * 33], s[1 * 33]); o.y = pk2(s[2 * 33], s[3 * 33]); o.z = pk2(s[4 * 33], s[5 * 33]); o.w = pk2(s[6 * 33], s[7 * 33]);
            const int dr = t_rowmap(d.kind, n0 + n); const bool ok = (n0 + n < d.N) && (d.kind != 1 || dr < PN_BF);
            if (ok) *(v4u*)(d.WT + (size_t)dr * d.ldt + (size_t)(k0 + 8 * c) * 2) = o; }
    }
    LDS_WAIT(); asm volatile("" ::: "memory");
}
constexpr int NIT_ALL = 16 + 32 * 146 + 32 * 274 + 2 * 16 * 64 + 32 * 64 + 2 * 32 * 16 + 8 * 64 + 32 * 2 + 2 * 32 * 8 + 3 * 64 * 512;
constexpr int NIT_LATE = 3 * 64 * 512, NIT_EARLY = NIT_ALL - NIT_LATE;
__device__ __forceinline__ void convert_range(Frame& F, int lo, int hi, int w, int nw) {
    const int tid_ = tid_opaque(), lane_ = tid_ & 63;
    LAS float* scr = (LAS float*)(F.lds + F.wave * 16384);
    int it = lo + w; if (it >= hi) return;
    TDesc d = p0_decode(F, it); float v[32]; t_load(d, lane_, v);
    for (;;) {
        const int itn = it + nw; const bool hn = itn < hi;
        TDesc dn = d; float vn[32];
        if (hn) { dn = p0_decode(F, itn); t_load(dn, lane_, vn); }
        t_finish(d, lane_, scr, v);
        if (!hn) break;
        d = dn; it = itn;
#pragma unroll
        for (int i = 0; i < 32; ++i) v[i] = vn[i];
    }
}
constexpr int MOD_EARLY = 86;
__device__ __forceinline__ void p0_early(Frame& F) {
    const int bx = (int)blockIdx.x;
    if (F.G <= MOD_EARLY + 8) { mod_chunks(F, bx, MOD_EARLY, F.G); convert_range(F, 0, NIT_EARLY, F.gw, F.ngw); return; }
    constexpr int SPLIT = (NIT_EARLY * 7) / 8;
    if (bx < MOD_EARLY) { mod_chunks(F, bx, MOD_EARLY, MOD_EARLY); convert_range(F, SPLIT, NIT_EARLY, bx * 8 + F.wave, MOD_EARLY * 8); }
    else convert_range(F, 0, SPLIT, (bx - MOD_EARLY) * 8 + F.wave, (F.G - MOD_EARLY) * 8);
}
constexpr int NCHUNK = 8;
__device__ __forceinline__ void convert_chunk(Frame& F, int& chunk) {
    if (chunk >= NCHUNK) return;
    const int per = (NIT_LATE + F.G - 1) / F.G, pc = (per + NCHUNK - 1) / NCHUNK;
    int lo = NIT_EARLY + (int)blockIdx.x * per + chunk * pc, hi = lo + pc; const int end = NIT_EARLY + ((int)blockIdx.x + 1) * per;
    hi = hi < end ? hi : end; hi = hi < NIT_ALL ? hi : NIT_ALL;
    __syncthreads();
    if (chunk == 0) { const int nl = 256 - MOD_EARLY; const int per_wg = (nl + F.G - 1) / F.G;
        mod_chunks(F, MOD_EARLY + (int)blockIdx.x * per_wg, (MOD_EARLY + ((int)blockIdx.x + 1) * per_wg) < 256 ? (MOD_EARLY + ((int)blockIdx.x + 1) * per_wg) : 256, 1); }
    convert_range(F, lo, hi, F.wave, 8);
    __syncthreads();
    ++chunk;
}
__device__ __forceinline__ void p0_bias1(Frame& F) {
    const int tid_ = tid_opaque(), lane_ = tid_ & 63;
    for (int o = F.gw; o < 512; o += F.ngw) { const int kv = o >> 8, j = o & 255; const float* pe = INP(7) + kv * 2048; const float* w1 = INP(8) + (size_t)kv * 2048 * 256 + j;
        float s = 0.f;
#pragma unroll 8
        for (int k = lane_; k < 2048; k += 64) s += pe[k] * w1[(size_t)k * 256];
        s = wave_sum(s); if (lane_ == 0) WSP(float, WS_BIAS1)[o] = s; }
}
__device__ __forceinline__ void p1_h1(Frame& F) {
    const int tid_ = tid_opaque(), lane_ = tid_ & 63; (void)lane_;
    const float* x = INP(0); const float* gpm = INP(4); const float* mod = WSP(float, WS_MOD); bf16* H1 = WSP(bf16, WS_H1); unsigned char* H1Q = WSP(unsigned char, WS_H1Q);
    for (int row = F.gw; row < NTOK; row += F.ngw) {
        const int b = row >> 11; const f32x4* xr = (const f32x4*)(x + (size_t)row * DM) + lane_;
        f32x4 v[8]; float s = 0.f;
#pragma unroll
        for (int j = 0; j < 8; ++j) { v[j] = xr[64 * j]; s += (v[j].x * v[j].x + v[j].y * v[j].y) + (v[j].z * v[j].z + v[j].w * v[j].w); }
        const float rstd = rsqrtf(wave_sum(s) * (1.f / DM) + EPS);
        const float* sh = mod + b * 12288; const float* scl = sh + 2048;
        int* o4 = (int*)(H1Q + (size_t)row * DM) + lane_; unsigned long long* o8 = (unsigned long long*)(H1 + (size_t)row * DM) + lane_;
#pragma unroll
        for (int j = 0; j < 8; ++j) { const int col = 4 * lane_ + 256 * j; const f32x4 g = *(const f32x4*)(gpm + col), a = *(const f32x4*)(scl + col), c = *(const f32x4*)(sh + col);
            const float r0 = v[j].x * rstd * g.x * (1.f + a.x) + c.x, r1 = v[j].y * rstd * g.y * (1.f + a.y) + c.y, r2 = v[j].z * rstd * g.z * (1.f + a.z) + c.z, r3 = v[j].w * rstd * g.w * (1.f + a.w) + c.w;
            int q8 = 0; q8 = __builtin_amdgcn_cvt_pk_fp8_f32(fminf(fmaxf(r0, -448.f), 448.f), fminf(fmaxf(r1, -448.f), 448.f), q8, false); q8 = __builtin_amdgcn_cvt_pk_fp8_f32(fminf(fmaxf(r2, -448.f), 448.f), fminf(fmaxf(r3, -448.f), 448.f), q8, true);
            o4[64 * j] = q8; o8[64 * j] = (unsigned long long)pk2(r0, r1) | ((unsigned long long)pk2(r2, r3) << 32); }
    }
}
__device__ __forceinline__ float gelu_tanh(float x) { const float u = 0.7978845608028654f * (x + 0.044715f * x * x * x); const float t = 1.f - 2.f * frcp(1.f + __expf(2.f * u)); return 0.5f * x * (1.f + t); }
__device__ __forceinline__ void p3_conv(Frame& F) {
    const int tid_ = tid_opaque(), lane_ = tid_ & 63; (void)lane_;
    const bf16* PROJ = WSP(bf16, WS_PROJ); bf16* QKC = WSP(bf16, WS_QKC); const float* cw = INP(10); const float* cb = INP(11);
    const int skip = F.G > 64 ? 32 : 0;
    if ((int)blockIdx.x < skip) return;
    const int c8 = (tid_ & 127) * 8, rg = F.wave >> 1;
    f32x4 w[4][2], bias[2];
#pragma unroll
    for (int i = 0; i < 4; ++i) { w[i][0] = *(const f32x4*)(cw + i * 1024 + c8); w[i][1] = *(const f32x4*)(cw + i * 1024 + c8 + 4); }
    bias[0] = *(const f32x4*)(cb + c8); bias[1] = *(const f32x4*)(cb + c8 + 4);
    const float sc = (c8 >= 512) ? 0.08838834764831845f : 1.f;
    for (int blk = (int)blockIdx.x - skip; blk < NTOK / 16; blk += F.G - skip) {
        const int r0 = blk * 16 + rg * 4; const bool head = (r0 & 2047) == 0;
        v4u q[7];
#pragma unroll
        for (int i = 0; i < 7; ++i) { const int row = (i < 3 && head) ? r0 : r0 - 3 + i; const GAS v4u* pr = UPTR(const v4u, PROJ + (size_t)row * PLD + PC_QKM) + (tid_ & 127); q[i] = *pr; }
        if (head) { q[0] = (v4u){0u, 0u, 0u, 0u}; q[1] = q[0]; q[2] = q[0]; }
#pragma unroll
        for (int o = 0; o < 4; ++o) {
            f32x4 a0 = bias[0], a1 = bias[1];
#pragma unroll
            for (int i = 0; i < 4; ++i) { const v4u x = q[o + i];
                a0 += (f32x4){bflo(x.x), bfhi(x.x), bflo(x.y), bfhi(x.y)} * w[i][0]; a1 += (f32x4){bflo(x.z), bfhi(x.z), bflo(x.w), bfhi(x.w)} * w[i][1]; }
            v4u ov; ov.x = pk2(a0.x * sigm(a0.x) * sc, a0.y * sigm(a0.y) * sc); ov.y = pk2(a0.z * sigm(a0.z) * sc, a0.w * sigm(a0.w) * sc);
            ov.z = pk2(a1.x * sigm(a1.x) * sc, a1.y * sigm(a1.y) * sc); ov.w = pk2(a1.z * sigm(a1.z) * sc, a1.w * sigm(a1.w) * sc);
            GAS v4u* po = UPTR(v4u, QKC + (size_t)(r0 + o) * 1024) + (tid_ & 127); *po = ov;
        }
    }
}
__device__ __forceinline__ void p3_gates(Frame& F) {
    const int tid_ = tid_opaque(), lane_ = tid_ & 63;
    const bf16* PROJ = WSP(bf16, WS_PROJ); const float* bg = INP(12); float* GA = WSP(float, WS_GA); float* GU = WSP(float, WS_GU); float* GM = WSP(float, WS_GM);
    LAS float* ex = (LAS float*)F.lds;
    for (int bh = (int)blockIdx.x; bh < 32; bh += F.G) {
        const int b = bh >> 2, h = bh & 3; float carryA = 0.f, cmax = -INFINITY; float Al[4], ul[4], Ml[4];
#pragma unroll
        for (int k = 0; k < 4; ++k) {
            const int t = F.wave * 256 + k * 64 + lane_; const bf16* pr = PROJ + (size_t)(b * SEQ + t) * PLD + PC_IF;
            const float ip = bf2f(pr[h]) + bg[h], fp = bf2f(pr[4 + h]) + bg[4 + h];
            const float lf = fminf(fp, 0.f) - log1pf(__expf(-fabsf(fp)));
            float A = lf;
#pragma unroll
            for (int o = 1; o < 64; o <<= 1) { const float n = __shfl_up(A, o); if (lane_ >= o) A += n; }
            A += carryA;
            const float u = ip - A; float M = u;
#pragma unroll
            for (int o = 1; o < 64; o <<= 1) { const float n = __shfl_up(M, o); if (lane_ >= o) M = fmaxf(M, n); }
            M = fmaxf(M, cmax);
            Al[k] = A; ul[k] = u; Ml[k] = M;
            carryA = rdlane(A, 63); cmax = rdlane(M, 63);
        }
        __syncthreads();
        if (lane_ == 0) { ex[2 * F.wave] = carryA; ex[2 * F.wave + 1] = cmax; }
        __syncthreads();
        float CA = 0.f, CM = 0.f;
        for (int w = 0; w < F.wave; ++w) { CM = fmaxf(CM, ex[2 * w + 1] - CA); CA += ex[2 * w]; }
#pragma unroll
        for (int k = 0; k < 4; ++k) { const int t = F.wave * 256 + k * 64 + lane_;
            GA[bh * SEQ + t] = (Al[k] + CA) * 1.4426950408889634f; GU[bh * SEQ + t] = (ul[k] - CA) * 1.4426950408889634f; GM[bh * SEQ + t] = fmaxf(Ml[k] - CA, CM) * 1.4426950408889634f; }
    }
    __syncthreads();
}
__device__ __forceinline__ void p4_kcv(Frame& F) {
    const int tid_ = tid_opaque(), lane_ = tid_ & 63; (void)lane_;
    const bf16* HIDC = WSP(bf16, WS_HIDC); bf16* KCB = WSP(bf16, WS_KCV); const float* w2 = INP(9);
    const int gt = blockIdx.x * 512 + tid_, ngt = F.G * 512;
    for (int idx = gt; idx < 8128 * 64; idx += ngt) {
        const int r = idx >> 6, d = idx & 63, kv = r / 4064, rr = r % 4064, b = rr / 508, n = (rr % 508) >> 2, g = rr & 3;
        const bf16* hrow = HIDC + ((size_t)kv * 4096 + rr) * 256; const float* w = w2 + kv * 256 * 64 + d; float s = 0.f;
#pragma unroll 8
        for (int j = 0; j < 256; ++j) s += bf2f(hrow[j]) * w[j * 64];
        KCB[((size_t)((kv * 8 + b) * 4 + g) * 128 + n) * 64 + d] = (bf16)f2bf(s);
    }
    for (int idx = gt; idx < 64 * 64; idx += ngt) { const int q = idx >> 6, d = idx & 63; KCB[((size_t)q * 128 + 127) * 64 + d] = 0; }
}
__device__ __forceinline__ void kcv_unit(Frame& F, int kv, int pm) {
    const int tid_ = tid_opaque(), lane_ = tid_ & 63, fr = lane_ & 15, fq = lane_ >> 4;
    const bf16* HIDC = WSP(bf16, WS_HIDC) + ((size_t)kv * 4096 + pm * 256) * 256; const bf16* w2t = WSP(bf16, WS_CW2) + (size_t)kv * 64 * 256; bf16* KCB = WSP(bf16, WS_KCV);
    asm volatile("s_waitcnt vmcnt(0)" ::: "memory"); __syncthreads();
#pragma unroll
    for (int rb = 0; rb < 2; ++rb) {
        const int r0 = F.wave * 32 + rb * 16;
        f32x4 acc[4];
#pragma unroll
        for (int db = 0; db < 4; ++db) acc[db] = (f32x4){0.f, 0.f, 0.f, 0.f};
#pragma unroll
        for (int ks = 0; ks < 8; ++ks) { const bf16x8 a = *(const bf16x8*)(HIDC + (size_t)(r0 + fr) * 256 + ks * 32 + fq * 8);
#pragma unroll
            for (int db = 0; db < 4; ++db) { const bf16x8 bb = *(const bf16x8*)(w2t + (size_t)(db * 16 + fr) * 256 + ks * 32 + fq * 8); acc[db] = __builtin_amdgcn_mfma_f32_16x16x32_bf16(a, bb, acc[db], 0, 0, 0); } }
#pragma unroll
        for (int reg = 0; reg < 4; ++reg) { const int rr = pm * 256 + r0 + 4 * fq + reg; if (rr < 4064) { const int b = rr / 508, n = (rr % 508) >> 2, g = rr & 3;
#pragma unroll
            for (int db = 0; db < 4; ++db) KCB[((size_t)((kv * 8 + b) * 4 + g) * 128 + n) * 64 + db * 16 + fr] = (bf16)f2bf(acc[db][reg]); } }
    }
    if (blockIdx.x == 0) for (int idx = tid_; idx < 64 * 64; idx += 512) { const int q = idx >> 6, d = idx & 63; KCB[((size_t)q * 128 + 127) * 64 + d] = 0; }
}
namespace fa {
typedef float f32x16 __attribute__((ext_vector_type(16)));
typedef short s16x4 __attribute__((ext_vector_type(4)));
typedef float f32x2_t __attribute__((ext_vector_type(2))); typedef __bf16 bf16x2_t __attribute__((ext_vector_type(2)));
constexpr int SLOTB = 8192, NSLOTS = 3, NKS = 4;
constexpr int LDS_K = 0, LDS_V = NKS * SLOTB, LDS_WS = LDS_V + NSLOTS * SLOTB, LDS_OST = LDS_WS + 8 * 1024, LDS_AUX = LDS_OST + 8 * 8192;
static_assert(LDS_AUX <= RING_BYTES, "attention lds");
__device__ __forceinline__ int crow(int r, int hi) { return (r & 3) + 8 * (r >> 2) + 4 * hi; }
__device__ __forceinline__ constexpr int crow0(int r) { return (r & 3) + 8 * (r >> 2); }
#define FA_SBAR() __builtin_amdgcn_sched_barrier(0)
__device__ __forceinline__ void glds16(const void* gsrc, unsigned lds_dst) { unsigned keep;
    asm volatile("s_mov_b32 %0, m0\n\ts_mov_b32 m0, %2\n\ts_nop 0\n\tglobal_load_lds_dwordx4 %1, off\n\ts_mov_b32 m0, %0" : "=&s"(keep) : "v"(gsrc), "s"(lds_dst) : "memory"); }
__device__ __forceinline__ unsigned cvtpk_s(float lo, float hi) { f32x2_t v = {lo, hi}; bf16x2_t b = __builtin_convertvector(v, bf16x2_t); return __builtin_bit_cast(unsigned, b); }
#define FA_WAIT_BAR(N) asm volatile("s_waitcnt vmcnt(" #N ") lgkmcnt(0)\n\ts_barrier" ::: "memory")
__device__ __forceinline__ void qkt(f32x16& p0, f32x16& p1, const LAS char* kb, const bf16x8* qr, const f32x16& c0) {
#pragma unroll
    for (int d0 = 0; d0 < 4; ++d0) {
        const bf16x8 b0 = *(const LAS bf16x8*)(kb + d0 * 2048);
        const bf16x8 b1 = *(const LAS bf16x8*)(kb + d0 * 2048 + 512);
        if (d0 == 0) { p0 = __builtin_amdgcn_mfma_f32_32x32x16_bf16(b0, qr[0], c0, 0, 0, 0); p1 = __builtin_amdgcn_mfma_f32_32x32x16_bf16(b1, qr[0], c0, 0, 0, 0); }
        else { p0 = __builtin_amdgcn_mfma_f32_32x32x16_bf16(b0, qr[d0], p0, 0, 0, 0); p1 = __builtin_amdgcn_mfma_f32_32x32x16_bf16(b1, qr[d0], p1, 0, 0, 0); }
        __builtin_amdgcn_sched_barrier(0xF); }
}
__device__ __forceinline__ float rowmax(const f32x16& p0, const f32x16& p1) {
    float a = fmaxf(fmaxf(p0[0], p0[1]), p1[0]), b = fmaxf(fmaxf(p0[2], p0[3]), p1[1]); a = fmaxf(fmaxf(a, p1[2]), p1[3]);
#pragma unroll
    for (int r = 4; r < 16; r += 4) { a = fmaxf(fmaxf(a, p0[r]), p0[r + 1]); b = fmaxf(fmaxf(b, p0[r + 2]), p0[r + 3]); a = fmaxf(fmaxf(a, p1[r]), p1[r + 1]); b = fmaxf(fmaxf(b, p1[r + 2]), p1[r + 3]); }
    const float m = fmaxf(a, b);
    auto rr = __builtin_amdgcn_permlane32_swap(__float_as_uint(m), __float_as_uint(m), false, false);
    return fmaxf(__uint_as_float(rr[0]), __uint_as_float(rr[1]));
}
__device__ __forceinline__ float swap_add(float v) { auto rr = __builtin_amdgcn_permlane32_swap(__float_as_uint(v), __float_as_uint(v), false, false); return __uint_as_float(rr[0]) + __uint_as_float(rr[1]); }
__device__ __forceinline__ void pv(f32x16* o, int vb, bf16x8 pa0, bf16x8 pa1, bf16x8 pa2, bf16x8 pa3) {
#pragma unroll
    for (int d0 = 0; d0 < 2; ++d0) { s16x4 lo[4], hi[4];
#pragma unroll
        for (int ks = 0; ks < 4; ++ks) {
            asm volatile("ds_read_b64_tr_b16 %0,%1 offset:%c2" : "=&v"(lo[ks]) : "v"(vb), "i"(d0 * 4096 + ks * 1024) : "memory");
            asm volatile("ds_read_b64_tr_b16 %0,%1 offset:%c2" : "=&v"(hi[ks]) : "v"(vb), "i"(d0 * 4096 + ks * 1024 + 512) : "memory"); }
        asm volatile("s_waitcnt lgkmcnt(0)" ::: "memory"); FA_SBAR();
#define FA_PK(k) (bf16x8){lo[k][0], lo[k][1], lo[k][2], lo[k][3], hi[k][0], hi[k][1], hi[k][2], hi[k][3]}
        o[d0] = __builtin_amdgcn_mfma_f32_32x32x16_bf16(pa0, FA_PK(0), o[d0], 0, 0, 0);
        o[d0] = __builtin_amdgcn_mfma_f32_32x32x16_bf16(pa1, FA_PK(1), o[d0], 0, 0, 0);
        o[d0] = __builtin_amdgcn_mfma_f32_32x32x16_bf16(pa2, FA_PK(2), o[d0], 0, 0, 0);
        o[d0] = __builtin_amdgcn_mfma_f32_32x32x16_bf16(pa3, FA_PK(3), o[d0], 0, 0, 0);
#undef FA_PK
    }
}
typedef short v4i16_t __attribute__((ext_vector_type(4)));
__device__ __forceinline__ s16x4 vtr(const LAS char* p) { return __builtin_bit_cast(s16x4, __builtin_amdgcn_ds_read_tr16_b64_v4i16((LAS v4i16_t*)p)); }
__device__ __forceinline__ void pv2(f32x16* o, const LAS char* vp, bf16x8 pa0, bf16x8 pa1, bf16x8 pa2, bf16x8 pa3) {
#pragma unroll
    for (int d0 = 0; d0 < 2; ++d0) {
        s16x4 lo[4], hi[4];
#pragma unroll
        for (int ks = 0; ks < 4; ++ks) { lo[ks] = vtr(vp + d0 * 4096 + ks * 1024); hi[ks] = vtr(vp + d0 * 4096 + ks * 1024 + 512); }
#define FA_PK(k) (bf16x8){lo[k][0], lo[k][1], lo[k][2], lo[k][3], hi[k][0], hi[k][1], hi[k][2], hi[k][3]}
        o[d0] = __builtin_amdgcn_mfma_f32_32x32x16_bf16(pa0, FA_PK(0), o[d0], 0, 0, 0);
        o[d0] = __builtin_amdgcn_mfma_f32_32x32x16_bf16(pa1, FA_PK(1), o[d0], 0, 0, 0);
        o[d0] = __builtin_amdgcn_mfma_f32_32x32x16_bf16(pa2, FA_PK(2), o[d0], 0, 0, 0);
        o[d0] = __builtin_amdgcn_mfma_f32_32x32x16_bf16(pa3, FA_PK(3), o[d0], 0, 0, 0);
#undef FA_PK
        __builtin_amdgcn_sched_barrier(0xF);
    }
}
struct Soft { float mhat, l; f32x16 o[2]; f32x16 negm; };
__device__ __forceinline__ void qk_half(f32x16& p, const LAS char* kbh, const bf16x8* qr) {
    const f32x16 zero = f32x16{};
#pragma unroll
    for (int d0 = 0; d0 < 4; ++d0) { const bf16x8 b = *(const LAS bf16x8*)(kbh + d0 * 2048); p = __builtin_amdgcn_mfma_f32_32x32x16_bf16(b, qr[d0], d0 == 0 ? zero : p, 0, 0, 0); }
}
__device__ __forceinline__ float rowmax16(const f32x16& p) {
    float a = fmaxf(fmaxf(p[0], p[1]), p[2]), b = fmaxf(fmaxf(p[3], p[4]), p[5]);
    a = fmaxf(fmaxf(a, p[6]), p[7]); b = fmaxf(fmaxf(b, p[8]), p[9]); a = fmaxf(fmaxf(a, p[10]), p[11]); b = fmaxf(fmaxf(b, p[12]), p[13]); a = fmaxf(fmaxf(a, p[14]), p[15]);
    const float m = fmaxf(a, b);
    auto rr = __builtin_amdgcn_permlane32_swap(__float_as_uint(m), __float_as_uint(m), false, false);
    return fmaxf(__uint_as_float(rr[0]), __uint_as_float(rr[1]));
}
__device__ __forceinline__ void soft_half(Soft& s, f32x16& p, const LAS char* vph, LAS float* wsf, int r32, int hi) {
    const float rm = rowmax16(p) - s.mhat;
    if (__any(rm > 8.f)) {
        const float dl = fmaxf(rm, 0.f); s.mhat += dl;
        const float f = __builtin_amdgcn_exp2f(-dl); s.l *= f; if (hi == 0) wsf[r32] = f;
        LDS_WAIT(); asm volatile("" ::: "memory");
        const LAS float* wh = wsf + 4 * hi;
#pragma unroll
        for (int d = 0; d < 2; ++d)
#pragma unroll
            for (int r = 0; r < 16; ++r) s.o[d][r] *= wh[crow0(r)];
        LDS_WAIT(); asm volatile("" ::: "memory");
    }
    float sa = 0.f; const float mh = s.mhat;
#pragma unroll
    for (int r = 0; r < 16; ++r) { p[r] = __builtin_amdgcn_exp2f(p[r] - mh); sa += p[r]; }
    s.l += sa;
    const v4u pw0 = (v4u){cvtpk_s(p[0], p[1]), cvtpk_s(p[2], p[3]), cvtpk_s(p[4], p[5]), cvtpk_s(p[6], p[7])};
    const v4u pw1 = (v4u){cvtpk_s(p[8], p[9]), cvtpk_s(p[10], p[11]), cvtpk_s(p[12], p[13]), cvtpk_s(p[14], p[15])};
#pragma unroll
    for (int d0 = 0; d0 < 2; ++d0) {
        const s16x4 l0 = vtr(vph + d0 * 4096), h0 = vtr(vph + d0 * 4096 + 512), l1 = vtr(vph + d0 * 4096 + 1024), h1 = vtr(vph + d0 * 4096 + 1536);
        s.o[d0] = __builtin_amdgcn_mfma_f32_32x32x16_bf16(__builtin_bit_cast(bf16x8, pw0), (bf16x8){l0[0], l0[1], l0[2], l0[3], h0[0], h0[1], h0[2], h0[3]}, s.o[d0], 0, 0, 0);
        s.o[d0] = __builtin_amdgcn_mfma_f32_32x32x16_bf16(__builtin_bit_cast(bf16x8, pw1), (bf16x8){l1[0], l1[1], l1[2], l1[3], h1[0], h1[1], h1[2], h1[3]}, s.o[d0], 0, 0, 0);
    }
}
struct P8 { f32x2 v[8]; };
__device__ __forceinline__ void qk_half_c(f32x16& p, const LAS char* kbh, const bf16x8* qr, const f32x16& negm) {
#pragma unroll
    for (int d0 = 0; d0 < 4; ++d0) { const bf16x8 b = *(const LAS bf16x8*)(kbh + d0 * 2048); p = __builtin_amdgcn_mfma_f32_32x32x16_bf16(b, qr[d0], d0 == 0 ? negm : p, 0, 0, 0); }
}
__device__ __forceinline__ void soft_half_c(Soft& s, f32x16& pin, f32x16& nx, const LAS char* vph, LAS float* wsf, int r32, int hi) {
    P8 p = __builtin_bit_cast(P8, pin);
    const float rm = rowmax16(pin);
    if (__any(rm > 8.f)) {
        const float dl = fmaxf(rm, 0.f); s.mhat += dl; const f32x2 d2 = {dl, dl};
        P8 n = __builtin_bit_cast(P8, nx);
#pragma unroll
        for (int i = 0; i < 8; ++i) { p.v[i] = p.v[i] - d2; n.v[i] = n.v[i] - d2; }
        nx = __builtin_bit_cast(f32x16, n);
#pragma unroll
        for (int r = 0; r < 16; ++r) s.negm[r] = -s.mhat;
        const float f = __builtin_amdgcn_exp2f(-dl); s.l *= f; if (hi == 0) wsf[r32] = f;
        LDS_WAIT(); asm volatile("" ::: "memory");
        const LAS float* wh = wsf + 4 * hi;
#pragma unroll
        for (int d = 0; d < 2; ++d)
#pragma unroll
            for (int r = 0; r < 16; ++r) s.o[d][r] *= wh[crow0(r)];
        LDS_WAIT(); asm volatile("" ::: "memory");
    }
#pragma unroll
    for (int i = 0; i < 8; ++i) { p.v[i].x = __builtin_amdgcn_exp2f(p.v[i].x); p.v[i].y = __builtin_amdgcn_exp2f(p.v[i].y); }
    f32x2 acc = (p.v[0] + p.v[1]) + (p.v[2] + p.v[3]); acc += (p.v[4] + p.v[5]) + (p.v[6] + p.v[7]);
    s.l += acc.x + acc.y;
    const v4u pw0 = (v4u){cvtpk_s(p.v[0].x, p.v[0].y), cvtpk_s(p.v[1].x, p.v[1].y), cvtpk_s(p.v[2].x, p.v[2].y), cvtpk_s(p.v[3].x, p.v[3].y)};
    const v4u pw1 = (v4u){cvtpk_s(p.v[4].x, p.v[4].y), cvtpk_s(p.v[5].x, p.v[5].y), cvtpk_s(p.v[6].x, p.v[6].y), cvtpk_s(p.v[7].x, p.v[7].y)};
#pragma unroll
    for (int d0 = 0; d0 < 2; ++d0) {
        const s16x4 l0 = vtr(vph + d0 * 4096), h0 = vtr(vph + d0 * 4096 + 512), l1 = vtr(vph + d0 * 4096 + 1024), h1 = vtr(vph + d0 * 4096 + 1536);
        s.o[d0] = __builtin_amdgcn_mfma_f32_32x32x16_bf16(__builtin_bit_cast(bf16x8, pw0), (bf16x8){l0[0], l0[1], l0[2], l0[3], h0[0], h0[1], h0[2], h0[3]}, s.o[d0], 0, 0, 0);
        s.o[d0] = __builtin_amdgcn_mfma_f32_32x32x16_bf16(__builtin_bit_cast(bf16x8, pw1), (bf16x8){l1[0], l1[1], l1[2], l1[3], h1[0], h1[1], h1[2], h1[3]}, s.o[d0], 0, 0, 0);
    }
}
__device__ __forceinline__ void mask_causal_h(f32x16& p, int tq, int hi, int half) {
#pragma unroll
    for (int r = 0; r < 16; ++r) { if (32 * half + crow(r, hi) > tq) p[r] = -INFINITY; }
}
__device__ __forceinline__ void mask_anti_h(f32x16& p, int tq, int hi, int half) {
#pragma unroll
    for (int r = 0; r < 16; ++r) { if (32 * half + crow(r, hi) <= tq) p[r] = -INFINITY; }
}
__device__ __forceinline__ void mask_all_h(f32x16& p, bool kill) {
#pragma unroll
    for (int r = 0; r < 16; ++r) p[r] = kill ? -INFINITY : p[r];
}
__device__ __forceinline__ void soft_reset(Soft& s) { s.mhat = 0.f; s.l = 0.f; s.o[0] = f32x16{}; s.o[1] = f32x16{}; s.negm = f32x16{}; asm volatile("" : "+v"(s.negm)); }
__device__ __forceinline__ void soft_step(Soft& s, f32x16& p0, f32x16& p1, int vb, LAS float* wsf, int r32, int hi) {
    const float rm = rowmax(p0, p1);
    if (__any(rm > 8.f)) {
        const float dl = fmaxf(rm, 0.f); s.mhat += dl;
#pragma unroll
        for (int r = 0; r < 16; ++r) { p0[r] -= dl; p1[r] -= dl; }
#pragma unroll
        for (int r = 0; r < 16; ++r) s.negm[r] = -s.mhat;
        asm volatile("" : "+v"(s.negm));
        const float f = exp2f(-dl); s.l *= f; if (hi == 0) wsf[r32] = f;
        LDS_WAIT(); asm volatile("" ::: "memory");
#pragma unroll
        for (int d = 0; d < 2; ++d)
#pragma unroll
            for (int r = 0; r < 16; ++r) s.o[d][r] *= wsf[crow(r, hi)];
        LDS_WAIT(); asm volatile("" ::: "memory");
    }
    float sacc = 0.f;
#pragma unroll
    for (int r = 0; r < 16; ++r) { p0[r] = exp2f(p0[r]); p1[r] = exp2f(p1[r]); sacc += p0[r] + p1[r]; }
    s.l += sacc;
    v4u pw0, pw1, pw2, pw3;
    pw0 = (v4u){cvtpk_s(p0[0], p0[1]), cvtpk_s(p0[2], p0[3]), cvtpk_s(p0[4], p0[5]), cvtpk_s(p0[6], p0[7])};
    pw1 = (v4u){cvtpk_s(p0[8], p0[9]), cvtpk_s(p0[10], p0[11]), cvtpk_s(p0[12], p0[13]), cvtpk_s(p0[14], p0[15])};
    pw2 = (v4u){cvtpk_s(p1[0], p1[1]), cvtpk_s(p1[2], p1[3]), cvtpk_s(p1[4], p1[5]), cvtpk_s(p1[6], p1[7])};
    pw3 = (v4u){cvtpk_s(p1[8], p1[9]), cvtpk_s(p1[10], p1[11]), cvtpk_s(p1[12], p1[13]), cvtpk_s(p1[14], p1[15])};
    pv(s.o, vb, __builtin_bit_cast(bf16x8, pw0), __builtin_bit_cast(bf16x8, pw1), __builtin_bit_cast(bf16x8, pw2), __builtin_bit_cast(bf16x8, pw3));
}
__device__ __forceinline__ void soft_step2(Soft& s, f32x16& p0, f32x16& p1, const LAS char* vp, LAS float* wsf, int r32, int hi) {
    const float rm = rowmax(p0, p1) - s.mhat;
    if (__any(rm > 8.f)) {
        const float dl = fmaxf(rm, 0.f); s.mhat += dl;
        const float f = __builtin_amdgcn_exp2f(-dl); s.l *= f; if (hi == 0) wsf[r32] = f;
        LDS_WAIT(); asm volatile("" ::: "memory");
        const LAS float* wh = wsf + 4 * hi;
#pragma unroll
        for (int d = 0; d < 2; ++d)
#pragma unroll
            for (int r = 0; r < 16; ++r) s.o[d][r] *= wh[crow0(r)];
        LDS_WAIT(); asm volatile("" ::: "memory");
    }
    float sa = 0.f, sb = 0.f; const float mh = s.mhat;
#pragma unroll
    for (int r = 0; r < 16; ++r) { p0[r] = __builtin_amdgcn_exp2f(p0[r] - mh); p1[r] = __builtin_amdgcn_exp2f(p1[r] - mh); sa += p0[r]; sb += p1[r]; }
    s.l += sa + sb;
    v4u pw0, pw1, pw2, pw3;
    pw0 = (v4u){cvtpk_s(p0[0], p0[1]), cvtpk_s(p0[2], p0[3]), cvtpk_s(p0[4], p0[5]), cvtpk_s(p0[6], p0[7])};
    pw1 = (v4u){cvtpk_s(p0[8], p0[9]), cvtpk_s(p0[10], p0[11]), cvtpk_s(p0[12], p0[13]), cvtpk_s(p0[14], p0[15])};
    pw2 = (v4u){cvtpk_s(p1[0], p1[1]), cvtpk_s(p1[2], p1[3]), cvtpk_s(p1[4], p1[5]), cvtpk_s(p1[6], p1[7])};
    pw3 = (v4u){cvtpk_s(p1[8], p1[9]), cvtpk_s(p1[10], p1[11]), cvtpk_s(p1[12], p1[13]), cvtpk_s(p1[14], p1[15])};
    pv2(s.o, vp, __builtin_bit_cast(bf16x8, pw0), __builtin_bit_cast(bf16x8, pw1), __builtin_bit_cast(bf16x8, pw2), __builtin_bit_cast(bf16x8, pw3));
}
__device__ __forceinline__ void soft_finish(Soft& s, f32x16* tot, float gate, LAS float* wsf, int r32, int hi) {
    const float lt = swap_add(s.l); const float fac = (lt > 0.f) ? gate / lt : 0.f;
    if (hi == 0) wsf[32 + r32] = fac;
    LDS_WAIT(); asm volatile("" ::: "memory");
#pragma unroll
    for (int r = 0; r < 16; ++r) { const float f = wsf[32 + crow(r, hi)]; tot[0][r] += s.o[0][r] * f; tot[1][r] += s.o[1][r] * f; }
    LDS_WAIT(); asm volatile("" ::: "memory");
    soft_reset(s);
}
__device__ __forceinline__ void soft_finish_stage(Soft& s, LAS float* stg, bool first, float gate, LAS float* wsf, int r32, int hi) {
    const float lt = swap_add(s.l); const float fac = (lt > 0.f) ? gate / lt : 0.f;
    if (hi == 0) wsf[32 + r32] = fac;
    LDS_WAIT(); asm volatile("" ::: "memory");
#pragma unroll
    for (int r = 0; r < 16; ++r) { const float f = (wsf + 32 + 4 * hi)[crow0(r)]; LAS float* sp = (stg + 4 * hi * 64 + r32) + crow0(r) * 64;
        if (first) { sp[0] = s.o[0][r] * f; sp[32] = s.o[1][r] * f; } else { sp[0] += s.o[0][r] * f; sp[32] += s.o[1][r] * f; } }
    LDS_WAIT(); asm volatile("" ::: "memory");
    soft_reset(s);
}
__device__ __forceinline__ void mask_causal(f32x16& p0, f32x16& p1, int tq, int hi) {
#pragma unroll
    for (int r = 0; r < 16; ++r) { const int kv = crow(r, hi); if (kv > tq) p0[r] = -INFINITY; if (kv + 32 > tq) p1[r] = -INFINITY; }
}
__device__ __forceinline__ void mask_anti(f32x16& p0, f32x16& p1, int tq, int hi) {
#pragma unroll
    for (int r = 0; r < 16; ++r) { const int kv = crow(r, hi); if (kv <= tq) p0[r] = -INFINITY; if (kv + 32 <= tq) p1[r] = -INFINITY; }
}
__device__ __forceinline__ void mask_all(f32x16& p0, f32x16& p1, bool kill) {
#pragma unroll
    for (int r = 0; r < 16; ++r) { p0[r] = kill ? -INFINITY : p0[r]; p1[r] = kill ? -INFINITY : p1[r]; }
}

__device__ __forceinline__ void sel_win_unit(LAS unsigned char* shm, int b, int g, int tb, const bf16* PROJ, const unsigned* SELM, const float* OACC, bf16* ONSA) {
    const int tid = tid_opaque(), lane = tid & 63, r32 = lane & 31, hi = lane >> 5; const int wid = __builtin_amdgcn_readfirstlane(tid >> 6);
    const int hh = wid & 3, th = wid >> 2, head = g * 4 + hh, tq = th * 32 + r32, t = tb * 64 + tq; const size_t row = (size_t)b * SEQ + t;
    const unsigned lds0 = (unsigned)(uintptr_t)shm;
    LAS float* wsf = (LAS float*)(shm + LDS_WS) + wid * 256;
    const bf16* bbase = PROJ + (size_t)b * SEQ * PLD + g * 64;
    const int nsel = tb + 1, jlo = (tb > 8) ? tb - 8 : 0, ntot = nsel + (tb - jlo + 1);
#define FA_KOFF(l_) ((unsigned)((l_) * PLD + wid * 8) * 2u)
#define FA_VOFF(l_) ((unsigned)((16 * (wid & 3) + ((l_) >> 2)) * PLD + (wid >> 2) * 32 + ((l_) & 3) * 8) * 2u)
    const unsigned koff_ = FA_KOFF(lane), voff_ = FA_VOFF(lane);
    const unsigned kdst = lds0 + LDS_K + wid * 1024, vdst = lds0 + LDS_V + wid * 1024;
#define FA_TILE(i) const int i_ = (i); const bool w_ = i_ >= nsel; const int j_ = w_ ? jlo + i_ - nsel : i_; const bf16* tb_ = bbase + (size_t)(j_ * 64) * PLD + (w_ ? PC_KW : PC_KS); const bf16* tv_ = bbase + (size_t)(j_ * 64) * PLD + (w_ ? PC_VW : PC_VS)
#define FA_ISSUE_K(i) do { if ((i) < ntot) { FA_TILE(i); glds16((const char*)tb_ + koff_, (unsigned)__builtin_amdgcn_readfirstlane(kdst + (unsigned)((i_ % NKS) * SLOTB))); } } while (0)
#define FA_ISSUE_V(i) do { if ((i) < ntot) { FA_TILE(i); glds16((const char*)tv_ + voff_, (unsigned)__builtin_amdgcn_readfirstlane(vdst + (unsigned)((i_ % NSLOTS) * SLOTB))); } } while (0)
    const bf16* prow = PROJ + row * PLD;
    bf16x8 qr[4];
#pragma unroll
    for (int d0 = 0; d0 < 4; ++d0) qr[d0] = *(const bf16x8*)(prow + PC_Q + head * 64 + d0 * 16 + hi * 8);
    if (hi == 0) { wsf[64 + r32] = sigm(bf2f(prow[PC_G3 + head * 3 + 1])); wsf[96 + r32] = sigm(bf2f(prow[PC_G3 + head * 3 + 2])); ((LAS unsigned*)wsf)[128 + r32] = __hip_atomic_load(SELM + (size_t)(b * 4 + g) * SEQ + t, RLX_AGENT); }
    FA_ISSUE_K(0); FA_ISSUE_V(0); FA_ISSUE_K(1); FA_ISSUE_K(2); FA_ISSUE_V(1);
    Soft st; soft_reset(st);
    LAS float* stg = (LAS float*)(shm + LDS_OST) + wid * 2048;
    const LAS char* kp0 = (const LAS char*)shm + LDS_K + hi * 1024 + r32 * 16;
    const LAS char* vp0 = (const LAS char*)shm + LDS_V + ((lane >> 4) & 1) * 32 + (lane & 3) * 8 + (4 * hi + ((lane & 15) >> 2)) * 64;
    if (ntot >= 3) { FA_WAIT_BAR(4); } else { FA_WAIT_BAR(3); }
    f32x16 sa_, sb_;
    qk_half_c(sa_, kp0, qr, st.negm); sb_ = sa_;
    for (int i = 0; i < ntot; ++i) {
        if (i + 2 < ntot) { FA_WAIT_BAR(2); } else if (i + 1 < ntot) { FA_WAIT_BAR(1); } else { FA_WAIT_BAR(0); }
        FA_ISSUE_K(i + 3); FA_ISSUE_V(i + 2);
        const bool issel = i < nsel; const int j = issel ? i : jlo + i - nsel;
        const int mcase = (j == tb) ? 1 : ((!issel && j == tb - 8) ? 2 : 0);
        bool kill = false; if (issel) { const unsigned mask = ((const LAS unsigned*)wsf)[128 + r32]; kill = !((mask >> i) & 1u); }
        const bool anyk = __any(kill);
        const LAS char* vpi = vp0 + (i % NSLOTS) * SLOTB;
        qk_half_c(sb_, kp0 + (i % NKS) * SLOTB + 512, qr, st.negm);
        if (anyk) mask_all_h(sa_, kill);
        if (mcase == 1) mask_causal_h(sa_, tq, hi, 0); else if (mcase == 2) mask_anti_h(sa_, tq, hi, 0);
        soft_half_c(st, sa_, sb_, vpi, wsf, r32, hi);
        if (i + 1 < ntot) qk_half_c(sa_, kp0 + ((i + 1) % NKS) * SLOTB, qr, st.negm);
        if (anyk) mask_all_h(sb_, kill);
        if (mcase == 1) mask_causal_h(sb_, tq, hi, 1); else if (mcase == 2) mask_anti_h(sb_, tq, hi, 1);
        soft_half_c(st, sb_, sa_, vpi + 2048, wsf, r32, hi);
        if (i == nsel - 1) { const float mo = st.mhat; soft_finish_stage(st, stg, true, wsf[64 + r32], wsf, r32, hi);
#pragma unroll
            for (int r = 0; r < 16; ++r) sa_[r] += mo; }
    }
    soft_finish_stage(st, stg, false, wsf[96 + r32], wsf, r32, hi);
    const size_t rowbase = (size_t)b * SEQ + tb * 64 + th * 32;
    { float t0[16], t1[16];
#pragma unroll
        for (int r = 0; r < 16; ++r) { const float* oa = OACC + (rowbase + crow(r, hi)) * 1024 + head * 64 + r32; const LAS float* sp = (stg + 4 * hi * 64 + r32) + crow0(r) * 64; t0[r] = sp[0] + oa[0]; t1[r] = sp[32] + oa[32]; }
        LDS_WAIT(); asm volatile("" ::: "memory");
        LAS bf16* sb = (LAS bf16*)stg;
#pragma unroll
        for (int r = 0; r < 16; ++r) { LAS bf16* bp = (sb + 4 * hi * 64 + r32) + crow0(r) * 64; bp[0] = (bf16)f2bf(t0[r]); bp[32] = (bf16)f2bf(t1[r]); }
        LDS_WAIT(); asm volatile("" ::: "memory");
#pragma unroll
        for (int i = 0; i < 4; ++i) { const int rr = i * 8 + (lane >> 3), ch = lane & 7; const v4u v = *(const LAS v4u*)(sb + rr * 64 + ch * 8); *(v4u*)(ONSA + (rowbase + rr) * 2048 + head * 64 + ch * 8) = v; } }
    asm volatile("s_waitcnt lgkmcnt(0)\n\ts_barrier" ::: "memory");
#undef FA_TILE
#undef FA_ISSUE_K
#undef FA_ISSUE_V
#undef FA_KOFF
#undef FA_VOFF
}
}
namespace cs {
using fa::f32x16; using fa::crow; using fa::glds16; using fa::cvtpk_s; using fa::pv; using fa::swap_add; using fa::qkt; using fa::rowmax;
constexpr int C_K = 0, C_V = 16384, C_WS = 32768, C_OWN = 34816, TBW = 32 * 33, C_CAR = C_OWN + 8 * TBW * 4, C_IMP = C_CAR + 8 * TBW * 4, C_END = C_IMP + 64 * 33 * 4;
static_assert(C_END <= RING_BYTES, "cmp lds");
__device__ __forceinline__ void mask_nv(f32x16& p0, f32x16& p1, int base, int nvalid, int hi) {
#pragma unroll
    for (int r = 0; r < 16; ++r) { const int n = base + crow(r, hi); if (n >= nvalid) p0[r] = -INFINITY; if (n + 32 >= nvalid) p1[r] = -INFINITY; }
}
__device__ __forceinline__ void imp_tile(const f32x16& p0, const f32x16& p1, LAS float* own, LAS float* car, int jt, int hi) {
#pragma unroll
    for (int a = 0; a < 4; ++a) {
        const int j0 = jt + 2 * a + hi, j1 = jt + 8 + 2 * a + hi;
        own[j0] = (p0[4 * a] + p0[4 * a + 1]) + (p0[4 * a + 2] + 0.5f * p0[4 * a + 3]); car[j0 + 1] = 0.5f * p0[4 * a + 3];
        own[j1] = (p1[4 * a] + p1[4 * a + 1]) + (p1[4 * a + 2] + 0.5f * p1[4 * a + 3]); if (j1 + 1 < 32) car[j1 + 1] = 0.5f * p1[4 * a + 3];
    }
}
__device__ __forceinline__ bf16x8 pk8(const f32x16& p, int o) { v4u w = (v4u){cvtpk_s(p[o], p[o + 1]), cvtpk_s(p[o + 2], p[o + 3]), cvtpk_s(p[o + 4], p[o + 5]), cvtpk_s(p[o + 6], p[o + 7])}; return __builtin_bit_cast(bf16x8, w); }
__device__ __forceinline__ void cmp_unit(LAS unsigned char* shm, int b, int g, int tb, const bf16* PROJ, const bf16* KCB, float* OACC, unsigned* SELM) {
    const int tid = tid_opaque(), lane = tid & 63, r32 = lane & 31, hi = lane >> 5; const int wid = __builtin_amdgcn_readfirstlane(tid >> 6);
    const int hh = wid & 3, th = wid >> 2, head = g * 4 + hh, tq = th * 32 + r32, t = tb * 64 + tq; const size_t row = (size_t)b * SEQ + t;
    const unsigned lds0 = (unsigned)(uintptr_t)shm;
    LAS float* wsf = (LAS float*)(shm + C_WS) + wid * 64;
    const int ntile = (tb >= 16) ? 2 : 1;
    const bf16* kc = KCB + (size_t)((0 * 8 + b) * 4 + g) * 8192; const bf16* vc = KCB + (size_t)((1 * 8 + b) * 4 + g) * 8192;
    for (int tau = 0; tau < ntile; ++tau) {
        glds16(kc + (size_t)(64 * tau + lane) * 64 + wid * 8, (unsigned)__builtin_amdgcn_readfirstlane(lds0 + C_K + tau * 8192 + wid * 1024));
        glds16(vc + (size_t)(64 * tau + 16 * (wid & 3) + (lane >> 2)) * 64 + (wid >> 2) * 32 + (lane & 3) * 8, (unsigned)__builtin_amdgcn_readfirstlane(lds0 + C_V + tau * 8192 + wid * 1024));
    }
    const bf16* prow = PROJ + row * PLD;
    bf16x8 qr[4];
#pragma unroll
    for (int d0 = 0; d0 < 4; ++d0) qr[d0] = *(const bf16x8*)(prow + PC_Q + head * 64 + d0 * 16 + hi * 8);
    const float g0 = sigm(bf2f(prow[PC_G3 + head * 3 + 0]));
    const int nvalid = (t >= 31) ? (((t - 31) >> 4) + 1) : 0;
    asm volatile("s_waitcnt vmcnt(0) lgkmcnt(0)\n\ts_barrier" ::: "memory");
    const LAS char* kp0 = (const LAS char*)shm + C_K + hi * 1024 + r32 * 16;
    const int vb0 = (int)(lds0 + C_V) + ((lane >> 4) & 1) * 32 + (lane & 3) * 8 + (4 * hi + ((lane & 15) >> 2)) * 64;
    const f32x16 zero = f32x16{};
    f32x16 p0, p1, p2, p3;
    qkt(p0, p1, kp0, qr, zero); mask_nv(p0, p1, 0, nvalid, hi);
    float m = rowmax(p0, p1);
    if (ntile == 2) { qkt(p2, p3, kp0 + 8192, qr, zero); mask_nv(p2, p3, 64, nvalid, hi); m = fmaxf(m, rowmax(p2, p3)); }
    m = fmaxf(m, -1e30f);
    float l = 0.f;
#pragma unroll
    for (int r = 0; r < 16; ++r) { p0[r] = exp2f(p0[r] - m); p1[r] = exp2f(p1[r] - m); l += p0[r] + p1[r]; }
    if (ntile == 2) {
#pragma unroll
        for (int r = 0; r < 16; ++r) { p2[r] = exp2f(p2[r] - m); p3[r] = exp2f(p3[r] - m); l += p2[r] + p3[r]; } }
    const float lt = swap_add(l); const float inv = (lt > 0.f) ? 1.f / lt : 0.f;
#pragma unroll
    for (int r = 0; r < 16; ++r) { p0[r] *= inv; p1[r] *= inv; }
    f32x16 o[2]; o[0] = f32x16{}; o[1] = f32x16{};
    pv(o, vb0, pk8(p0, 0), pk8(p0, 8), pk8(p1, 0), pk8(p1, 8));
    LAS float* own = (LAS float*)(shm + C_OWN) + wid * TBW + r32 * 33; LAS float* car = (LAS float*)(shm + C_CAR) + wid * TBW + r32 * 33;
    imp_tile(p0, p1, own, car, 0, hi);
    if (ntile == 2) {
#pragma unroll
        for (int r = 0; r < 16; ++r) { p2[r] *= inv; p3[r] *= inv; }
        pv(o, vb0 + 8192, pk8(p2, 0), pk8(p2, 8), pk8(p3, 0), pk8(p3, 8));
        imp_tile(p2, p3, own, car, 16, hi);
    }
    if (hi == 0) wsf[r32] = g0;
    LDS_WAIT(); asm volatile("" ::: "memory");
    const size_t rowbase = (size_t)b * SEQ + tb * 64 + th * 32;
#pragma unroll
    for (int r = 0; r < 16; ++r) { const float gq = wsf[crow(r, hi)]; float* oa = OACC + (rowbase + crow(r, hi)) * 1024 + head * 64 + r32; oa[0] = o[0][r] * gq; oa[32] = o[1][r] * gq; }
    asm volatile("s_waitcnt lgkmcnt(0)\n\ts_barrier" ::: "memory");
    LAS float* IMPS = (LAS float*)(shm + C_IMP);
#pragma unroll
    for (int pass = 0; pass < 4; ++pass) { const int tok = pass * 16 + (tid >> 5), j = tid & 31, q = tok & 31, w0 = (tok >> 5) * 4; float v = 0.f;
        if (j < 16 * ntile) {
#pragma unroll
            for (int k = 0; k < 4; ++k) { v += ((LAS float*)(shm + C_OWN))[(w0 + k) * TBW + q * 33 + j]; if (j > 0) v += ((LAS float*)(shm + C_CAR))[(w0 + k) * TBW + q * 33 + j]; } }
        IMPS[tok * 33 + j] = v; }
    asm volatile("s_waitcnt lgkmcnt(0)\n\ts_barrier" ::: "memory");
#pragma unroll
    for (int pass = 0; pass < 4; ++pass) { const int tok = pass * 16 + (tid >> 5), j = tid & 31, cur = tb;
        const bool forced = (j == 0) || (j == cur) || (j == cur - 1);
        const float score = (j <= cur) ? IMPS[tok * 33 + j] + (forced ? 1000.f : 0.f) : -1e9f;
        int rank = 0;
        for (int i = 0; i < 32; ++i) { const bool fi = (i == 0) || (i == cur) || (i == cur - 1); const float si = (i <= cur) ? IMPS[tok * 33 + i] + (fi ? 1000.f : 0.f) : -1e9f; rank += ((si > score) || (si == score && i < j)) ? 1 : 0; }
        const bool sel = (rank < 16) && (score > -5e8f);
        const unsigned long long bal = __ballot(sel);
        if ((lane & 31) == 0) SELM[(size_t)(b * 4 + g) * SEQ + tb * 64 + tok] = (unsigned)(bal >> (lane & 32)); }
    asm volatile("s_waitcnt vmcnt(0) lgkmcnt(0)\n\ts_barrier" ::: "memory");
}
}
__device__ __forceinline__ void p5_cmp_select(Frame& F) {
    const int tid_ = tid_opaque(), lane_ = tid_ & 63; (void)lane_;
    const bf16* PROJ = WSP(bf16, WS_PROJ); const bf16* KCB = WSP(bf16, WS_KCV); float* OACC = WSP(float, WS_OACC); unsigned* SELM = WSP(unsigned, WS_SELM);
    for (int u = blockIdx.x; u < 1024; u += F.G) { const int bg = u >> 5, tb = u & 31; cs::cmp_unit(F.lds, bg >> 2, bg & 3, tb, PROJ, KCB, OACC, SELM); }
}
namespace ml {
using fa::f32x16; using fa::crow; using fa::glds16; using fa::cvtpk_s; using fa::swap_add; using fa::vtr;
constexpr int NR = 4, KSL = 8192, VSL = 16384;
constexpr int L_K = 0, L_V = NR * KSL, L_W = L_V + NR * VSL, L_WS = L_W + 8192, L_UT = L_WS + 8 * 256, L_END = L_UT + 8192;
static_assert(L_END <= RING_BYTES, "mlstm lds");
__device__ __forceinline__ void mlstm_unit(LAS unsigned char* shm, int b, int h, int tb, const bf16* PROJ, const bf16* QKC, const float* GA2, const float* GU2, const float* GM2, const float* mhg, bf16* OML) {
    const int tid = tid_opaque(), lane = tid & 63, r32 = lane & 31, hi = lane >> 5; const int wid = __builtin_amdgcn_readfirstlane(tid >> 6);
    const int vq = wid & 3, th = wid >> 2, tq = th * 32 + r32, t = tb * 64 + tq, bh = b * 4 + h; const size_t row = (size_t)b * SEQ + t;
    const unsigned lds0 = (unsigned)(uintptr_t)shm;
    LAS float* wsf = (LAS float*)(shm + L_WS) + wid * 64;
    LAS float* ut = (LAS float*)(shm + L_UT);
    const int n = 2 * (tb + 1);
    for (int i = tid; i < n * 32; i += 512) ut[i] = GU2[bh * SEQ + i];
    const bf16* kbase = QKC + (size_t)b * SEQ * 1024 + 512 + h * 128 + (size_t)(lane & 31) * 1024 + (2 * wid + (lane >> 5)) * 8;
    const bf16* vb0 = PROJ + (size_t)b * SEQ * PLD + PC_VM + h * 256 + (size_t)(lane >> 2) * PLD + (lane & 3) * 8;
    const int pa = 2 * wid, pb = 2 * wid + 1;
    const bf16* vbaseA = vb0 + (size_t)(16 * (pa & 1)) * PLD + (pa >> 2) * 64 + ((pa >> 1) & 1) * 32;
    const bf16* vbaseB = vb0 + (size_t)(16 * (pb & 1)) * PLD + (pb >> 2) * 64 + ((pb >> 1) & 1) * 32;
    const unsigned kdst = lds0 + L_K + wid * 1024, vdst = lds0 + L_V + wid * 2048;
#define ML_ISSUE_K(i) do { const int i_ = (i); if (i_ < n) glds16(kbase + (size_t)(i_ * 32) * 1024, (unsigned)__builtin_amdgcn_readfirstlane(kdst + (unsigned)((i_ & 3) * KSL))); } while (0)
#define ML_ISSUE_V(i) do { const int i_ = (i); if (i_ >= 0 && i_ < n) { const unsigned d_ = (unsigned)__builtin_amdgcn_readfirstlane(vdst + (unsigned)((i_ & 3) * VSL)); \
        glds16(vbaseA + (size_t)(i_ * 32) * PLD, d_); glds16(vbaseB + (size_t)(i_ * 32) * PLD, d_ + 1024u); } } while (0)
    bf16x8 qr[8];
#pragma unroll
    for (int d0 = 0; d0 < 8; ++d0) qr[d0] = *(const bf16x8*)(QKC + row * 1024 + h * 128 + d0 * 16 + hi * 8);
    const float M2 = GM2[bh * SEQ + t], A2 = GA2[bh * SEQ + t];
    ML_ISSUE_K(0); ML_ISSUE_K(1); ML_ISSUE_V(0); ML_ISSUE_K(2); ML_ISSUE_V(1);
    f32x16 o[2]; o[0] = f32x16{}; o[1] = f32x16{}; float den = 0.f;
    const f32x16 zero = f32x16{};
    const int vbl = ((lane >> 4) & 1) * 32 + (lane & 3) * 8 + (4 * hi + ((lane & 15) >> 2)) * 64;
    LAS unsigned char* wbase = shm + L_W + th * 2048 + lane * 16;
    for (int s = 0; s <= n; ++s) {
        if (s + 2 < n) asm volatile("s_waitcnt vmcnt(6) lgkmcnt(0)\n\ts_barrier" ::: "memory");
        else if (s + 2 == n) asm volatile("s_waitcnt vmcnt(5) lgkmcnt(0)\n\ts_barrier" ::: "memory");
        else if (s + 1 == n) asm volatile("s_waitcnt vmcnt(2) lgkmcnt(0)\n\ts_barrier" ::: "memory");
        else asm volatile("s_waitcnt vmcnt(0) lgkmcnt(0)\n\ts_barrier" ::: "memory");
        ML_ISSUE_K(s + 3); ML_ISSUE_V(s + 2);
        if (s < n && vq == (s & 3)) {
            const LAS char* kb = (const LAS char*)shm + L_K + (s & 3) * KSL + hi * 512 + r32 * 16;
            f32x16 p0;
#pragma unroll
            for (int d0 = 0; d0 < 8; ++d0) { const bf16x8 b0 = *(const LAS bf16x8*)(kb + d0 * 1024); p0 = __builtin_amdgcn_mfma_f32_32x32x16_bf16(b0, qr[d0], d0 == 0 ? zero : p0, 0, 0, 0); }
            const LAS float* up = ut + s * 32 + 4 * hi;
            fa::P8 q0 = __builtin_bit_cast(fa::P8, p0);
            const f32x2 m2 = {M2, M2};
#pragma unroll
            for (int a = 0; a < 4; ++a) { const f32x4 u0 = *(const LAS f32x4*)(up + 8 * a);
                f32x2 e0 = (f32x2){u0.x, u0.y} - m2, e1 = (f32x2){u0.z, u0.w} - m2;
                e0.x = __builtin_amdgcn_exp2f(e0.x); e0.y = __builtin_amdgcn_exp2f(e0.y); e1.x = __builtin_amdgcn_exp2f(e1.x); e1.y = __builtin_amdgcn_exp2f(e1.y);
                q0.v[2 * a] *= e0; q0.v[2 * a + 1] *= e1; }
            if (s >= 2 * tb) {
                const int kb32 = 32 * (s & 1);
#pragma unroll
                for (int r = 0; r < 16; ++r) { if (kb32 + fa::crow(r, hi) > tq) q0.v[r >> 1][r & 1] = 0.f; } }
            { f32x2 d2 = (q0.v[0] + q0.v[1]) + (q0.v[2] + q0.v[3]); d2 += (q0.v[4] + q0.v[5]) + (q0.v[6] + q0.v[7]); den += d2.x + d2.y; }
            LAS unsigned char* wp = wbase + (s & 1) * 4096;
            *(LAS v4u*)(wp) = (v4u){cvtpk_s(q0.v[0].x, q0.v[0].y), cvtpk_s(q0.v[1].x, q0.v[1].y), cvtpk_s(q0.v[2].x, q0.v[2].y), cvtpk_s(q0.v[3].x, q0.v[3].y)};
            *(LAS v4u*)(wp + 1024) = (v4u){cvtpk_s(q0.v[4].x, q0.v[4].y), cvtpk_s(q0.v[5].x, q0.v[5].y), cvtpk_s(q0.v[6].x, q0.v[6].y), cvtpk_s(q0.v[7].x, q0.v[7].y)};
        }
        if (s >= 1) {
            const LAS unsigned char* wp = wbase + ((s - 1) & 1) * 4096;
            const v4u pw0 = *(const LAS v4u*)(wp), pw1 = *(const LAS v4u*)(wp + 1024);
            const LAS char* vp = (const LAS char*)shm + L_V + ((s - 1) & 3) * VSL + vq * 4096 + vbl;
#pragma unroll
            for (int d0 = 0; d0 < 2; ++d0) {
                const fa::s16x4 l0 = vtr(vp + d0 * 2048), h0 = vtr(vp + d0 * 2048 + 512), l1 = vtr(vp + d0 * 2048 + 1024), h1 = vtr(vp + d0 * 2048 + 1536);
                o[d0] = __builtin_amdgcn_mfma_f32_32x32x16_bf16(__builtin_bit_cast(bf16x8, pw0), (bf16x8){l0[0], l0[1], l0[2], l0[3], h0[0], h0[1], h0[2], h0[3]}, o[d0], 0, 0, 0);
                o[d0] = __builtin_amdgcn_mfma_f32_32x32x16_bf16(__builtin_bit_cast(bf16x8, pw1), (bf16x8){l1[0], l1[1], l1[2], l1[3], h1[0], h1[1], h1[2], h1[3]}, o[d0], 0, 0, 0);
            }
        }
    }
    { const float dt = swap_add(den); if (hi == 0) wsf[r32] = dt; }
    asm volatile("s_waitcnt lgkmcnt(0)\n\ts_barrier" ::: "memory");
    { const LAS float* wd = (const LAS float*)(shm + L_WS) + th * 4 * 64; const float dt = (wd[r32] + wd[64 + r32]) + (wd[128 + r32] + wd[192 + r32]);
      const float dd = fmaxf(fabsf(dt), __builtin_amdgcn_exp2f(-(A2 + M2))); if (hi == 0) wsf[32 + r32] = 1.f / dd; }
    LDS_WAIT(); asm volatile("" ::: "memory");
    LAS float* Hst = (LAS float*)shm;
#pragma unroll
    for (int r = 0; r < 16; ++r) { const float f = wsf[32 + crow(r, hi)]; LAS float* hp = Hst + (th * 32 + crow(r, hi)) * 256 + vq * 64 + r32; hp[0] = o[0][r] * f; hp[32] = o[1][r] * f; }
    asm volatile("s_waitcnt lgkmcnt(0)\n\ts_barrier" ::: "memory");
#pragma unroll
    for (int k = 0; k < 8; ++k) { const int tr = wid * 8 + k; const f32x4 hv = *(const LAS f32x4*)(Hst + tr * 256 + 4 * lane);
        const float ssq = wave_sum((hv.x * hv.x + hv.y * hv.y) + (hv.z * hv.z + hv.w * hv.w)); const float rs = rsqrtf(ssq * (1.f / 256.f) + EPS);
        const size_t orow = (size_t)b * SEQ + tb * 64 + tr; const v2u om = *(const v2u*)(PROJ + orow * PLD + PC_OM + h * 256 + 4 * lane); const f32x4 gg = *(const f32x4*)(mhg + h * 256 + 4 * lane);
        v2u ov; ov.x = pk2(sigm(bflo(om.x)) * hv.x * rs * gg.x, sigm(bfhi(om.x)) * hv.y * rs * gg.y); ov.y = pk2(sigm(bflo(om.y)) * hv.z * rs * gg.z, sigm(bfhi(om.y)) * hv.w * rs * gg.w);
        *(v2u*)(OML + orow * 2048 + h * 256 + 4 * lane) = ov; }
    asm volatile("s_waitcnt lgkmcnt(0)\n\ts_barrier" ::: "memory");
#undef ML_ISSUE_K
#undef ML_ISSUE_V
}
}
__device__ __forceinline__ void p5_mlstm(Frame& F, int& chunk) {
    const int tid_ = tid_opaque(), lane_ = tid_ & 63; (void)lane_;
    const bf16* PROJ = WSP(bf16, WS_PROJ); const bf16* QKC = WSP(bf16, WS_QKC); bf16* OML = WSP(bf16, WS_OMIX) + 1024;
    const float* GA = WSP(float, WS_GA); const float* GU = WSP(float, WS_GU); const float* GM = WSP(float, WS_GM); const float* mhg = INP(13);
    unsigned* ctr = WSP(unsigned, WS_CTL) + CW_MLQ; LAS int* tk = (LAS int*)(F.lds + LDSCTL_OFF + 64);
    __syncthreads();
    if (tid_ == 0) tk[0] = (int)__hip_atomic_fetch_add(ctr, 1u, RLX_AGENT);
    __syncthreads();
    int u = tk[0];
    while (u < 1024) {
        int nxt = 0; if (tid_ == 0) nxt = (int)__hip_atomic_fetch_add(ctr, 1u, RLX_AGENT);
        const int bh = u & 31, tb = 31 - (u >> 5);
        ml::mlstm_unit(F.lds, bh >> 2, bh & 3, tb, PROJ, QKC, GA, GU, GM, mhg, OML);
        convert_chunk(F, chunk);
        if (tid_ == 0) tk[0] = nxt;
        __syncthreads();
        u = tk[0];
        __syncthreads();
    }
}
__device__ __forceinline__ void p6_sel_win(Frame& F, int& chunk) {
    const int tid_ = tid_opaque(), lane_ = tid_ & 63; (void)lane_;
    const bf16* PROJ = WSP(bf16, WS_PROJ); float* OACC = WSP(float, WS_OACC); unsigned* SELM = WSP(unsigned, WS_SELM); bf16* ONSA = WSP(bf16, WS_OMIX); const bf16* KCB = WSP(bf16, WS_KCV);
    __syncthreads();
    if (F.G == 256) {
        const int bx = blockIdx.x, xcd = bx % 8, w = bx / 8, s = w & 15;
        for (int i = 0; i < 4; ++i) { const int bg = 4 * xcd + 2 * (i >> 1) + (w >> 4); const int tb = (i & 1) ? 31 - s : s;
            cs::cmp_unit(F.lds, bg >> 2, bg & 3, tb, PROJ, KCB, OACC, SELM); fa::sel_win_unit(F.lds, bg >> 2, bg & 3, tb, PROJ, SELM, OACC, ONSA); convert_chunk(F, chunk); }
    } else {
        for (int u = blockIdx.x; u < 1024; u += F.G) { const int bg = u >> 5, tb = u & 31;
            cs::cmp_unit(F.lds, bg >> 2, bg & 3, tb, PROJ, KCB, OACC, SELM); fa::sel_win_unit(F.lds, bg >> 2, bg & 3, tb, PROJ, SELM, OACC, ONSA); convert_chunk(F, chunk); }
    }
    while (chunk < NCHUNK) convert_chunk(F, chunk);
}
__device__ __forceinline__ void p10_rows(Frame& F) {
    const int tid_ = tid_opaque(), lane_ = tid_ & 63; (void)lane_;
    const float* x = INP(0); const float* gpost = INP(5); const float* gpre = INP(17); const float* mod = WSP(float, WS_MOD); const bf16* Y = WSP(bf16, WS_Y); bf16* H2 = WSP(bf16, WS_H2); unsigned char* H2Q = WSP(unsigned char, WS_H2Q);
    LAS float* A1 = (LAS float*)F.lds; LAS float* A2 = A1 + 2048; LAS float* C2 = A1 + 4096;
    int cur_b = -1;
    for (int blk = blockIdx.x; blk < NTOK / 64; blk += F.G) {
        const int b = blk >> 5;
        if (b != cur_b) { __syncthreads(); const float* mb = mod + b * 12288;
            const f32x4 g = *(const f32x4*)(gpost + 4 * tid_), gt = *(const f32x4*)(mb + 4096 + 4 * tid_), gp = *(const f32x4*)(gpre + 4 * tid_), a = *(const f32x4*)(mb + 8192 + 4 * tid_), c = *(const f32x4*)(mb + 6144 + 4 * tid_);
            *(LAS f32x4*)(A1 + 4 * tid_) = g * gt; *(LAS f32x4*)(A2 + 4 * tid_) = gp * (1.f + a); *(LAS f32x4*)(C2 + 4 * tid_) = c; __syncthreads(); cur_b = b; }
        const int row0 = blk * 64 + F.wave * 8;
        v2u yq[8]; f32x4 xx[8];
        { const GAS v2u* yr = UPTR(const v2u, Y + (size_t)row0 * DM) + lane_; const GAS f32x4* xr = UPTR(const f32x4, x + (size_t)row0 * DM) + lane_;
#pragma unroll
          for (int j = 0; j < 8; ++j) { yq[j] = yr[64 * j]; xx[j] = xr[64 * j]; } }
#pragma unroll
        for (int k = 0; k < 8; ++k) {
            const int row = row0 + k;
            v2u yn[8]; f32x4 xn[8];
            if (k + 1 < 8) { const GAS v2u* yr = UPTR(const v2u, Y + (size_t)(row + 1) * DM) + lane_; const GAS f32x4* xr = UPTR(const f32x4, x + (size_t)(row + 1) * DM) + lane_;
#pragma unroll
                for (int j = 0; j < 8; ++j) { yn[j] = yr[64 * j]; xn[j] = xr[64 * j]; } }
            GAS f32x4* orow = UPTR(f32x4, F.out + (size_t)row * DM) + lane_;
            f32x4 v[8]; float s = 0.f;
#pragma unroll
            for (int j = 0; j < 8; ++j) { const v2u q = yq[j]; v[j] = (f32x4){bflo(q.x), bfhi(q.x), bflo(q.y), bfhi(q.y)}; s += (v[j].x * v[j].x + v[j].y * v[j].y) + (v[j].z * v[j].z + v[j].w * v[j].w); }
            const float rstd = rsqrtf(wave_sum(s) * (1.f / DM) + EPS);
            float s1 = 0.f;
#pragma unroll
            for (int j = 0; j < 8; ++j) { const f32x4 a1 = *(LAS f32x4*)(A1 + 4 * lane_ + 256 * j);
                v[j] = xx[j] + a1 * (v[j] * rstd); orow[64 * j] = v[j]; s1 += (v[j].x * v[j].x + v[j].y * v[j].y) + (v[j].z * v[j].z + v[j].w * v[j].w); }
            const float rstd1 = rsqrtf(wave_sum(s1) * (1.f / DM) + EPS);
            GAS unsigned long long* o8 = UPTR(unsigned long long, H2 + (size_t)row * DM) + lane_; GAS int* o4 = UPTR(int, H2Q + (size_t)row * DM) + lane_;
#pragma unroll
            for (int j = 0; j < 8; ++j) { const int col = 4 * lane_ + 256 * j; const f32x4 a2 = *(LAS f32x4*)(A2 + col), c2 = *(LAS f32x4*)(C2 + col);
                const f32x4 r = v[j] * rstd1 * a2 + c2;
                o8[64 * j] = (unsigned long long)pk2(r.x, r.y) | ((unsigned long long)pk2(r.z, r.w) << 32);
                int q8 = 0; q8 = __builtin_amdgcn_cvt_pk_fp8_f32(fminf(fmaxf(r.x, -448.f), 448.f), fminf(fmaxf(r.y, -448.f), 448.f), q8, false); q8 = __builtin_amdgcn_cvt_pk_fp8_f32(fminf(fmaxf(r.z, -448.f), 448.f), fminf(fmaxf(r.w, -448.f), 448.f), q8, true);
                o4[64 * j] = q8; }
            if (k + 1 < 8) {
#pragma unroll
                for (int j = 0; j < 8; ++j) { yq[j] = yn[j]; xx[j] = xn[j]; } }
        }
    }
    __syncthreads();
}
__device__ __forceinline__ void p12_route(Frame& F, int cbase = CW_CNT) {
    const int tid_ = tid_opaque(), lane_ = tid_ & 63; (void)lane_;
    const float* LG = WSP(float, WS_LOGITS); const float* br = INP(20); unsigned* cnt = WSP(unsigned, WS_CTL) + cbase;
    int* TE = WSP(int, WS_TE); int* TP = WSP(int, WS_TP); float* TW = WSP(float, WS_TW);
    LAS int* cw = (LAS int*)F.lds; LAS int* basee = cw + 512;
    const int lane = lane_; const float brl = br[lane];
    for (int tblk = blockIdx.x; tblk < NTOK / 64; tblk += F.G) {
        __syncthreads();
        int c = 0; unsigned selm = 0u, posb = 0u, kb = 0u; float wv[8];
#pragma unroll
        for (int k = 0; k < 8; ++k) { const int t = tblk * 64 + F.wave * 8 + k;
            const float s = sigm_ieee(LG[(size_t)t * 64 + lane]); const float sb = s + brl;
            const int grp = lane >> 3; float m1 = -INFINITY, m2 = -INFINITY;
#pragma unroll
            for (int i = 0; i < 8; ++i) { const float v = __shfl(sb, grp * 8 + i); if (v > m1) { m2 = m1; m1 = v; } else if (v > m2) { m2 = v; } }
            const float gs = m1 + m2; int grank = 0;
#pragma unroll
            for (int gi = 0; gi < 8; ++gi) { const float o = __shfl(gs, gi * 8); grank += ((o > gs) || (o == gs && gi < grp)) ? 1 : 0; }
            const float ms = (grank < 4) ? sb : -1e9f; int rank = 0;
            for (int i = 0; i < 64; ++i) { const float o = rdlane(ms, i); rank += ((o > ms) || (o == ms && i < lane)) ? 1 : 0; }
            const bool sel = rank < 8;
            const float wsum = wave_sum(sel ? s : 0.f);
            const unsigned long long bal = __ballot(sel);
            wv[k] = s / wsum * 2.5f;
            if (sel) { selm |= 1u << k; posb |= (unsigned)c << (3 * k); kb |= (unsigned)(__popcll(bal & ((1ull << lane) - 1ull)) & 7) << (3 * k); ++c; } }
        cw[F.wave * 64 + lane] = c;
        __syncthreads();
        if (F.wave == 0) { int tot = 0;
#pragma unroll
            for (int w = 0; w < 8; ++w) tot += cw[w * 64 + lane];
            basee[lane] = tot ? (int)atomicAdd(&cnt[lane], (unsigned)tot) : 0; }
        __syncthreads();
        int off = basee[lane];
        for (int w = 0; w < F.wave; ++w) off += cw[w * 64 + lane];
#pragma unroll
        for (int k = 0; k < 8; ++k) if ((selm >> k) & 1u) { const int t = tblk * 64 + F.wave * 8 + k; const int idx = t * 8 + (int)((kb >> (3 * k)) & 7u);
            TE[idx] = lane; TP[idx] = off + (int)((posb >> (3 * k)) & 7u); TW[idx] = wv[k]; }
    }
    __syncthreads();
}
__device__ __forceinline__ void p13_slots(Frame& F) {
    const int tid_ = tid_opaque(), lane_ = tid_ & 63; (void)lane_;
    unsigned* cnt = WSP(unsigned, WS_CTL) + CW_CNT; LAS int* rs = (LAS int*)F.lds;
    const int* TE = WSP(int, WS_TE); const int* TP = WSP(int, WS_TP); const float* TW = WSP(float, WS_TW);
    int* TOKSLOT = WSP(int, WS_TOKSLOT); int* SLOTTOK = WSP(int, WS_SLOTTOK); float* SLOTW = WSP(float, WS_SLOTW); int* RT = WSP(int, WS_RT);
    LAS int* ts = rs + 80;
    if (tid_ < 64) { const int c = (int)__hip_atomic_load(cnt + tid_, RLX_AGENT); const int nt_ = (c + 255) >> 8; int a = c, tt = nt_;
#pragma unroll
        for (int o = 1; o < 64; o <<= 1) { const int n = __shfl_up(a, o), n2 = __shfl_up(tt, o); if (lane_ >= o) { a += n; tt += n2; } }
        rs[tid_ + 1] = a; ts[tid_ + 1] = tt; if (tid_ == 0) { rs[0] = 0; ts[0] = 0; } }
    __syncthreads();
    const int gt = blockIdx.x * 512 + tid_, ngt = F.G * 512;
    for (int idx = gt; idx < NSLOT; idx += ngt) { const int e = TE[idx], slot = rs[e] + TP[idx]; SLOTTOK[slot] = idx >> 3; SLOTW[slot] = TW[idx]; TOKSLOT[idx] = slot; }
    for (int idx = gt; idx < NTOK; idx += ngt) { SLOTTOK[NSLOT + idx] = idx; SLOTW[NSLOT + idx] = 1.f; }
    if (blockIdx.x == 0) {
        if (tid_ < 64) { const int e = tid_, c = rs[e + 1] - rs[e]; int j = ts[e]; for (int r = 0; r * 256 < c; ++r, ++j) { RT[3 * j] = e; RT[3 * j + 1] = rs[e] + 256 * r; RT[3 * j + 2] = (c - 256 * r) < 256 ? (c - 256 * r) : 256; } }
        else if (tid_ < 128) { const int r = tid_ - 64, j = ts[64] + r; RT[3 * j] = 64; RT[3 * j + 1] = NSLOT + 256 * r; RT[3 * j + 2] = 256; }
        if (tid_ == 0) __hip_atomic_store(WSP(unsigned, WS_CTL) + CW_NTILES, (unsigned)(ts[64] + 64), RLX_AGENT);
    }
    __syncthreads();
}
__device__ __forceinline__ void p16_final(Frame& F, bool do_store = true) {
    const int tid_ = tid_opaque(), lane_ = tid_ & 63; (void)lane_;
    const unsigned char* YS = WSP(unsigned char, WS_YSLOT); const int* TOKSLOT = WSP(int, WS_TOKSLOT); const float* gpost = INP(18); const float* mod = WSP(float, WS_MOD);
    LAS float* A = (LAS float*)F.lds;
    int cur_b = -1;
    for (int blk = blockIdx.x; blk < NTOK / 64; blk += F.G) {
        const int b = blk >> 5;
        if (b != cur_b) { __syncthreads();
            const f32x4 g = *(const f32x4*)(gpost + 4 * tid_), gt = *(const f32x4*)(mod + b * 12288 + 10240 + 4 * tid_);
            *(LAS f32x4*)(A + 4 * tid_) = g * gt * (1.f / 64.f); __syncthreads(); cur_b = b; }
        const int row0 = blk * 64 + F.wave * 8;
        const int myslot = TOKSLOT[row0 * 8 + lane_];
        int q[3][24]; f32x4 xx[8];
#define P16_ISSUE(kk, gg) do { _Pragma("unroll") for (int r = 0; r < 3; ++r) { const int k9 = 3 * (gg) + r; \
            const int slot = (k9 < 8) ? __builtin_amdgcn_readlane(myslot, (kk) * 8 + k9) : NSLOT + row0 + (kk); \
            const GAS int* yr = UPTR(const int, YS + (size_t)slot * DM) + lane_; \
            _Pragma("unroll") for (int j = 0; j < 8; ++j) q[gg][8 * r + j] = yr[64 * j]; } } while (0)
        P16_ISSUE(0, 0); P16_ISSUE(0, 1); P16_ISSUE(0, 2);
#pragma unroll 1
        for (int k = 0; k < 8; ++k) {
            const int row = row0 + k;
            { const GAS f32x4* xr = UPTR(const f32x4, F.out + (size_t)row * DM) + lane_;
#pragma unroll
              for (int j = 0; j < 8; ++j) xx[j] = xr[64 * j]; }
            f32x4 acc[8];
#pragma unroll
            for (int j = 0; j < 8; ++j) acc[j] = (f32x4){0.f, 0.f, 0.f, 0.f};
#pragma unroll
            for (int g = 0; g < 3; ++g) {
#pragma unroll
                for (int r = 0; r < 3; ++r)
#pragma unroll
                    for (int j = 0; j < 8; ++j) { const int w = q[g][8 * r + j]; const f32x2 lo = __builtin_amdgcn_cvt_pk_f32_fp8(w, false), hi = __builtin_amdgcn_cvt_pk_f32_fp8(w, true);
                        acc[j].x += lo.x; acc[j].y += lo.y; acc[j].z += hi.x; acc[j].w += hi.y; }
                if (k + 1 < 8) P16_ISSUE(k + 1, g);
            }
            float s = 0.f;
#pragma unroll
            for (int j = 0; j < 8; ++j) s += (acc[j].x * acc[j].x + acc[j].y * acc[j].y) + (acc[j].z * acc[j].z + acc[j].w * acc[j].w);
            const float rstd = rsqrtf(wave_sum(s) * (1.f / (4096.f * DM)) + EPS);
            GAS f32x4* orow = UPTR(f32x4, F.out + (size_t)row * DM) + lane_;
            unsigned aoff = 16u * (unsigned)lane_; asm volatile("" : "+v"(aoff));
#pragma unroll
            for (int j = 0; j < 8; ++j) { const f32x4 a = *(LAS f32x4*)((LAS unsigned char*)A + aoff + 1024 * j);
                if (do_store || F.G == 12345) orow[64 * j] = xx[j] + a * (acc[j] * rstd); }
        }
#undef P16_ISSUE
    }
}

constexpr int NPHASE = 17;
struct Args { const float* in[27]; float* out; unsigned char* ws; int ph_lo, ph_hi, li, pad; };
__global__ void __launch_bounds__(512, 2) mega_fwd(Args args) {
    extern __shared__ __attribute__((aligned(16))) unsigned char lds[];
    Frame F;
    F.lds = (LAS unsigned char*)lds; F.ws = args.ws; F.in = args.in; F.out = args.out;
    F.tid = threadIdx.x; F.lane = F.tid & 63; F.wave = __builtin_amdgcn_readfirstlane(F.tid >> 6); F.G = gridDim.x;
    F.gw = blockIdx.x * 8 + F.wave; F.ngw = F.G * 8;
    volatile LAS unsigned* MISC = (volatile LAS unsigned*)(F.lds + MISC_OFF);
    for (int u = F.tid; u < (LDS_BYTES - LDSCTL_OFF) / 4; u += 512) ((LAS unsigned*)(F.lds + LDSCTL_OFF))[u] = 0u;
    __syncthreads();
    unsigned* ctl = (unsigned*)(args.ws + WS_CTL);
    XcdBarrier bar; bar.bar = ctl + CW_BAR; bar.x = 0; bar.st = nullptr;
    if (!MK_PER_PHASE) bar = xcd_barrier_post(ctl + CW_BAR, MISC + 8);
    const int lo = args.ph_lo, hi = args.ph_hi;
#define IN(k) (lo <= (k) && (k) < hi)
#define SEAM(k) do { if (IN(k) && IN((k) + 1)) xcd_barrier(bar); } while (0)
    bf16* PROJ = WSP(bf16, WS_PROJ);
    int chunk = 0;
    const int vcu_ = (F.G % 8 == 0) ? (int)(blockIdx.x % 8) * (F.G / 8) + (int)(blockIdx.x / 8) : (int)blockIdx.x;

    if (IN(0)) { p0_bias1(F); p0_early(F); } SEAM(0);
    if (IN(1)) REP(1, { p1_h1(F); }); SEAM(1);
    if (IN(2)) REP(2, {
        { pg8::Gemm g{WSP(bf16, WS_H1), WSP(bf16, WS_WIN), DM, 128, 0, 0}; pg8::StaticOrder S; S.init(NTOK, PN_BF, F.G, (int)blockIdx.x, PRB(2));
          pg8::EpiBf16 E{PROJ, PLD, 4, QC2};
          pg8::gemm_phase<pg8::EpiBf16, pg8::StaticOrder, false, true>(F.lds, g, S, E); }
        { pg8::Gemm g{WSP(unsigned char, WS_H1Q), WSP(unsigned char, WS_WIN8), DM, 128, 127 - 6, 127}; pg8::StaticOrder S; S.init(NTOK, PN_F8, F.G, (int)blockIdx.x, PRB(3));
          pg8::EpiBf16 E{PROJ + PN_BF, PLD, 1 << 20, 1.f / 64.f};
          pg8::gemm_phase<pg8::EpiBf16, pg8::StaticOrder, false, true, true>(F.lds, g, S, E); }
    }); SEAM(2);
    if (IN(3)) REP(3, { p3_conv(F); p3_gates(F); }); SEAM(3);
    if (IN(4)) {
        { pg8::Gemm g{PROJ, WSP(bf16, WS_CW1), DM, PLD * 2, 0, 0}; pg8::CmpOrder S{F.G, (int)blockIdx.x}; pg8::EpiCmpHid E{WSP(bf16, WS_HIDC), WSP(float, WS_BIAS1)};
          pg8::gemm_phase<pg8::EpiCmpHid, pg8::CmpOrder, true, true>(F.lds, g, S, E);
          if ((int)blockIdx.x < 32) kcv_unit(F, (int)blockIdx.x >> 4, (int)blockIdx.x & 15); }
        p5_mlstm(F, chunk); } SEAM(4);
    if (IN(6)) { p6_sel_win(F, chunk); } SEAM(6);
    if (IN(7)) REP(7, {
        pg8::Gemm g{WSP(bf16, WS_OMIX), WSP(bf16, WS_WUP), DM, 128, 0, 0}; pg8::StaticOrder S; S.init(NTOK, DM, F.G, (int)blockIdx.x);
        pg8::EpiGate E{WSP(bf16, WS_MERGED), PROJ + PC_GB, PLD, nullptr}; pg8::MidGate MH{PROJ + PC_GA, PROJ + PC_GB, PLD};
        pg8::gemm_phase<pg8::EpiGate, pg8::StaticOrder, false, true, false, false, pg8::MidGate>(F.lds, g, S, E, MH);
    }); SEAM(7);
    if (IN(9)) REP(9, {
        pg8::Gemm g{WSP(bf16, WS_MERGED), WSP(bf16, WS_WOUT), DM, 128, 0, 0}; pg8::StaticOrder S; S.init(NTOK, DM, F.G, (int)blockIdx.x);
        pg8::EpiBf16 E{WSP(bf16, WS_Y), DM, 0, 1.f};
        pg8::gemm_phase<pg8::EpiBf16, pg8::StaticOrder, false, true>(F.lds, g, S, E);
    }); SEAM(9);
    if (IN(10)) REP(10, { p10_rows(F); }); SEAM(10);
    if (IN(11)) REP(11, {
        pg8::Gemm g{WSP(bf16, WS_H2), WSP(bf16, WS_WR), DM, 128, 0, 0}; pg8::StaticOrder S; S.init(NTOK, 256, F.G, (int)blockIdx.x);
        pg8::EpiF32 E{WSP(float, WS_LOGITS), 64, 64};
        pg8::gemm_phase<pg8::EpiF32, pg8::StaticOrder, false, true>(F.lds, g, S, E);
    }); SEAM(11);
    if (IN(12)) { if ((PROBE_DUP >> 12) & 1) p12_route(F, 256); p12_route(F); } SEAM(12);
    if (IN(13)) REP(13, { p13_slots(F); }); SEAM(13);
    if (IN(14)) REP(14, {
        const int ntiles = (int)__hip_atomic_load(ctl + CW_NTILES, RLX_AGENT);
        LAS int* rtc = (LAS int*)(F.lds + RT_LDS_OFF); for (int i = threadIdx.x; i < 3 * ntiles; i += 512) rtc[i] = WSP(int, WS_RT)[i]; __syncthreads();
        pg8::Gemm g{WSP(unsigned char, WS_H2Q), WSP(unsigned char, WS_WEGU), DM, 128, 127 - 6, 127}; pg8::MoeOrder S{rtc, ntiles, 4, F.G, vcu_, WSP(int, WS_SLOTTOK), 2048u, PRB(14)};
        pg8::EpiSwiglu E{WSP(unsigned char, WS_HID), WSP(float, WS_SLOTW)};
        pg8::gemm_phase<pg8::EpiSwiglu, pg8::MoeOrder, true, true, true, false>(F.lds, g, S, E);
    }); SEAM(14);
    if (IN(15)) REP(15, {
        const int ntiles = (int)__hip_atomic_load(ctl + CW_NTILES, RLX_AGENT);
        LAS int* rtc = (LAS int*)(F.lds + RT_LDS_OFF); for (int i = threadIdx.x; i < 3 * ntiles; i += 512) rtc[i] = WSP(int, WS_RT)[i]; __syncthreads();
        pg8::Gemm g{WSP(unsigned char, WS_HID), WSP(unsigned char, WS_WED), EFF, 128, 127 - 6, 127 - 4}; pg8::MoeOrder S{rtc, ntiles, 8, F.G, vcu_, nullptr, 512u, PRB(15)};
        pg8::EpiFp8 E{WSP(unsigned char, WS_YSLOT), DM, 64.f / 1024.f};
        pg8::gemm_phase<pg8::EpiFp8, pg8::MoeOrder, false, true, true>(F.lds, g, S, E);
    }); SEAM(15);
    if (IN(16)) { if ((PROBE_DUP >> 16) & 1) p16_final(F, false); p16_final(F); }
#undef IN
#undef SEAM
}

extern "C" void kernel_launch(void* const* d_in, const int* in_sizes, int n_in, void* d_out, int out_size, void* d_ws, size_t ws_size, hipStream_t stream) {
    static int grid = 0;
    if (grid == 0) {
        if (n_in != 27 || out_size != NTOK * DM || ws_size < WS_END) { fprintf(stderr, "kernel_launch: unexpected shapes (n_in %d out %d ws %zu)\n", n_in, out_size, ws_size); grid = -1; return; }
        int dev = 0, cus = 0, per_cu = 0;
        if (hipGetDevice(&dev) != hipSuccess || hipDeviceGetAttribute(&cus, hipDeviceAttributeMultiprocessorCount, dev) != hipSuccess) { grid = -1; return; }
        if (hipFuncSetAttribute((const void*)mega_fwd, hipFuncAttributeMaxDynamicSharedMemorySize, LDS_BYTES) != hipSuccess) { fprintf(stderr, "kernel_launch: hipFuncSetAttribute failed\n"); grid = -1; return; }
        if (hipOccupancyMaxActiveBlocksPerMultiprocessor(&per_cu, (const void*)mega_fwd, 512, LDS_BYTES) != hipSuccess || per_cu < 1) fprintf(stderr, "kernel_launch: occupancy query says %d\n", per_cu);
        (void)hipGetLastError();
        grid = cus;
    }
    if (grid < 0) return;
    (void)hipMemsetAsync((char*)d_ws + WS_CTL, 0, CTL_ZERO_BYTES, stream);
    Args a{};
    for (int i = 0; i < 27; ++i) a.in[i] = (const float*)d_in[i];
    a.out = (float*)d_out; a.ws = (unsigned char*)d_ws;
#if MK_PER_PHASE
    for (int p = 0; p < NPHASE; ++p) { a.ph_lo = p; a.ph_hi = p + 1; a.li = p; hipLaunchKernelGGL(mega_fwd, dim3(grid), dim3(512), LDS_BYTES, stream, a); }
#else
    a.ph_lo = 0; a.ph_hi = NPHASE; a.li = 0;
    hipLaunchKernelGGL(mega_fwd, dim3(grid), dim3(512), LDS_BYTES, stream, a);
#endif
}
```

```cpp
#include <hip/hip_runtime.h>
#include <cstdio>
#include <cstdint>

#define GAS __attribute__((address_space(1)))
#define LAS __attribute__((address_space(3)))
typedef unsigned short bf16;
typedef unsigned v4u __attribute__((ext_vector_type(4)));
typedef unsigned v2u __attribute__((ext_vector_type(2)));
typedef float f32x4 __attribute__((ext_vector_type(4)));
typedef float f32x2 __attribute__((ext_vector_type(2)));
typedef short bf16x8 __attribute__((ext_vector_type(8)));
typedef GAS unsigned gu32;
typedef int v8i __attribute__((ext_vector_type(8)));
typedef int v4i __attribute__((ext_vector_type(4)));

#ifndef PROBE_DUP
#define PROBE_DUP 0x0
#endif
#define PRB(k) (1 + ((PROBE_DUP >> (16 + (k))) & 1))
#define REP(k, ...) do { __VA_ARGS__ if ((PROBE_DUP >> (k)) & 1) { __VA_ARGS__ } } while (0)
#ifndef MK_PER_PHASE
#define MK_PER_PHASE 0
#endif

constexpr int NB = 8, SEQ = 2048, DM = 2048, NTOK = NB * SEQ;
constexpr int PLD = 9984;
constexpr int PC_Q = 0, PC_KC = 1024, PC_KS = 1280, PC_KW = 1536, PC_QKM = 1792, PC_G3 = 2816, PC_IF = 2864, PC_VC = 3072, PC_VS = 3328, PC_VW = 3584, PC_VM = 3840, PC_OM = 4864, PC_GA = 5888, PC_GB = 7936;
constexpr int PN_BF = 3072, PN_F8 = 6912;
constexpr int D_IN = 9784;
constexpr int PROJ_MODE = 1;
constexpr int NEXP = 64, EFF = 512;
constexpr int NSLOT = NTOK * 8;
constexpr int NSLOT_ALL = NSLOT + NTOK;
constexpr float EPS = 1e-6f;
constexpr float QC2 = 0.18033688011112042f;

constexpr size_t MiB = 1u << 20;
constexpr size_t WS_CTL = 0, CTL_ZERO_BYTES = 64 * 1024;
constexpr size_t WS_MOD = 1 * MiB;
constexpr size_t WS_BIAS1 = 1 * MiB + 512 * 1024;
constexpr size_t WS_GA = 2 * MiB, WS_GU = 2 * MiB + 256 * 1024, WS_GM = 2 * MiB + 512 * 1024;
constexpr size_t WS_SELM = 3 * MiB;
constexpr size_t WS_KCV = 4 * MiB;
constexpr size_t WS_HIDC = 6 * MiB;
constexpr size_t WS_TE = 14 * MiB, WS_TP = 14 * MiB + 512 * 1024, WS_TW = 15 * MiB, WS_TOKSLOT = 15 * MiB + 512 * 1024;
constexpr size_t WS_SLOTTOK = 16 * MiB, WS_SLOTW = 17 * MiB, WS_RT = 18 * MiB;
constexpr size_t WS_LOGITS = 19 * MiB;
constexpr size_t WS_WED = 32 * MiB;
constexpr size_t WS_WOUT = 162 * MiB;
constexpr size_t WS_WUP = 170 * MiB;
constexpr size_t WS_CW1 = 178 * MiB;
constexpr size_t WS_CW2 = 181 * MiB;
constexpr size_t WS_WR = 180 * MiB;
constexpr size_t WS_H2 = 182 * MiB;
constexpr size_t WS_HID = 246 * MiB;
constexpr size_t WS_H2Q = 340 * MiB;
constexpr size_t WS_WIN = 392 * MiB;
constexpr size_t WS_WIN8 = 412 * MiB;
constexpr size_t WS_WEGU = 432 * MiB;
constexpr size_t WS_PROJ = 692 * MiB;
constexpr size_t WS_H1 = 1004 * MiB;
constexpr size_t WS_H1Q = 1068 * MiB;
constexpr size_t WS_END = 1100 * MiB;
constexpr size_t WS_OACC = WS_HID;
constexpr size_t WS_OMIX = WS_HID + 64 * MiB;
constexpr size_t WS_T1 = WS_H2;
constexpr size_t WS_QKC = WS_H1;
constexpr size_t WS_MERGED = WS_H1;
constexpr size_t WS_Y = WS_PROJ;
constexpr size_t WS_YSLOT = WS_WEGU;
static_assert(WS_YSLOT + (size_t)NSLOT_ALL * 2048 <= WS_END, "yslot");
static_assert(WS_HID + (size_t)(NSLOT_ALL + 256) * 512 <= WS_H2Q && WS_H2Q + (size_t)NTOK * DM <= WS_WIN, "hid");
constexpr int CW_CNT = 64;
constexpr int CW_MLQ = 200;
constexpr int CW_NTILES = 192;
constexpr int CW_BAR = 4096;

constexpr int RT_LDS_OFF = 131072 + 512 + 4096;
constexpr int RING_BYTES = 131072, LDSCTL_OFF = RING_BYTES, MISC_OFF = LDSCTL_OFF + 320, LDS_BYTES = 147456;

#define LDS_WAIT() asm volatile("s_waitcnt lgkmcnt(0)" ::: "memory")
#define VM_WAIT() asm volatile("s_waitcnt vmcnt(0)" ::: "memory")
#define RLX_AGENT __ATOMIC_RELAXED, __HIP_MEMORY_SCOPE_AGENT
__device__ __forceinline__ unsigned f2bf(float f) { unsigned u = __builtin_bit_cast(unsigned, f); return (u + 0x7fffu + ((u >> 16) & 1u)) >> 16; }
__device__ __forceinline__ unsigned pk2(float lo, float hi) { return f2bf(lo) | (f2bf(hi) << 16); }
__device__ __forceinline__ float bf2f(unsigned h) { return __uint_as_float(h << 16); }
__device__ __forceinline__ float bflo(unsigned w) { return __uint_as_float(w << 16); }
__device__ __forceinline__ float bfhi(unsigned w) { return __uint_as_float(w & 0xffff0000u); }
__device__ __forceinline__ float frcp(float x) { return __builtin_amdgcn_rcpf(x); }
__device__ __forceinline__ float sigm(float x) { return frcp(1.f + __expf(-x)); }
__device__ __forceinline__ float sigm_ieee(float x) { return 1.f / (1.f + __expf(-x)); }
__device__ __forceinline__ float wave_sum(float v) {
#pragma unroll
    for (int o = 1; o < 64; o <<= 1) v += __shfl_xor(v, o);
    return v;
}
__device__ __forceinline__ float wave_max(float v) {
#pragma unroll
    for (int o = 1; o < 64; o <<= 1) v = fmaxf(v, __shfl_xor(v, o));
    return v;
}
__device__ __forceinline__ unsigned long long uaddr(const void* p) {
    const unsigned long long a = (unsigned long long)p; const unsigned lo = __builtin_amdgcn_readfirstlane((unsigned)a), hi = __builtin_amdgcn_readfirstlane((unsigned)(a >> 32));
    return ((unsigned long long)hi << 32) | lo; }
#define UPTR(T, p) ((GAS T*)uaddr(p))
__device__ __forceinline__ int tid_opaque() { int t = threadIdx.x; asm volatile("" : "+v"(t)); return t; }
__device__ __forceinline__ float rdlane(float v, int l) { return __int_as_float(__builtin_amdgcn_readlane(__float_as_int(v), l)); }

namespace pg8 {
constexpr int BM = 256, BK = 64, HALF = 128, HTB = HALF * BK * 2, STAGE_BYTES = 8 * HTB, NXCD = 8, WGM = 8;
__host__ __device__ __forceinline__ int lds_byte(int r, int c) { const int st = (r >> 4) * 2 + (c >> 5), rr = r & 15, cc = c & 31, ob = rr * 64 + cc * 2; return st * 1024 + (ob ^ (((ob >> 9) & 1) << 5)); }
__host__ __device__ __forceinline__ void stage_rc(int b, int& R, int& C) { const int st = b / 1024, sb = b % 1024, swz = sb ^ (((sb >> 9) & 1) << 5); R = (st >> 1) * 16 + swz / 64; C = (st & 1) * 32 + (swz % 64) / 2; }
__host__ __device__ __forceinline__ int perm32(int rho) { const int n = rho >> 4, i = rho & 15; return 8 * (i >> 2) + 4 * n + (i & 3); }

struct Unit { int arow, pn, valid, aux; };
struct Gemm { const void* A; const void* Bt; int K; int kstepA; int scW, scX; };

struct StaticOrder {
    int nM, nN, nwg, G, c, reps;
    __device__ void init(int M, int N, int G_, int c_, int reps_ = 1) { nM = M / BM; nN = N / BM; nwg = nM * nN; G = G_; c = c_; reps = reps_; }
    __device__ bool next(int i, Unit& u) const {
        long L = (long)i * G + c; if (L >= (long)nwg * reps) return false; L %= nwg;
        int wgid = (int)L; { const int q = nwg / NXCD, r = nwg % NXCD, xcd = wgid % NXCD, off = wgid / NXCD; wgid = (xcd < r ? xcd * (q + 1) : r * (q + 1) + (xcd - r) * q) + off; }
        const int nig = WGM * nN, gid = wgid / nig, fm = gid * WGM, gsz = (nM - fm) < WGM ? (nM - fm) : WGM;
        u.arow = (fm + ((wgid % nig) % gsz)) * BM; u.pn = (wgid % nig) / gsz; u.valid = BM; u.aux = u.pn; return true;
    }
    __device__ __forceinline__ unsigned rowkey(const Unit&, int) const { return 0u; }
    __device__ __forceinline__ unsigned keyoff(const Unit&, unsigned) const { return 0u; }
};
struct CmpOrder {
    int G, c;
    __device__ bool next(int i, Unit& u) const { const int L = i * G + c; if (L >= 32) return false; const int kv = L >> 4, pm = L & 15; u.arow = 256 * pm; u.pn = kv; u.valid = (4064 - 256 * pm) < 256 ? (4064 - 256 * pm) : 256; u.aux = kv; return true; }
    __device__ __forceinline__ unsigned rowkey(const Unit& u, int lr) const { int rr = u.arow + lr; rr = (rr < 4064) ? rr : 0; const int b = rr / 508, n = (rr % 508) >> 2, g = rr & 3; return (unsigned)((b * SEQ + 16 * n) | (g << 14)); }
    __device__ __forceinline__ unsigned keyoff(const Unit& u, unsigned key) const { return (unsigned)(((size_t)(key & 0x3fffu) * PLD + (u.aux ? PC_VC : PC_KC) + (key >> 14) * 64) * 2); }
};
struct MoeOrder {
    const LAS int* rt; int ntiles, NCT, G, c; const int* rows; unsigned rbytes; int reps;
    __device__ __forceinline__ unsigned rowkey(const Unit& u, int lr) const { return (unsigned)((lr < u.valid) ? rows[u.arow + lr] : 0); }
    __device__ __forceinline__ unsigned keyoff(const Unit&, unsigned key) const { return key * rbytes; }
    __device__ bool next(int i, Unit& u) const {
        long L = (long)i * G + c; if (L >= (long)ntiles * NCT * reps) return false; L %= (long)ntiles * NCT;
        const int j = (int)(L / NCT), ct = (int)(L % NCT);
        const int e = __builtin_amdgcn_readfirstlane(rt[3 * j]), base = __builtin_amdgcn_readfirstlane(rt[3 * j + 1]), v = __builtin_amdgcn_readfirstlane(rt[3 * j + 2]);
        u.arow = base; u.pn = e * NCT + ct; u.valid = v; u.aux = ct; return true;
    }
};

__device__ __forceinline__ unsigned cvt_pk_bf16(float lo, float hi) { unsigned r; asm volatile("v_cvt_pk_bf16_f32 %0, %1, %2" : "=v"(r) : "v"(lo), "v"(hi)); return r; }

struct EpiBf16 {
    static constexpr bool PERM = true;
    bf16* O; int ldc; int nscaled; float scale0; float scale1 = 1.f;
    __device__ __forceinline__ void operator()(const f32x4 (&acc)[2][2][4][2], const Unit& u, int wr, int wc, int fr, int fq) const {
        const float sc = (u.aux < nscaled) ? scale0 : scale1;
#pragma unroll
        for (int ai = 0; ai < 2; ++ai)
#pragma unroll
            for (int m = 0; m < 4; ++m) { const int lr = ai * HALF + wr * 64 + m * 16 + fr; if (lr < u.valid) { bf16* rowp = O + (size_t)(u.arow + lr) * ldc + u.aux * BM + wc * 32 + 8 * fq;
#pragma unroll
                for (int bj = 0; bj < 2; ++bj) { const f32x4 v0 = acc[ai][bj][m][0] * sc, v1 = acc[ai][bj][m][1] * sc; v4u w; w.x = cvt_pk_bf16(v0[0], v0[1]); w.y = cvt_pk_bf16(v0[2], v0[3]); w.z = cvt_pk_bf16(v1[0], v1[1]); w.w = cvt_pk_bf16(v1[2], v1[3]);
                    *(v4u*)(rowp + bj * HALF) = w; } } }
    }
};
struct EpiFp8 {
    static constexpr bool PERM = true;
    unsigned char* O; int ldc; float scale;
    __device__ __forceinline__ void operator()(const f32x4 (&acc)[2][2][4][2], const Unit& u, int wr, int wc, int fr, int fq) const {
#pragma unroll
        for (int ai = 0; ai < 2; ++ai)
#pragma unroll
            for (int m = 0; m < 4; ++m) { const int lr = ai * HALF + wr * 64 + m * 16 + fr; if (lr < u.valid) { unsigned char* rowp = O + (size_t)(u.arow + lr) * ldc + u.aux * BM + wc * 32 + 8 * fq;
#pragma unroll
                for (int bj = 0; bj < 2; ++bj) { float r[8];
#pragma unroll
                    for (int n = 0; n < 2; ++n)
#pragma unroll
                        for (int k = 0; k < 4; ++k) r[4 * n + k] = fminf(fmaxf(acc[ai][bj][m][n][k] * scale, -448.f), 448.f);
                    int o0 = 0, o1 = 0; o0 = __builtin_amdgcn_cvt_pk_fp8_f32(r[0], r[1], o0, false); o0 = __builtin_amdgcn_cvt_pk_fp8_f32(r[2], r[3], o0, true);
                    o1 = __builtin_amdgcn_cvt_pk_fp8_f32(r[4], r[5], o1, false); o1 = __builtin_amdgcn_cvt_pk_fp8_f32(r[6], r[7], o1, true);
                    v2u o; o.x = (unsigned)o0; o.y = (unsigned)o1; *(v2u*)(rowp + bj * HALF) = o; } } }
    }
};
struct EpiGate {
    static constexpr bool PERM = true;
    bf16* O; const bf16* gate; int ldg; const bf16* prev;
    __device__ __forceinline__ void operator()(const f32x4 (&acc)[2][2][4][2], const Unit& u, int wr, int wc, int fr, int fq) const {
#pragma unroll
        for (int ai = 0; ai < 2; ++ai)
#pragma unroll
            for (int m = 0; m < 4; ++m) { const int row = u.arow + ai * HALF + wr * 64 + m * 16 + fr; const int col = u.pn * BM + wc * 32 + 8 * fq;
#pragma unroll
                for (int bj = 0; bj < 2; ++bj) {
                    const v4u gq = *(const v4u*)(gate + (size_t)row * ldg + col + bj * HALF);
                    const f32x4 v0 = acc[ai][bj][m][0], v1 = acc[ai][bj][m][1];
                    float r[8];
                    r[0] = sigm(bflo(gq.x)) * v0[0]; r[1] = sigm(bfhi(gq.x)) * v0[1]; r[2] = sigm(bflo(gq.y)) * v0[2]; r[3] = sigm(bfhi(gq.y)) * v0[3];
                    r[4] = sigm(bflo(gq.z)) * v1[0]; r[5] = sigm(bfhi(gq.z)) * v1[1]; r[6] = sigm(bflo(gq.w)) * v1[2]; r[7] = sigm(bfhi(gq.w)) * v1[3];
                    if (prev) { const v4u pq = *(const v4u*)(prev + (size_t)row * 2048 + col + bj * HALF);
                        r[0] += bflo(pq.x); r[1] += bfhi(pq.x); r[2] += bflo(pq.y); r[3] += bfhi(pq.y); r[4] += bflo(pq.z); r[5] += bfhi(pq.z); r[6] += bflo(pq.w); r[7] += bfhi(pq.w); }
                    v4u w; w.x = cvt_pk_bf16(r[0], r[1]); w.y = cvt_pk_bf16(r[2], r[3]); w.z = cvt_pk_bf16(r[4], r[5]); w.w = cvt_pk_bf16(r[6], r[7]);
                    *(v4u*)(O + (size_t)row * 2048 + col + bj * HALF) = w; } }
    }
};
struct MidGate {
    static constexpr bool ON = true;
    const bf16* ga; const bf16* gb; int ldg;
    __device__ __forceinline__ void operator()(f32x4 (&acc)[2][2][4][2], const Unit& u, int wr, int wc, int fr, int fq) const {
#pragma unroll
        for (int ai = 0; ai < 2; ++ai)
#pragma unroll
            for (int m = 0; m < 4; ++m) { const size_t off = (size_t)(u.arow + ai * HALF + wr * 64 + m * 16 + fr) * ldg + u.pn * BM + wc * 32 + 8 * fq;
#pragma unroll
                for (int bj = 0; bj < 2; ++bj) { const v4u a = *(const v4u*)(ga + off + bj * HALF), b = *(const v4u*)(gb + off + bj * HALF);
#define MG_R(xa, xb) ((1.f + __expf(-(xb))) * frcp(1.f + __expf(-(xa))))
                    acc[ai][bj][m][0][0] *= MG_R(bflo(a.x), bflo(b.x)); acc[ai][bj][m][0][1] *= MG_R(bfhi(a.x), bfhi(b.x)); acc[ai][bj][m][0][2] *= MG_R(bflo(a.y), bflo(b.y)); acc[ai][bj][m][0][3] *= MG_R(bfhi(a.y), bfhi(b.y));
                    acc[ai][bj][m][1][0] *= MG_R(bflo(a.z), bflo(b.z)); acc[ai][bj][m][1][1] *= MG_R(bfhi(a.z), bfhi(b.z)); acc[ai][bj][m][1][2] *= MG_R(bflo(a.w), bflo(b.w)); acc[ai][bj][m][1][3] *= MG_R(bfhi(a.w), bfhi(b.w));
#undef MG_R
                } }
    }
};
struct EpiF32 {
    static constexpr bool PERM = false;
    float* C; int ldc; int ncols;
    __device__ __forceinline__ void operator()(const f32x4 (&acc)[2][2][4][2], const Unit& u, int wr, int wc, int fr, int fq) const {
#pragma unroll
        for (int ai = 0; ai < 2; ++ai)
#pragma unroll
            for (int m = 0; m < 4; ++m) { float* rowp = C + (size_t)(u.arow + ai * HALF + wr * 64 + m * 16 + fr) * ldc; const int col0 = u.pn * BM + wc * 32 + 4 * fq;
#pragma unroll
                for (int bj = 0; bj < 2; ++bj)
#pragma unroll
                    for (int n = 0; n < 2; ++n) { const int col = col0 + bj * HALF + n * 16; if (col < ncols) *(f32x4*)(rowp + col) = acc[ai][bj][m][n]; } }
    }
};
struct EpiCmpHid {
    static constexpr bool PERM = true;
    bf16* H; const float* bias;
    __device__ __forceinline__ void operator()(const f32x4 (&acc)[2][2][4][2], const Unit& u, int wr, int wc, int fr, int fq) const {
        f32x4 bv[2][2];
#pragma unroll
        for (int bj = 0; bj < 2; ++bj)
#pragma unroll
            for (int n = 0; n < 2; ++n) bv[bj][n] = *(const f32x4*)(bias + u.aux * 256 + bj * HALF + wc * 32 + 8 * fq + 4 * n);
#pragma unroll
        for (int ai = 0; ai < 2; ++ai)
#pragma unroll
            for (int m = 0; m < 4; ++m) { const int lr = ai * HALF + wr * 64 + m * 16 + fr; if (lr < u.valid) { bf16* rowp = H + (size_t)(u.aux * 4096 + u.arow + lr) * 256 + wc * 32 + 8 * fq;
#pragma unroll
                for (int bj = 0; bj < 2; ++bj) { float r[8];
#pragma unroll
                    for (int n = 0; n < 2; ++n)
#pragma unroll
                        for (int k = 0; k < 4; ++k) { const float x = acc[ai][bj][m][n][k] + bv[bj][n][k]; const float uu = 0.7978845608028654f * (x + 0.044715f * x * x * x); const float th = 1.f - 2.f * frcp(1.f + __expf(2.f * uu)); r[4 * n + k] = 0.5f * x * (1.f + th); }
                    v4u w; w.x = cvt_pk_bf16(r[0], r[1]); w.y = cvt_pk_bf16(r[2], r[3]); w.z = cvt_pk_bf16(r[4], r[5]); w.w = cvt_pk_bf16(r[6], r[7]);
                    *(v4u*)(rowp + bj * HALF) = w; } } }
    }
};
struct EpiSwiglu {
    static constexpr bool PERM = true;
    unsigned char* H; const float* w;
    __device__ __forceinline__ void operator()(const f32x4 (&acc)[2][2][4][2], const Unit& u, int wr, int wc, int fr, int fq) const {
#pragma unroll
        for (int ai = 0; ai < 2; ++ai)
#pragma unroll
            for (int m = 0; m < 4; ++m) { const int lr = ai * HALF + wr * 64 + m * 16 + fr; if (lr < u.valid) { const int row = u.arow + lr; const float ws = w[row];
                float r[8];
#pragma unroll
                for (int n = 0; n < 2; ++n)
#pragma unroll
                    for (int k = 0; k < 4; ++k) { const float gv = acc[ai][0][m][n][k] * (1.f / 64.f), uv = acc[ai][1][m][n][k] * (1.f / 64.f); r[4 * n + k] = fminf(fmaxf(gv * sigm(gv) * uv * ws * 16.f, -448.f), 448.f); }
                int o0 = 0, o1 = 0; o0 = __builtin_amdgcn_cvt_pk_fp8_f32(r[0], r[1], o0, false); o0 = __builtin_amdgcn_cvt_pk_fp8_f32(r[2], r[3], o0, true);
                o1 = __builtin_amdgcn_cvt_pk_fp8_f32(r[4], r[5], o1, false); o1 = __builtin_amdgcn_cvt_pk_fp8_f32(r[6], r[7], o1, true);
                v2u o; o.x = (unsigned)o0; o.y = (unsigned)o1;
                *(v2u*)(H + (size_t)row * EFF + u.aux * HALF + wc * 32 + 8 * fq) = o; } }
    }
};

struct NoMid { static constexpr bool ON = false; __device__ __forceinline__ void operator()(f32x4 (&)[2][2][4][2], const Unit&, int, int, int, int) const {} };
template <class Epi, class Sched, bool GATHER, bool ALIGN_EPI, bool FP8 = false, bool RD32 = false, class Mid = NoMid>
__device__ __forceinline__ void gemm_phase(LAS unsigned char* lds, const Gemm g, const Sched& S, const Epi& E, const Mid& MH = Mid()) {
    const int tid = tid_opaque(), wid = __builtin_amdgcn_readfirstlane(tid >> 6), lane = tid & 63, wr = wid >> 2, wc = wid & 3, fr = lane & 15, fq = lane >> 4;
    constexpr int EB = FP8 ? 1 : 2;
    const int K = g.K; const size_t rstep = (size_t)K * EB; const int nt = (int)(rstep / 128);
    unsigned voffA[2], voffB[2];
#pragma unroll
    for (int i = 0; i < 2; ++i) { int R, C; stage_rc(tid * 16 + i * 8192, R, C); const int Rb = Epi::PERM ? ((R & ~31) + perm32(R & 31)) : R;
        voffA[i] = (unsigned)(R * rstep + C * 2); voffB[i] = (unsigned)(Rb * rstep + C * 2); }
    const unsigned r64 = (unsigned)(64 * rstep);
    const size_t kstep = (size_t)(BK * 2);
    const size_t kstepA = GATHER ? (size_t)g.kstepA : kstep;
    const size_t hstep = (size_t)HALF * rstep;
    const size_t tstep = 2 * hstep;
    const unsigned ldsw = (unsigned)wid * 1024u;
    const int aoff = lds_byte(wr * 64 + fr, fq * (FP8 ? 16 : 8)), boff = lds_byte(wc * 32 + fr, fq * (FP8 ? 16 : 8));
    unsigned gkey[2];
    LAS v2u* gstash = (LAS v2u*)(lds + STAGE_BYTES + 512 + tid * 8);
    unsigned gcol = 0; { int R_, C_; stage_rc(tid * 16, R_, C_); gcol = (unsigned)C_ * 2u; }
    Unit gu;
#define PG8_SA(b, h) (((b) * 2 + (h)) * HTB)
#define PG8_SB(b, h) ((4 + (b) * 2 + (h)) * HTB)
#define PG8_STG(bufoff, ptr, v0, v1) do { \
        __builtin_amdgcn_global_load_lds((const unsigned*)((const char*)(ptr) + (v0)), (LAS unsigned*)(lds + (bufoff) + ldsw), 16, 0, 0); \
        __builtin_amdgcn_global_load_lds((const unsigned*)((const char*)(ptr) + (v1)), (LAS unsigned*)(lds + (bufoff) + ldsw + 8192), 16, 0, 0); } while (0)
#define PG8_STAGE_B(bufoff, ptr) PG8_STG(bufoff, ptr, voffB[0], voffB[0] + r64)
#define PG8_STAGE_A(bufoff, ptr, h, nx) do { if constexpr (GATHER) { const unsigned o0_ = S.keyoff(gu, gkey[h] & 0xffffu) + gcol, o1_ = S.keyoff(gu, gkey[h] >> 16) + gcol; PG8_STG(bufoff, ptr, o0_, o1_); } \
        else { PG8_STG(bufoff, (const char*)(ptr) + (h) * hstep, voffA[0], voffA[0] + r64); } } while (0)
#define PG8_GLOAD(dst, u) do { int R_, C_; stage_rc(tid * 16, R_, C_); _Pragma("unroll") for (int h_ = 0; h_ < 2; ++h_) \
        dst[h_] = S.rowkey((u), h_ * HALF + R_) | (S.rowkey((u), h_ * HALF + R_ + 64) << 16); } while (0)
#define PG8_RD8(off) (RD32 ? *(const LAS v8i*)(lds + (off)) : __builtin_shufflevector(*(const LAS v4i*)(lds + (off)), *(const LAS v4i*)(lds + (off) + 16), 0, 1, 2, 3, 4, 5, 6, 7))
#define PG8_LDA(dst, b, h) do { if constexpr (FP8) { _Pragma("unroll") for (int m = 0; m < 4; ++m) dst##8[m] = PG8_RD8(PG8_SA(b, h) + aoff + m * 2048); } \
        else { _Pragma("unroll") for (int m = 0; m < 4; ++m) _Pragma("unroll") for (int k = 0; k < 2; ++k) dst[m][k] = *(const LAS bf16x8*)(lds + PG8_SA(b, h) + aoff + m * 2048 + k * 1024); } } while (0)
#define PG8_LDB(dst, b, h) do { if constexpr (FP8) { _Pragma("unroll") for (int n = 0; n < 2; ++n) dst##8[n] = PG8_RD8(PG8_SB(b, h) + boff + n * 2048); } \
        else { _Pragma("unroll") for (int n = 0; n < 2; ++n) _Pragma("unroll") for (int k = 0; k < 2; ++k) dst[n][k] = *(const LAS bf16x8*)(lds + PG8_SB(b, h) + boff + n * 2048 + k * 1024); } } while (0)
#define PG8_MMA(ai, bj, At, Bt) do { __builtin_amdgcn_s_setprio(1); if constexpr (FP8) { _Pragma("unroll") for (int m = 0; m < 4; ++m) _Pragma("unroll") for (int n = 0; n < 2; ++n) \
        asm volatile("v_mfma_f32_16x16x128_f8f6f4 %0, %1, %2, %0" : "+v"(acc[ai][bj][m][n]) : "v"(Bt##8[n]), "v"(At##8[m])); } \
        else { _Pragma("unroll") for (int m = 0; m < 4; ++m) _Pragma("unroll") for (int n = 0; n < 2; ++n) _Pragma("unroll") for (int k = 0; k < 2; ++k) \
        acc[ai][bj][m][n] = __builtin_amdgcn_mfma_f32_16x16x32_bf16(Bt[n][k], At[m][k], acc[ai][bj][m][n], 0, 0, 0); } __builtin_amdgcn_s_setprio(0); } while (0)
#define PG8_WAIT_V(n) asm volatile("s_waitcnt vmcnt(" #n ")" ::: "memory")
#define PG8_WAIT_L(n) asm volatile("s_waitcnt lgkmcnt(" #n ")" ::: "memory")
#define PG8_BAR __builtin_amdgcn_s_barrier()
#define PG8_SCHED __builtin_amdgcn_sched_barrier(0)
    Unit cur, nxt; int ui = 0;
    if (!S.next(0, cur)) return;
    f32x4 acc[2][2][4][2];
#pragma unroll
    for (int a = 0; a < 2; ++a)
#pragma unroll
        for (int b = 0; b < 2; ++b)
#pragma unroll
            for (int m = 0; m < 4; ++m)
#pragma unroll
                for (int n = 0; n < 2; ++n) acc[a][b][m][n] = (f32x4){0.f, 0.f, 0.f, 0.f};
    bf16x8 At[4][2], B0[2][2], B1[2][2]; v8i At8[4], B08[2], B18[2];
    const char* cA = GATHER ? (const char*)g.A : (const char*)g.A + (size_t)cur.arow * rstep; const char* cB = (const char*)g.Bt + (size_t)cur.pn * tstep;
    if constexpr (GATHER) { PG8_GLOAD(gkey, cur); gu = cur; }
    PG8_STAGE_B(PG8_SB(0, 0), cB); PG8_STAGE_B(PG8_SB(0, 1), cB + hstep); PG8_STAGE_A(PG8_SA(0, 0), cA, 0, false); PG8_STAGE_A(PG8_SA(0, 1), cA, 1, false);
    if (wr == 1) PG8_BAR;
    PG8_WAIT_V(2); PG8_BAR;
    PG8_STAGE_B(PG8_SB(1, 0), cB + kstep); PG8_STAGE_A(PG8_SA(1, 0), cA + kstepA, 0, false); PG8_STAGE_B(PG8_SB(1, 1), cB + hstep + kstep);
    PG8_WAIT_V(6); PG8_BAR;
    for (;;) {
        const bool has_next = S.next(ui + 1, nxt);
        if constexpr (GATHER) { if (has_next) { unsigned gt_[2]; PG8_GLOAD(gt_, nxt); *gstash = (v2u){gt_[0], gt_[1]}; } }
        const char* nA = GATHER ? cA : (has_next ? (const char*)g.A + (size_t)nxt.arow * rstep : cA); const char* nB = has_next ? (const char*)g.Bt + (size_t)nxt.pn * tstep : cB;
        for (int t = 0; t < nt; t += 2) {
            const bool last = (t == nt - 2);
            const bool nx = last && has_next;
            if constexpr (Mid::ON) { if (t == nt / 2) { Unit mu; mu.arow = __builtin_amdgcn_readfirstlane(cur.arow); mu.pn = __builtin_amdgcn_readfirstlane(cur.pn); mu.valid = cur.valid; mu.aux = cur.aux;
                int fr_ = fr, fq_ = fq; asm volatile("" : "+s"(mu.arow), "+s"(mu.pn), "+v"(fr_), "+v"(fq_)); MH(acc, mu, wr, wc, fr_, fq_); } }
            const char* a1 = cA + (size_t)(t + 1) * kstepA;
            const char* a2 = last ? nA : cA + (size_t)(t + 2) * kstepA; const char* b2 = last ? nB : cB + (size_t)(t + 2) * kstep;
            const char* a3 = a2 + kstepA; const char* b3 = b2 + kstep;
            PG8_LDB(B0, 0, 0); PG8_LDB(B1, 0, 1); PG8_SCHED; PG8_LDA(At, 0, 0); PG8_STAGE_A(PG8_SA(1, 1), a1, 1, false);
            if constexpr (GATHER) { if (nx) { const v2u s_ = *gstash; gkey[0] = s_.x; gkey[1] = s_.y; gu = nxt; } }
            PG8_WAIT_V(8); PG8_WAIT_L(0); PG8_BAR; PG8_MMA(0, 0, At, B0); PG8_MMA(0, 1, At, B1); PG8_BAR; PG8_SCHED;
            PG8_LDA(At, 0, 1); PG8_STAGE_B(PG8_SB(0, 0), b2); PG8_STAGE_B(PG8_SB(0, 1), b2 + hstep); PG8_STAGE_A(PG8_SA(0, 0), a2, 0, nx);
            PG8_WAIT_V(8); PG8_WAIT_L(0); PG8_BAR; PG8_MMA(1, 0, At, B0); PG8_MMA(1, 1, At, B1); PG8_BAR; PG8_SCHED;
            PG8_LDB(B0, 1, 0); PG8_LDB(B1, 1, 1); PG8_SCHED; PG8_LDA(At, 1, 0); PG8_STAGE_A(PG8_SA(0, 1), a2, 1, nx);
            PG8_WAIT_V(8); PG8_WAIT_L(0); PG8_BAR; PG8_MMA(0, 0, At, B0); PG8_MMA(0, 1, At, B1); PG8_BAR; PG8_SCHED;
            PG8_LDA(At, 1, 1); PG8_STAGE_B(PG8_SB(1, 0), b3); PG8_STAGE_B(PG8_SB(1, 1), b3 + hstep); PG8_STAGE_A(PG8_SA(1, 0), a3, 0, nx);
            PG8_WAIT_V(8); PG8_WAIT_L(0); PG8_BAR; PG8_MMA(1, 0, At, B0); PG8_MMA(1, 1, At, B1); PG8_BAR; PG8_SCHED;
        }
        if constexpr (ALIGN_EPI) { if (wr == 0) PG8_BAR; }
        if constexpr (FP8) asm volatile("s_nop 15\n\ts_nop 7" ::: "memory");
        { Unit eu; eu.arow = __builtin_amdgcn_readfirstlane(cur.arow); eu.pn = __builtin_amdgcn_readfirstlane(cur.pn); eu.valid = __builtin_amdgcn_readfirstlane(cur.valid); eu.aux = __builtin_amdgcn_readfirstlane(cur.aux);
          asm volatile("" : "+s"(eu.arow), "+s"(eu.pn), "+s"(eu.valid), "+s"(eu.aux));
          int fr_ = fr, fq_ = fq; asm volatile("" : "+v"(fr_), "+v"(fq_));
          E(acc, eu, wr, wc, fr_, fq_); }
        if (!has_next) break;
#pragma unroll
        for (int a = 0; a < 2; ++a)
#pragma unroll
            for (int b = 0; b < 2; ++b)
#pragma unroll
                for (int m = 0; m < 4; ++m)
#pragma unroll
                    for (int n = 0; n < 2; ++n) acc[a][b][m][n] = (f32x4){0.f, 0.f, 0.f, 0.f};
        cur = nxt; cA = nA; cB = nB; ++ui;
        if constexpr (ALIGN_EPI) { if (wr == 1) PG8_BAR; }
    }
    PG8_WAIT_V(0);
    if constexpr (!ALIGN_EPI) { if (wr == 0) PG8_BAR; }
    PG8_BAR;
#undef PG8_SA
#undef PG8_SB
#undef PG8_STG
#undef PG8_STAGE_A
#undef PG8_STAGE_B
#undef PG8_GLOAD
#undef PG8_LDA
#undef PG8_RD8
#undef PG8_LDB
#undef PG8_MMA
#undef PG8_WAIT_V
#undef PG8_WAIT_L
#undef PG8_BAR
#undef PG8_SCHED
}
}

#define XB_TMO      128
#define XB_XCNT(j)  (256  + 64 * (j))
#define XB_XSUB(j)  (1280 + 64 * (j))
#define XB_XGEN(j)  (2304 + 64 * (j))
#define XB_TOP      3328
#define XB_TOPGEN   3392
#define XCD_BAR_WORDS 3456
#define XB_SPIN_CAP (1u << 22)

__device__ __forceinline__ unsigned xb_ld(unsigned* p)              { return __hip_atomic_load(p, __ATOMIC_RELAXED, __HIP_MEMORY_SCOPE_AGENT); }
__device__ __forceinline__ unsigned xb_add(unsigned* p, unsigned v) { return __hip_atomic_fetch_add(p, v, __ATOMIC_RELAXED, __HIP_MEMORY_SCOPE_AGENT); }
__device__ __forceinline__ unsigned xb_xcc_id() { return (unsigned)__builtin_amdgcn_s_getreg((3 << 11) | 20) & 0xFu; }
#define XB_SPIN(cond, bar) do { unsigned _sp = 0; while (cond) { __builtin_amdgcn_s_sleep(1); \
    if ((++_sp & 255u) == 0u) { if (xb_ld(&(bar)[XB_TMO])) break; if (_sp > XB_SPIN_CAP) { atomicAdd(&(bar)[XB_TMO], 1u); break; } } } } while (0)

struct XcdBarrier { unsigned* bar; unsigned x; volatile LAS unsigned* st; };

__device__ __forceinline__ XcdBarrier xcd_barrier_post(unsigned* bar, volatile LAS unsigned* st) {
    XcdBarrier b; b.bar = bar; b.x = xb_xcc_id(); b.st = st;
    if (threadIdx.x == 0) (void)xb_add(&bar[XB_XCNT(b.x)], 1u);
    return b;
}
__device__ __forceinline__ void xcd_barrier_complete(unsigned* bar, unsigned x, unsigned& nloc, unsigned& nx) {
    const unsigned G = gridDim.x * gridDim.y * gridDim.z;
    unsigned sum, cnt, mine, sp = 0u;
    for (;;) {
        sum = 0u; cnt = 0u; mine = 0u;
#pragma unroll
        for (unsigned j = 0; j < 16; ++j) { const unsigned c = xb_ld(&bar[XB_XCNT(j)]); sum += c; cnt += (c > 0u) ? 1u : 0u; mine = (j == x) ? c : mine; }
        if (sum == G) break;
        __builtin_amdgcn_s_sleep(1);
        if ((++sp & 255u) == 0u) { if (xb_ld(&bar[XB_TMO])) break; if (sp > XB_SPIN_CAP) { atomicAdd(&bar[XB_TMO], 1u); break; } }
    }
    nloc = mine > 0u ? mine : 1u; nx = cnt > 0u ? cnt : 1u;
}
__device__ __forceinline__ void xcd_barrier(const XcdBarrier& b) {
    asm volatile("s_waitcnt vmcnt(0)" ::: "memory");
    __syncthreads();
    if (threadIdx.x == 0) {
        unsigned* bar = b.bar;
        __builtin_amdgcn_s_waitcnt(0);
        unsigned nloc = b.st[0], nx = b.st[1];
        if (nloc == 0u) { xcd_barrier_complete(bar, b.x, nloc, nx); b.st[0] = nloc; b.st[1] = nx; }
        const unsigned old = xb_add(&bar[XB_XSUB(b.x)], 1u);
        const unsigned gen = old / nloc;
        if (old + 1u == (gen + 1u) * nloc) {
            __builtin_amdgcn_fence(__ATOMIC_RELEASE, "agent");
            asm volatile("s_waitcnt vmcnt(0)" ::: "memory");
            const unsigned og = xb_add(&bar[XB_TOP], 1u);
            const unsigned tg = og / nx;
            if (og + 1u == (tg + 1u) * nx) xb_add(&bar[XB_TOPGEN], 1u);
            else XB_SPIN(xb_ld(&bar[XB_TOPGEN]) == tg, bar);
            __builtin_amdgcn_fence(__ATOMIC_ACQUIRE, "agent");
            xb_add(&bar[XB_XGEN(b.x)], 1u);
            asm volatile("s_waitcnt vmcnt(0)" ::: "memory");
        } else {
            XB_SPIN(xb_ld(&bar[XB_XGEN(b.x)]) == gen, bar);
            __builtin_amdgcn_fence(__ATOMIC_ACQUIRE, "agent");
            asm volatile("s_waitcnt vmcnt(0)" ::: "memory");
        }
    }
    __syncthreads();
}

struct Frame {
    LAS unsigned char* lds;
    unsigned char* ws;
    const float* const* in;
    float* out;
    int tid, lane, wave, G, gw, ngw;
};
#define WSP(T, off) ((T*)(F.ws + (off)))
#define INP(k) (F.in[k])

template <class RowMap>
__device__ __forceinline__ void transpose_item(const float* W, int K, int N, bf16* WT, int ldt, LAS float* scr, int item, int lane, RowMap rm) {
    const int nblk = (N + 31) / 32, kb = item / nblk, nb = item % nblk, k0 = 64 * kb, n0 = 32 * nb;
    const int nn = n0 + (lane & 31);
#pragma unroll 8
    for (int i = 0; i < 32; ++i) { const int kk = 2 * i + (lane >> 5); scr[kk * 33 + (lane & 31)] = (nn < N) ? W[(size_t)(k0 + kk) * N + nn] : 0.f; }
    LDS_WAIT(); asm volatile("" ::: "memory");
    const int c = lane & 7;
#pragma unroll
    for (int j = 0; j < 4; ++j) { const int n = (lane >> 3) + 8 * j; const LAS float* s = scr + (8 * c) * 33 + n;
        v4u o; o.x = pk2(s[0 * 33], s[1 * 33]); o.y = pk2(s[2 * 33], s[3 * 33]); o.z = pk2(s[4 * 33], s[5 * 33]); o.w = pk2(s[6 * 33], s[7 * 33]);
        if (n0 + n < N) *(v4u*)(WT + (size_t)rm(n0 + n) * ldt + k0 + 8 * c) = o; }
    LDS_WAIT(); asm volatile("" ::: "memory");
}
template <class RowMap>
__device__ __forceinline__ void transpose_item8(const float* W, int K, int N, unsigned char* WT, int ldt, LAS float* scr, int item, int lane, RowMap rm) {
    const int nblk = (N + 31) / 32, kb = item / nblk, nb = item % nblk, k0 = 64 * kb, n0 = 32 * nb;
    const int nn = n0 + (lane & 31);
#pragma unroll 8
    for (int i = 0; i < 32; ++i) { const int kk = 2 * i + (lane >> 5); scr[kk * 33 + (lane & 31)] = (nn < N) ? W[(size_t)(k0 + kk) * N + nn] : 0.f; }
    LDS_WAIT(); asm volatile("" ::: "memory");
    const int c = lane & 3;
#pragma unroll
    for (int j = 0; j < 2; ++j) { const int n = (lane >> 2) + 16 * j; const LAS float* s = scr + (16 * c) * 33 + n; int w[4];
#pragma unroll
        for (int q = 0; q < 4; ++q) { int t = 0; t = __builtin_amdgcn_cvt_pk_fp8_f32(s[(4 * q) * 33] * 64.f, s[(4 * q + 1) * 33] * 64.f, t, false); t = __builtin_amdgcn_cvt_pk_fp8_f32(s[(4 * q + 2) * 33] * 64.f, s[(4 * q + 3) * 33] * 64.f, t, true); w[q] = t; }
        if (n0 + n < N) *(v4i*)(WT + (size_t)rm(n0 + n) * ldt + k0 + 16 * c) = (v4i){w[0], w[1], w[2], w[3]}; }
    LDS_WAIT(); asm volatile("" ::: "memory");
}
struct RmId { __device__ __forceinline__ int operator()(int n) const { return n; } };
struct RmWin { __device__ __forceinline__ int operator()(int n) const { return n < 2560 ? n : (n < 2608 ? PC_G3 + (n - 2560) : (n < 4656 ? n - 48 : (n < 4664 ? PC_IF + (n - 4656) : n - 56))); } };
struct RmGU { int up; __device__ __forceinline__ int operator()(int n) const { return 256 * (n >> 7) + (n & 127) + 128 * up; } };

__device__ __forceinline__ void mod_chunks(Frame& F, int first, int last, int stride) {
    const int tid_ = tid_opaque(), lane_ = tid_ & 63; (void)lane_;
    const float* c = INP(1); const float* w_ada = INP(2); const float* b_ada = INP(3);
    float* mod = WSP(float, WS_MOD);
    LAS float* sc = (LAS float*)F.lds; LAS float* red = (LAS float*)(F.lds + 65536);
    __syncthreads();
    { f32x4 cv[8];
#pragma unroll
      for (int j = 0; j < 8; ++j) cv[j] = *(const f32x4*)(c + 4 * tid_ + 2048 * j);
#pragma unroll
      for (int j = 0; j < 8; ++j) { f32x4 o; o.x = cv[j].x * sigm(cv[j].x); o.y = cv[j].y * sigm(cv[j].y); o.z = cv[j].z * sigm(cv[j].z); o.w = cv[j].w * sigm(cv[j].w); *(LAS f32x4*)(sc + 4 * tid_ + 2048 * j) = o; } }
    __syncthreads();
    for (int ci = first; ci < last; ci += stride) {
        const int cq = tid_ % 12, kg = tid_ / 12;
        if (tid_ < 504) {
            float acc[8][4];
#pragma unroll
            for (int b = 0; b < 8; ++b)
#pragma unroll
                for (int j = 0; j < 4; ++j) acc[b][j] = 0.f;
            const float* wp = w_ada + 48 * ci + 4 * cq;
            f32x4 wc[7], wn[7];
#pragma unroll
            for (int u = 0; u < 7; ++u) { wc[u] = __builtin_nontemporal_load((const f32x4*)(wp + (size_t)(kg + 42 * u) * 12288)); wn[u] = wc[u]; }
#pragma unroll 1
            for (int bi = 0; bi < 7; ++bi) {
                if (bi < 6) {
#pragma unroll
                    for (int u = 0; u < 7; ++u) { int k = kg + 42 * (7 * (bi + 1) + u); k = k < DM ? k : DM - 1; wn[u] = __builtin_nontemporal_load((const f32x4*)(wp + (size_t)k * 12288)); } }
#pragma unroll
                for (int u = 0; u < 7; ++u) { const int k = kg + 42 * (7 * bi + u); const bool ok = k < DM; const int kc = ok ? k : DM - 1;
#pragma unroll
                    for (int b = 0; b < 8; ++b) { const float s = ok ? sc[b * DM + kc] : 0.f;
#pragma unroll
                        for (int j = 0; j < 4; ++j) acc[b][j] += s * wc[u][j]; } }
#pragma unroll
                for (int u = 0; u < 7; ++u) wc[u] = wn[u];
            }
#pragma unroll
            for (int b = 0; b < 8; ++b)
#pragma unroll
                for (int j = 0; j < 4; ++j) red[(kg * 12 + cq) * 32 + b * 4 + j] = acc[b][j];
        }
        __syncthreads();
        if (tid_ < 384) { const int b = tid_ / 48, col = tid_ % 48, q = col >> 2, j = col & 3; float s = 0.f;
            for (int k2 = 0; k2 < 42; ++k2) s += red[(k2 * 12 + q) * 32 + b * 4 + j];
            mod[b * 12288 + 48 * ci + col] = s + b_ada[48 * ci + col]; }
        __syncthreads();
    }
}
struct TDesc { const float* W; int K, N; unsigned char* WT; int ldt; int kind; int item; int nblk, nb0; };
__device__ __forceinline__ TDesc p0_decode(Frame& F, int it) {
    constexpr int I_WIN = PROJ_MODE ? 0 : 32 * 146, I_WIN8 = PROJ_MODE ? 32 * 306 : 32 * 274, I_UP = 16 * 64, I_OUT = 32 * 64, I_SH = 32 * 16, I_SHD = 8 * 64, I_R = 32 * 2, I_EG = 64 * 512, I_C1 = 32 * 8;
    unsigned char* WeGU = WSP(unsigned char, WS_WEGU); unsigned char* WeD = WSP(unsigned char, WS_WED);
    int r = it;
    if (r < I_WIN) return TDesc{INP(6), DM, D_IN, WSP(unsigned char, WS_WIN), DM * 2, 1, r, 146, 0}; r -= I_WIN;
    if (r < I_WIN8) { if (PROJ_MODE) return TDesc{INP(6), DM, D_IN, WSP(unsigned char, WS_WIN8), DM, 6, r, 306, 0}; return TDesc{INP(6), DM, D_IN, WSP(unsigned char, WS_WIN8), DM, 5, r, 274, 32}; } r -= I_WIN8;
    if (r < I_UP) return TDesc{INP(14), 1024, DM, WSP(unsigned char, WS_WUP), 2048 * 2, 0, r, (DM + 31) / 32, 0}; r -= I_UP;
    if (r < I_UP) return TDesc{INP(15), 1024, DM, WSP(unsigned char, WS_WUP) + 1024 * 2, 2048 * 2, 0, r, (DM + 31) / 32, 0}; r -= I_UP;
    if (r < I_OUT) return TDesc{INP(16), DM, DM, WSP(unsigned char, WS_WOUT), DM * 2, 0, r, (DM + 31) / 32, 0}; r -= I_OUT;
    if (r < I_SH) return TDesc{INP(24), DM, EFF, WeGU + (size_t)64 * 1024 * DM, DM, 3, r, (EFF + 31) / 32, 0}; r -= I_SH;
    if (r < I_SH) return TDesc{INP(25), DM, EFF, WeGU + (size_t)64 * 1024 * DM, DM, 4, r, (EFF + 31) / 32, 0}; r -= I_SH;
    if (r < I_SHD) return TDesc{INP(26), EFF, DM, WeD + (size_t)64 * DM * EFF, EFF, 2, r, (DM + 31) / 32, 0}; r -= I_SHD;
    if (r < I_R) return TDesc{INP(19), DM, NEXP, WSP(unsigned char, WS_WR), DM * 2, 0, r, (NEXP + 31) / 32, 0}; r -= I_R;
    if (r < 16) { const int kv = r >> 3; return TDesc{INP(9) + (size_t)kv * 256 * 64, 256, 64, WSP(unsigned char, WS_CW2) + (size_t)kv * 64 * 256 * 2, 256 * 2, 0, r & 7, 2, 0}; } r -= 16;
    if (r < 2 * I_C1) { const int kv = r >> 8; return TDesc{INP(8) + (size_t)kv * DM * 256, DM, 256, WSP(unsigned char, WS_CW1) + (size_t)kv * 256 * DM * 2, DM * 2, 0, r & 255, (256 + 31) / 32, 0}; } r -= 2 * I_C1;
    if (r < I_EG) { const int e = r >> 9; return TDesc{INP(21) + (size_t)e * DM * EFF, DM, EFF, WeGU + (size_t)e * 1024 * DM, DM, 3, r & 511, (EFF + 31) / 32, 0}; } r -= I_EG;
    if (r < I_EG) { const int e = r >> 9; return TDesc{INP(22) + (size_t)e * DM * EFF, DM, EFF, WeGU + (size_t)e * 1024 * DM, DM, 4, r & 511, (EFF + 31) / 32, 0}; } r -= I_EG;
    { const int e = r >> 9; return TDesc{INP(23) + (size_t)e * EFF * DM, EFF, DM, WeD + (size_t)e * DM * EFF, EFF, 2, r & 511, (DM + 31) / 32, 0}; }
}
__device__ __forceinline__ void t_load(const TDesc& d, int lane, float (&v)[32]) {
    const int nblk = d.nblk, kb = d.item / nblk, nb = d.nb0 + d.item % nblk; int nn = 32 * nb + (lane & 31); nn = nn < d.N ? nn : d.N - 1;
    const float* p = d.W + (size_t)(64 * kb + (lane >> 5)) * d.N + nn;
#pragma unroll
    for (int i = 0; i < 32; ++i) v[i] = __builtin_nontemporal_load(p + (size_t)(2 * i) * d.N);
}
__device__ __forceinline__ int t_rowmap(int kind, int n) {
    if (kind == 1 || kind == 5 || kind == 6) { if (n < 1024) return n;
        if (n < 2560) { const int i = (n - 1024) >> 8, c = (n - 1024) & 255; return ((i & 1) ? PC_VC : PC_KC) + (i >> 1) * 256 + c; }
        if (n < 2608) return PC_G3 + (n - 2560); if (n < 3632) return PC_QKM + (n - 2608); if (n < 4656) return PC_VM + (n - 3632); if (n < 4664) return PC_IF + (n - 4656); return n + 200; }
    if (kind == 3 || kind == 4) return 256 * (n >> 7) + (n & 127) + 128 * (kind - 3);
    return n;
}
__device__ __forceinline__ void t_finish(const TDesc& d, int lane, LAS float* scr, const float (&v)[32]) {
    const int nblk = d.nblk, kb = d.item / nblk, nb = d.nb0 + d.item % nblk, k0 = 64 * kb, n0 = 32 * nb;
#pragma unroll
    for (int i = 0; i < 32; ++i) scr[(2 * i + (lane >> 5)) * 33 + (lane & 31)] = v[i];
    LDS_WAIT(); asm volatile("" ::: "memory");
    if (d.kind >= 2) {
        const int c = lane & 3;
#pragma unroll
        for (int j = 0; j < 2; ++j) { const int n = (lane >> 2) + 16 * j; const LAS float* s = scr + (16 * c) * 33 + n; int w[4];
#pragma unroll
            for (int q = 0; q < 4; ++q) { int t = 0; t = __builtin_amdgcn_cvt_pk_fp8_f32(s[(4 * q) * 33] * 64.f, s[(4 * q + 1) * 33] * 64.f, t, false); t = __builtin_amdgcn_cvt_pk_fp8_f32(s[(4 * q + 2) * 33] * 64.f, s[(4 * q + 3) * 33] * 64.f, t, true); w[q] = t; }
            int dr = t_rowmap(d.kind, n0 + n); bool ok = n0 + n < d.N; if (d.kind == 5) { ok = ok && dr >= PN_BF; dr -= PN_BF; }
            if (ok) *(v4i*)(d.WT + (size_t)dr * d.ldt + k0 + 16 * c) = (v4i){w[0], w[1], w[2], w[3]}; }
    } else {
        const int c = lane & 7;
#pragma unroll
        for (int j = 0; j < 4; ++j) { const int n = (lane >> 3) + 8 * j; const LAS float* s = scr + (8 * c) * 33 + n;
            v4u o; o.x = pk2(s[0 * 33], s[1 * 33]); o.y = pk2(s[2 * 33], s[3 * 33]); o.z = pk2(s[4 * 33], s[5 * 33]); o.w = pk2(s[6 * 33], s[7 * 33]);
            const int dr = t_rowmap(d.kind, n0 + n); const bool ok = (n0 + n < d.N) && (d.kind != 1 || dr < PN_BF);
            if (ok) *(v4u*)(d.WT + (size_t)dr * d.ldt + (size_t)(k0 + 8 * c) * 2) = o; }
    }
    LDS_WAIT(); asm volatile("" ::: "memory");
}
constexpr int NIT_ALL = 16 + (PROJ_MODE ? 32 * 306 : 32 * 146 + 32 * 274) + 2 * 16 * 64 + 32 * 64 + 2 * 32 * 16 + 8 * 64 + 32 * 2 + 2 * 32 * 8 + 3 * 64 * 512;
constexpr int NIT_LATE = 3 * 64 * 512, NIT_EARLY = NIT_ALL - NIT_LATE;
__device__ __forceinline__ void convert_range(Frame& F, int lo, int hi, int w, int nw) {
    const int tid_ = tid_opaque(), lane_ = tid_ & 63;
    LAS float* scr = (LAS float*)(F.lds + F.wave * 16384);
    int it = lo + w; if (it >= hi) return;
    TDesc d = p0_decode(F, it); float v[32]; t_load(d, lane_, v);
    for (;;) {
        const int itn = it + nw; const bool hn = itn < hi;
        TDesc dn = d; float vn[32];
        if (hn) { dn = p0_decode(F, itn); t_load(dn, lane_, vn); }
        t_finish(d, lane_, scr, v);
        if (!hn) break;
        d = dn; it = itn;
#pragma unroll
        for (int i = 0; i < 32; ++i) v[i] = vn[i];
    }
}
constexpr int MOD_EARLY = 86;
__device__ __forceinline__ void p0_early(Frame& F) {
    const int bx = (int)blockIdx.x;
    if (F.G <= MOD_EARLY + 8) { mod_chunks(F, bx, MOD_EARLY, F.G); convert_range(F, 0, NIT_EARLY, F.gw, F.ngw); return; }
    constexpr int SPLIT = (NIT_EARLY * 7) / 8;
    if (bx < MOD_EARLY) { mod_chunks(F, bx, MOD_EARLY, MOD_EARLY); convert_range(F, SPLIT, NIT_EARLY, bx * 8 + F.wave, MOD_EARLY * 8); }
    else convert_range(F, 0, SPLIT, (bx - MOD_EARLY) * 8 + F.wave, (F.G - MOD_EARLY) * 8);
}
constexpr int NCHUNK = 8;
__device__ __forceinline__ void convert_chunk(Frame& F, int& chunk) {
    if (chunk >= NCHUNK) return;
    const int per = (NIT_LATE + F.G - 1) / F.G, pc = (per + NCHUNK - 1) / NCHUNK;
    int lo = NIT_EARLY + (int)blockIdx.x * per + chunk * pc, hi = lo + pc; const int end = NIT_EARLY + ((int)blockIdx.x + 1) * per;
    hi = hi < end ? hi : end; hi = hi < NIT_ALL ? hi : NIT_ALL;
    __syncthreads();
    if (chunk == 0) { const int nl = 256 - MOD_EARLY; const int per_wg = (nl + F.G - 1) / F.G;
        mod_chunks(F, MOD_EARLY + (int)blockIdx.x * per_wg, (MOD_EARLY + ((int)blockIdx.x + 1) * per_wg) < 256 ? (MOD_EARLY + ((int)blockIdx.x + 1) * per_wg) : 256, 1); }
    convert_range(F, lo, hi, F.wave, 8);
    __syncthreads();
    ++chunk;
}
__device__ __forceinline__ void p0_bias1(Frame& F) {
    const int tid_ = tid_opaque(), lane_ = tid_ & 63;
    for (int o = F.gw; o < 512; o += F.ngw) { const int kv = o >> 8, j = o & 255; const float* pe = INP(7) + kv * 2048; const float* w1 = INP(8) + (size_t)kv * 2048 * 256 + j;
        float s = 0.f;
#pragma unroll 8
        for (int k = lane_; k < 2048; k += 64) s += pe[k] * w1[(size_t)k * 256];
        s = wave_sum(s); if (lane_ == 0) WSP(float, WS_BIAS1)[o] = s; }
}
__device__ __forceinline__ void p1_h1(Frame& F) {
    const int tid_ = tid_opaque(), lane_ = tid_ & 63; (void)lane_;
    const float* x = INP(0); const float* gpm = INP(4); const float* mod = WSP(float, WS_MOD); bf16* H1 = WSP(bf16, WS_H1); unsigned char* H1Q = WSP(unsigned char, WS_H1Q);
    for (int row = F.gw; row < NTOK; row += F.ngw) {
        const int b = row >> 11; const f32x4* xr = (const f32x4*)(x + (size_t)row * DM) + lane_;
        f32x4 v[8]; float s = 0.f;
#pragma unroll
        for (int j = 0; j < 8; ++j) { v[j] = xr[64 * j]; s += (v[j].x * v[j].x + v[j].y * v[j].y) + (v[j].z * v[j].z + v[j].w * v[j].w); }
        const float rstd = rsqrtf(wave_sum(s) * (1.f / DM) + EPS);
        const float* sh = mod + b * 12288; const float* scl = sh + 2048;
        int* o4 = (int*)(H1Q + (size_t)row * DM) + lane_; unsigned long long* o8 = (unsigned long long*)(H1 + (size_t)row * DM) + lane_;
#pragma unroll
        for (int j = 0; j < 8; ++j) { const int col = 4 * lane_ + 256 * j; const f32x4 g = *(const f32x4*)(gpm + col), a = *(const f32x4*)(scl + col), c = *(const f32x4*)(sh + col);
            const float r0 = v[j].x * rstd * g.x * (1.f + a.x) + c.x, r1 = v[j].y * rstd * g.y * (1.f + a.y) + c.y, r2 = v[j].z * rstd * g.z * (1.f + a.z) + c.z, r3 = v[j].w * rstd * g.w * (1.f + a.w) + c.w;
            int q8 = 0; q8 = __builtin_amdgcn_cvt_pk_fp8_f32(fminf(fmaxf(r0, -448.f), 448.f), fminf(fmaxf(r1, -448.f), 448.f), q8, false); q8 = __builtin_amdgcn_cvt_pk_fp8_f32(fminf(fmaxf(r2, -448.f), 448.f), fminf(fmaxf(r3, -448.f), 448.f), q8, true);
            o4[64 * j] = q8; if (PROJ_MODE == 0) o8[64 * j] = (unsigned long long)pk2(r0, r1) | ((unsigned long long)pk2(r2, r3) << 32); }
    }
}
__device__ __forceinline__ float gelu_tanh(float x) { const float u = 0.7978845608028654f * (x + 0.044715f * x * x * x); const float t = 1.f - 2.f * frcp(1.f + __expf(2.f * u)); return 0.5f * x * (1.f + t); }
__device__ __forceinline__ void p3_conv(Frame& F) {
    const int tid_ = tid_opaque(), lane_ = tid_ & 63; (void)lane_;
    const bf16* PROJ = WSP(bf16, WS_PROJ); bf16* QKC = WSP(bf16, WS_QKC); const float* cw = INP(10); const float* cb = INP(11);
    const int skip = F.G > 64 ? 32 : 0;
    if ((int)blockIdx.x < skip) return;
    const int c8 = (tid_ & 127) * 8, rg = F.wave >> 1;
    f32x4 w[4][2], bias[2];
#pragma unroll
    for (int i = 0; i < 4; ++i) { w[i][0] = *(const f32x4*)(cw + i * 1024 + c8); w[i][1] = *(const f32x4*)(cw + i * 1024 + c8 + 4); }
    bias[0] = *(const f32x4*)(cb + c8); bias[1] = *(const f32x4*)(cb + c8 + 4);
    const float sc = (c8 >= 512) ? 0.08838834764831845f : 1.f;
    for (int blk = (int)blockIdx.x - skip; blk < NTOK / 16; blk += F.G - skip) {
        const int r0 = blk * 16 + rg * 4; const bool head = (r0 & 2047) == 0;
        v4u q[7];
#pragma unroll
        for (int i = 0; i < 7; ++i) { const int row = (i < 3 && head) ? r0 : r0 - 3 + i; const GAS v4u* pr = UPTR(const v4u, PROJ + (size_t)row * PLD + PC_QKM) + (tid_ & 127); q[i] = *pr; }
        if (head) { q[0] = (v4u){0u, 0u, 0u, 0u}; q[1] = q[0]; q[2] = q[0]; }
#pragma unroll
        for (int o = 0; o < 4; ++o) {
            f32x4 a0 = bias[0], a1 = bias[1];
#pragma unroll
            for (int i = 0; i < 4; ++i) { const v4u x = q[o + i];
                a0 += (f32x4){bflo(x.x), bfhi(x.x), bflo(x.y), bfhi(x.y)} * w[i][0]; a1 += (f32x4){bflo(x.z), bfhi(x.z), bflo(x.w), bfhi(x.w)} * w[i][1]; }
            v4u ov; ov.x = pk2(a0.x * sigm(a0.x) * sc, a0.y * sigm(a0.y) * sc); ov.y = pk2(a0.z * sigm(a0.z) * sc, a0.w * sigm(a0.w) * sc);
            ov.z = pk2(a1.x * sigm(a1.x) * sc, a1.y * sigm(a1.y) * sc); ov.w = pk2(a1.z * sigm(a1.z) * sc, a1.w * sigm(a1.w) * sc);
            GAS v4u* po = UPTR(v4u, QKC + (size_t)(r0 + o) * 1024) + (tid_ & 127); *po = ov;
        }
    }
}
__device__ __forceinline__ void p3_gates(Frame& F) {
    const int tid_ = tid_opaque(), lane_ = tid_ & 63;
    const bf16* PROJ = WSP(bf16, WS_PROJ); const float* bg = INP(12); float* GA = WSP(float, WS_GA); float* GU = WSP(float, WS_GU); float* GM = WSP(float, WS_GM);
    LAS float* ex = (LAS float*)F.lds;
    for (int bh = (int)blockIdx.x; bh < 32; bh += F.G) {
        const int b = bh >> 2, h = bh & 3; float carryA = 0.f, cmax = -INFINITY; float Al[4], ul[4], Ml[4];
#pragma unroll
        for (int k = 0; k < 4; ++k) {
            const int t = F.wave * 256 + k * 64 + lane_; const bf16* pr = PROJ + (size_t)(b * SEQ + t) * PLD + PC_IF;
            const float ip = bf2f(pr[h]) + bg[h], fp = bf2f(pr[4 + h]) + bg[4 + h];
            const float lf = fminf(fp, 0.f) - log1pf(__expf(-fabsf(fp)));
            float A = lf;
#pragma unroll
            for (int o = 1; o < 64; o <<= 1) { const float n = __shfl_up(A, o); if (lane_ >= o) A += n; }
            A += carryA;
            const float u = ip - A; float M = u;
#pragma unroll
            for (int o = 1; o < 64; o <<= 1) { const float n = __shfl_up(M, o); if (lane_ >= o) M = fmaxf(M, n); }
            M = fmaxf(M, cmax);
            Al[k] = A; ul[k] = u; Ml[k] = M;
            carryA = rdlane(A, 63); cmax = rdlane(M, 63);
        }
        __syncthreads();
        if (lane_ == 0) { ex[2 * F.wave] = carryA; ex[2 * F.wave + 1] = cmax; }
        __syncthreads();
        float CA = 0.f, CM = 0.f;
        for (int w = 0; w < F.wave; ++w) { CM = fmaxf(CM, ex[2 * w + 1] - CA); CA += ex[2 * w]; }
#pragma unroll
        for (int k = 0; k < 4; ++k) { const int t = F.wave * 256 + k * 64 + lane_;
            GA[bh * SEQ + t] = (Al[k] + CA) * 1.4426950408889634f; GU[bh * SEQ + t] = (ul[k] - CA) * 1.4426950408889634f; GM[bh * SEQ + t] = fmaxf(Ml[k] - CA, CM) * 1.4426950408889634f; }
    }
    __syncthreads();
}
__device__ __forceinline__ void p4_kcv(Frame& F) {
    const int tid_ = tid_opaque(), lane_ = tid_ & 63; (void)lane_;
    const bf16* HIDC = WSP(bf16, WS_HIDC); bf16* KCB = WSP(bf16, WS_KCV); const float* w2 = INP(9);
    const int gt = blockIdx.x * 512 + tid_, ngt = F.G * 512;
    for (int idx = gt; idx < 8128 * 64; idx += ngt) {
        const int r = idx >> 6, d = idx & 63, kv = r / 4064, rr = r % 4064, b = rr / 508, n = (rr % 508) >> 2, g = rr & 3;
        const bf16* hrow = HIDC + ((size_t)kv * 4096 + rr) * 256; const float* w = w2 + kv * 256 * 64 + d; float s = 0.f;
#pragma unroll 8
        for (int j = 0; j < 256; ++j) s += bf2f(hrow[j]) * w[j * 64];
        KCB[((size_t)((kv * 8 + b) * 4 + g) * 128 + n) * 64 + d] = (bf16)f2bf(s);
    }
    for (int idx = gt; idx < 64 * 64; idx += ngt) { const int q = idx >> 6, d = idx & 63; KCB[((size_t)q * 128 + 127) * 64 + d] = 0; }
}
__device__ __forceinline__ void kcv_unit(Frame& F, int kv, int pm) {
    const int tid_ = tid_opaque(), lane_ = tid_ & 63, fr = lane_ & 15, fq = lane_ >> 4;
    const bf16* HIDC = WSP(bf16, WS_HIDC) + ((size_t)kv * 4096 + pm * 256) * 256; const bf16* w2t = WSP(bf16, WS_CW2) + (size_t)kv * 64 * 256; bf16* KCB = WSP(bf16, WS_KCV);
    asm volatile("s_waitcnt vmcnt(0)" ::: "memory"); __syncthreads();
#pragma unroll
    for (int rb = 0; rb < 2; ++rb) {
        const int r0 = F.wave * 32 + rb * 16;
        f32x4 acc[4];
#pragma unroll
        for (int db = 0; db < 4; ++db) acc[db] = (f32x4){0.f, 0.f, 0.f, 0.f};
#pragma unroll
        for (int ks = 0; ks < 8; ++ks) { const bf16x8 a = *(const bf16x8*)(HIDC + (size_t)(r0 + fr) * 256 + ks * 32 + fq * 8);
#pragma unroll
            for (int db = 0; db < 4; ++db) { const bf16x8 bb = *(const bf16x8*)(w2t + (size_t)(db * 16 + fr) * 256 + ks * 32 + fq * 8); acc[db] = __builtin_amdgcn_mfma_f32_16x16x32_bf16(a, bb, acc[db], 0, 0, 0); } }
#pragma unroll
        for (int reg = 0; reg < 4; ++reg) { const int rr = pm * 256 + r0 + 4 * fq + reg; if (rr < 4064) { const int b = rr / 508, n = (rr % 508) >> 2, g = rr & 3;
#pragma unroll
            for (int db = 0; db < 4; ++db) KCB[((size_t)((kv * 8 + b) * 4 + g) * 128 + n) * 64 + db * 16 + fr] = (bf16)f2bf(acc[db][reg]); } }
    }
    if (blockIdx.x == 0) for (int idx = tid_; idx < 64 * 64; idx += 512) { const int q = idx >> 6, d = idx & 63; KCB[((size_t)q * 128 + 127) * 64 + d] = 0; }
}
namespace fa {
typedef float f32x16 __attribute__((ext_vector_type(16)));
typedef short s16x4 __attribute__((ext_vector_type(4)));
typedef float f32x2_t __attribute__((ext_vector_type(2))); typedef __bf16 bf16x2_t __attribute__((ext_vector_type(2)));
constexpr int SLOTB = 8192, NSLOTS = 3, NKS = 4;
constexpr int LDS_K = 0, LDS_V = NKS * SLOTB, LDS_WS = LDS_V + NSLOTS * SLOTB, LDS_OST = LDS_WS + 8 * 1024, LDS_AUX = LDS_OST + 8 * 8192;
static_assert(LDS_AUX <= RING_BYTES, "attention lds");
__device__ __forceinline__ int crow(int r, int hi) { return (r & 3) + 8 * (r >> 2) + 4 * hi; }
__device__ __forceinline__ constexpr int crow0(int r) { return (r & 3) + 8 * (r >> 2); }
#define FA_SBAR() __builtin_amdgcn_sched_barrier(0)
__device__ __forceinline__ void glds16(const void* gsrc, unsigned lds_dst) { unsigned keep;
    asm volatile("s_mov_b32 %0, m0\n\ts_mov_b32 m0, %2\n\ts_nop 0\n\tglobal_load_lds_dwordx4 %1, off\n\ts_mov_b32 m0, %0" : "=&s"(keep) : "v"(gsrc), "s"(lds_dst) : "memory"); }
__device__ __forceinline__ unsigned cvtpk_s(float lo, float hi) { f32x2_t v = {lo, hi}; bf16x2_t b = __builtin_convertvector(v, bf16x2_t); return __builtin_bit_cast(unsigned, b); }
#define FA_WAIT_BAR(N) asm volatile("s_waitcnt vmcnt(" #N ") lgkmcnt(0)\n\ts_barrier" ::: "memory")
__device__ __forceinline__ void qkt(f32x16& p0, f32x16& p1, const LAS char* kb, const bf16x8* qr, const f32x16& c0) {
#pragma unroll
    for (int d0 = 0; d0 < 4; ++d0) {
        const bf16x8 b0 = *(const LAS bf16x8*)(kb + d0 * 2048);
        const bf16x8 b1 = *(const LAS bf16x8*)(kb + d0 * 2048 + 512);
        if (d0 == 0) { p0 = __builtin_amdgcn_mfma_f32_32x32x16_bf16(b0, qr[0], c0, 0, 0, 0); p1 = __builtin_amdgcn_mfma_f32_32x32x16_bf16(b1, qr[0], c0, 0, 0, 0); }
        else { p0 = __builtin_amdgcn_mfma_f32_32x32x16_bf16(b0, qr[d0], p0, 0, 0, 0); p1 = __builtin_amdgcn_mfma_f32_32x32x16_bf16(b1, qr[d0], p1, 0, 0, 0); }
        __builtin_amdgcn_sched_barrier(0xF); }
}
__device__ __forceinline__ float rowmax(const f32x16& p0, const f32x16& p1) {
    float a = fmaxf(fmaxf(p0[0], p0[1]), p1[0]), b = fmaxf(fmaxf(p0[2], p0[3]), p1[1]); a = fmaxf(fmaxf(a, p1[2]), p1[3]);
#pragma unroll
    for (int r = 4; r < 16; r += 4) { a = fmaxf(fmaxf(a, p0[r]), p0[r + 1]); b = fmaxf(fmaxf(b, p0[r + 2]), p0[r + 3]); a = fmaxf(fmaxf(a, p1[r]), p1[r + 1]); b = fmaxf(fmaxf(b, p1[r + 2]), p1[r + 3]); }
    const float m = fmaxf(a, b);
    auto rr = __builtin_amdgcn_permlane32_swap(__float_as_uint(m), __float_as_uint(m), false, false);
    return fmaxf(__uint_as_float(rr[0]), __uint_as_float(rr[1]));
}
__device__ __forceinline__ float swap_add(float v) { auto rr = __builtin_amdgcn_permlane32_swap(__float_as_uint(v), __float_as_uint(v), false, false); return __uint_as_float(rr[0]) + __uint_as_float(rr[1]); }
__device__ __forceinline__ void pv(f32x16* o, int vb, bf16x8 pa0, bf16x8 pa1, bf16x8 pa2, bf16x8 pa3) {
#pragma unroll
    for (int d0 = 0; d0 < 2; ++d0) { s16x4 lo[4], hi[4];
#pragma unroll
        for (int ks = 0; ks < 4; ++ks) {
            asm volatile("ds_read_b64_tr_b16 %0,%1 offset:%c2" : "=&v"(lo[ks]) : "v"(vb), "i"(d0 * 4096 + ks * 1024) : "memory");
            asm volatile("ds_read_b64_tr_b16 %0,%1 offset:%c2" : "=&v"(hi[ks]) : "v"(vb), "i"(d0 * 4096 + ks * 1024 + 512) : "memory"); }
        asm volatile("s_waitcnt lgkmcnt(0)" ::: "memory"); FA_SBAR();
#define FA_PK(k) (bf16x8){lo[k][0], lo[k][1], lo[k][2], lo[k][3], hi[k][0], hi[k][1], hi[k][2], hi[k][3]}
        o[d0] = __builtin_amdgcn_mfma_f32_32x32x16_bf16(pa0, FA_PK(0), o[d0], 0, 0, 0);
        o[d0] = __builtin_amdgcn_mfma_f32_32x32x16_bf16(pa1, FA_PK(1), o[d0], 0, 0, 0);
        o[d0] = __builtin_amdgcn_mfma_f32_32x32x16_bf16(pa2, FA_PK(2), o[d0], 0, 0, 0);
        o[d0] = __builtin_amdgcn_mfma_f32_32x32x16_bf16(pa3, FA_PK(3), o[d0], 0, 0, 0);
#undef FA_PK
    }
}
typedef short v4i16_t __attribute__((ext_vector_type(4)));
__device__ __forceinline__ s16x4 vtr(const LAS char* p) { return __builtin_bit_cast(s16x4, __builtin_amdgcn_ds_read_tr16_b64_v4i16((LAS v4i16_t*)p)); }
__device__ __forceinline__ void pv2(f32x16* o, const LAS char* vp, bf16x8 pa0, bf16x8 pa1, bf16x8 pa2, bf16x8 pa3) {
#pragma unroll
    for (int d0 = 0; d0 < 2; ++d0) {
        s16x4 lo[4], hi[4];
#pragma unroll
        for (int ks = 0; ks < 4; ++ks) { lo[ks] = vtr(vp + d0 * 4096 + ks * 1024); hi[ks] = vtr(vp + d0 * 4096 + ks * 1024 + 512); }
#define FA_PK(k) (bf16x8){lo[k][0], lo[k][1], lo[k][2], lo[k][3], hi[k][0], hi[k][1], hi[k][2], hi[k][3]}
        o[d0] = __builtin_amdgcn_mfma_f32_32x32x16_bf16(pa0, FA_PK(0), o[d0], 0, 0, 0);
        o[d0] = __builtin_amdgcn_mfma_f32_32x32x16_bf16(pa1, FA_PK(1), o[d0], 0, 0, 0);
        o[d0] = __builtin_amdgcn_mfma_f32_32x32x16_bf16(pa2, FA_PK(2), o[d0], 0, 0, 0);
        o[d0] = __builtin_amdgcn_mfma_f32_32x32x16_bf16(pa3, FA_PK(3), o[d0], 0, 0, 0);
#undef FA_PK
        __builtin_amdgcn_sched_barrier(0xF);
    }
}
struct Soft { float mhat, l; f32x16 o[2]; f32x16 negm; };
__device__ __forceinline__ void qk_half(f32x16& p, const LAS char* kbh, const bf16x8* qr) {
    const f32x16 zero = f32x16{};
#pragma unroll
    for (int d0 = 0; d0 < 4; ++d0) { const bf16x8 b = *(const LAS bf16x8*)(kbh + d0 * 2048); p = __builtin_amdgcn_mfma_f32_32x32x16_bf16(b, qr[d0], d0 == 0 ? zero : p, 0, 0, 0); }
}
__device__ __forceinline__ float rowmax16(const f32x16& p) {
    float a = fmaxf(fmaxf(p[0], p[1]), p[2]), b = fmaxf(fmaxf(p[3], p[4]), p[5]);
    a = fmaxf(fmaxf(a, p[6]), p[7]); b = fmaxf(fmaxf(b, p[8]), p[9]); a = fmaxf(fmaxf(a, p[10]), p[11]); b = fmaxf(fmaxf(b, p[12]), p[13]); a = fmaxf(fmaxf(a, p[14]), p[15]);
    const float m = fmaxf(a, b);
    auto rr = __builtin_amdgcn_permlane32_swap(__float_as_uint(m), __float_as_uint(m), false, false);
    return fmaxf(__uint_as_float(rr[0]), __uint_as_float(rr[1]));
}
__device__ __forceinline__ void soft_half(Soft& s, f32x16& p, const LAS char* vph, LAS float* wsf, int r32, int hi) {
    const float rm = rowmax16(p) - s.mhat;
    if (__any(rm > 8.f)) {
        const float dl = fmaxf(rm, 0.f); s.mhat += dl;
        const float f = __builtin_amdgcn_exp2f(-dl); s.l *= f; if (hi == 0) wsf[r32] = f;
        LDS_WAIT(); asm volatile("" ::: "memory");
        const LAS float* wh = wsf + 4 * hi;
#pragma unroll
        for (int d = 0; d < 2; ++d)
#pragma unroll
            for (int r = 0; r < 16; ++r) s.o[d][r] *= wh[crow0(r)];
        LDS_WAIT(); asm volatile("" ::: "memory");
    }
    float sa = 0.f; const float mh = s.mhat;
#pragma unroll
    for (int r = 0; r < 16; ++r) { p[r] = __builtin_amdgcn_exp2f(p[r] - mh); sa += p[r]; }
    s.l += sa;
    const v4u pw0 = (v4u){cvtpk_s(p[0], p[1]), cvtpk_s(p[2], p[3]), cvtpk_s(p[4], p[5]), cvtpk_s(p[6], p[7])};
    const v4u pw1 = (v4u){cvtpk_s(p[8], p[9]), cvtpk_s(p[10], p[11]), cvtpk_s(p[12], p[13]), cvtpk_s(p[14], p[15])};
#pragma unroll
    for (int d0 = 0; d0 < 2; ++d0) {
        const s16x4 l0 = vtr(vph + d0 * 4096), h0 = vtr(vph + d0 * 4096 + 512), l1 = vtr(vph + d0 * 4096 + 1024), h1 = vtr(vph + d0 * 4096 + 1536);
        s.o[d0] = __builtin_amdgcn_mfma_f32_32x32x16_bf16(__builtin_bit_cast(bf16x8, pw0), (bf16x8){l0[0], l0[1], l0[2], l0[3], h0[0], h0[1], h0[2], h0[3]}, s.o[d0], 0, 0, 0);
        s.o[d0] = __builtin_amdgcn_mfma_f32_32x32x16_bf16(__builtin_bit_cast(bf16x8, pw1), (bf16x8){l1[0], l1[1], l1[2], l1[3], h1[0], h1[1], h1[2], h1[3]}, s.o[d0], 0, 0, 0);
    }
}
struct P8 { f32x2 v[8]; };
__device__ __forceinline__ void qk_half_c(f32x16& p, const LAS char* kbh, const bf16x8* qr, const f32x16& negm) {
#pragma unroll
    for (int d0 = 0; d0 < 4; ++d0) { const bf16x8 b = *(const LAS bf16x8*)(kbh + d0 * 2048); p = __builtin_amdgcn_mfma_f32_32x32x16_bf16(b, qr[d0], d0 == 0 ? negm : p, 0, 0, 0); }
}
__device__ __forceinline__ void soft_half_c(Soft& s, f32x16& pin, f32x16& nx, const LAS char* vph, LAS float* wsf, int r32, int hi) {
    P8 p = __builtin_bit_cast(P8, pin);
    const float rm = rowmax16(pin);
    if (__any(rm > 8.f)) {
        const float dl = fmaxf(rm, 0.f); s.mhat += dl; const f32x2 d2 = {dl, dl};
        P8 n = __builtin_bit_cast(P8, nx);
#pragma unroll
        for (int i = 0; i < 8; ++i) { p.v[i] = p.v[i] - d2; n.v[i] = n.v[i] - d2; }
        nx = __builtin_bit_cast(f32x16, n);
#pragma unroll
        for (int r = 0; r < 16; ++r) s.negm[r] = -s.mhat;
        const float f = __builtin_amdgcn_exp2f(-dl); s.l *= f; if (hi == 0) wsf[r32] = f;
        LDS_WAIT(); asm volatile("" ::: "memory");
        const LAS float* wh = wsf + 4 * hi;
#pragma unroll
        for (int d = 0; d < 2; ++d)
#pragma unroll
            for (int r = 0; r < 16; ++r) s.o[d][r] *= wh[crow0(r)];
        LDS_WAIT(); asm volatile("" ::: "memory");
    }
#pragma unroll
    for (int i = 0; i < 8; ++i) { p.v[i].x = __builtin_amdgcn_exp2f(p.v[i].x); p.v[i].y = __builtin_amdgcn_exp2f(p.v[i].y); }
    f32x2 acc = (p.v[0] + p.v[1]) + (p.v[2] + p.v[3]); acc += (p.v[4] + p.v[5]) + (p.v[6] + p.v[7]);
    s.l += acc.x + acc.y;
    const v4u pw0 = (v4u){cvtpk_s(p.v[0].x, p.v[0].y), cvtpk_s(p.v[1].x, p.v[1].y), cvtpk_s(p.v[2].x, p.v[2].y), cvtpk_s(p.v[3].x, p.v[3].y)};
    const v4u pw1 = (v4u){cvtpk_s(p.v[4].x, p.v[4].y), cvtpk_s(p.v[5].x, p.v[5].y), cvtpk_s(p.v[6].x, p.v[6].y), cvtpk_s(p.v[7].x, p.v[7].y)};
#pragma unroll
    for (int d0 = 0; d0 < 2; ++d0) {
        const s16x4 l0 = vtr(vph + d0 * 4096), h0 = vtr(vph + d0 * 4096 + 512), l1 = vtr(vph + d0 * 4096 + 1024), h1 = vtr(vph + d0 * 4096 + 1536);
        s.o[d0] = __builtin_amdgcn_mfma_f32_32x32x16_bf16(__builtin_bit_cast(bf16x8, pw0), (bf16x8){l0[0], l0[1], l0[2], l0[3], h0[0], h0[1], h0[2], h0[3]}, s.o[d0], 0, 0, 0);
        s.o[d0] = __builtin_amdgcn_mfma_f32_32x32x16_bf16(__builtin_bit_cast(bf16x8, pw1), (bf16x8){l1[0], l1[1], l1[2], l1[3], h1[0], h1[1], h1[2], h1[3]}, s.o[d0], 0, 0, 0);
    }
}
__device__ __forceinline__ void mask_causal_h(f32x16& p, int tq, int hi, int half) {
#pragma unroll
    for (int r = 0; r < 16; ++r) { if (32 * half + crow(r, hi) > tq) p[r] = -INFINITY; }
}
__device__ __forceinline__ void mask_anti_h(f32x16& p, int tq, int hi, int half) {
#pragma unroll
    for (int r = 0; r < 16; ++r) { if (32 * half + crow(r, hi) <= tq) p[r] = -INFINITY; }
}
__device__ __forceinline__ void mask_all_h(f32x16& p, bool kill) {
#pragma unroll
    for (int r = 0; r < 16; ++r) p[r] = kill ? -INFINITY : p[r];
}
__device__ __forceinline__ void soft_reset(Soft& s) { s.mhat = 0.f; s.l = 0.f; s.o[0] = f32x16{}; s.o[1] = f32x16{}; s.negm = f32x16{}; asm volatile("" : "+v"(s.negm)); }
__device__ __forceinline__ void soft_step(Soft& s, f32x16& p0, f32x16& p1, int vb, LAS float* wsf, int r32, int hi) {
    const float rm = rowmax(p0, p1);
    if (__any(rm > 8.f)) {
        const float dl = fmaxf(rm, 0.f); s.mhat += dl;
#pragma unroll
        for (int r = 0; r < 16; ++r) { p0[r] -= dl; p1[r] -= dl; }
#pragma unroll
        for (int r = 0; r < 16; ++r) s.negm[r] = -s.mhat;
        asm volatile("" : "+v"(s.negm));
        const float f = exp2f(-dl); s.l *= f; if (hi == 0) wsf[r32] = f;
        LDS_WAIT(); asm volatile("" ::: "memory");
#pragma unroll
        for (int d = 0; d < 2; ++d)
#pragma unroll
            for (int r = 0; r < 16; ++r) s.o[d][r] *= wsf[crow(r, hi)];
        LDS_WAIT(); asm volatile("" ::: "memory");
    }
    float sacc = 0.f;
#pragma unroll
    for (int r = 0; r < 16; ++r) { p0[r] = exp2f(p0[r]); p1[r] = exp2f(p1[r]); sacc += p0[r] + p1[r]; }
    s.l += sacc;
    v4u pw0, pw1, pw2, pw3;
    pw0 = (v4u){cvtpk_s(p0[0], p0[1]), cvtpk_s(p0[2], p0[3]), cvtpk_s(p0[4], p0[5]), cvtpk_s(p0[6], p0[7])};
    pw1 = (v4u){cvtpk_s(p0[8], p0[9]), cvtpk_s(p0[10], p0[11]), cvtpk_s(p0[12], p0[13]), cvtpk_s(p0[14], p0[15])};
    pw2 = (v4u){cvtpk_s(p1[0], p1[1]), cvtpk_s(p1[2], p1[3]), cvtpk_s(p1[4], p1[5]), cvtpk_s(p1[6], p1[7])};
    pw3 = (v4u){cvtpk_s(p1[8], p1[9]), cvtpk_s(p1[10], p1[11]), cvtpk_s(p1[12], p1[13]), cvtpk_s(p1[14], p1[15])};
    pv(s.o, vb, __builtin_bit_cast(bf16x8, pw0), __builtin_bit_cast(bf16x8, pw1), __builtin_bit_cast(bf16x8, pw2), __builtin_bit_cast(bf16x8, pw3));
}
__device__ __forceinline__ void soft_step2(Soft& s, f32x16& p0, f32x16& p1, const LAS char* vp, LAS float* wsf, int r32, int hi) {
    const float rm = rowmax(p0, p1) - s.mhat;
    if (__any(rm > 8.f)) {
        const float dl = fmaxf(rm, 0.f); s.mhat += dl;
        const float f = __builtin_amdgcn_exp2f(-dl); s.l *= f; if (hi == 0) wsf[r32] = f;
        LDS_WAIT(); asm volatile("" ::: "memory");
        const LAS float* wh = wsf + 4 * hi;
#pragma unroll
        for (int d = 0; d < 2; ++d)
#pragma unroll
            for (int r = 0; r < 16; ++r) s.o[d][r] *= wh[crow0(r)];
        LDS_WAIT(); asm volatile("" ::: "memory");
    }
    float sa = 0.f, sb = 0.f; const float mh = s.mhat;
#pragma unroll
    for (int r = 0; r < 16; ++r) { p0[r] = __builtin_amdgcn_exp2f(p0[r] - mh); p1[r] = __builtin_amdgcn_exp2f(p1[r] - mh); sa += p0[r]; sb += p1[r]; }
    s.l += sa + sb;
    v4u pw0, pw1, pw2, pw3;
    pw0 = (v4u){cvtpk_s(p0[0], p0[1]), cvtpk_s(p0[2], p0[3]), cvtpk_s(p0[4], p0[5]), cvtpk_s(p0[6], p0[7])};
    pw1 = (v4u){cvtpk_s(p0[8], p0[9]), cvtpk_s(p0[10], p0[11]), cvtpk_s(p0[12], p0[13]), cvtpk_s(p0[14], p0[15])};
    pw2 = (v4u){cvtpk_s(p1[0], p1[1]), cvtpk_s(p1[2], p1[3]), cvtpk_s(p1[4], p1[5]), cvtpk_s(p1[6], p1[7])};
    pw3 = (v4u){cvtpk_s(p1[8], p1[9]), cvtpk_s(p1[10], p1[11]), cvtpk_s(p1[12], p1[13]), cvtpk_s(p1[14], p1[15])};
    pv2(s.o, vp, __builtin_bit_cast(bf16x8, pw0), __builtin_bit_cast(bf16x8, pw1), __builtin_bit_cast(bf16x8, pw2), __builtin_bit_cast(bf16x8, pw3));
}
__device__ __forceinline__ void soft_finish(Soft& s, f32x16* tot, float gate, LAS float* wsf, int r32, int hi) {
    const float lt = swap_add(s.l); const float fac = (lt > 0.f) ? gate / lt : 0.f;
    if (hi == 0) wsf[32 + r32] = fac;
    LDS_WAIT(); asm volatile("" ::: "memory");
#pragma unroll
    for (int r = 0; r < 16; ++r) { const float f = wsf[32 + crow(r, hi)]; tot[0][r] += s.o[0][r] * f; tot[1][r] += s.o[1][r] * f; }
    LDS_WAIT(); asm volatile("" ::: "memory");
    soft_reset(s);
}
__device__ __forceinline__ void soft_finish_stage(Soft& s, LAS float* stg, bool first, float gate, LAS float* wsf, int r32, int hi) {
    const float lt = swap_add(s.l); const float fac = (lt > 0.f) ? gate / lt : 0.f;
    if (hi == 0) wsf[32 + r32] = fac;
    LDS_WAIT(); asm volatile("" ::: "memory");
#pragma unroll
    for (int r = 0; r < 16; ++r) { const float f = (wsf + 32 + 4 * hi)[crow0(r)]; LAS float* sp = (stg + 4 * hi * 64 + r32) + crow0(r) * 64;
        if (first) { sp[0] = s.o[0][r] * f; sp[32] = s.o[1][r] * f; } else { sp[0] += s.o[0][r] * f; sp[32] += s.o[1][r] * f; } }
    LDS_WAIT(); asm volatile("" ::: "memory");
    soft_reset(s);
}
__device__ __forceinline__ void mask_causal(f32x16& p0, f32x16& p1, int tq, int hi) {
#pragma unroll
    for (int r = 0; r < 16; ++r) { const int kv = crow(r, hi); if (kv > tq) p0[r] = -INFINITY; if (kv + 32 > tq) p1[r] = -INFINITY; }
}
__device__ __forceinline__ void mask_anti(f32x16& p0, f32x16& p1, int tq, int hi) {
#pragma unroll
    for (int r = 0; r < 16; ++r) { const int kv = crow(r, hi); if (kv <= tq) p0[r] = -INFINITY; if (kv + 32 <= tq) p1[r] = -INFINITY; }
}
__device__ __forceinline__ void mask_all(f32x16& p0, f32x16& p1, bool kill) {
#pragma unroll
    for (int r = 0; r < 16; ++r) { p0[r] = kill ? -INFINITY : p0[r]; p1[r] = kill ? -INFINITY : p1[r]; }
}

__device__ __forceinline__ void sel_win_unit(LAS unsigned char* shm, int b, int g, int tb, const bf16* PROJ, const unsigned* SELM, const float* OACC, bf16* ONSA) {
    const int tid = tid_opaque(), lane = tid & 63, r32 = lane & 31, hi = lane >> 5; const int wid = __builtin_amdgcn_readfirstlane(tid >> 6);
    const int hh = wid & 3, th = wid >> 2, head = g * 4 + hh, tq = th * 32 + r32, t = tb * 64 + tq; const size_t row = (size_t)b * SEQ + t;
    const unsigned lds0 = (unsigned)(uintptr_t)shm;
    LAS float* wsf = (LAS float*)(shm + LDS_WS) + wid * 256;
    const bf16* bbase = PROJ + (size_t)b * SEQ * PLD + g * 64;
    const int nsel = tb + 1, jlo = (tb > 8) ? tb - 8 : 0, ntot = nsel + (tb - jlo + 1);
#define FA_KOFF(l_) ((unsigned)((l_) * PLD + wid * 8) * 2u)
#define FA_VOFF(l_) ((unsigned)((16 * (wid & 3) + ((l_) >> 2)) * PLD + (wid >> 2) * 32 + ((l_) & 3) * 8) * 2u)
    const unsigned koff_ = FA_KOFF(lane), voff_ = FA_VOFF(lane);
    const unsigned kdst = lds0 + LDS_K + wid * 1024, vdst = lds0 + LDS_V + wid * 1024;
#define FA_TILE(i) const int i_ = (i); const bool w_ = i_ >= nsel; const int j_ = w_ ? jlo + i_ - nsel : i_; const bf16* tb_ = bbase + (size_t)(j_ * 64) * PLD + (w_ ? PC_KW : PC_KS); const bf16* tv_ = bbase + (size_t)(j_ * 64) * PLD + (w_ ? PC_VW : PC_VS)
#define FA_ISSUE_K(i) do { if ((i) < ntot) { FA_TILE(i); glds16((const char*)tb_ + koff_, (unsigned)__builtin_amdgcn_readfirstlane(kdst + (unsigned)((i_ % NKS) * SLOTB))); } } while (0)
#define FA_ISSUE_V(i) do { if ((i) < ntot) { FA_TILE(i); glds16((const char*)tv_ + voff_, (unsigned)__builtin_amdgcn_readfirstlane(vdst + (unsigned)((i_ % NSLOTS) * SLOTB))); } } while (0)
    const bf16* prow = PROJ + row * PLD;
    bf16x8 qr[4];
#pragma unroll
    for (int d0 = 0; d0 < 4; ++d0) qr[d0] = *(const bf16x8*)(prow + PC_Q + head * 64 + d0 * 16 + hi * 8);
    if (hi == 0) { wsf[64 + r32] = sigm(bf2f(prow[PC_G3 + head * 3 + 1])); wsf[96 + r32] = sigm(bf2f(prow[PC_G3 + head * 3 + 2])); ((LAS unsigned*)wsf)[128 + r32] = __hip_atomic_load(SELM + (size_t)(b * 4 + g) * SEQ + t, RLX_AGENT); }
    FA_ISSUE_K(0); FA_ISSUE_V(0); FA_ISSUE_K(1); FA_ISSUE_K(2); FA_ISSUE_V(1);
    Soft st; soft_reset(st);
    LAS float* stg = (LAS float*)(shm + LDS_OST) + wid * 2048;
    const LAS char* kp0 = (const LAS char*)shm + LDS_K + hi * 1024 + r32 * 16;
    const LAS char* vp0 = (const LAS char*)shm + LDS_V + ((lane >> 4) & 1) * 32 + (lane & 3) * 8 + (4 * hi + ((lane & 15) >> 2)) * 64;
    if (ntot >= 3) { FA_WAIT_BAR(4); } else { FA_WAIT_BAR(3); }
    f32x16 sa_, sb_;
    qk_half_c(sa_, kp0, qr, st.negm); sb_ = sa_;
    for (int i = 0; i < ntot; ++i) {
        if (i + 2 < ntot) { FA_WAIT_BAR(2); } else if (i + 1 < ntot) { FA_WAIT_BAR(1); } else { FA_WAIT_BAR(0); }
        FA_ISSUE_K(i + 3); FA_ISSUE_V(i + 2);
        const bool issel = i < nsel; const int j = issel ? i : jlo + i - nsel;
        const int mcase = (j == tb) ? 1 : ((!issel && j == tb - 8) ? 2 : 0);
        bool kill = false; if (issel) { const unsigned mask = ((const LAS unsigned*)wsf)[128 + r32]; kill = !((mask >> i) & 1u); }
        const bool anyk = __any(kill);
        const LAS char* vpi = vp0 + (i % NSLOTS) * SLOTB;
        qk_half_c(sb_, kp0 + (i % NKS) * SLOTB + 512, qr, st.negm);
        if (anyk) mask_all_h(sa_, kill);
        if (mcase == 1) mask_causal_h(sa_, tq, hi, 0); else if (mcase == 2) mask_anti_h(sa_, tq, hi, 0);
        soft_half_c(st, sa_, sb_, vpi, wsf, r32, hi);
        if (i + 1 < ntot) qk_half_c(sa_, kp0 + ((i + 1) % NKS) * SLOTB, qr, st.negm);
        if (anyk) mask_all_h(sb_, kill);
        if (mcase == 1) mask_causal_h(sb_, tq, hi, 1); else if (mcase == 2) mask_anti_h(sb_, tq, hi, 1);
        soft_half_c(st, sb_, sa_, vpi + 2048, wsf, r32, hi);
        if (i == nsel - 1) { const float mo = st.mhat; soft_finish_stage(st, stg, true, wsf[64 + r32], wsf, r32, hi);
#pragma unroll
            for (int r = 0; r < 16; ++r) sa_[r] += mo; }
    }
    soft_finish_stage(st, stg, false, wsf[96 + r32], wsf, r32, hi);
    const size_t rowbase = (size_t)b * SEQ + tb * 64 + th * 32;
    { float t0[16], t1[16];
#pragma unroll
        for (int r = 0; r < 16; ++r) { const float* oa = OACC + (rowbase + crow(r, hi)) * 1024 + head * 64 + r32; const LAS float* sp = (stg + 4 * hi * 64 + r32) + crow0(r) * 64; t0[r] = sp[0] + oa[0]; t1[r] = sp[32] + oa[32]; }
        LDS_WAIT(); asm volatile("" ::: "memory");
        LAS bf16* sb = (LAS bf16*)stg;
#pragma unroll
        for (int r = 0; r < 16; ++r) { LAS bf16* bp = (sb + 4 * hi * 64 + r32) + crow0(r) * 64; bp[0] = (bf16)f2bf(t0[r]); bp[32] = (bf16)f2bf(t1[r]); }
        LDS_WAIT(); asm volatile("" ::: "memory");
#pragma unroll
        for (int i = 0; i < 4; ++i) { const int rr = i * 8 + (lane >> 3), ch = lane & 7; const v4u v = *(const LAS v4u*)(sb + rr * 64 + ch * 8); *(v4u*)(ONSA + (rowbase + rr) * 2048 + head * 64 + ch * 8) = v; } }
    asm volatile("s_waitcnt lgkmcnt(0)\n\ts_barrier" ::: "memory");
#undef FA_TILE
#undef FA_ISSUE_K
#undef FA_ISSUE_V
#undef FA_KOFF
#undef FA_VOFF
}
}
namespace cs {
using fa::f32x16; using fa::crow; using fa::glds16; using fa::cvtpk_s; using fa::pv; using fa::swap_add; using fa::qkt; using fa::rowmax;
constexpr int C_K = 0, C_V = 16384, C_WS = 32768, C_OWN = 34816, TBW = 32 * 33, C_CAR = C_OWN + 8 * TBW * 4, C_IMP = C_CAR + 8 * TBW * 4, C_END = C_IMP + 64 * 33 * 4;
static_assert(C_END <= RING_BYTES, "cmp lds");
__device__ __forceinline__ void mask_nv(f32x16& p0, f32x16& p1, int base, int nvalid, int hi) {
#pragma unroll
    for (int r = 0; r < 16; ++r) { const int n = base + crow(r, hi); if (n >= nvalid) p0[r] = -INFINITY; if (n + 32 >= nvalid) p1[r] = -INFINITY; }
}
__device__ __forceinline__ void imp_tile(const f32x16& p0, const f32x16& p1, LAS float* own, LAS float* car, int jt, int hi) {
#pragma unroll
    for (int a = 0; a < 4; ++a) {
        const int j0 = jt + 2 * a + hi, j1 = jt + 8 + 2 * a + hi;
        own[j0] = (p0[4 * a] + p0[4 * a + 1]) + (p0[4 * a + 2] + 0.5f * p0[4 * a + 3]); car[j0 + 1] = 0.5f * p0[4 * a + 3];
        own[j1] = (p1[4 * a] + p1[4 * a + 1]) + (p1[4 * a + 2] + 0.5f * p1[4 * a + 3]); if (j1 + 1 < 32) car[j1 + 1] = 0.5f * p1[4 * a + 3];
    }
}
__device__ __forceinline__ bf16x8 pk8(const f32x16& p, int o) { v4u w = (v4u){cvtpk_s(p[o], p[o + 1]), cvtpk_s(p[o + 2], p[o + 3]), cvtpk_s(p[o + 4], p[o + 5]), cvtpk_s(p[o + 6], p[o + 7])}; return __builtin_bit_cast(bf16x8, w); }
__device__ __forceinline__ void cmp_unit(LAS unsigned char* shm, int b, int g, int tb, const bf16* PROJ, const bf16* KCB, float* OACC, unsigned* SELM) {
    const int tid = tid_opaque(), lane = tid & 63, r32 = lane & 31, hi = lane >> 5; const int wid = __builtin_amdgcn_readfirstlane(tid >> 6);
    const int hh = wid & 3, th = wid >> 2, head = g * 4 + hh, tq = th * 32 + r32, t = tb * 64 + tq; const size_t row = (size_t)b * SEQ + t;
    const unsigned lds0 = (unsigned)(uintptr_t)shm;
    LAS float* wsf = (LAS float*)(shm + C_WS) + wid * 64;
    const int ntile = (tb >= 16) ? 2 : 1;
    const bf16* kc = KCB + (size_t)((0 * 8 + b) * 4 + g) * 8192; const bf16* vc = KCB + (size_t)((1 * 8 + b) * 4 + g) * 8192;
    for (int tau = 0; tau < ntile; ++tau) {
        glds16(kc + (size_t)(64 * tau + lane) * 64 + wid * 8, (unsigned)__builtin_amdgcn_readfirstlane(lds0 + C_K + tau * 8192 + wid * 1024));
        glds16(vc + (size_t)(64 * tau + 16 * (wid & 3) + (lane >> 2)) * 64 + (wid >> 2) * 32 + (lane & 3) * 8, (unsigned)__builtin_amdgcn_readfirstlane(lds0 + C_V + tau * 8192 + wid * 1024));
    }
    const bf16* prow = PROJ + row * PLD;
    bf16x8 qr[4];
#pragma unroll
    for (int d0 = 0; d0 < 4; ++d0) qr[d0] = *(const bf16x8*)(prow + PC_Q + head * 64 + d0 * 16 + hi * 8);
    const float g0 = sigm(bf2f(prow[PC_G3 + head * 3 + 0]));
    const int nvalid = (t >= 31) ? (((t - 31) >> 4) + 1) : 0;
    asm volatile("s_waitcnt vmcnt(0) lgkmcnt(0)\n\ts_barrier" ::: "memory");
    const LAS char* kp0 = (const LAS char*)shm + C_K + hi * 1024 + r32 * 16;
    const int vb0 = (int)(lds0 + C_V) + ((lane >> 4) & 1) * 32 + (lane & 3) * 8 + (4 * hi + ((lane & 15) >> 2)) * 64;
    const f32x16 zero = f32x16{};
    f32x16 p0, p1, p2, p3;
    qkt(p0, p1, kp0, qr, zero); mask_nv(p0, p1, 0, nvalid, hi);
    float m = rowmax(p0, p1);
    if (ntile == 2) { qkt(p2, p3, kp0 + 8192, qr, zero); mask_nv(p2, p3, 64, nvalid, hi); m = fmaxf(m, rowmax(p2, p3)); }
    m = fmaxf(m, -1e30f);
    float l = 0.f;
#pragma unroll
    for (int r = 0; r < 16; ++r) { p0[r] = exp2f(p0[r] - m); p1[r] = exp2f(p1[r] - m); l += p0[r] + p1[r]; }
    if (ntile == 2) {
#pragma unroll
        for (int r = 0; r < 16; ++r) { p2[r] = exp2f(p2[r] - m); p3[r] = exp2f(p3[r] - m); l += p2[r] + p3[r]; } }
    const float lt = swap_add(l); const float inv = (lt > 0.f) ? 1.f / lt : 0.f;
#pragma unroll
    for (int r = 0; r < 16; ++r) { p0[r] *= inv; p1[r] *= inv; }
    f32x16 o[2]; o[0] = f32x16{}; o[1] = f32x16{};
    pv(o, vb0, pk8(p0, 0), pk8(p0, 8), pk8(p1, 0), pk8(p1, 8));
    LAS float* own = (LAS float*)(shm + C_OWN) + wid * TBW + r32 * 33; LAS float* car = (LAS float*)(shm + C_CAR) + wid * TBW + r32 * 33;
    imp_tile(p0, p1, own, car, 0, hi);
    if (ntile == 2) {
#pragma unroll
        for (int r = 0; r < 16; ++r) { p2[r] *= inv; p3[r] *= inv; }
        pv(o, vb0 + 8192, pk8(p2, 0), pk8(p2, 8), pk8(p3, 0), pk8(p3, 8));
        imp_tile(p2, p3, own, car, 16, hi);
    }
    if (hi == 0) wsf[r32] = g0;
    LDS_WAIT(); asm volatile("" ::: "memory");
    const size_t rowbase = (size_t)b * SEQ + tb * 64 + th * 32;
#pragma unroll
    for (int r = 0; r < 16; ++r) { const float gq = wsf[crow(r, hi)]; float* oa = OACC + (rowbase + crow(r, hi)) * 1024 + head * 64 + r32; oa[0] = o[0][r] * gq; oa[32] = o[1][r] * gq; }
    asm volatile("s_waitcnt lgkmcnt(0)\n\ts_barrier" ::: "memory");
    LAS float* IMPS = (LAS float*)(shm + C_IMP);
#pragma unroll
    for (int pass = 0; pass < 4; ++pass) { const int tok = pass * 16 + (tid >> 5), j = tid & 31, q = tok & 31, w0 = (tok >> 5) * 4; float v = 0.f;
        if (j < 16 * ntile) {
#pragma unroll
            for (int k = 0; k < 4; ++k) { v += ((LAS float*)(shm + C_OWN))[(w0 + k) * TBW + q * 33 + j]; if (j > 0) v += ((LAS float*)(shm + C_CAR))[(w0 + k) * TBW + q * 33 + j]; } }
        IMPS[tok * 33 + j] = v; }
    asm volatile("s_waitcnt lgkmcnt(0)\n\ts_barrier" ::: "memory");
#pragma unroll
    for (int pass = 0; pass < 4; ++pass) { const int tok = pass * 16 + (tid >> 5), j = tid & 31, cur = tb;
        const bool forced = (j == 0) || (j == cur) || (j == cur - 1);
        const float score = (j <= cur) ? IMPS[tok * 33 + j] + (forced ? 1000.f : 0.f) : -1e9f;
        int rank = 0;
        for (int i = 0; i < 32; ++i) { const bool fi = (i == 0) || (i == cur) || (i == cur - 1); const float si = (i <= cur) ? IMPS[tok * 33 + i] + (fi ? 1000.f : 0.f) : -1e9f; rank += ((si > score) || (si == score && i < j)) ? 1 : 0; }
        const bool sel = (rank < 16) && (score > -5e8f);
        const unsigned long long bal = __ballot(sel);
        if ((lane & 31) == 0) SELM[(size_t)(b * 4 + g) * SEQ + tb * 64 + tok] = (unsigned)(bal >> (lane & 32)); }
    asm volatile("s_waitcnt vmcnt(0) lgkmcnt(0)\n\ts_barrier" ::: "memory");
}
}
__device__ __forceinline__ void p5_cmp_select(Frame& F) {
    const int tid_ = tid_opaque(), lane_ = tid_ & 63; (void)lane_;
    const bf16* PROJ = WSP(bf16, WS_PROJ); const bf16* KCB = WSP(bf16, WS_KCV); float* OACC = WSP(float, WS_OACC); unsigned* SELM = WSP(unsigned, WS_SELM);
    for (int u = blockIdx.x; u < 1024; u += F.G) { const int bg = u >> 5, tb = u & 31; cs::cmp_unit(F.lds, bg >> 2, bg & 3, tb, PROJ, KCB, OACC, SELM); }
}
namespace ml {
using fa::f32x16; using fa::crow; using fa::glds16; using fa::cvtpk_s; using fa::swap_add; using fa::vtr;
constexpr int NR = 4, KSL = 8192, VSL = 16384;
constexpr int L_K = 0, L_V = NR * KSL, L_W = L_V + NR * VSL, L_WS = L_W + 8192, L_UT = L_WS + 8 * 256, L_END = L_UT + 8192;
static_assert(L_END <= RING_BYTES, "mlstm lds");
__device__ __forceinline__ void mlstm_unit(LAS unsigned char* shm, int b, int h, int tb, const bf16* PROJ, const bf16* QKC, const float* GA2, const float* GU2, const float* GM2, const float* mhg, bf16* OML) {
    const int tid = tid_opaque(), lane = tid & 63, r32 = lane & 31, hi = lane >> 5; const int wid = __builtin_amdgcn_readfirstlane(tid >> 6);
    const int vq = wid & 3, th = wid >> 2, tq = th * 32 + r32, t = tb * 64 + tq, bh = b * 4 + h; const size_t row = (size_t)b * SEQ + t;
    const unsigned lds0 = (unsigned)(uintptr_t)shm;
    LAS float* wsf = (LAS float*)(shm + L_WS) + wid * 64;
    LAS float* ut = (LAS float*)(shm + L_UT);
    const int n = 2 * (tb + 1);
    for (int i = tid; i < n * 32; i += 512) ut[i] = GU2[bh * SEQ + i];
    const bf16* kbase = QKC + (size_t)b * SEQ * 1024 + 512 + h * 128 + (size_t)(lane & 31) * 1024 + (2 * wid + (lane >> 5)) * 8;
    const bf16* vb0 = PROJ + (size_t)b * SEQ * PLD + PC_VM + h * 256 + (size_t)(lane >> 2) * PLD + (lane & 3) * 8;
    const int pa = 2 * wid, pb = 2 * wid + 1;
    const bf16* vbaseA = vb0 + (size_t)(16 * (pa & 1)) * PLD + (pa >> 2) * 64 + ((pa >> 1) & 1) * 32;
    const bf16* vbaseB = vb0 + (size_t)(16 * (pb & 1)) * PLD + (pb >> 2) * 64 + ((pb >> 1) & 1) * 32;
    const unsigned kdst = lds0 + L_K + wid * 1024, vdst = lds0 + L_V + wid * 2048;
#define ML_ISSUE_K(i) do { const int i_ = (i); if (i_ < n) glds16(kbase + (size_t)(i_ * 32) * 1024, (unsigned)__builtin_amdgcn_readfirstlane(kdst + (unsigned)((i_ & 3) * KSL))); } while (0)
#define ML_ISSUE_V(i) do { const int i_ = (i); if (i_ >= 0 && i_ < n) { const unsigned d_ = (unsigned)__builtin_amdgcn_readfirstlane(vdst + (unsigned)((i_ & 3) * VSL)); \
        glds16(vbaseA + (size_t)(i_ * 32) * PLD, d_); glds16(vbaseB + (size_t)(i_ * 32) * PLD, d_ + 1024u); } } while (0)
    bf16x8 qr[8];
#pragma unroll
    for (int d0 = 0; d0 < 8; ++d0) qr[d0] = *(const bf16x8*)(QKC + row * 1024 + h * 128 + d0 * 16 + hi * 8);
    const float M2 = GM2[bh * SEQ + t], A2 = GA2[bh * SEQ + t];
    ML_ISSUE_K(0); ML_ISSUE_K(1); ML_ISSUE_V(0); ML_ISSUE_K(2); ML_ISSUE_V(1);
    f32x16 o[2]; o[0] = f32x16{}; o[1] = f32x16{}; float den = 0.f;
    const f32x16 zero = f32x16{};
    const int vbl = ((lane >> 4) & 1) * 32 + (lane & 3) * 8 + (4 * hi + ((lane & 15) >> 2)) * 64;
    LAS unsigned char* wbase = shm + L_W + th * 2048 + lane * 16;
    for (int s = 0; s <= n; ++s) {
        if (s + 2 < n) asm volatile("s_waitcnt vmcnt(6) lgkmcnt(0)\n\ts_barrier" ::: "memory");
        else if (s + 2 == n) asm volatile("s_waitcnt vmcnt(5) lgkmcnt(0)\n\ts_barrier" ::: "memory");
        else if (s + 1 == n) asm volatile("s_waitcnt vmcnt(2) lgkmcnt(0)\n\ts_barrier" ::: "memory");
        else asm volatile("s_waitcnt vmcnt(0) lgkmcnt(0)\n\ts_barrier" ::: "memory");
        ML_ISSUE_K(s + 3); ML_ISSUE_V(s + 2);
        if (s < n && vq == (s & 3)) {
            const LAS char* kb = (const LAS char*)shm + L_K + (s & 3) * KSL + hi * 512 + r32 * 16;
            f32x16 p0;
#pragma unroll
            for (int d0 = 0; d0 < 8; ++d0) { const bf16x8 b0 = *(const LAS bf16x8*)(kb + d0 * 1024); p0 = __builtin_amdgcn_mfma_f32_32x32x16_bf16(b0, qr[d0], d0 == 0 ? zero : p0, 0, 0, 0); }
            const LAS float* up = ut + s * 32 + 4 * hi;
            fa::P8 q0 = __builtin_bit_cast(fa::P8, p0);
            const f32x2 m2 = {M2, M2};
#pragma unroll
            for (int a = 0; a < 4; ++a) { const f32x4 u0 = *(const LAS f32x4*)(up + 8 * a);
                f32x2 e0 = (f32x2){u0.x, u0.y} - m2, e1 = (f32x2){u0.z, u0.w} - m2;
                e0.x = __builtin_amdgcn_exp2f(e0.x); e0.y = __builtin_amdgcn_exp2f(e0.y); e1.x = __builtin_amdgcn_exp2f(e1.x); e1.y = __builtin_amdgcn_exp2f(e1.y);
                q0.v[2 * a] *= e0; q0.v[2 * a + 1] *= e1; }
            if (s >= 2 * tb) {
                const int kb32 = 32 * (s & 1);
#pragma unroll
                for (int r = 0; r < 16; ++r) { if (kb32 + fa::crow(r, hi) > tq) q0.v[r >> 1][r & 1] = 0.f; } }
            { f32x2 d2 = (q0.v[0] + q0.v[1]) + (q0.v[2] + q0.v[3]); d2 += (q0.v[4] + q0.v[5]) + (q0.v[6] + q0.v[7]); den += d2.x + d2.y; }
            LAS unsigned char* wp = wbase + (s & 1) * 4096;
            *(LAS v4u*)(wp) = (v4u){cvtpk_s(q0.v[0].x, q0.v[0].y), cvtpk_s(q0.v[1].x, q0.v[1].y), cvtpk_s(q0.v[2].x, q0.v[2].y), cvtpk_s(q0.v[3].x, q0.v[3].y)};
            *(LAS v4u*)(wp + 1024) = (v4u){cvtpk_s(q0.v[4].x, q0.v[4].y), cvtpk_s(q0.v[5].x, q0.v[5].y), cvtpk_s(q0.v[6].x, q0.v[6].y), cvtpk_s(q0.v[7].x, q0.v[7].y)};
        }
        if (s >= 1) {
            const LAS unsigned char* wp = wbase + ((s - 1) & 1) * 4096;
            const v4u pw0 = *(const LAS v4u*)(wp), pw1 = *(const LAS v4u*)(wp + 1024);
            const LAS char* vp = (const LAS char*)shm + L_V + ((s - 1) & 3) * VSL + vq * 4096 + vbl;
#pragma unroll
            for (int d0 = 0; d0 < 2; ++d0) {
                const fa::s16x4 l0 = vtr(vp + d0 * 2048), h0 = vtr(vp + d0 * 2048 + 512), l1 = vtr(vp + d0 * 2048 + 1024), h1 = vtr(vp + d0 * 2048 + 1536);
                o[d0] = __builtin_amdgcn_mfma_f32_32x32x16_bf16(__builtin_bit_cast(bf16x8, pw0), (bf16x8){l0[0], l0[1], l0[2], l0[3], h0[0], h0[1], h0[2], h0[3]}, o[d0], 0, 0, 0);
                o[d0] = __builtin_amdgcn_mfma_f32_32x32x16_bf16(__builtin_bit_cast(bf16x8, pw1), (bf16x8){l1[0], l1[1], l1[2], l1[3], h1[0], h1[1], h1[2], h1[3]}, o[d0], 0, 0, 0);
            }
        }
    }
    { const float dt = swap_add(den); if (hi == 0) wsf[r32] = dt; }
    asm volatile("s_waitcnt lgkmcnt(0)\n\ts_barrier" ::: "memory");
    { const LAS float* wd = (const LAS float*)(shm + L_WS) + th * 4 * 64; const float dt = (wd[r32] + wd[64 + r32]) + (wd[128 + r32] + wd[192 + r32]);
      const float dd = fmaxf(fabsf(dt), __builtin_amdgcn_exp2f(-(A2 + M2))); if (hi == 0) wsf[32 + r32] = 1.f / dd; }
    LDS_WAIT(); asm volatile("" ::: "memory");
    LAS float* Hst = (LAS float*)shm;
#pragma unroll
    for (int r = 0; r < 16; ++r) { const float f = wsf[32 + crow(r, hi)]; LAS float* hp = Hst + (th * 32 + crow(r, hi)) * 256 + vq * 64 + r32; hp[0] = o[0][r] * f; hp[32] = o[1][r] * f; }
    asm volatile("s_waitcnt lgkmcnt(0)\n\ts_barrier" ::: "memory");
#pragma unroll
    for (int k = 0; k < 8; ++k) { const int tr = wid * 8 + k; const f32x4 hv = *(const LAS f32x4*)(Hst + tr * 256 + 4 * lane);
        const float ssq = wave_sum((hv.x * hv.x + hv.y * hv.y) + (hv.z * hv.z + hv.w * hv.w)); const float rs = rsqrtf(ssq * (1.f / 256.f) + EPS);
        const size_t orow = (size_t)b * SEQ + tb * 64 + tr; const v2u om = *(const v2u*)(PROJ + orow * PLD + PC_OM + h * 256 + 4 * lane); const f32x4 gg = *(const f32x4*)(mhg + h * 256 + 4 * lane);
        v2u ov; ov.x = pk2(sigm(bflo(om.x)) * hv.x * rs * gg.x, sigm(bfhi(om.x)) * hv.y * rs * gg.y); ov.y = pk2(sigm(bflo(om.y)) * hv.z * rs * gg.z, sigm(bfhi(om.y)) * hv.w * rs * gg.w);
        *(v2u*)(OML + orow * 2048 + h * 256 + 4 * lane) = ov; }
    asm volatile("s_waitcnt lgkmcnt(0)\n\ts_barrier" ::: "memory");
#undef ML_ISSUE_K
#undef ML_ISSUE_V
}
}
__device__ __forceinline__ void p5_mlstm(Frame& F, int& chunk) {
    const int tid_ = tid_opaque(), lane_ = tid_ & 63; (void)lane_;
    const bf16* PROJ = WSP(bf16, WS_PROJ); const bf16* QKC = WSP(bf16, WS_QKC); bf16* OML = WSP(bf16, WS_OMIX) + 1024;
    const float* GA = WSP(float, WS_GA); const float* GU = WSP(float, WS_GU); const float* GM = WSP(float, WS_GM); const float* mhg = INP(13);
    unsigned* ctr = WSP(unsigned, WS_CTL) + CW_MLQ; LAS int* tk = (LAS int*)(F.lds + LDSCTL_OFF + 64);
    __syncthreads();
    if (tid_ == 0) tk[0] = (int)__hip_atomic_fetch_add(ctr, 1u, RLX_AGENT);
    __syncthreads();
    int u = tk[0];
    while (u < 1024) {
        int nxt = 0; if (tid_ == 0) nxt = (int)__hip_atomic_fetch_add(ctr, 1u, RLX_AGENT);
        const int bh = u & 31, tb = 31 - (u >> 5);
        ml::mlstm_unit(F.lds, bh >> 2, bh & 3, tb, PROJ, QKC, GA, GU, GM, mhg, OML);
        convert_chunk(F, chunk);
        if (tid_ == 0) tk[0] = nxt;
        __syncthreads();
        u = tk[0];
        __syncthreads();
    }
}
__device__ __forceinline__ void p6_sel_win(Frame& F, int& chunk) {
    const int tid_ = tid_opaque(), lane_ = tid_ & 63; (void)lane_;
    const bf16* PROJ = WSP(bf16, WS_PROJ); float* OACC = WSP(float, WS_OACC); unsigned* SELM = WSP(unsigned, WS_SELM); bf16* ONSA = WSP(bf16, WS_OMIX); const bf16* KCB = WSP(bf16, WS_KCV);
    __syncthreads();
    if (F.G == 256) {
        const int bx = blockIdx.x, xcd = bx % 8, w = bx / 8, s = w & 15;
        for (int i = 0; i < 4; ++i) { const int bg = 4 * xcd + 2 * (i >> 1) + (w >> 4); const int tb = (i & 1) ? 31 - s : s;
            cs::cmp_unit(F.lds, bg >> 2, bg & 3, tb, PROJ, KCB, OACC, SELM); fa::sel_win_unit(F.lds, bg >> 2, bg & 3, tb, PROJ, SELM, OACC, ONSA); convert_chunk(F, chunk); }
    } else {
        for (int u = blockIdx.x; u < 1024; u += F.G) { const int bg = u >> 5, tb = u & 31;
            cs::cmp_unit(F.lds, bg >> 2, bg & 3, tb, PROJ, KCB, OACC, SELM); fa::sel_win_unit(F.lds, bg >> 2, bg & 3, tb, PROJ, SELM, OACC, ONSA); convert_chunk(F, chunk); }
    }
    while (chunk < NCHUNK) convert_chunk(F, chunk);
}
__device__ __forceinline__ void p10_rows(Frame& F) {
    const int tid_ = tid_opaque(), lane_ = tid_ & 63; (void)lane_;
    const float* x = INP(0); const float* gpost = INP(5); const float* gpre = INP(17); const float* mod = WSP(float, WS_MOD); const bf16* Y = WSP(bf16, WS_Y); bf16* H2 = WSP(bf16, WS_H2); unsigned char* H2Q = WSP(unsigned char, WS_H2Q);
    LAS float* A1 = (LAS float*)F.lds; LAS float* A2 = A1 + 2048; LAS float* C2 = A1 + 4096;
    int cur_b = -1;
    for (int blk = blockIdx.x; blk < NTOK / 64; blk += F.G) {
        const int b = blk >> 5;
        if (b != cur_b) { __syncthreads(); const float* mb = mod + b * 12288;
            const f32x4 g = *(const f32x4*)(gpost + 4 * tid_), gt = *(const f32x4*)(mb + 4096 + 4 * tid_), gp = *(const f32x4*)(gpre + 4 * tid_), a = *(const f32x4*)(mb + 8192 + 4 * tid_), c = *(const f32x4*)(mb + 6144 + 4 * tid_);
            *(LAS f32x4*)(A1 + 4 * tid_) = g * gt; *(LAS f32x4*)(A2 + 4 * tid_) = gp * (1.f + a); *(LAS f32x4*)(C2 + 4 * tid_) = c; __syncthreads(); cur_b = b; }
        const int row0 = blk * 64 + F.wave * 8;
        v2u yq[8]; f32x4 xx[8];
        { const GAS v2u* yr = UPTR(const v2u, Y + (size_t)row0 * DM) + lane_; const GAS f32x4* xr = UPTR(const f32x4, x + (size_t)row0 * DM) + lane_;
#pragma unroll
          for (int j = 0; j < 8; ++j) { yq[j] = yr[64 * j]; xx[j] = xr[64 * j]; } }
#pragma unroll
        for (int k = 0; k < 8; ++k) {
            const int row = row0 + k;
            v2u yn[8]; f32x4 xn[8];
            if (k + 1 < 8) { const GAS v2u* yr = UPTR(const v2u, Y + (size_t)(row + 1) * DM) + lane_; const GAS f32x4* xr = UPTR(const f32x4, x + (size_t)(row + 1) * DM) + lane_;
#pragma unroll
                for (int j = 0; j < 8; ++j) { yn[j] = yr[64 * j]; xn[j] = xr[64 * j]; } }
            GAS f32x4* orow = UPTR(f32x4, F.out + (size_t)row * DM) + lane_;
            f32x4 v[8]; float s = 0.f;
#pragma unroll
            for (int j = 0; j < 8; ++j) { const v2u q = yq[j]; v[j] = (f32x4){bflo(q.x), bfhi(q.x), bflo(q.y), bfhi(q.y)}; s += (v[j].x * v[j].x + v[j].y * v[j].y) + (v[j].z * v[j].z + v[j].w * v[j].w); }
            const float rstd = rsqrtf(wave_sum(s) * (1.f / DM) + EPS);
            float s1 = 0.f;
#pragma unroll
            for (int j = 0; j < 8; ++j) { const f32x4 a1 = *(LAS f32x4*)(A1 + 4 * lane_ + 256 * j);
                v[j] = xx[j] + a1 * (v[j] * rstd); orow[64 * j] = v[j]; s1 += (v[j].x * v[j].x + v[j].y * v[j].y) + (v[j].z * v[j].z + v[j].w * v[j].w); }
            const float rstd1 = rsqrtf(wave_sum(s1) * (1.f / DM) + EPS);
            GAS unsigned long long* o8 = UPTR(unsigned long long, H2 + (size_t)row * DM) + lane_; GAS int* o4 = UPTR(int, H2Q + (size_t)row * DM) + lane_;
#pragma unroll
            for (int j = 0; j < 8; ++j) { const int col = 4 * lane_ + 256 * j; const f32x4 a2 = *(LAS f32x4*)(A2 + col), c2 = *(LAS f32x4*)(C2 + col);
                const f32x4 r = v[j] * rstd1 * a2 + c2;
                o8[64 * j] = (unsigned long long)pk2(r.x, r.y) | ((unsigned long long)pk2(r.z, r.w) << 32);
                int q8 = 0; q8 = __builtin_amdgcn_cvt_pk_fp8_f32(fminf(fmaxf(r.x, -448.f), 448.f), fminf(fmaxf(r.y, -448.f), 448.f), q8, false); q8 = __builtin_amdgcn_cvt_pk_fp8_f32(fminf(fmaxf(r.z, -448.f), 448.f), fminf(fmaxf(r.w, -448.f), 448.f), q8, true);
                o4[64 * j] = q8; }
            if (k + 1 < 8) {
#pragma unroll
                for (int j = 0; j < 8; ++j) { yq[j] = yn[j]; xx[j] = xn[j]; } }
        }
    }
    __syncthreads();
}
__device__ __forceinline__ void p12_route(Frame& F, int cbase = CW_CNT) {
    const int tid_ = tid_opaque(), lane_ = tid_ & 63; (void)lane_;
    const float* LG = WSP(float, WS_LOGITS); const float* br = INP(20); unsigned* cnt = WSP(unsigned, WS_CTL) + cbase;
    int* TE = WSP(int, WS_TE); int* TP = WSP(int, WS_TP); float* TW = WSP(float, WS_TW);
    LAS int* cw = (LAS int*)F.lds; LAS int* basee = cw + 512;
    const int lane = lane_; const float brl = br[lane];
    for (int tblk = blockIdx.x; tblk < NTOK / 64; tblk += F.G) {
        __syncthreads();
        int c = 0; unsigned selm = 0u, posb = 0u, kb = 0u; float wv[8];
#pragma unroll
        for (int k = 0; k < 8; ++k) { const int t = tblk * 64 + F.wave * 8 + k;
            const float s = sigm_ieee(LG[(size_t)t * 64 + lane]); const float sb = s + brl;
            const int grp = lane >> 3; float m1 = -INFINITY, m2 = -INFINITY;
#pragma unroll
            for (int i = 0; i < 8; ++i) { const float v = __shfl(sb, grp * 8 + i); if (v > m1) { m2 = m1; m1 = v; } else if (v > m2) { m2 = v; } }
            const float gs = m1 + m2; int grank = 0;
#pragma unroll
            for (int gi = 0; gi < 8; ++gi) { const float o = __shfl(gs, gi * 8); grank += ((o > gs) || (o == gs && gi < grp)) ? 1 : 0; }
            const float ms = (grank < 4) ? sb : -1e9f; int rank = 0;
            for (int i = 0; i < 64; ++i) { const float o = rdlane(ms, i); rank += ((o > ms) || (o == ms && i < lane)) ? 1 : 0; }
            const bool sel = rank < 8;
            const float wsum = wave_sum(sel ? s : 0.f);
            const unsigned long long bal = __ballot(sel);
            wv[k] = s / wsum * 2.5f;
            if (sel) { selm |= 1u << k; posb |= (unsigned)c << (3 * k); kb |= (unsigned)(__popcll(bal & ((1ull << lane) - 1ull)) & 7) << (3 * k); ++c; } }
        cw[F.wave * 64 + lane] = c;
        __syncthreads();
        if (F.wave == 0) { int tot = 0;
#pragma unroll
            for (int w = 0; w < 8; ++w) tot += cw[w * 64 + lane];
            basee[lane] = tot ? (int)atomicAdd(&cnt[lane], (unsigned)tot) : 0; }
        __syncthreads();
        int off = basee[lane];
        for (int w = 0; w < F.wave; ++w) off += cw[w * 64 + lane];
#pragma unroll
        for (int k = 0; k < 8; ++k) if ((selm >> k) & 1u) { const int t = tblk * 64 + F.wave * 8 + k; const int idx = t * 8 + (int)((kb >> (3 * k)) & 7u);
            TE[idx] = lane; TP[idx] = off + (int)((posb >> (3 * k)) & 7u); TW[idx] = wv[k]; }
    }
    __syncthreads();
}
__device__ __forceinline__ void p13_slots(Frame& F) {
    const int tid_ = tid_opaque(), lane_ = tid_ & 63; (void)lane_;
    unsigned* cnt = WSP(unsigned, WS_CTL) + CW_CNT; LAS int* rs = (LAS int*)F.lds;
    const int* TE = WSP(int, WS_TE); const int* TP = WSP(int, WS_TP); const float* TW = WSP(float, WS_TW);
    int* TOKSLOT = WSP(int, WS_TOKSLOT); int* SLOTTOK = WSP(int, WS_SLOTTOK); float* SLOTW = WSP(float, WS_SLOTW); int* RT = WSP(int, WS_RT);
    LAS int* ts = rs + 80;
    if (tid_ < 64) { const int c = (int)__hip_atomic_load(cnt + tid_, RLX_AGENT); const int nt_ = (c + 255) >> 8; int a = c, tt = nt_;
#pragma unroll
        for (int o = 1; o < 64; o <<= 1) { const int n = __shfl_up(a, o), n2 = __shfl_up(tt, o); if (lane_ >= o) { a += n; tt += n2; } }
        rs[tid_ + 1] = a; ts[tid_ + 1] = tt; if (tid_ == 0) { rs[0] = 0; ts[0] = 0; } }
    __syncthreads();
    const int gt = blockIdx.x * 512 + tid_, ngt = F.G * 512;
    for (int idx = gt; idx < NSLOT; idx += ngt) { const int e = TE[idx], slot = rs[e] + TP[idx]; SLOTTOK[slot] = idx >> 3; SLOTW[slot] = TW[idx]; TOKSLOT[idx] = slot; }
    for (int idx = gt; idx < NTOK; idx += ngt) { SLOTTOK[NSLOT + idx] = idx; SLOTW[NSLOT + idx] = 1.f; }
    if (blockIdx.x == 0) {
        if (tid_ < 64) { const int e = tid_, c = rs[e + 1] - rs[e]; int j = ts[e]; for (int r = 0; r * 256 < c; ++r, ++j) { RT[3 * j] = e; RT[3 * j + 1] = rs[e] + 256 * r; RT[3 * j + 2] = (c - 256 * r) < 256 ? (c - 256 * r) : 256; } }
        else if (tid_ < 128) { const int r = tid_ - 64, j = ts[64] + r; RT[3 * j] = 64; RT[3 * j + 1] = NSLOT + 256 * r; RT[3 * j + 2] = 256; }
        if (tid_ == 0) __hip_atomic_store(WSP(unsigned, WS_CTL) + CW_NTILES, (unsigned)(ts[64] + 64), RLX_AGENT);
    }
    __syncthreads();
}
__device__ __forceinline__ void p16_final(Frame& F, bool do_store = true) {
    const int tid_ = tid_opaque(), lane_ = tid_ & 63; (void)lane_;
    const unsigned char* YS = WSP(unsigned char, WS_YSLOT); const int* TOKSLOT = WSP(int, WS_TOKSLOT); const float* gpost = INP(18); const float* mod = WSP(float, WS_MOD);
    LAS float* A = (LAS float*)F.lds;
    int cur_b = -1;
    for (int blk = blockIdx.x; blk < NTOK / 64; blk += F.G) {
        const int b = blk >> 5;
        if (b != cur_b) { __syncthreads();
            const f32x4 g = *(const f32x4*)(gpost + 4 * tid_), gt = *(const f32x4*)(mod + b * 12288 + 10240 + 4 * tid_);
            *(LAS f32x4*)(A + 4 * tid_) = g * gt * (1.f / 64.f); __syncthreads(); cur_b = b; }
        const int row0 = blk * 64 + F.wave * 8;
        const int myslot = TOKSLOT[row0 * 8 + lane_];
        int q[3][24]; f32x4 xx[8];
#define P16_ISSUE(kk, gg) do { _Pragma("unroll") for (int r = 0; r < 3; ++r) { const int k9 = 3 * (gg) + r; \
            const int slot = (k9 < 8) ? __builtin_amdgcn_readlane(myslot, (kk) * 8 + k9) : NSLOT + row0 + (kk); \
            const GAS int* yr = UPTR(const int, YS + (size_t)slot * DM) + lane_; \
            _Pragma("unroll") for (int j = 0; j < 8; ++j) q[gg][8 * r + j] = yr[64 * j]; } } while (0)
        P16_ISSUE(0, 0); P16_ISSUE(0, 1); P16_ISSUE(0, 2);
#pragma unroll 1
        for (int k = 0; k < 8; ++k) {
            const int row = row0 + k;
            { const GAS f32x4* xr = UPTR(const f32x4, F.out + (size_t)row * DM) + lane_;
#pragma unroll
              for (int j = 0; j < 8; ++j) xx[j] = xr[64 * j]; }
            f32x4 acc[8];
#pragma unroll
            for (int j = 0; j < 8; ++j) acc[j] = (f32x4){0.f, 0.f, 0.f, 0.f};
#pragma unroll
            for (int g = 0; g < 3; ++g) {
#pragma unroll
                for (int r = 0; r < 3; ++r)
#pragma unroll
                    for (int j = 0; j < 8; ++j) { const int w = q[g][8 * r + j]; const f32x2 lo = __builtin_amdgcn_cvt_pk_f32_fp8(w, false), hi = __builtin_amdgcn_cvt_pk_f32_fp8(w, true);
                        acc[j].x += lo.x; acc[j].y += lo.y; acc[j].z += hi.x; acc[j].w += hi.y; }
                if (k + 1 < 8) P16_ISSUE(k + 1, g);
            }
            float s = 0.f;
#pragma unroll
            for (int j = 0; j < 8; ++j) s += (acc[j].x * acc[j].x + acc[j].y * acc[j].y) + (acc[j].z * acc[j].z + acc[j].w * acc[j].w);
            const float rstd = rsqrtf(wave_sum(s) * (1.f / (4096.f * DM)) + EPS);
            GAS f32x4* orow = UPTR(f32x4, F.out + (size_t)row * DM) + lane_;
            unsigned aoff = 16u * (unsigned)lane_; asm volatile("" : "+v"(aoff));
#pragma unroll
            for (int j = 0; j < 8; ++j) { const f32x4 a = *(LAS f32x4*)((LAS unsigned char*)A + aoff + 1024 * j);
                if (do_store || F.G == 12345) orow[64 * j] = xx[j] + a * (acc[j] * rstd); }
        }
#undef P16_ISSUE
    }
}

constexpr int NPHASE = 17;
struct Args { const float* in[27]; float* out; unsigned char* ws; int ph_lo, ph_hi, li, pad; };
__global__ void __launch_bounds__(512, 2) mega_fwd(Args args) {
    extern __shared__ __attribute__((aligned(16))) unsigned char lds[];
    Frame F;
    F.lds = (LAS unsigned char*)lds; F.ws = args.ws; F.in = args.in; F.out = args.out;
    F.tid = threadIdx.x; F.lane = F.tid & 63; F.wave = __builtin_amdgcn_readfirstlane(F.tid >> 6); F.G = gridDim.x;
    F.gw = blockIdx.x * 8 + F.wave; F.ngw = F.G * 8;
    volatile LAS unsigned* MISC = (volatile LAS unsigned*)(F.lds + MISC_OFF);
    for (int u = F.tid; u < (LDS_BYTES - LDSCTL_OFF) / 4; u += 512) ((LAS unsigned*)(F.lds + LDSCTL_OFF))[u] = 0u;
    __syncthreads();
    unsigned* ctl = (unsigned*)(args.ws + WS_CTL);
    XcdBarrier bar; bar.bar = ctl + CW_BAR; bar.x = 0; bar.st = nullptr;
    if (!MK_PER_PHASE) bar = xcd_barrier_post(ctl + CW_BAR, MISC + 8);
    const int lo = args.ph_lo, hi = args.ph_hi;
#define IN(k) (lo <= (k) && (k) < hi)
#define SEAM(k) do { if (IN(k) && IN((k) + 1)) xcd_barrier(bar); } while (0)
    bf16* PROJ = WSP(bf16, WS_PROJ);
    int chunk = 0;
    const int vcu_ = (F.G % 8 == 0) ? (int)(blockIdx.x % 8) * (F.G / 8) + (int)(blockIdx.x / 8) : (int)blockIdx.x;

    if (IN(0)) { p0_bias1(F); p0_early(F); } SEAM(0);
    if (IN(1)) REP(1, { p1_h1(F); }); SEAM(1);
    if (IN(2)) REP(2, {
        if constexpr (PROJ_MODE == 0) {
        { pg8::Gemm g{WSP(bf16, WS_H1), WSP(bf16, WS_WIN), DM, 128, 0, 0}; pg8::StaticOrder S; S.init(NTOK, PN_BF, F.G, (int)blockIdx.x, PRB(2));
          pg8::EpiBf16 E{PROJ, PLD, 4, QC2};
          pg8::gemm_phase<pg8::EpiBf16, pg8::StaticOrder, false, true>(F.lds, g, S, E); }
        { pg8::Gemm g{WSP(unsigned char, WS_H1Q), WSP(unsigned char, WS_WIN8), DM, 128, 127 - 6, 127}; pg8::StaticOrder S; S.init(NTOK, PN_F8, F.G, (int)blockIdx.x, PRB(3));
          pg8::EpiBf16 E{PROJ + PN_BF, PLD, 1 << 20, 1.f / 64.f};
          pg8::gemm_phase<pg8::EpiBf16, pg8::StaticOrder, false, true, true>(F.lds, g, S, E); }
        } else {
          pg8::Gemm g{WSP(unsigned char, WS_H1Q), WSP(unsigned char, WS_WIN8), DM, 128, 127 - 6, 127}; pg8::StaticOrder S; S.init(NTOK, PLD, F.G, (int)blockIdx.x, PRB(3));
          pg8::EpiBf16 E{PROJ, PLD, 4, QC2 / 64.f, 1.f / 64.f};
          pg8::gemm_phase<pg8::EpiBf16, pg8::StaticOrder, false, true, true>(F.lds, g, S, E); }
    }); SEAM(2);
    if (IN(3)) REP(3, { p3_conv(F); p3_gates(F); }); SEAM(3);
    if (IN(4)) {
        { pg8::Gemm g{PROJ, WSP(bf16, WS_CW1), DM, PLD * 2, 0, 0}; pg8::CmpOrder S{F.G, (int)blockIdx.x}; pg8::EpiCmpHid E{WSP(bf16, WS_HIDC), WSP(float, WS_BIAS1)};
          pg8::gemm_phase<pg8::EpiCmpHid, pg8::CmpOrder, true, true>(F.lds, g, S, E);
          if ((int)blockIdx.x < 32) kcv_unit(F, (int)blockIdx.x >> 4, (int)blockIdx.x & 15); }
        p5_mlstm(F, chunk); } SEAM(4);
    if (IN(6)) { p6_sel_win(F, chunk); } SEAM(6);
    if (IN(7)) REP(7, {
        pg8::Gemm g{WSP(bf16, WS_OMIX), WSP(bf16, WS_WUP), DM, 128, 0, 0}; pg8::StaticOrder S; S.init(NTOK, DM, F.G, (int)blockIdx.x);
        pg8::EpiGate E{WSP(bf16, WS_MERGED), PROJ + PC_GB, PLD, nullptr}; pg8::MidGate MH{PROJ + PC_GA, PROJ + PC_GB, PLD};
        pg8::gemm_phase<pg8::EpiGate, pg8::StaticOrder, false, true, false, false, pg8::MidGate>(F.lds, g, S, E, MH);
    }); SEAM(7);
    if (IN(9)) REP(9, {
        pg8::Gemm g{WSP(bf16, WS_MERGED), WSP(bf16, WS_WOUT), DM, 128, 0, 0}; pg8::StaticOrder S; S.init(NTOK, DM, F.G, (int)blockIdx.x);
        pg8::EpiBf16 E{WSP(bf16, WS_Y), DM, 0, 1.f};
        pg8::gemm_phase<pg8::EpiBf16, pg8::StaticOrder, false, true>(F.lds, g, S, E);
    }); SEAM(9);
    if (IN(10)) REP(10, { p10_rows(F); }); SEAM(10);
    if (IN(11)) REP(11, {
        pg8::Gemm g{WSP(bf16, WS_H2), WSP(bf16, WS_WR), DM, 128, 0, 0}; pg8::StaticOrder S; S.init(NTOK, 256, F.G, (int)blockIdx.x);
        pg8::EpiF32 E{WSP(float, WS_LOGITS), 64, 64};
        pg8::gemm_phase<pg8::EpiF32, pg8::StaticOrder, false, true>(F.lds, g, S, E);
    }); SEAM(11);
    if (IN(12)) { if ((PROBE_DUP >> 12) & 1) p12_route(F, 256); p12_route(F); } SEAM(12);
    if (IN(13)) REP(13, { p13_slots(F); }); SEAM(13);
    if (IN(14)) REP(14, {
        const int ntiles = (int)__hip_atomic_load(ctl + CW_NTILES, RLX_AGENT);
        LAS int* rtc = (LAS int*)(F.lds + RT_LDS_OFF); for (int i = threadIdx.x; i < 3 * ntiles; i += 512) rtc[i] = WSP(int, WS_RT)[i]; __syncthreads();
        pg8::Gemm g{WSP(unsigned char, WS_H2Q), WSP(unsigned char, WS_WEGU), DM, 128, 127 - 6, 127}; pg8::MoeOrder S{rtc, ntiles, 4, F.G, vcu_, WSP(int, WS_SLOTTOK), 2048u, PRB(14)};
        pg8::EpiSwiglu E{WSP(unsigned char, WS_HID), WSP(float, WS_SLOTW)};
        pg8::gemm_phase<pg8::EpiSwiglu, pg8::MoeOrder, true, true, true, false>(F.lds, g, S, E);
    }); SEAM(14);
    if (IN(15)) REP(15, {
        const int ntiles = (int)__hip_atomic_load(ctl + CW_NTILES, RLX_AGENT);
        LAS int* rtc = (LAS int*)(F.lds + RT_LDS_OFF); for (int i = threadIdx.x; i < 3 * ntiles; i += 512) rtc[i] = WSP(int, WS_RT)[i]; __syncthreads();
        pg8::Gemm g{WSP(unsigned char, WS_HID), WSP(unsigned char, WS_WED), EFF, 128, 127 - 6, 127 - 4}; pg8::MoeOrder S{rtc, ntiles, 8, F.G, vcu_, nullptr, 512u, PRB(15)};
        pg8::EpiFp8 E{WSP(unsigned char, WS_YSLOT), DM, 64.f / 1024.f};
        pg8::gemm_phase<pg8::EpiFp8, pg8::MoeOrder, false, true, true>(F.lds, g, S, E);
    }); SEAM(15);
    if (IN(16)) { if ((PROBE_DUP >> 16) & 1) p16_final(F, false); p16_final(F); }
#undef IN
#undef SEAM
}

extern "C" void kernel_launch(void* const* d_in, const int* in_sizes, int n_in, void* d_out, int out_size, void* d_ws, size_t ws_size, hipStream_t stream) {
    static int grid = 0;
    if (grid == 0) {
        if (n_in != 27 || out_size != NTOK * DM || ws_size < WS_END) { fprintf(stderr, "kernel_launch: unexpected shapes (n_in %d out %d ws %zu)\n", n_in, out_size, ws_size); grid = -1; return; }
        int dev = 0, cus = 0, per_cu = 0;
        if (hipGetDevice(&dev) != hipSuccess || hipDeviceGetAttribute(&cus, hipDeviceAttributeMultiprocessorCount, dev) != hipSuccess) { grid = -1; return; }
        if (hipFuncSetAttribute((const void*)mega_fwd, hipFuncAttributeMaxDynamicSharedMemorySize, LDS_BYTES) != hipSuccess) { fprintf(stderr, "kernel_launch: hipFuncSetAttribute failed\n"); grid = -1; return; }
        if (hipOccupancyMaxActiveBlocksPerMultiprocessor(&per_cu, (const void*)mega_fwd, 512, LDS_BYTES) != hipSuccess || per_cu < 1) fprintf(stderr, "kernel_launch: occupancy query says %d\n", per_cu);
        (void)hipGetLastError();
        grid = cus;
    }
    if (grid < 0) return;
    (void)hipMemsetAsync((char*)d_ws + WS_CTL, 0, CTL_ZERO_BYTES, stream);
    Args a{};
    for (int i = 0; i < 27; ++i) a.in[i] = (const float*)d_in[i];
    a.out = (float*)d_out; a.ws = (unsigned char*)d_ws;
#if MK_PER_PHASE
    for (int p = 0; p < NPHASE; ++p) { a.ph_lo = p; a.ph_hi = p + 1; a.li = p; hipLaunchKernelGGL(mega_fwd, dim3(grid), dim3(512), LDS_BYTES, stream, a); }
#else
    a.ph_lo = 0; a.ph_hi = NPHASE; a.li = 0;
    hipLaunchKernelGGL(mega_fwd, dim3(grid), dim3(512), LDS_BYTES, stream, a);
#endif
}
```

```cpp
#include <hip/hip_runtime.h>
#include <cstdio>
#include <cstdint>

#define GAS __attribute__((address_space(1)))
#define LAS __attribute__((address_space(3)))
typedef unsigned short bf16;
typedef unsigned v4u __attribute__((ext_vector_type(4)));
typedef unsigned v2u __attribute__((ext_vector_type(2)));
typedef float f32x4 __attribute__((ext_vector_type(4)));
typedef float f32x2 __attribute__((ext_vector_type(2)));
typedef short bf16x8 __attribute__((ext_vector_type(8)));
typedef GAS unsigned gu32;
typedef int v8i __attribute__((ext_vector_type(8)));
typedef int v4i __attribute__((ext_vector_type(4)));

#ifndef PROBE_DUP
#define PROBE_DUP 0x0
#endif
#define PRB(k) (1 + ((PROBE_DUP >> (16 + (k))) & 1))
#define REP(k, ...) do { __VA_ARGS__ if ((PROBE_DUP >> (k)) & 1) { __VA_ARGS__ } } while (0)
#ifndef MK_PER_PHASE
#define MK_PER_PHASE 0
#endif

constexpr int NB = 8, SEQ = 2048, DM = 2048, NTOK = NB * SEQ;
constexpr int PLD = 9984;
constexpr int PC_Q = 0, PC_KC = 1024, PC_KS = 1280, PC_KW = 1536, PC_QKM = 1792, PC_G3 = 2816, PC_IF = 2864, PC_VC = 3072, PC_VS = 3328, PC_VW = 3584, PC_VM = 3840, PC_OM = 4864, PC_GA = 5888, PC_GB = 7936;
constexpr int PN_BF = 3072, PN_F8 = 6912;
constexpr int D_IN = 9784;
constexpr int PROJ_MODE = 1;
constexpr int NEXP = 64, EFF = 512;
constexpr int NSLOT = NTOK * 8;
constexpr int NSLOT_ALL = NSLOT + NTOK;
constexpr float EPS = 1e-6f;
constexpr float QC2 = 0.18033688011112042f;

constexpr size_t MiB = 1u << 20;
constexpr size_t WS_CTL = 0, CTL_ZERO_BYTES = 64 * 1024;
constexpr size_t WS_MOD = 1 * MiB;
constexpr size_t WS_BIAS1 = 1 * MiB + 512 * 1024;
constexpr size_t WS_GA = 2 * MiB, WS_GU = 2 * MiB + 256 * 1024, WS_GM = 2 * MiB + 512 * 1024;
constexpr size_t WS_SELM = 3 * MiB;
constexpr size_t WS_KCV = 4 * MiB;
constexpr size_t WS_HIDC = 6 * MiB;
constexpr size_t WS_TE = 14 * MiB, WS_TP = 14 * MiB + 512 * 1024, WS_TW = 15 * MiB, WS_TOKSLOT = 15 * MiB + 512 * 1024;
constexpr size_t WS_SLOTTOK = 16 * MiB, WS_SLOTW = 17 * MiB, WS_RT = 18 * MiB;
constexpr size_t WS_LOGITS = 19 * MiB;
constexpr size_t WS_WED = 32 * MiB;
constexpr size_t WS_WOUT = 162 * MiB;
constexpr size_t WS_WUP = 170 * MiB;
constexpr size_t WS_CW1 = 178 * MiB;
constexpr size_t WS_CW2 = 181 * MiB;
constexpr size_t WS_WR = 180 * MiB;
constexpr size_t WS_H2 = 182 * MiB;
constexpr size_t WS_HID = 246 * MiB;
constexpr size_t WS_H2Q = 340 * MiB;
constexpr size_t WS_WIN = 392 * MiB;
constexpr size_t WS_WIN8 = 412 * MiB;
constexpr size_t WS_WEGU = 432 * MiB;
constexpr size_t WS_PROJ = 692 * MiB;
constexpr size_t WS_H1 = 1004 * MiB;
constexpr size_t WS_H1Q = 1068 * MiB;
constexpr size_t WS_END = 1100 * MiB;
constexpr size_t WS_OACC = WS_HID;
constexpr size_t WS_OMIX = WS_HID + 64 * MiB;
constexpr size_t WS_T1 = WS_H2;
constexpr size_t WS_QKC = WS_H1;
constexpr size_t WS_MERGED = WS_H1;
constexpr size_t WS_X1B = WS_H1;
constexpr size_t WS_Y = WS_PROJ;
constexpr size_t WS_YSLOT = WS_WEGU;
static_assert(WS_YSLOT + (size_t)NSLOT_ALL * 2048 <= WS_END, "yslot");
static_assert(WS_HID + (size_t)(NSLOT_ALL + 256) * 512 <= WS_H2Q && WS_H2Q + (size_t)NTOK * DM <= WS_WIN, "hid");
constexpr int CW_CNT = 64;
constexpr int CW_MLQ = 200;
constexpr int CW_NTILES = 192;
constexpr int CW_BAR = 4096;

constexpr int RT_LDS_OFF = 131072 + 512 + 4096;
constexpr int RING_BYTES = 131072, LDSCTL_OFF = RING_BYTES, MISC_OFF = LDSCTL_OFF + 320, LDS_BYTES = 147456;

#define LDS_WAIT() asm volatile("s_waitcnt lgkmcnt(0)" ::: "memory")
#define VM_WAIT() asm volatile("s_waitcnt vmcnt(0)" ::: "memory")
#define RLX_AGENT __ATOMIC_RELAXED, __HIP_MEMORY_SCOPE_AGENT
__device__ __forceinline__ unsigned f2bf(float f) { unsigned u = __builtin_bit_cast(unsigned, f); return (u + 0x7fffu + ((u >> 16) & 1u)) >> 16; }
__device__ __forceinline__ unsigned pk2(float lo, float hi) { return f2bf(lo) | (f2bf(hi) << 16); }
__device__ __forceinline__ float bf2f(unsigned h) { return __uint_as_float(h << 16); }
__device__ __forceinline__ float bflo(unsigned w) { return __uint_as_float(w << 16); }
__device__ __forceinline__ float bfhi(unsigned w) { return __uint_as_float(w & 0xffff0000u); }
__device__ __forceinline__ float frcp(float x) { return __builtin_amdgcn_rcpf(x); }
__device__ __forceinline__ float sigm(float x) { return frcp(1.f + __expf(-x)); }
__device__ __forceinline__ float sigm_ieee(float x) { return 1.f / (1.f + __expf(-x)); }
__device__ __forceinline__ float wave_sum(float v) {
#pragma unroll
    for (int o = 1; o < 64; o <<= 1) v += __shfl_xor(v, o);
    return v;
}
__device__ __forceinline__ float wave_max(float v) {
#pragma unroll
    for (int o = 1; o < 64; o <<= 1) v = fmaxf(v, __shfl_xor(v, o));
    return v;
}
__device__ __forceinline__ unsigned long long uaddr(const void* p) {
    const unsigned long long a = (unsigned long long)p; const unsigned lo = __builtin_amdgcn_readfirstlane((unsigned)a), hi = __builtin_amdgcn_readfirstlane((unsigned)(a >> 32));
    return ((unsigned long long)hi << 32) | lo; }
#define UPTR(T, p) ((GAS T*)uaddr(p))
__device__ __forceinline__ int tid_opaque() { int t = threadIdx.x; asm volatile("" : "+v"(t)); return t; }
__device__ __forceinline__ float rdlane(float v, int l) { return __int_as_float(__builtin_amdgcn_readlane(__float_as_int(v), l)); }

namespace pg8 {
constexpr int BM = 256, BK = 64, HALF = 128, HTB = HALF * BK * 2, STAGE_BYTES = 8 * HTB, NXCD = 8, WGM = 8;
__host__ __device__ __forceinline__ int lds_byte(int r, int c) { const int st = (r >> 4) * 2 + (c >> 5), rr = r & 15, cc = c & 31, ob = rr * 64 + cc * 2; return st * 1024 + (ob ^ (((ob >> 9) & 1) << 5)); }
__host__ __device__ __forceinline__ void stage_rc(int b, int& R, int& C) { const int st = b / 1024, sb = b % 1024, swz = sb ^ (((sb >> 9) & 1) << 5); R = (st >> 1) * 16 + swz / 64; C = (st & 1) * 32 + (swz % 64) / 2; }
__host__ __device__ __forceinline__ int perm32(int rho) { const int n = rho >> 4, i = rho & 15; return 8 * (i >> 2) + 4 * n + (i & 3); }

struct Unit { int arow, pn, valid, aux; };
struct Gemm { const void* A; const void* Bt; int K; int kstepA; int scW, scX; };

struct StaticOrder {
    int nM, nN, nwg, G, c, reps;
    __device__ void init(int M, int N, int G_, int c_, int reps_ = 1) { nM = M / BM; nN = N / BM; nwg = nM * nN; G = G_; c = c_; reps = reps_; }
    __device__ bool next(int i, Unit& u) const {
        long L = (long)i * G + c; if (L >= (long)nwg * reps) return false; L %= nwg;
        int wgid = (int)L; { const int q = nwg / NXCD, r = nwg % NXCD, xcd = wgid % NXCD, off = wgid / NXCD; wgid = (xcd < r ? xcd * (q + 1) : r * (q + 1) + (xcd - r) * q) + off; }
        const int nig = WGM * nN, gid = wgid / nig, fm = gid * WGM, gsz = (nM - fm) < WGM ? (nM - fm) : WGM;
        u.arow = (fm + ((wgid % nig) % gsz)) * BM; u.pn = (wgid % nig) / gsz; u.valid = BM; u.aux = u.pn; return true;
    }
    __device__ __forceinline__ unsigned rowkey(const Unit&, int) const { return 0u; }
    __device__ __forceinline__ unsigned keyoff(const Unit&, unsigned) const { return 0u; }
};
struct CmpOrder {
    int G, c;
    __device__ bool next(int i, Unit& u) const { const int L = i * G + c; if (L >= 32) return false; const int kv = L >> 4, pm = L & 15; u.arow = 256 * pm; u.pn = kv; u.valid = (4064 - 256 * pm) < 256 ? (4064 - 256 * pm) : 256; u.aux = kv; return true; }
    __device__ __forceinline__ unsigned rowkey(const Unit& u, int lr) const { int rr = u.arow + lr; rr = (rr < 4064) ? rr : 0; const int b = rr / 508, n = (rr % 508) >> 2, g = rr & 3; return (unsigned)((b * SEQ + 16 * n) | (g << 14)); }
    __device__ __forceinline__ unsigned keyoff(const Unit& u, unsigned key) const { return (unsigned)(((size_t)(key & 0x3fffu) * PLD + (u.aux ? PC_VC : PC_KC) + (key >> 14) * 64) * 2); }
};
struct MoeOrder {
    const LAS int* rt; int ntiles, NCT, G, c; const int* rows; unsigned rbytes; int reps;
    __device__ __forceinline__ unsigned rowkey(const Unit& u, int lr) const { return (unsigned)((lr < u.valid) ? rows[u.arow + lr] : 0); }
    __device__ __forceinline__ unsigned keyoff(const Unit&, unsigned key) const { return key * rbytes; }
    __device__ bool next(int i, Unit& u) const {
        long L = (long)i * G + c; if (L >= (long)ntiles * NCT * reps) return false; L %= (long)ntiles * NCT;
        const int j = (int)(L / NCT), ct = (int)(L % NCT);
        const int e = __builtin_amdgcn_readfirstlane(rt[3 * j]), base = __builtin_amdgcn_readfirstlane(rt[3 * j + 1]), v = __builtin_amdgcn_readfirstlane(rt[3 * j + 2]);
        u.arow = base; u.pn = e * NCT + ct; u.valid = v; u.aux = ct; return true;
    }
};

__device__ __forceinline__ unsigned cvt_pk_bf16(float lo, float hi) { unsigned r; asm volatile("v_cvt_pk_bf16_f32 %0, %1, %2" : "=v"(r) : "v"(lo), "v"(hi)); return r; }

struct EpiBf16 {
    static constexpr bool PERM = true;
    bf16* O; int ldc; int nscaled; float scale0; float scale1 = 1.f;
    __device__ __forceinline__ void operator()(const f32x4 (&acc)[2][2][4][2], const Unit& u, int wr, int wc, int fr, int fq) const {
        const float sc = (u.aux < nscaled) ? scale0 : scale1;
#pragma unroll
        for (int ai = 0; ai < 2; ++ai)
#pragma unroll
            for (int m = 0; m < 4; ++m) { const int lr = ai * HALF + wr * 64 + m * 16 + fr; if (lr < u.valid) { bf16* rowp = O + (size_t)(u.arow + lr) * ldc + u.aux * BM + wc * 32 + 8 * fq;
#pragma unroll
                for (int bj = 0; bj < 2; ++bj) { const f32x4 v0 = acc[ai][bj][m][0] * sc, v1 = acc[ai][bj][m][1] * sc; v4u w; w.x = cvt_pk_bf16(v0[0], v0[1]); w.y = cvt_pk_bf16(v0[2], v0[3]); w.z = cvt_pk_bf16(v1[0], v1[1]); w.w = cvt_pk_bf16(v1[2], v1[3]);
                    *(v4u*)(rowp + bj * HALF) = w; } } }
    }
};
struct EpiFp8 {
    static constexpr bool PERM = true;
    unsigned char* O; int ldc; float scale;
    __device__ __forceinline__ void operator()(const f32x4 (&acc)[2][2][4][2], const Unit& u, int wr, int wc, int fr, int fq) const {
#pragma unroll
        for (int ai = 0; ai < 2; ++ai)
#pragma unroll
            for (int m = 0; m < 4; ++m) { const int lr = ai * HALF + wr * 64 + m * 16 + fr; if (lr < u.valid) { unsigned char* rowp = O + (size_t)(u.arow + lr) * ldc + u.aux * BM + wc * 32 + 8 * fq;
#pragma unroll
                for (int bj = 0; bj < 2; ++bj) { float r[8];
#pragma unroll
                    for (int n = 0; n < 2; ++n)
#pragma unroll
                        for (int k = 0; k < 4; ++k) r[4 * n + k] = fminf(fmaxf(acc[ai][bj][m][n][k] * scale, -448.f), 448.f);
                    int o0 = 0, o1 = 0; o0 = __builtin_amdgcn_cvt_pk_fp8_f32(r[0], r[1], o0, false); o0 = __builtin_amdgcn_cvt_pk_fp8_f32(r[2], r[3], o0, true);
                    o1 = __builtin_amdgcn_cvt_pk_fp8_f32(r[4], r[5], o1, false); o1 = __builtin_amdgcn_cvt_pk_fp8_f32(r[6], r[7], o1, true);
                    v2u o; o.x = (unsigned)o0; o.y = (unsigned)o1; *(v2u*)(rowp + bj * HALF) = o; } } }
    }
};
struct EpiGate {
    static constexpr bool PERM = true;
    bf16* O; const bf16* gate; int ldg; const bf16* prev;
    __device__ __forceinline__ void operator()(const f32x4 (&acc)[2][2][4][2], const Unit& u, int wr, int wc, int fr, int fq) const {
#pragma unroll
        for (int ai = 0; ai < 2; ++ai)
#pragma unroll
            for (int m = 0; m < 4; ++m) { const int row = u.arow + ai * HALF + wr * 64 + m * 16 + fr; const int col = u.pn * BM + wc * 32 + 8 * fq;
#pragma unroll
                for (int bj = 0; bj < 2; ++bj) {
                    const v4u gq = *(const v4u*)(gate + (size_t)row * ldg + col + bj * HALF);
                    const f32x4 v0 = acc[ai][bj][m][0], v1 = acc[ai][bj][m][1];
                    float r[8];
                    r[0] = sigm(bflo(gq.x)) * v0[0]; r[1] = sigm(bfhi(gq.x)) * v0[1]; r[2] = sigm(bflo(gq.y)) * v0[2]; r[3] = sigm(bfhi(gq.y)) * v0[3];
                    r[4] = sigm(bflo(gq.z)) * v1[0]; r[5] = sigm(bfhi(gq.z)) * v1[1]; r[6] = sigm(bflo(gq.w)) * v1[2]; r[7] = sigm(bfhi(gq.w)) * v1[3];
                    if (prev) { const v4u pq = *(const v4u*)(prev + (size_t)row * 2048 + col + bj * HALF);
                        r[0] += bflo(pq.x); r[1] += bfhi(pq.x); r[2] += bflo(pq.y); r[3] += bfhi(pq.y); r[4] += bflo(pq.z); r[5] += bfhi(pq.z); r[6] += bflo(pq.w); r[7] += bfhi(pq.w); }
                    v4u w; w.x = cvt_pk_bf16(r[0], r[1]); w.y = cvt_pk_bf16(r[2], r[3]); w.z = cvt_pk_bf16(r[4], r[5]); w.w = cvt_pk_bf16(r[6], r[7]);
                    *(v4u*)(O + (size_t)row * 2048 + col + bj * HALF) = w; } }
    }
};
struct MidGate {
    static constexpr bool ON = true;
    const bf16* ga; const bf16* gb; int ldg;
    __device__ __forceinline__ void operator()(f32x4 (&acc)[2][2][4][2], const Unit& u, int wr, int wc, int fr, int fq) const {
#pragma unroll
        for (int ai = 0; ai < 2; ++ai)
#pragma unroll
            for (int m = 0; m < 4; ++m) { const size_t off = (size_t)(u.arow + ai * HALF + wr * 64 + m * 16 + fr) * ldg + u.pn * BM + wc * 32 + 8 * fq;
#pragma unroll
                for (int bj = 0; bj < 2; ++bj) { const v4u a = *(const v4u*)(ga + off + bj * HALF), b = *(const v4u*)(gb + off + bj * HALF);
#define MG_R(xa, xb) ((1.f + __expf(-(xb))) * frcp(1.f + __expf(-(xa))))
                    acc[ai][bj][m][0][0] *= MG_R(bflo(a.x), bflo(b.x)); acc[ai][bj][m][0][1] *= MG_R(bfhi(a.x), bfhi(b.x)); acc[ai][bj][m][0][2] *= MG_R(bflo(a.y), bflo(b.y)); acc[ai][bj][m][0][3] *= MG_R(bfhi(a.y), bfhi(b.y));
                    acc[ai][bj][m][1][0] *= MG_R(bflo(a.z), bflo(b.z)); acc[ai][bj][m][1][1] *= MG_R(bfhi(a.z), bfhi(b.z)); acc[ai][bj][m][1][2] *= MG_R(bflo(a.w), bflo(b.w)); acc[ai][bj][m][1][3] *= MG_R(bfhi(a.w), bfhi(b.w));
#undef MG_R
                } }
    }
};
struct EpiF32 {
    static constexpr bool PERM = false;
    float* C; int ldc; int ncols;
    __device__ __forceinline__ void operator()(const f32x4 (&acc)[2][2][4][2], const Unit& u, int wr, int wc, int fr, int fq) const {
#pragma unroll
        for (int ai = 0; ai < 2; ++ai)
#pragma unroll
            for (int m = 0; m < 4; ++m) { float* rowp = C + (size_t)(u.arow + ai * HALF + wr * 64 + m * 16 + fr) * ldc; const int col0 = u.pn * BM + wc * 32 + 4 * fq;
#pragma unroll
                for (int bj = 0; bj < 2; ++bj)
#pragma unroll
                    for (int n = 0; n < 2; ++n) { const int col = col0 + bj * HALF + n * 16; if (col < ncols) *(f32x4*)(rowp + col) = acc[ai][bj][m][n]; } }
    }
};
struct EpiCmpHid {
    static constexpr bool PERM = true;
    bf16* H; const float* bias;
    __device__ __forceinline__ void operator()(const f32x4 (&acc)[2][2][4][2], const Unit& u, int wr, int wc, int fr, int fq) const {
        f32x4 bv[2][2];
#pragma unroll
        for (int bj = 0; bj < 2; ++bj)
#pragma unroll
            for (int n = 0; n < 2; ++n) bv[bj][n] = *(const f32x4*)(bias + u.aux * 256 + bj * HALF + wc * 32 + 8 * fq + 4 * n);
#pragma unroll
        for (int ai = 0; ai < 2; ++ai)
#pragma unroll
            for (int m = 0; m < 4; ++m) { const int lr = ai * HALF + wr * 64 + m * 16 + fr; if (lr < u.valid) { bf16* rowp = H + (size_t)(u.aux * 4096 + u.arow + lr) * 256 + wc * 32 + 8 * fq;
#pragma unroll
                for (int bj = 0; bj < 2; ++bj) { float r[8];
#pragma unroll
                    for (int n = 0; n < 2; ++n)
#pragma unroll
                        for (int k = 0; k < 4; ++k) { const float x = acc[ai][bj][m][n][k] + bv[bj][n][k]; const float uu = 0.7978845608028654f * (x + 0.044715f * x * x * x); const float th = 1.f - 2.f * frcp(1.f + __expf(2.f * uu)); r[4 * n + k] = 0.5f * x * (1.f + th); }
                    v4u w; w.x = cvt_pk_bf16(r[0], r[1]); w.y = cvt_pk_bf16(r[2], r[3]); w.z = cvt_pk_bf16(r[4], r[5]); w.w = cvt_pk_bf16(r[6], r[7]);
                    *(v4u*)(rowp + bj * HALF) = w; } } }
    }
};
struct EpiSwiglu {
    static constexpr bool PERM = true;
    unsigned char* H; const float* w;
    __device__ __forceinline__ void operator()(const f32x4 (&acc)[2][2][4][2], const Unit& u, int wr, int wc, int fr, int fq) const {
#pragma unroll
        for (int ai = 0; ai < 2; ++ai)
#pragma unroll
            for (int m = 0; m < 4; ++m) { const int lr = ai * HALF + wr * 64 + m * 16 + fr; if (lr < u.valid) { const int row = u.arow + lr; const float ws = w[row];
                float r[8];
#pragma unroll
                for (int n = 0; n < 2; ++n)
#pragma unroll
                    for (int k = 0; k < 4; ++k) { const float gv = acc[ai][0][m][n][k] * (1.f / 64.f), uv = acc[ai][1][m][n][k] * (1.f / 64.f); r[4 * n + k] = fminf(fmaxf(gv * sigm(gv) * uv * ws * 16.f, -448.f), 448.f); }
                int o0 = 0, o1 = 0; o0 = __builtin_amdgcn_cvt_pk_fp8_f32(r[0], r[1], o0, false); o0 = __builtin_amdgcn_cvt_pk_fp8_f32(r[2], r[3], o0, true);
                o1 = __builtin_amdgcn_cvt_pk_fp8_f32(r[4], r[5], o1, false); o1 = __builtin_amdgcn_cvt_pk_fp8_f32(r[6], r[7], o1, true);
                v2u o; o.x = (unsigned)o0; o.y = (unsigned)o1;
                *(v2u*)(H + (size_t)row * EFF + u.aux * HALF + wc * 32 + 8 * fq) = o; } }
    }
};

struct NoMid { static constexpr bool ON = false; __device__ __forceinline__ void operator()(f32x4 (&)[2][2][4][2], const Unit&, int, int, int, int) const {} };
template <class Epi, class Sched, bool GATHER, bool ALIGN_EPI, bool FP8 = false, bool RD32 = false, class Mid = NoMid>
__device__ __forceinline__ void gemm_phase(LAS unsigned char* lds, const Gemm g, const Sched& S, const Epi& E, const Mid& MH = Mid()) {
    const int tid = tid_opaque(), wid = __builtin_amdgcn_readfirstlane(tid >> 6), lane = tid & 63, wr = wid >> 2, wc = wid & 3, fr = lane & 15, fq = lane >> 4;
    constexpr int EB = FP8 ? 1 : 2;
    const int K = g.K; const size_t rstep = (size_t)K * EB; const int nt = (int)(rstep / 128);
    unsigned voffA[2], voffB[2];
#pragma unroll
    for (int i = 0; i < 2; ++i) { int R, C; stage_rc(tid * 16 + i * 8192, R, C); const int Rb = Epi::PERM ? ((R & ~31) + perm32(R & 31)) : R;
        voffA[i] = (unsigned)(R * rstep + C * 2); voffB[i] = (unsigned)(Rb * rstep + C * 2); }
    const unsigned r64 = (unsigned)(64 * rstep);
    const size_t kstep = (size_t)(BK * 2);
    const size_t kstepA = GATHER ? (size_t)g.kstepA : kstep;
    const size_t hstep = (size_t)HALF * rstep;
    const size_t tstep = 2 * hstep;
    const unsigned ldsw = (unsigned)wid * 1024u;
    const int aoff = lds_byte(wr * 64 + fr, fq * (FP8 ? 16 : 8)), boff = lds_byte(wc * 32 + fr, fq * (FP8 ? 16 : 8));
    unsigned gkey[2];
    LAS v2u* gstash = (LAS v2u*)(lds + STAGE_BYTES + 512 + tid * 8);
    unsigned gcol = 0; { int R_, C_; stage_rc(tid * 16, R_, C_); gcol = (unsigned)C_ * 2u; }
    Unit gu;
#define PG8_SA(b, h) (((b) * 2 + (h)) * HTB)
#define PG8_SB(b, h) ((4 + (b) * 2 + (h)) * HTB)
#define PG8_STG(bufoff, ptr, v0, v1) do { \
        __builtin_amdgcn_global_load_lds((const unsigned*)((const char*)(ptr) + (v0)), (LAS unsigned*)(lds + (bufoff) + ldsw), 16, 0, 0); \
        __builtin_amdgcn_global_load_lds((const unsigned*)((const char*)(ptr) + (v1)), (LAS unsigned*)(lds + (bufoff) + ldsw + 8192), 16, 0, 0); } while (0)
#define PG8_STAGE_B(bufoff, ptr) PG8_STG(bufoff, ptr, voffB[0], voffB[0] + r64)
#define PG8_STAGE_A(bufoff, ptr, h, nx) do { if constexpr (GATHER) { const unsigned o0_ = S.keyoff(gu, gkey[h] & 0xffffu) + gcol, o1_ = S.keyoff(gu, gkey[h] >> 16) + gcol; PG8_STG(bufoff, ptr, o0_, o1_); } \
        else { PG8_STG(bufoff, (const char*)(ptr) + (h) * hstep, voffA[0], voffA[0] + r64); } } while (0)
#define PG8_GLOAD(dst, u) do { int R_, C_; stage_rc(tid * 16, R_, C_); _Pragma("unroll") for (int h_ = 0; h_ < 2; ++h_) \
        dst[h_] = S.rowkey((u), h_ * HALF + R_) | (S.rowkey((u), h_ * HALF + R_ + 64) << 16); } while (0)
#define PG8_RD8(off) (RD32 ? *(const LAS v8i*)(lds + (off)) : __builtin_shufflevector(*(const LAS v4i*)(lds + (off)), *(const LAS v4i*)(lds + (off) + 16), 0, 1, 2, 3, 4, 5, 6, 7))
#define PG8_LDA(dst, b, h) do { if constexpr (FP8) { _Pragma("unroll") for (int m = 0; m < 4; ++m) dst##8[m] = PG8_RD8(PG8_SA(b, h) + aoff + m * 2048); } \
        else { _Pragma("unroll") for (int m = 0; m < 4; ++m) _Pragma("unroll") for (int k = 0; k < 2; ++k) dst[m][k] = *(const LAS bf16x8*)(lds + PG8_SA(b, h) + aoff + m * 2048 + k * 1024); } } while (0)
#define PG8_LDB(dst, b, h) do { if constexpr (FP8) { _Pragma("unroll") for (int n = 0; n < 2; ++n) dst##8[n] = PG8_RD8(PG8_SB(b, h) + boff + n * 2048); } \
        else { _Pragma("unroll") for (int n = 0; n < 2; ++n) _Pragma("unroll") for (int k = 0; k < 2; ++k) dst[n][k] = *(const LAS bf16x8*)(lds + PG8_SB(b, h) + boff + n * 2048 + k * 1024); } } while (0)
#define PG8_MMA(ai, bj, At, Bt) do { __builtin_amdgcn_s_setprio(1); if constexpr (FP8) { _Pragma("unroll") for (int m = 0; m < 4; ++m) _Pragma("unroll") for (int n = 0; n < 2; ++n) \
        asm volatile("v_mfma_f32_16x16x128_f8f6f4 %0, %1, %2, %0" : "+v"(acc[ai][bj][m][n]) : "v"(Bt##8[n]), "v"(At##8[m])); } \
        else { _Pragma("unroll") for (int m = 0; m < 4; ++m) _Pragma("unroll") for (int n = 0; n < 2; ++n) _Pragma("unroll") for (int k = 0; k < 2; ++k) \
        acc[ai][bj][m][n] = __builtin_amdgcn_mfma_f32_16x16x32_bf16(Bt[n][k], At[m][k], acc[ai][bj][m][n], 0, 0, 0); } __builtin_amdgcn_s_setprio(0); } while (0)
#define PG8_WAIT_V(n) asm volatile("s_waitcnt vmcnt(" #n ")" ::: "memory")
#define PG8_WAIT_L(n) asm volatile("s_waitcnt lgkmcnt(" #n ")" ::: "memory")
#define PG8_BAR __builtin_amdgcn_s_barrier()
#define PG8_SCHED __builtin_amdgcn_sched_barrier(0)
    Unit cur, nxt; int ui = 0;
    if (!S.next(0, cur)) return;
    f32x4 acc[2][2][4][2];
#pragma unroll
    for (int a = 0; a < 2; ++a)
#pragma unroll
        for (int b = 0; b < 2; ++b)
#pragma unroll
            for (int m = 0; m < 4; ++m)
#pragma unroll
                for (int n = 0; n < 2; ++n) acc[a][b][m][n] = (f32x4){0.f, 0.f, 0.f, 0.f};
    bf16x8 At[4][2], B0[2][2], B1[2][2]; v8i At8[4], B08[2], B18[2];
    const char* cA = GATHER ? (const char*)g.A : (const char*)g.A + (size_t)cur.arow * rstep; const char* cB = (const char*)g.Bt + (size_t)cur.pn * tstep;
    if constexpr (GATHER) { PG8_GLOAD(gkey, cur); gu = cur; }
    PG8_STAGE_B(PG8_SB(0, 0), cB); PG8_STAGE_B(PG8_SB(0, 1), cB + hstep); PG8_STAGE_A(PG8_SA(0, 0), cA, 0, false); PG8_STAGE_A(PG8_SA(0, 1), cA, 1, false);
    if (wr == 1) PG8_BAR;
    PG8_WAIT_V(2); PG8_BAR;
    PG8_STAGE_B(PG8_SB(1, 0), cB + kstep); PG8_STAGE_A(PG8_SA(1, 0), cA + kstepA, 0, false); PG8_STAGE_B(PG8_SB(1, 1), cB + hstep + kstep);
    PG8_WAIT_V(6); PG8_BAR;
    for (;;) {
        const bool has_next = S.next(ui + 1, nxt);
        if constexpr (GATHER) { if (has_next) { unsigned gt_[2]; PG8_GLOAD(gt_, nxt); *gstash = (v2u){gt_[0], gt_[1]}; } }
        const char* nA = GATHER ? cA : (has_next ? (const char*)g.A + (size_t)nxt.arow * rstep : cA); const char* nB = has_next ? (const char*)g.Bt + (size_t)nxt.pn * tstep : cB;
        for (int t = 0; t < nt; t += 2) {
            const bool last = (t == nt - 2);
            const bool nx = last && has_next;
            if constexpr (Mid::ON) { if (t == nt / 2) { Unit mu; mu.arow = __builtin_amdgcn_readfirstlane(cur.arow); mu.pn = __builtin_amdgcn_readfirstlane(cur.pn); mu.valid = cur.valid; mu.aux = cur.aux;
                int fr_ = fr, fq_ = fq; asm volatile("" : "+s"(mu.arow), "+s"(mu.pn), "+v"(fr_), "+v"(fq_)); MH(acc, mu, wr, wc, fr_, fq_); } }
            const char* a1 = cA + (size_t)(t + 1) * kstepA;
            const char* a2 = last ? nA : cA + (size_t)(t + 2) * kstepA; const char* b2 = last ? nB : cB + (size_t)(t + 2) * kstep;
            const char* a3 = a2 + kstepA; const char* b3 = b2 + kstep;
            PG8_LDB(B0, 0, 0); PG8_LDB(B1, 0, 1); PG8_SCHED; PG8_LDA(At, 0, 0); PG8_STAGE_A(PG8_SA(1, 1), a1, 1, false);
            if constexpr (GATHER) { if (nx) { const v2u s_ = *gstash; gkey[0] = s_.x; gkey[1] = s_.y; gu = nxt; } }
            PG8_WAIT_V(8); PG8_WAIT_L(0); PG8_BAR; PG8_MMA(0, 0, At, B0); PG8_MMA(0, 1, At, B1); PG8_BAR; PG8_SCHED;
            PG8_LDA(At, 0, 1); PG8_STAGE_B(PG8_SB(0, 0), b2); PG8_STAGE_B(PG8_SB(0, 1), b2 + hstep); PG8_STAGE_A(PG8_SA(0, 0), a2, 0, nx);
            PG8_WAIT_V(8); PG8_WAIT_L(0); PG8_BAR; PG8_MMA(1, 0, At, B0); PG8_MMA(1, 1, At, B1); PG8_BAR; PG8_SCHED;
            PG8_LDB(B0, 1, 0); PG8_LDB(B1, 1, 1); PG8_SCHED; PG8_LDA(At, 1, 0); PG8_STAGE_A(PG8_SA(0, 1), a2, 1, nx);
            PG8_WAIT_V(8); PG8_WAIT_L(0); PG8_BAR; PG8_MMA(0, 0, At, B0); PG8_MMA(0, 1, At, B1); PG8_BAR; PG8_SCHED;
            PG8_LDA(At, 1, 1); PG8_STAGE_B(PG8_SB(1, 0), b3); PG8_STAGE_B(PG8_SB(1, 1), b3 + hstep); PG8_STAGE_A(PG8_SA(1, 0), a3, 0, nx);
            PG8_WAIT_V(8); PG8_WAIT_L(0); PG8_BAR; PG8_MMA(1, 0, At, B0); PG8_MMA(1, 1, At, B1); PG8_BAR; PG8_SCHED;
        }
        if constexpr (ALIGN_EPI) { if (wr == 0) PG8_BAR; }
        if constexpr (FP8) asm volatile("s_nop 15\n\ts_nop 7" ::: "memory");
        { Unit eu; eu.arow = __builtin_amdgcn_readfirstlane(cur.arow); eu.pn = __builtin_amdgcn_readfirstlane(cur.pn); eu.valid = __builtin_amdgcn_readfirstlane(cur.valid); eu.aux = __builtin_amdgcn_readfirstlane(cur.aux);
          asm volatile("" : "+s"(eu.arow), "+s"(eu.pn), "+s"(eu.valid), "+s"(eu.aux));
          int fr_ = fr, fq_ = fq; asm volatile("" : "+v"(fr_), "+v"(fq_));
          E(acc, eu, wr, wc, fr_, fq_); }
        if (!has_next) break;
#pragma unroll
        for (int a = 0; a < 2; ++a)
#pragma unroll
            for (int b = 0; b < 2; ++b)
#pragma unroll
                for (int m = 0; m < 4; ++m)
#pragma unroll
                    for (int n = 0; n < 2; ++n) acc[a][b][m][n] = (f32x4){0.f, 0.f, 0.f, 0.f};
        cur = nxt; cA = nA; cB = nB; ++ui;
        if constexpr (ALIGN_EPI) { if (wr == 1) PG8_BAR; }
    }
    PG8_WAIT_V(0);
    if constexpr (!ALIGN_EPI) { if (wr == 0) PG8_BAR; }
    PG8_BAR;
#undef PG8_SA
#undef PG8_SB
#undef PG8_STG
#undef PG8_STAGE_A
#undef PG8_STAGE_B
#undef PG8_GLOAD
#undef PG8_LDA
#undef PG8_RD8
#undef PG8_LDB
#undef PG8_MMA
#undef PG8_WAIT_V
#undef PG8_WAIT_L
#undef PG8_BAR
#undef PG8_SCHED
}
}

#define XB_TMO      128
#define XB_XCNT(j)  (256  + 64 * (j))
#define XB_XSUB(j)  (1280 + 64 * (j))
#define XB_XGEN(j)  (2304 + 64 * (j))
#define XB_TOP      3328
#define XB_TOPGEN   3392
#define XCD_BAR_WORDS 3456
#define XB_SPIN_CAP (1u << 22)

__device__ __forceinline__ unsigned xb_ld(unsigned* p)              { return __hip_atomic_load(p, __ATOMIC_RELAXED, __HIP_MEMORY_SCOPE_AGENT); }
__device__ __forceinline__ unsigned xb_add(unsigned* p, unsigned v) { return __hip_atomic_fetch_add(p, v, __ATOMIC_RELAXED, __HIP_MEMORY_SCOPE_AGENT); }
__device__ __forceinline__ unsigned xb_xcc_id() { return (unsigned)__builtin_amdgcn_s_getreg((3 << 11) | 20) & 0xFu; }
#define XB_SPIN(cond, bar) do { unsigned _sp = 0; while (cond) { __builtin_amdgcn_s_sleep(1); \
    if ((++_sp & 255u) == 0u) { if (xb_ld(&(bar)[XB_TMO])) break; if (_sp > XB_SPIN_CAP) { atomicAdd(&(bar)[XB_TMO], 1u); break; } } } } while (0)

struct XcdBarrier { unsigned* bar; unsigned x; volatile LAS unsigned* st; };

__device__ __forceinline__ XcdBarrier xcd_barrier_post(unsigned* bar, volatile LAS unsigned* st) {
    XcdBarrier b; b.bar = bar; b.x = xb_xcc_id(); b.st = st;
    if (threadIdx.x == 0) (void)xb_add(&bar[XB_XCNT(b.x)], 1u);
    return b;
}
__device__ __forceinline__ void xcd_barrier_complete(unsigned* bar, unsigned x, unsigned& nloc, unsigned& nx) {
    const unsigned G = gridDim.x * gridDim.y * gridDim.z;
    unsigned sum, cnt, mine, sp = 0u;
    for (;;) {
        sum = 0u; cnt = 0u; mine = 0u;
#pragma unroll
        for (unsigned j = 0; j < 16; ++j) { const unsigned c = xb_ld(&bar[XB_XCNT(j)]); sum += c; cnt += (c > 0u) ? 1u : 0u; mine = (j == x) ? c : mine; }
        if (sum == G) break;
        __builtin_amdgcn_s_sleep(1);
        if ((++sp & 255u) == 0u) { if (xb_ld(&bar[XB_TMO])) break; if (sp > XB_SPIN_CAP) { atomicAdd(&bar[XB_TMO], 1u); break; } }
    }
    nloc = mine > 0u ? mine : 1u; nx = cnt > 0u ? cnt : 1u;
}
__device__ __forceinline__ void xcd_barrier(const XcdBarrier& b) {
    asm volatile("s_waitcnt vmcnt(0)" ::: "memory");
    __syncthreads();
    if (threadIdx.x == 0) {
        unsigned* bar = b.bar;
        __builtin_amdgcn_s_waitcnt(0);
        unsigned nloc = b.st[0], nx = b.st[1];
        if (nloc == 0u) { xcd_barrier_complete(bar, b.x, nloc, nx); b.st[0] = nloc; b.st[1] = nx; }
        const unsigned old = xb_add(&bar[XB_XSUB(b.x)], 1u);
        const unsigned gen = old / nloc;
        if (old + 1u == (gen + 1u) * nloc) {
            __builtin_amdgcn_fence(__ATOMIC_RELEASE, "agent");
            asm volatile("s_waitcnt vmcnt(0)" ::: "memory");
            const unsigned og = xb_add(&bar[XB_TOP], 1u);
            const unsigned tg = og / nx;
            if (og + 1u == (tg + 1u) * nx) xb_add(&bar[XB_TOPGEN], 1u);
            else XB_SPIN(xb_ld(&bar[XB_TOPGEN]) == tg, bar);
            __builtin_amdgcn_fence(__ATOMIC_ACQUIRE, "agent");
            xb_add(&bar[XB_XGEN(b.x)], 1u);
            asm volatile("s_waitcnt vmcnt(0)" ::: "memory");
        } else {
            XB_SPIN(xb_ld(&bar[XB_XGEN(b.x)]) == gen, bar);
            __builtin_amdgcn_fence(__ATOMIC_ACQUIRE, "agent");
            asm volatile("s_waitcnt vmcnt(0)" ::: "memory");
        }
    }
    __syncthreads();
}

struct Frame {
    LAS unsigned char* lds;
    unsigned char* ws;
    const float* const* in;
    float* out;
    int tid, lane, wave, G, gw, ngw;
};
#define WSP(T, off) ((T*)(F.ws + (off)))
#define INP(k) (F.in[k])

template <class RowMap>
__device__ __forceinline__ void transpose_item(const float* W, int K, int N, bf16* WT, int ldt, LAS float* scr, int item, int lane, RowMap rm) {
    const int nblk = (N + 31) / 32, kb = item / nblk, nb = item % nblk, k0 = 64 * kb, n0 = 32 * nb;
    const int nn = n0 + (lane & 31);
#pragma unroll 8
    for (int i = 0; i < 32; ++i) { const int kk = 2 * i + (lane >> 5); scr[kk * 33 + (lane & 31)] = (nn < N) ? W[(size_t)(k0 + kk) * N + nn] : 0.f; }
    LDS_WAIT(); asm volatile("" ::: "memory");
    const int c = lane & 7;
#pragma unroll
    for (int j = 0; j < 4; ++j) { const int n = (lane >> 3) + 8 * j; const LAS float* s = scr + (8 * c) * 33 + n;
        v4u o; o.x = pk2(s[0 * 33], s[1 * 33]); o.y = pk2(s[2 * 33], s[3 * 33]); o.z = pk2(s[4 * 33], s[5 * 33]); o.w = pk2(s[6 * 33], s[7 * 33]);
        if (n0 + n < N) *(v4u*)(WT + (size_t)rm(n0 + n) * ldt + k0 + 8 * c) = o; }
    LDS_WAIT(); asm volatile("" ::: "memory");
}
template <class RowMap>
__device__ __forceinline__ void transpose_item8(const float* W, int K, int N, unsigned char* WT, int ldt, LAS float* scr, int item, int lane, RowMap rm) {
    const int nblk = (N + 31) / 32, kb = item / nblk, nb = item % nblk, k0 = 64 * kb, n0 = 32 * nb;
    const int nn = n0 + (lane & 31);
#pragma unroll 8
    for (int i = 0; i < 32; ++i) { const int kk = 2 * i + (lane >> 5); scr[kk * 33 + (lane & 31)] = (nn < N) ? W[(size_t)(k0 + kk) * N + nn] : 0.f; }
    LDS_WAIT(); asm volatile("" ::: "memory");
    const int c = lane & 3;
#pragma unroll
    for (int j = 0; j < 2; ++j) { const int n = (lane >> 2) + 16 * j; const LAS float* s = scr + (16 * c) * 33 + n; int w[4];
#pragma unroll
        for (int q = 0; q < 4; ++q) { int t = 0; t = __builtin_amdgcn_cvt_pk_fp8_f32(s[(4 * q) * 33] * 64.f, s[(4 * q + 1) * 33] * 64.f, t, false); t = __builtin_amdgcn_cvt_pk_fp8_f32(s[(4 * q + 2) * 33] * 64.f, s[(4 * q + 3) * 33] * 64.f, t, true); w[q] = t; }
        if (n0 + n < N) *(v4i*)(WT + (size_t)rm(n0 + n) * ldt + k0 + 16 * c) = (v4i){w[0], w[1], w[2], w[3]}; }
    LDS_WAIT(); asm volatile("" ::: "memory");
}
struct RmId { __device__ __forceinline__ int operator()(int n) const { return n; } };
struct RmWin { __device__ __forceinline__ int operator()(int n) const { return n < 2560 ? n : (n < 2608 ? PC_G3 + (n - 2560) : (n < 4656 ? n - 48 : (n < 4664 ? PC_IF + (n - 4656) : n - 56))); } };
struct RmGU { int up; __device__ __forceinline__ int operator()(int n) const { return 256 * (n >> 7) + (n & 127) + 128 * up; } };

__device__ __forceinline__ void mod_chunks(Frame& F, int first, int last, int stride) {
    const int tid_ = tid_opaque(), lane_ = tid_ & 63; (void)lane_;
    const float* c = INP(1); const float* w_ada = INP(2); const float* b_ada = INP(3);
    float* mod = WSP(float, WS_MOD);
    LAS float* sc = (LAS float*)F.lds; LAS float* red = (LAS float*)(F.lds + 65536);
    __syncthreads();
    { f32x4 cv[8];
#pragma unroll
      for (int j = 0; j < 8; ++j) cv[j] = *(const f32x4*)(c + 4 * tid_ + 2048 * j);
#pragma unroll
      for (int j = 0; j < 8; ++j) { f32x4 o; o.x = cv[j].x * sigm(cv[j].x); o.y = cv[j].y * sigm(cv[j].y); o.z = cv[j].z * sigm(cv[j].z); o.w = cv[j].w * sigm(cv[j].w); *(LAS f32x4*)(sc + 4 * tid_ + 2048 * j) = o; } }
    __syncthreads();
    for (int ci = first; ci < last; ci += stride) {
        const int cq = tid_ % 12, kg = tid_ / 12;
        if (tid_ < 504) {
            float acc[8][4];
#pragma unroll
            for (int b = 0; b < 8; ++b)
#pragma unroll
                for (int j = 0; j < 4; ++j) acc[b][j] = 0.f;
            const float* wp = w_ada + 48 * ci + 4 * cq;
            f32x4 wc[7], wn[7];
#pragma unroll
            for (int u = 0; u < 7; ++u) { wc[u] = __builtin_nontemporal_load((const f32x4*)(wp + (size_t)(kg + 42 * u) * 12288)); wn[u] = wc[u]; }
#pragma unroll 1
            for (int bi = 0; bi < 7; ++bi) {
                if (bi < 6) {
#pragma unroll
                    for (int u = 0; u < 7; ++u) { int k = kg + 42 * (7 * (bi + 1) + u); k = k < DM ? k : DM - 1; wn[u] = __builtin_nontemporal_load((const f32x4*)(wp + (size_t)k * 12288)); } }
#pragma unroll
                for (int u = 0; u < 7; ++u) { const int k = kg + 42 * (7 * bi + u); const bool ok = k < DM; const int kc = ok ? k : DM - 1;
#pragma unroll
                    for (int b = 0; b < 8; ++b) { const float s = ok ? sc[b * DM + kc] : 0.f;
#pragma unroll
                        for (int j = 0; j < 4; ++j) acc[b][j] += s * wc[u][j]; } }
#pragma unroll
                for (int u = 0; u < 7; ++u) wc[u] = wn[u];
            }
#pragma unroll
            for (int b = 0; b < 8; ++b)
#pragma unroll
                for (int j = 0; j < 4; ++j) red[(kg * 12 + cq) * 32 + b * 4 + j] = acc[b][j];
        }
        __syncthreads();
        if (tid_ < 384) { const int b = tid_ / 48, col = tid_ % 48, q = col >> 2, j = col & 3; float s = 0.f;
            for (int k2 = 0; k2 < 42; ++k2) s += red[(k2 * 12 + q) * 32 + b * 4 + j];
            mod[b * 12288 + 48 * ci + col] = s + b_ada[48 * ci + col]; }
        __syncthreads();
    }
}
struct TDesc { const float* W; int K, N; unsigned char* WT; int ldt; int kind; int item; int nblk, nb0; };
__device__ __forceinline__ TDesc p0_decode(Frame& F, int it) {
    constexpr int I_WIN = PROJ_MODE ? 0 : 32 * 146, I_WIN8 = PROJ_MODE ? 32 * 306 : 32 * 274, I_UP = 16 * 64, I_OUT = 32 * 64, I_SH = 32 * 16, I_SHD = 8 * 64, I_R = 32 * 2, I_EG = 64 * 512, I_C1 = 32 * 8;
    unsigned char* WeGU = WSP(unsigned char, WS_WEGU); unsigned char* WeD = WSP(unsigned char, WS_WED);
    int r = it;
    if (r < I_WIN) return TDesc{INP(6), DM, D_IN, WSP(unsigned char, WS_WIN), DM * 2, 1, r, 146, 0}; r -= I_WIN;
    if (r < I_WIN8) { if (PROJ_MODE) return TDesc{INP(6), DM, D_IN, WSP(unsigned char, WS_WIN8), DM, 6, r, 306, 0}; return TDesc{INP(6), DM, D_IN, WSP(unsigned char, WS_WIN8), DM, 5, r, 274, 32}; } r -= I_WIN8;
    if (r < I_UP) return TDesc{INP(14), 1024, DM, WSP(unsigned char, WS_WUP), 2048 * 2, 0, r, (DM + 31) / 32, 0}; r -= I_UP;
    if (r < I_UP) return TDesc{INP(15), 1024, DM, WSP(unsigned char, WS_WUP) + 1024 * 2, 2048 * 2, 0, r, (DM + 31) / 32, 0}; r -= I_UP;
    if (r < I_OUT) return TDesc{INP(16), DM, DM, WSP(unsigned char, WS_WOUT), DM * 2, 0, r, (DM + 31) / 32, 0}; r -= I_OUT;
    if (r < I_SH) return TDesc{INP(24), DM, EFF, WeGU + (size_t)64 * 1024 * DM, DM, 3, r, (EFF + 31) / 32, 0}; r -= I_SH;
    if (r < I_SH) return TDesc{INP(25), DM, EFF, WeGU + (size_t)64 * 1024 * DM, DM, 4, r, (EFF + 31) / 32, 0}; r -= I_SH;
    if (r < I_SHD) return TDesc{INP(26), EFF, DM, WeD + (size_t)64 * DM * EFF, EFF, 2, r, (DM + 31) / 32, 0}; r -= I_SHD;
    if (r < I_R) return TDesc{INP(19), DM, NEXP, WSP(unsigned char, WS_WR), DM * 2, 0, r, (NEXP + 31) / 32, 0}; r -= I_R;
    if (r < 16) { const int kv = r >> 3; return TDesc{INP(9) + (size_t)kv * 256 * 64, 256, 64, WSP(unsigned char, WS_CW2) + (size_t)kv * 64 * 256 * 2, 256 * 2, 0, r & 7, 2, 0}; } r -= 16;
    if (r < 2 * I_C1) { const int kv = r >> 8; return TDesc{INP(8) + (size_t)kv * DM * 256, DM, 256, WSP(unsigned char, WS_CW1) + (size_t)kv * 256 * DM * 2, DM * 2, 0, r & 255, (256 + 31) / 32, 0}; } r -= 2 * I_C1;
    if (r < I_EG) { const int e = r >> 9; return TDesc{INP(21) + (size_t)e * DM * EFF, DM, EFF, WeGU + (size_t)e * 1024 * DM, DM, 3, r & 511, (EFF + 31) / 32, 0}; } r -= I_EG;
    if (r < I_EG) { const int e = r >> 9; return TDesc{INP(22) + (size_t)e * DM * EFF, DM, EFF, WeGU + (size_t)e * 1024 * DM, DM, 4, r & 511, (EFF + 31) / 32, 0}; } r -= I_EG;
    { const int e = r >> 9; return TDesc{INP(23) + (size_t)e * EFF * DM, EFF, DM, WeD + (size_t)e * DM * EFF, EFF, 2, r & 511, (DM + 31) / 32, 0}; }
}
__device__ __forceinline__ void t_load(const TDesc& d, int lane, float (&v)[32]) {
    const int nblk = d.nblk, kb = d.item / nblk, nb = d.nb0 + d.item % nblk; int nn = 32 * nb + (lane & 31); nn = nn < d.N ? nn : d.N - 1;
    const float* p = d.W + (size_t)(64 * kb + (lane >> 5)) * d.N + nn;
#pragma unroll
    for (int i = 0; i < 32; ++i) v[i] = __builtin_nontemporal_load(p + (size_t)(2 * i) * d.N);
}
__device__ __forceinline__ int t_rowmap(int kind, int n) {
    if (kind == 1 || kind == 5 || kind == 6) { if (n < 1024) return n;
        if (n < 2560) { const int i = (n - 1024) >> 8, c = (n - 1024) & 255; return ((i & 1) ? PC_VC : PC_KC) + (i >> 1) * 256 + c; }
        if (n < 2608) return PC_G3 + (n - 2560); if (n < 3632) return PC_QKM + (n - 2608); if (n < 4656) return PC_VM + (n - 3632); if (n < 4664) return PC_IF + (n - 4656); return n + 200; }
    if (kind == 3 || kind == 4) return 256 * (n >> 7) + (n & 127) + 128 * (kind - 3);
    return n;
}
__device__ __forceinline__ void t_finish(const TDesc& d, int lane, LAS float* scr, const float (&v)[32]) {
    const int nblk = d.nblk, kb = d.item / nblk, nb = d.nb0 + d.item % nblk, k0 = 64 * kb, n0 = 32 * nb;
#pragma unroll
    for (int i = 0; i < 32; ++i) scr[(2 * i + (lane >> 5)) * 33 + (lane & 31)] = v[i];
    LDS_WAIT(); asm volatile("" ::: "memory");
    if (d.kind >= 2) {
        const int c = lane & 3;
#pragma unroll
        for (int j = 0; j < 2; ++j) { const int n = (lane >> 2) + 16 * j; const LAS float* s = scr + (16 * c) * 33 + n; int w[4];
#pragma unroll
            for (int q = 0; q < 4; ++q) { int t = 0; t = __builtin_amdgcn_cvt_pk_fp8_f32(s[(4 * q) * 33] * 64.f, s[(4 * q + 1) * 33] * 64.f, t, false); t = __builtin_amdgcn_cvt_pk_fp8_f32(s[(4 * q + 2) * 33] * 64.f, s[(4 * q + 3) * 33] * 64.f, t, true); w[q] = t; }
            int dr = t_rowmap(d.kind, n0 + n); bool ok = n0 + n < d.N; if (d.kind == 5) { ok = ok && dr >= PN_BF; dr -= PN_BF; }
            if (ok) *(v4i*)(d.WT + (size_t)dr * d.ldt + k0 + 16 * c) = (v4i){w[0], w[1], w[2], w[3]}; }
    } else {
        const int c = lane & 7;
#pragma unroll
        for (int j = 0; j < 4; ++j) { const int n = (lane >> 3) + 8 * j; const LAS float* s = scr + (8 * c) * 33 + n;
            v4u o; o.x = pk2(s[0 * 33], s[1 * 33]); o.y = pk2(s[2 * 33], s[3 * 33]); o.z = pk2(s[4 * 33], s[5 * 33]); o.w = pk2(s[6 * 33], s[7 * 33]);
            const int dr = t_rowmap(d.kind, n0 + n); const bool ok = (n0 + n < d.N) && (d.kind != 1 || dr < PN_BF);
            if (ok) *(v4u*)(d.WT + (size_t)dr * d.ldt + (size_t)(k0 + 8 * c) * 2) = o; }
    }
    LDS_WAIT(); asm volatile("" ::: "memory");
}
constexpr int NIT_ALL = 16 + (PROJ_MODE ? 32 * 306 : 32 * 146 + 32 * 274) + 2 * 16 * 64 + 32 * 64 + 2 * 32 * 16 + 8 * 64 + 32 * 2 + 2 * 32 * 8 + 3 * 64 * 512;
constexpr int NIT_LATE = 3 * 64 * 512, NIT_EARLY = NIT_ALL - NIT_LATE;
__device__ __forceinline__ void convert_range(Frame& F, int lo, int hi, int w, int nw) {
    const int tid_ = tid_opaque(), lane_ = tid_ & 63;
    LAS float* scr = (LAS float*)(F.lds + F.wave * 16384);
    int it = lo + w; if (it >= hi) return;
    TDesc d = p0_decode(F, it); float v[32]; t_load(d, lane_, v);
    for (;;) {
        const int itn = it + nw; const bool hn = itn < hi;
        TDesc dn = d; float vn[32];
        if (hn) { dn = p0_decode(F, itn); t_load(dn, lane_, vn); }
        t_finish(d, lane_, scr, v);
        if (!hn) break;
        d = dn; it = itn;
#pragma unroll
        for (int i = 0; i < 32; ++i) v[i] = vn[i];
    }
}
constexpr int MOD_EARLY = 86;
__device__ __forceinline__ void p0_early(Frame& F) {
    const int bx = (int)blockIdx.x;
    if (F.G <= MOD_EARLY + 8) { mod_chunks(F, bx, MOD_EARLY, F.G); convert_range(F, 0, NIT_EARLY, F.gw, F.ngw); return; }
    constexpr int SPLIT = (NIT_EARLY * 7) / 8;
    if (bx < MOD_EARLY) { mod_chunks(F, bx, MOD_EARLY, MOD_EARLY); convert_range(F, SPLIT, NIT_EARLY, bx * 8 + F.wave, MOD_EARLY * 8); }
    else convert_range(F, 0, SPLIT, (bx - MOD_EARLY) * 8 + F.wave, (F.G - MOD_EARLY) * 8);
}
constexpr int NCHUNK = 8;
__device__ __forceinline__ void convert_chunk(Frame& F, int& chunk) {
    if (chunk >= NCHUNK) return;
    const int per = (NIT_LATE + F.G - 1) / F.G, pc = (per + NCHUNK - 1) / NCHUNK;
    int lo = NIT_EARLY + (int)blockIdx.x * per + chunk * pc, hi = lo + pc; const int end = NIT_EARLY + ((int)blockIdx.x + 1) * per;
    hi = hi < end ? hi : end; hi = hi < NIT_ALL ? hi : NIT_ALL;
    __syncthreads();
    if (chunk == 0) { const int nl = 256 - MOD_EARLY; const int per_wg = (nl + F.G - 1) / F.G;
        mod_chunks(F, MOD_EARLY + (int)blockIdx.x * per_wg, (MOD_EARLY + ((int)blockIdx.x + 1) * per_wg) < 256 ? (MOD_EARLY + ((int)blockIdx.x + 1) * per_wg) : 256, 1); }
    convert_range(F, lo, hi, F.wave, 8);
    __syncthreads();
    ++chunk;
}
__device__ __forceinline__ void p0_bias1(Frame& F) {
    const int tid_ = tid_opaque(), lane_ = tid_ & 63;
    for (int o = F.gw; o < 512; o += F.ngw) { const int kv = o >> 8, j = o & 255; const float* pe = INP(7) + kv * 2048; const float* w1 = INP(8) + (size_t)kv * 2048 * 256 + j;
        float s = 0.f;
#pragma unroll 8
        for (int k = lane_; k < 2048; k += 64) s += pe[k] * w1[(size_t)k * 256];
        s = wave_sum(s); if (lane_ == 0) WSP(float, WS_BIAS1)[o] = s; }
}
__device__ __forceinline__ void p1_h1(Frame& F) {
    const int tid_ = tid_opaque(), lane_ = tid_ & 63; (void)lane_;
    const float* x = INP(0); const float* gpm = INP(4); const float* mod = WSP(float, WS_MOD); bf16* H1 = WSP(bf16, WS_H1); unsigned char* H1Q = WSP(unsigned char, WS_H1Q);
    for (int row = F.gw; row < NTOK; row += F.ngw) {
        const int b = row >> 11; const f32x4* xr = (const f32x4*)(x + (size_t)row * DM) + lane_;
        f32x4 v[8]; float s = 0.f;
#pragma unroll
        for (int j = 0; j < 8; ++j) { v[j] = xr[64 * j]; s += (v[j].x * v[j].x + v[j].y * v[j].y) + (v[j].z * v[j].z + v[j].w * v[j].w); }
        const float rstd = rsqrtf(wave_sum(s) * (1.f / DM) + EPS);
        const float* sh = mod + b * 12288; const float* scl = sh + 2048;
        int* o4 = (int*)(H1Q + (size_t)row * DM) + lane_; unsigned long long* o8 = (unsigned long long*)(H1 + (size_t)row * DM) + lane_;
#pragma unroll
        for (int j = 0; j < 8; ++j) { const int col = 4 * lane_ + 256 * j; const f32x4 g = *(const f32x4*)(gpm + col), a = *(const f32x4*)(scl + col), c = *(const f32x4*)(sh + col);
            const float r0 = v[j].x * rstd * g.x * (1.f + a.x) + c.x, r1 = v[j].y * rstd * g.y * (1.f + a.y) + c.y, r2 = v[j].z * rstd * g.z * (1.f + a.z) + c.z, r3 = v[j].w * rstd * g.w * (1.f + a.w) + c.w;
            int q8 = 0; q8 = __builtin_amdgcn_cvt_pk_fp8_f32(fminf(fmaxf(r0, -448.f), 448.f), fminf(fmaxf(r1, -448.f), 448.f), q8, false); q8 = __builtin_amdgcn_cvt_pk_fp8_f32(fminf(fmaxf(r2, -448.f), 448.f), fminf(fmaxf(r3, -448.f), 448.f), q8, true);
            o4[64 * j] = q8; if (PROJ_MODE == 0) o8[64 * j] = (unsigned long long)pk2(r0, r1) | ((unsigned long long)pk2(r2, r3) << 32); }
    }
}
__device__ __forceinline__ float gelu_tanh(float x) { const float u = 0.7978845608028654f * (x + 0.044715f * x * x * x); const float t = 1.f - 2.f * frcp(1.f + __expf(2.f * u)); return 0.5f * x * (1.f + t); }
__device__ __forceinline__ void p3_conv(Frame& F) {
    const int tid_ = tid_opaque(), lane_ = tid_ & 63; (void)lane_;
    const bf16* PROJ = WSP(bf16, WS_PROJ); bf16* QKC = WSP(bf16, WS_QKC); const float* cw = INP(10); const float* cb = INP(11);
    const int skip = F.G > 64 ? 32 : 0;
    if ((int)blockIdx.x < skip) return;
    const int c8 = (tid_ & 127) * 8, rg = F.wave >> 1;
    f32x4 w[4][2], bias[2];
#pragma unroll
    for (int i = 0; i < 4; ++i) { w[i][0] = *(const f32x4*)(cw + i * 1024 + c8); w[i][1] = *(const f32x4*)(cw + i * 1024 + c8 + 4); }
    bias[0] = *(const f32x4*)(cb + c8); bias[1] = *(const f32x4*)(cb + c8 + 4);
    const float sc = (c8 >= 512) ? 0.08838834764831845f : 1.f;
    for (int blk = (int)blockIdx.x - skip; blk < NTOK / 16; blk += F.G - skip) {
        const int r0 = blk * 16 + rg * 4; const bool head = (r0 & 2047) == 0;
        v4u q[7];
#pragma unroll
        for (int i = 0; i < 7; ++i) { const int row = (i < 3 && head) ? r0 : r0 - 3 + i; const GAS v4u* pr = UPTR(const v4u, PROJ + (size_t)row * PLD + PC_QKM) + (tid_ & 127); q[i] = *pr; }
        if (head) { q[0] = (v4u){0u, 0u, 0u, 0u}; q[1] = q[0]; q[2] = q[0]; }
#pragma unroll
        for (int o = 0; o < 4; ++o) {
            f32x4 a0 = bias[0], a1 = bias[1];
#pragma unroll
            for (int i = 0; i < 4; ++i) { const v4u x = q[o + i];
                a0 += (f32x4){bflo(x.x), bfhi(x.x), bflo(x.y), bfhi(x.y)} * w[i][0]; a1 += (f32x4){bflo(x.z), bfhi(x.z), bflo(x.w), bfhi(x.w)} * w[i][1]; }
            v4u ov; ov.x = pk2(a0.x * sigm(a0.x) * sc, a0.y * sigm(a0.y) * sc); ov.y = pk2(a0.z * sigm(a0.z) * sc, a0.w * sigm(a0.w) * sc);
            ov.z = pk2(a1.x * sigm(a1.x) * sc, a1.y * sigm(a1.y) * sc); ov.w = pk2(a1.z * sigm(a1.z) * sc, a1.w * sigm(a1.w) * sc);
            GAS v4u* po = UPTR(v4u, QKC + (size_t)(r0 + o) * 1024) + (tid_ & 127); *po = ov;
        }
    }
}
__device__ __forceinline__ void p3_gates(Frame& F) {
    const int tid_ = tid_opaque(), lane_ = tid_ & 63;
    const bf16* PROJ = WSP(bf16, WS_PROJ); const float* bg = INP(12); float* GA = WSP(float, WS_GA); float* GU = WSP(float, WS_GU); float* GM = WSP(float, WS_GM);
    LAS float* ex = (LAS float*)F.lds;
    for (int bh = (int)blockIdx.x; bh < 32; bh += F.G) {
        const int b = bh >> 2, h = bh & 3; float carryA = 0.f, cmax = -INFINITY; float Al[4], ul[4], Ml[4];
#pragma unroll
        for (int k = 0; k < 4; ++k) {
            const int t = F.wave * 256 + k * 64 + lane_; const bf16* pr = PROJ + (size_t)(b * SEQ + t) * PLD + PC_IF;
            const float ip = bf2f(pr[h]) + bg[h], fp = bf2f(pr[4 + h]) + bg[4 + h];
            const float lf = fminf(fp, 0.f) - log1pf(__expf(-fabsf(fp)));
            float A = lf;
#pragma unroll
            for (int o = 1; o < 64; o <<= 1) { const float n = __shfl_up(A, o); if (lane_ >= o) A += n; }
            A += carryA;
            const float u = ip - A; float M = u;
#pragma unroll
            for (int o = 1; o < 64; o <<= 1) { const float n = __shfl_up(M, o); if (lane_ >= o) M = fmaxf(M, n); }
            M = fmaxf(M, cmax);
            Al[k] = A; ul[k] = u; Ml[k] = M;
            carryA = rdlane(A, 63); cmax = rdlane(M, 63);
        }
        __syncthreads();
        if (lane_ == 0) { ex[2 * F.wave] = carryA; ex[2 * F.wave + 1] = cmax; }
        __syncthreads();
        float CA = 0.f, CM = 0.f;
        for (int w = 0; w < F.wave; ++w) { CM = fmaxf(CM, ex[2 * w + 1] - CA); CA += ex[2 * w]; }
#pragma unroll
        for (int k = 0; k < 4; ++k) { const int t = F.wave * 256 + k * 64 + lane_;
            GA[bh * SEQ + t] = (Al[k] + CA) * 1.4426950408889634f; GU[bh * SEQ + t] = (ul[k] - CA) * 1.4426950408889634f; GM[bh * SEQ + t] = fmaxf(Ml[k] - CA, CM) * 1.4426950408889634f; }
    }
    __syncthreads();
}
__device__ __forceinline__ void p4_kcv(Frame& F) {
    const int tid_ = tid_opaque(), lane_ = tid_ & 63; (void)lane_;
    const bf16* HIDC = WSP(bf16, WS_HIDC); bf16* KCB = WSP(bf16, WS_KCV); const float* w2 = INP(9);
    const int gt = blockIdx.x * 512 + tid_, ngt = F.G * 512;
    for (int idx = gt; idx < 8128 * 64; idx += ngt) {
        const int r = idx >> 6, d = idx & 63, kv = r / 4064, rr = r % 4064, b = rr / 508, n = (rr % 508) >> 2, g = rr & 3;
        const bf16* hrow = HIDC + ((size_t)kv * 4096 + rr) * 256; const float* w = w2 + kv * 256 * 64 + d; float s = 0.f;
#pragma unroll 8
        for (int j = 0; j < 256; ++j) s += bf2f(hrow[j]) * w[j * 64];
        KCB[((size_t)((kv * 8 + b) * 4 + g) * 128 + n) * 64 + d] = (bf16)f2bf(s);
    }
    for (int idx = gt; idx < 64 * 64; idx += ngt) { const int q = idx >> 6, d = idx & 63; KCB[((size_t)q * 128 + 127) * 64 + d] = 0; }
}
__device__ __forceinline__ void kcv_unit(Frame& F, int kv, int pm) {
    const int tid_ = tid_opaque(), lane_ = tid_ & 63, fr = lane_ & 15, fq = lane_ >> 4;
    const bf16* HIDC = WSP(bf16, WS_HIDC) + ((size_t)kv * 4096 + pm * 256) * 256; const bf16* w2t = WSP(bf16, WS_CW2) + (size_t)kv * 64 * 256; bf16* KCB = WSP(bf16, WS_KCV);
    asm volatile("s_waitcnt vmcnt(0)" ::: "memory"); __syncthreads();
#pragma unroll
    for (int rb = 0; rb < 2; ++rb) {
        const int r0 = F.wave * 32 + rb * 16;
        f32x4 acc[4];
#pragma unroll
        for (int db = 0; db < 4; ++db) acc[db] = (f32x4){0.f, 0.f, 0.f, 0.f};
#pragma unroll
        for (int ks = 0; ks < 8; ++ks) { const bf16x8 a = *(const bf16x8*)(HIDC + (size_t)(r0 + fr) * 256 + ks * 32 + fq * 8);
#pragma unroll
            for (int db = 0; db < 4; ++db) { const bf16x8 bb = *(const bf16x8*)(w2t + (size_t)(db * 16 + fr) * 256 + ks * 32 + fq * 8); acc[db] = __builtin_amdgcn_mfma_f32_16x16x32_bf16(a, bb, acc[db], 0, 0, 0); } }
#pragma unroll
        for (int reg = 0; reg < 4; ++reg) { const int rr = pm * 256 + r0 + 4 * fq + reg; if (rr < 4064) { const int b = rr / 508, n = (rr % 508) >> 2, g = rr & 3;
#pragma unroll
            for (int db = 0; db < 4; ++db) KCB[((size_t)((kv * 8 + b) * 4 + g) * 128 + n) * 64 + db * 16 + fr] = (bf16)f2bf(acc[db][reg]); } }
    }
    if (blockIdx.x == 0) for (int idx = tid_; idx < 64 * 64; idx += 512) { const int q = idx >> 6, d = idx & 63; KCB[((size_t)q * 128 + 127) * 64 + d] = 0; }
}
namespace fa {
typedef float f32x16 __attribute__((ext_vector_type(16)));
typedef short s16x4 __attribute__((ext_vector_type(4)));
typedef float f32x2_t __attribute__((ext_vector_type(2))); typedef __bf16 bf16x2_t __attribute__((ext_vector_type(2)));
constexpr int SLOTB = 8192, NSLOTS = 3, NKS = 4;
constexpr int LDS_K = 0, LDS_V = NKS * SLOTB, LDS_WS = LDS_V + NSLOTS * SLOTB, LDS_OST = LDS_WS + 8 * 1024, LDS_AUX = LDS_OST + 8 * 8192;
static_assert(LDS_AUX <= RING_BYTES, "attention lds");
__device__ __forceinline__ int crow(int r, int hi) { return (r & 3) + 8 * (r >> 2) + 4 * hi; }
__device__ __forceinline__ constexpr int crow0(int r) { return (r & 3) + 8 * (r >> 2); }
#define FA_SBAR() __builtin_amdgcn_sched_barrier(0)
__device__ __forceinline__ void glds16(const void* gsrc, unsigned lds_dst) { unsigned keep;
    asm volatile("s_mov_b32 %0, m0\n\ts_mov_b32 m0, %2\n\ts_nop 0\n\tglobal_load_lds_dwordx4 %1, off\n\ts_mov_b32 m0, %0" : "=&s"(keep) : "v"(gsrc), "s"(lds_dst) : "memory"); }
__device__ __forceinline__ unsigned cvtpk_s(float lo, float hi) { f32x2_t v = {lo, hi}; bf16x2_t b = __builtin_convertvector(v, bf16x2_t); return __builtin_bit_cast(unsigned, b); }
#define FA_WAIT_BAR(N) asm volatile("s_waitcnt vmcnt(" #N ") lgkmcnt(0)\n\ts_barrier" ::: "memory")
__device__ __forceinline__ void qkt(f32x16& p0, f32x16& p1, const LAS char* kb, const bf16x8* qr, const f32x16& c0) {
#pragma unroll
    for (int d0 = 0; d0 < 4; ++d0) {
        const bf16x8 b0 = *(const LAS bf16x8*)(kb + d0 * 2048);
        const bf16x8 b1 = *(const LAS bf16x8*)(kb + d0 * 2048 + 512);
        if (d0 == 0) { p0 = __builtin_amdgcn_mfma_f32_32x32x16_bf16(b0, qr[0], c0, 0, 0, 0); p1 = __builtin_amdgcn_mfma_f32_32x32x16_bf16(b1, qr[0], c0, 0, 0, 0); }
        else { p0 = __builtin_amdgcn_mfma_f32_32x32x16_bf16(b0, qr[d0], p0, 0, 0, 0); p1 = __builtin_amdgcn_mfma_f32_32x32x16_bf16(b1, qr[d0], p1, 0, 0, 0); }
        __builtin_amdgcn_sched_barrier(0xF); }
}
__device__ __forceinline__ float rowmax(const f32x16& p0, const f32x16& p1) {
    float a = fmaxf(fmaxf(p0[0], p0[1]), p1[0]), b = fmaxf(fmaxf(p0[2], p0[3]), p1[1]); a = fmaxf(fmaxf(a, p1[2]), p1[3]);
#pragma unroll
    for (int r = 4; r < 16; r += 4) { a = fmaxf(fmaxf(a, p0[r]), p0[r + 1]); b = fmaxf(fmaxf(b, p0[r + 2]), p0[r + 3]); a = fmaxf(fmaxf(a, p1[r]), p1[r + 1]); b = fmaxf(fmaxf(b, p1[r + 2]), p1[r + 3]); }
    const float m = fmaxf(a, b);
    auto rr = __builtin_amdgcn_permlane32_swap(__float_as_uint(m), __float_as_uint(m), false, false);
    return fmaxf(__uint_as_float(rr[0]), __uint_as_float(rr[1]));
}
__device__ __forceinline__ float swap_add(float v) { auto rr = __builtin_amdgcn_permlane32_swap(__float_as_uint(v), __float_as_uint(v), false, false); return __uint_as_float(rr[0]) + __uint_as_float(rr[1]); }
__device__ __forceinline__ void pv(f32x16* o, int vb, bf16x8 pa0, bf16x8 pa1, bf16x8 pa2, bf16x8 pa3) {
#pragma unroll
    for (int d0 = 0; d0 < 2; ++d0) { s16x4 lo[4], hi[4];
#pragma unroll
        for (int ks = 0; ks < 4; ++ks) {
            asm volatile("ds_read_b64_tr_b16 %0,%1 offset:%c2" : "=&v"(lo[ks]) : "v"(vb), "i"(d0 * 4096 + ks * 1024) : "memory");
            asm volatile("ds_read_b64_tr_b16 %0,%1 offset:%c2" : "=&v"(hi[ks]) : "v"(vb), "i"(d0 * 4096 + ks * 1024 + 512) : "memory"); }
        asm volatile("s_waitcnt lgkmcnt(0)" ::: "memory"); FA_SBAR();
#define FA_PK(k) (bf16x8){lo[k][0], lo[k][1], lo[k][2], lo[k][3], hi[k][0], hi[k][1], hi[k][2], hi[k][3]}
        o[d0] = __builtin_amdgcn_mfma_f32_32x32x16_bf16(pa0, FA_PK(0), o[d0], 0, 0, 0);
        o[d0] = __builtin_amdgcn_mfma_f32_32x32x16_bf16(pa1, FA_PK(1), o[d0], 0, 0, 0);
        o[d0] = __builtin_amdgcn_mfma_f32_32x32x16_bf16(pa2, FA_PK(2), o[d0], 0, 0, 0);
        o[d0] = __builtin_amdgcn_mfma_f32_32x32x16_bf16(pa3, FA_PK(3), o[d0], 0, 0, 0);
#undef FA_PK
    }
}
typedef short v4i16_t __attribute__((ext_vector_type(4)));
__device__ __forceinline__ s16x4 vtr(const LAS char* p) { return __builtin_bit_cast(s16x4, __builtin_amdgcn_ds_read_tr16_b64_v4i16((LAS v4i16_t*)p)); }
__device__ __forceinline__ void pv2(f32x16* o, const LAS char* vp, bf16x8 pa0, bf16x8 pa1, bf16x8 pa2, bf16x8 pa3) {
#pragma unroll
    for (int d0 = 0; d0 < 2; ++d0) {
        s16x4 lo[4], hi[4];
#pragma unroll
        for (int ks = 0; ks < 4; ++ks) { lo[ks] = vtr(vp + d0 * 4096 + ks * 1024); hi[ks] = vtr(vp + d0 * 4096 + ks * 1024 + 512); }
#define FA_PK(k) (bf16x8){lo[k][0], lo[k][1], lo[k][2], lo[k][3], hi[k][0], hi[k][1], hi[k][2], hi[k][3]}
        o[d0] = __builtin_amdgcn_mfma_f32_32x32x16_bf16(pa0, FA_PK(0), o[d0], 0, 0, 0);
        o[d0] = __builtin_amdgcn_mfma_f32_32x32x16_bf16(pa1, FA_PK(1), o[d0], 0, 0, 0);
        o[d0] = __builtin_amdgcn_mfma_f32_32x32x16_bf16(pa2, FA_PK(2), o[d0], 0, 0, 0);
        o[d0] = __builtin_amdgcn_mfma_f32_32x32x16_bf16(pa3, FA_PK(3), o[d0], 0, 0, 0);
#undef FA_PK
        __builtin_amdgcn_sched_barrier(0xF);
    }
}
struct Soft { float mhat, l; f32x16 o[2]; f32x16 negm; };
__device__ __forceinline__ void qk_half(f32x16& p, const LAS char* kbh, const bf16x8* qr) {
    const f32x16 zero = f32x16{};
#pragma unroll
    for (int d0 = 0; d0 < 4; ++d0) { const bf16x8 b = *(const LAS bf16x8*)(kbh + d0 * 2048); p = __builtin_amdgcn_mfma_f32_32x32x16_bf16(b, qr[d0], d0 == 0 ? zero : p, 0, 0, 0); }
}
__device__ __forceinline__ float rowmax16(const f32x16& p) {
    float a = fmaxf(fmaxf(p[0], p[1]), p[2]), b = fmaxf(fmaxf(p[3], p[4]), p[5]);
    a = fmaxf(fmaxf(a, p[6]), p[7]); b = fmaxf(fmaxf(b, p[8]), p[9]); a = fmaxf(fmaxf(a, p[10]), p[11]); b = fmaxf(fmaxf(b, p[12]), p[13]); a = fmaxf(fmaxf(a, p[14]), p[15]);
    const float m = fmaxf(a, b);
    auto rr = __builtin_amdgcn_permlane32_swap(__float_as_uint(m), __float_as_uint(m), false, false);
    return fmaxf(__uint_as_float(rr[0]), __uint_as_float(rr[1]));
}
__device__ __forceinline__ void soft_half(Soft& s, f32x16& p, const LAS char* vph, LAS float* wsf, int r32, int hi) {
    const float rm = rowmax16(p) - s.mhat;
    if (__any(rm > 8.f)) {
        const float dl = fmaxf(rm, 0.f); s.mhat += dl;
        const float f = __builtin_amdgcn_exp2f(-dl); s.l *= f; if (hi == 0) wsf[r32] = f;
        LDS_WAIT(); asm volatile("" ::: "memory");
        const LAS float* wh = wsf + 4 * hi;
#pragma unroll
        for (int d = 0; d < 2; ++d)
#pragma unroll
            for (int r = 0; r < 16; ++r) s.o[d][r] *= wh[crow0(r)];
        LDS_WAIT(); asm volatile("" ::: "memory");
    }
    float sa = 0.f; const float mh = s.mhat;
#pragma unroll
    for (int r = 0; r < 16; ++r) { p[r] = __builtin_amdgcn_exp2f(p[r] - mh); sa += p[r]; }
    s.l += sa;
    const v4u pw0 = (v4u){cvtpk_s(p[0], p[1]), cvtpk_s(p[2], p[3]), cvtpk_s(p[4], p[5]), cvtpk_s(p[6], p[7])};
    const v4u pw1 = (v4u){cvtpk_s(p[8], p[9]), cvtpk_s(p[10], p[11]), cvtpk_s(p[12], p[13]), cvtpk_s(p[14], p[15])};
#pragma unroll
    for (int d0 = 0; d0 < 2; ++d0) {
        const s16x4 l0 = vtr(vph + d0 * 4096), h0 = vtr(vph + d0 * 4096 + 512), l1 = vtr(vph + d0 * 4096 + 1024), h1 = vtr(vph + d0 * 4096 + 1536);
        s.o[d0] = __builtin_amdgcn_mfma_f32_32x32x16_bf16(__builtin_bit_cast(bf16x8, pw0), (bf16x8){l0[0], l0[1], l0[2], l0[3], h0[0], h0[1], h0[2], h0[3]}, s.o[d0], 0, 0, 0);
        s.o[d0] = __builtin_amdgcn_mfma_f32_32x32x16_bf16(__builtin_bit_cast(bf16x8, pw1), (bf16x8){l1[0], l1[1], l1[2], l1[3], h1[0], h1[1], h1[2], h1[3]}, s.o[d0], 0, 0, 0);
    }
}
struct P8 { f32x2 v[8]; };
__device__ __forceinline__ void qk_half_c(f32x16& p, const LAS char* kbh, const bf16x8* qr, const f32x16& negm) {
#pragma unroll
    for (int d0 = 0; d0 < 4; ++d0) { const bf16x8 b = *(const LAS bf16x8*)(kbh + d0 * 2048); p = __builtin_amdgcn_mfma_f32_32x32x16_bf16(b, qr[d0], d0 == 0 ? negm : p, 0, 0, 0); }
}
__device__ __forceinline__ void soft_half_c(Soft& s, f32x16& pin, f32x16& nx, const LAS char* vph, LAS float* wsf, int r32, int hi) {
    P8 p = __builtin_bit_cast(P8, pin);
    const float rm = rowmax16(pin);
    if (__any(rm > 8.f)) {
        const float dl = fmaxf(rm, 0.f); s.mhat += dl; const f32x2 d2 = {dl, dl};
        P8 n = __builtin_bit_cast(P8, nx);
#pragma unroll
        for (int i = 0; i < 8; ++i) { p.v[i] = p.v[i] - d2; n.v[i] = n.v[i] - d2; }
        nx = __builtin_bit_cast(f32x16, n);
#pragma unroll
        for (int r = 0; r < 16; ++r) s.negm[r] = -s.mhat;
        const float f = __builtin_amdgcn_exp2f(-dl); s.l *= f; if (hi == 0) wsf[r32] = f;
        LDS_WAIT(); asm volatile("" ::: "memory");
        const LAS float* wh = wsf + 4 * hi;
#pragma unroll
        for (int d = 0; d < 2; ++d)
#pragma unroll
            for (int r = 0; r < 16; ++r) s.o[d][r] *= wh[crow0(r)];
        LDS_WAIT(); asm volatile("" ::: "memory");
    }
#pragma unroll
    for (int i = 0; i < 8; ++i) { p.v[i].x = __builtin_amdgcn_exp2f(p.v[i].x); p.v[i].y = __builtin_amdgcn_exp2f(p.v[i].y); }
    f32x2 acc = (p.v[0] + p.v[1]) + (p.v[2] + p.v[3]); acc += (p.v[4] + p.v[5]) + (p.v[6] + p.v[7]);
    s.l += acc.x + acc.y;
    const v4u pw0 = (v4u){cvtpk_s(p.v[0].x, p.v[0].y), cvtpk_s(p.v[1].x, p.v[1].y), cvtpk_s(p.v[2].x, p.v[2].y), cvtpk_s(p.v[3].x, p.v[3].y)};
    const v4u pw1 = (v4u){cvtpk_s(p.v[4].x, p.v[4].y), cvtpk_s(p.v[5].x, p.v[5].y), cvtpk_s(p.v[6].x, p.v[6].y), cvtpk_s(p.v[7].x, p.v[7].y)};
#pragma unroll
    for (int d0 = 0; d0 < 2; ++d0) {
        const s16x4 l0 = vtr(vph + d0 * 4096), h0 = vtr(vph + d0 * 4096 + 512), l1 = vtr(vph + d0 * 4096 + 1024), h1 = vtr(vph + d0 * 4096 + 1536);
        s.o[d0] = __builtin_amdgcn_mfma_f32_32x32x16_bf16(__builtin_bit_cast(bf16x8, pw0), (bf16x8){l0[0], l0[1], l0[2], l0[3], h0[0], h0[1], h0[2], h0[3]}, s.o[d0], 0, 0, 0);
        s.o[d0] = __builtin_amdgcn_mfma_f32_32x32x16_bf16(__builtin_bit_cast(bf16x8, pw1), (bf16x8){l1[0], l1[1], l1[2], l1[3], h1[0], h1[1], h1[2], h1[3]}, s.o[d0], 0, 0, 0);
    }
}
__device__ __forceinline__ void mask_causal_h(f32x16& p, int tq, int hi, int half) {
#pragma unroll
    for (int r = 0; r < 16; ++r) { if (32 * half + crow(r, hi) > tq) p[r] = -INFINITY; }
}
__device__ __forceinline__ void mask_anti_h(f32x16& p, int tq, int hi, int half) {
#pragma unroll
    for (int r = 0; r < 16; ++r) { if (32 * half + crow(r, hi) <= tq) p[r] = -INFINITY; }
}
__device__ __forceinline__ void mask_all_h(f32x16& p, bool kill) {
#pragma unroll
    for (int r = 0; r < 16; ++r) p[r] = kill ? -INFINITY : p[r];
}
__device__ __forceinline__ void soft_reset(Soft& s) { s.mhat = 0.f; s.l = 0.f; s.o[0] = f32x16{}; s.o[1] = f32x16{}; s.negm = f32x16{}; asm volatile("" : "+v"(s.negm)); }
__device__ __forceinline__ void soft_step(Soft& s, f32x16& p0, f32x16& p1, int vb, LAS float* wsf, int r32, int hi) {
    const float rm = rowmax(p0, p1);
    if (__any(rm > 8.f)) {
        const float dl = fmaxf(rm, 0.f); s.mhat += dl;
#pragma unroll
        for (int r = 0; r < 16; ++r) { p0[r] -= dl; p1[r] -= dl; }
#pragma unroll
        for (int r = 0; r < 16; ++r) s.negm[r] = -s.mhat;
        asm volatile("" : "+v"(s.negm));
        const float f = exp2f(-dl); s.l *= f; if (hi == 0) wsf[r32] = f;
        LDS_WAIT(); asm volatile("" ::: "memory");
#pragma unroll
        for (int d = 0; d < 2; ++d)
#pragma unroll
            for (int r = 0; r < 16; ++r) s.o[d][r] *= wsf[crow(r, hi)];
        LDS_WAIT(); asm volatile("" ::: "memory");
    }
    float sacc = 0.f;
#pragma unroll
    for (int r = 0; r < 16; ++r) { p0[r] = exp2f(p0[r]); p1[r] = exp2f(p1[r]); sacc += p0[r] + p1[r]; }
    s.l += sacc;
    v4u pw0, pw1, pw2, pw3;
    pw0 = (v4u){cvtpk_s(p0[0], p0[1]), cvtpk_s(p0[2], p0[3]), cvtpk_s(p0[4], p0[5]), cvtpk_s(p0[6], p0[7])};
    pw1 = (v4u){cvtpk_s(p0[8], p0[9]), cvtpk_s(p0[10], p0[11]), cvtpk_s(p0[12], p0[13]), cvtpk_s(p0[14], p0[15])};
    pw2 = (v4u){cvtpk_s(p1[0], p1[1]), cvtpk_s(p1[2], p1[3]), cvtpk_s(p1[4], p1[5]), cvtpk_s(p1[6], p1[7])};
    pw3 = (v4u){cvtpk_s(p1[8], p1[9]), cvtpk_s(p1[10], p1[11]), cvtpk_s(p1[12], p1[13]), cvtpk_s(p1[14], p1[15])};
    pv(s.o, vb, __builtin_bit_cast(bf16x8, pw0), __builtin_bit_cast(bf16x8, pw1), __builtin_bit_cast(bf16x8, pw2), __builtin_bit_cast(bf16x8, pw3));
}
__device__ __forceinline__ void soft_step2(Soft& s, f32x16& p0, f32x16& p1, const LAS char* vp, LAS float* wsf, int r32, int hi) {
    const float rm = rowmax(p0, p1) - s.mhat;
    if (__any(rm > 8.f)) {
        const float dl = fmaxf(rm, 0.f); s.mhat += dl;
        const float f = __builtin_amdgcn_exp2f(-dl); s.l *= f; if (hi == 0) wsf[r32] = f;
        LDS_WAIT(); asm volatile("" ::: "memory");
        const LAS float* wh = wsf + 4 * hi;
#pragma unroll
        for (int d = 0; d < 2; ++d)
#pragma unroll
            for (int r = 0; r < 16; ++r) s.o[d][r] *= wh[crow0(r)];
        LDS_WAIT(); asm volatile("" ::: "memory");
    }
    float sa = 0.f, sb = 0.f; const float mh = s.mhat;
#pragma unroll
    for (int r = 0; r < 16; ++r) { p0[r] = __builtin_amdgcn_exp2f(p0[r] - mh); p1[r] = __builtin_amdgcn_exp2f(p1[r] - mh); sa += p0[r]; sb += p1[r]; }
    s.l += sa + sb;
    v4u pw0, pw1, pw2, pw3;
    pw0 = (v4u){cvtpk_s(p0[0], p0[1]), cvtpk_s(p0[2], p0[3]), cvtpk_s(p0[4], p0[5]), cvtpk_s(p0[6], p0[7])};
    pw1 = (v4u){cvtpk_s(p0[8], p0[9]), cvtpk_s(p0[10], p0[11]), cvtpk_s(p0[12], p0[13]), cvtpk_s(p0[14], p0[15])};
    pw2 = (v4u){cvtpk_s(p1[0], p1[1]), cvtpk_s(p1[2], p1[3]), cvtpk_s(p1[4], p1[5]), cvtpk_s(p1[6], p1[7])};
    pw3 = (v4u){cvtpk_s(p1[8], p1[9]), cvtpk_s(p1[10], p1[11]), cvtpk_s(p1[12], p1[13]), cvtpk_s(p1[14], p1[15])};
    pv2(s.o, vp, __builtin_bit_cast(bf16x8, pw0), __builtin_bit_cast(bf16x8, pw1), __builtin_bit_cast(bf16x8, pw2), __builtin_bit_cast(bf16x8, pw3));
}
__device__ __forceinline__ void soft_finish(Soft& s, f32x16* tot, float gate, LAS float* wsf, int r32, int hi) {
    const float lt = swap_add(s.l); const float fac = (lt > 0.f) ? gate / lt : 0.f;
    if (hi == 0) wsf[32 + r32] = fac;
    LDS_WAIT(); asm volatile("" ::: "memory");
#pragma unroll
    for (int r = 0; r < 16; ++r) { const float f = wsf[32 + crow(r, hi)]; tot[0][r] += s.o[0][r] * f; tot[1][r] += s.o[1][r] * f; }
    LDS_WAIT(); asm volatile("" ::: "memory");
    soft_reset(s);
}
__device__ __forceinline__ void soft_finish_stage(Soft& s, LAS float* stg, bool first, float gate, LAS float* wsf, int r32, int hi) {
    const float lt = swap_add(s.l); const float fac = (lt > 0.f) ? gate / lt : 0.f;
    if (hi == 0) wsf[32 + r32] = fac;
    LDS_WAIT(); asm volatile("" ::: "memory");
#pragma unroll
    for (int r = 0; r < 16; ++r) { const float f = (wsf + 32 + 4 * hi)[crow0(r)]; LAS float* sp = (stg + 4 * hi * 64 + r32) + crow0(r) * 64;
        if (first) { sp[0] = s.o[0][r] * f; sp[32] = s.o[1][r] * f; } else { sp[0] += s.o[0][r] * f; sp[32] += s.o[1][r] * f; } }
    LDS_WAIT(); asm volatile("" ::: "memory");
    soft_reset(s);
}
__device__ __forceinline__ void mask_causal(f32x16& p0, f32x16& p1, int tq, int hi) {
#pragma unroll
    for (int r = 0; r < 16; ++r) { const int kv = crow(r, hi); if (kv > tq) p0[r] = -INFINITY; if (kv + 32 > tq) p1[r] = -INFINITY; }
}
__device__ __forceinline__ void mask_anti(f32x16& p0, f32x16& p1, int tq, int hi) {
#pragma unroll
    for (int r = 0; r < 16; ++r) { const int kv = crow(r, hi); if (kv <= tq) p0[r] = -INFINITY; if (kv + 32 <= tq) p1[r] = -INFINITY; }
}
__device__ __forceinline__ void mask_all(f32x16& p0, f32x16& p1, bool kill) {
#pragma unroll
    for (int r = 0; r < 16; ++r) { p0[r] = kill ? -INFINITY : p0[r]; p1[r] = kill ? -INFINITY : p1[r]; }
}

__device__ __forceinline__ void sel_win_unit(LAS unsigned char* shm, int b, int g, int tb, const bf16* PROJ, const unsigned* SELM, const float* OACC, bf16* ONSA) {
    const int tid = tid_opaque(), lane = tid & 63, r32 = lane & 31, hi = lane >> 5; const int wid = __builtin_amdgcn_readfirstlane(tid >> 6);
    const int hh = wid & 3, th = wid >> 2, head = g * 4 + hh, tq = th * 32 + r32, t = tb * 64 + tq; const size_t row = (size_t)b * SEQ + t;
    const unsigned lds0 = (unsigned)(uintptr_t)shm;
    LAS float* wsf = (LAS float*)(shm + LDS_WS) + wid * 256;
    const bf16* bbase = PROJ + (size_t)b * SEQ * PLD + g * 64;
    const int nsel = tb + 1, jlo = (tb > 8) ? tb - 8 : 0, ntot = nsel + (tb - jlo + 1);
#define FA_KOFF(l_) ((unsigned)((l_) * PLD + wid * 8) * 2u)
#define FA_VOFF(l_) ((unsigned)((16 * (wid & 3) + ((l_) >> 2)) * PLD + (wid >> 2) * 32 + ((l_) & 3) * 8) * 2u)
    const unsigned koff_ = FA_KOFF(lane), voff_ = FA_VOFF(lane);
    const unsigned kdst = lds0 + LDS_K + wid * 1024, vdst = lds0 + LDS_V + wid * 1024;
#define FA_TILE(i) const int i_ = (i); const bool w_ = i_ >= nsel; const int j_ = w_ ? jlo + i_ - nsel : i_; const bf16* tb_ = bbase + (size_t)(j_ * 64) * PLD + (w_ ? PC_KW : PC_KS); const bf16* tv_ = bbase + (size_t)(j_ * 64) * PLD + (w_ ? PC_VW : PC_VS)
#define FA_ISSUE_K(i) do { if ((i) < ntot) { FA_TILE(i); glds16((const char*)tb_ + koff_, (unsigned)__builtin_amdgcn_readfirstlane(kdst + (unsigned)((i_ % NKS) * SLOTB))); } } while (0)
#define FA_ISSUE_V(i) do { if ((i) < ntot) { FA_TILE(i); glds16((const char*)tv_ + voff_, (unsigned)__builtin_amdgcn_readfirstlane(vdst + (unsigned)((i_ % NSLOTS) * SLOTB))); } } while (0)
    const bf16* prow = PROJ + row * PLD;
    bf16x8 qr[4];
#pragma unroll
    for (int d0 = 0; d0 < 4; ++d0) qr[d0] = *(const bf16x8*)(prow + PC_Q + head * 64 + d0 * 16 + hi * 8);
    if (hi == 0) { wsf[64 + r32] = sigm(bf2f(prow[PC_G3 + head * 3 + 1])); wsf[96 + r32] = sigm(bf2f(prow[PC_G3 + head * 3 + 2])); ((LAS unsigned*)wsf)[128 + r32] = __hip_atomic_load(SELM + (size_t)(b * 4 + g) * SEQ + t, RLX_AGENT); }
    FA_ISSUE_K(0); FA_ISSUE_V(0); FA_ISSUE_K(1); FA_ISSUE_K(2); FA_ISSUE_V(1);
    Soft st; soft_reset(st);
    LAS float* stg = (LAS float*)(shm + LDS_OST) + wid * 2048;
    const LAS char* kp0 = (const LAS char*)shm + LDS_K + hi * 1024 + r32 * 16;
    const LAS char* vp0 = (const LAS char*)shm + LDS_V + ((lane >> 4) & 1) * 32 + (lane & 3) * 8 + (4 * hi + ((lane & 15) >> 2)) * 64;
    if (ntot >= 3) { FA_WAIT_BAR(4); } else { FA_WAIT_BAR(3); }
    f32x16 sa_, sb_;
    qk_half_c(sa_, kp0, qr, st.negm); sb_ = sa_;
    for (int i = 0; i < ntot; ++i) {
        if (i + 2 < ntot) { FA_WAIT_BAR(2); } else if (i + 1 < ntot) { FA_WAIT_BAR(1); } else { FA_WAIT_BAR(0); }
        FA_ISSUE_K(i + 3); FA_ISSUE_V(i + 2);
        const bool issel = i < nsel; const int j = issel ? i : jlo + i - nsel;
        const int mcase = (j == tb) ? 1 : ((!issel && j == tb - 8) ? 2 : 0);
        bool kill = false; if (issel) { const unsigned mask = ((const LAS unsigned*)wsf)[128 + r32]; kill = !((mask >> i) & 1u); }
        const bool anyk = __any(kill);
        const LAS char* vpi = vp0 + (i % NSLOTS) * SLOTB;
        qk_half_c(sb_, kp0 + (i % NKS) * SLOTB + 512, qr, st.negm);
        if (anyk) mask_all_h(sa_, kill);
        if (mcase == 1) mask_causal_h(sa_, tq, hi, 0); else if (mcase == 2) mask_anti_h(sa_, tq, hi, 0);
        soft_half_c(st, sa_, sb_, vpi, wsf, r32, hi);
        if (i + 1 < ntot) qk_half_c(sa_, kp0 + ((i + 1) % NKS) * SLOTB, qr, st.negm);
        if (anyk) mask_all_h(sb_, kill);
        if (mcase == 1) mask_causal_h(sb_, tq, hi, 1); else if (mcase == 2) mask_anti_h(sb_, tq, hi, 1);
        soft_half_c(st, sb_, sa_, vpi + 2048, wsf, r32, hi);
        if (i == nsel - 1) { const float mo = st.mhat; soft_finish_stage(st, stg, true, wsf[64 + r32], wsf, r32, hi);
#pragma unroll
            for (int r = 0; r < 16; ++r) sa_[r] += mo; }
    }
    soft_finish_stage(st, stg, false, wsf[96 + r32], wsf, r32, hi);
    const size_t rowbase = (size_t)b * SEQ + tb * 64 + th * 32;
    { float t0[16], t1[16];
#pragma unroll
        for (int r = 0; r < 16; ++r) { const float* oa = OACC + (rowbase + crow(r, hi)) * 1024 + head * 64 + r32; const LAS float* sp = (stg + 4 * hi * 64 + r32) + crow0(r) * 64; t0[r] = sp[0] + oa[0]; t1[r] = sp[32] + oa[32]; }
        LDS_WAIT(); asm volatile("" ::: "memory");
        LAS bf16* sb = (LAS bf16*)stg;
#pragma unroll
        for (int r = 0; r < 16; ++r) { LAS bf16* bp = (sb + 4 * hi * 64 + r32) + crow0(r) * 64; bp[0] = (bf16)f2bf(t0[r]); bp[32] = (bf16)f2bf(t1[r]); }
        LDS_WAIT(); asm volatile("" ::: "memory");
#pragma unroll
        for (int i = 0; i < 4; ++i) { const int rr = i * 8 + (lane >> 3), ch = lane & 7; const v4u v = *(const LAS v4u*)(sb + rr * 64 + ch * 8); *(v4u*)(ONSA + (rowbase + rr) * 2048 + head * 64 + ch * 8) = v; } }
    asm volatile("s_waitcnt lgkmcnt(0)\n\ts_barrier" ::: "memory");
#undef FA_TILE
#undef FA_ISSUE_K
#undef FA_ISSUE_V
#undef FA_KOFF
#undef FA_VOFF
}
}
namespace cs {
using fa::f32x16; using fa::crow; using fa::glds16; using fa::cvtpk_s; using fa::pv; using fa::swap_add; using fa::qkt; using fa::rowmax;
constexpr int C_K = 0, C_V = 16384, C_WS = 32768, C_OWN = 34816, TBW = 32 * 33, C_CAR = C_OWN + 8 * TBW * 4, C_IMP = C_CAR + 8 * TBW * 4, C_END = C_IMP + 64 * 33 * 4;
static_assert(C_END <= RING_BYTES, "cmp lds");
__device__ __forceinline__ void mask_nv(f32x16& p0, f32x16& p1, int base, int nvalid, int hi) {
#pragma unroll
    for (int r = 0; r < 16; ++r) { const int n = base + crow(r, hi); if (n >= nvalid) p0[r] = -INFINITY; if (n + 32 >= nvalid) p1[r] = -INFINITY; }
}
__device__ __forceinline__ void imp_tile(const f32x16& p0, const f32x16& p1, LAS float* own, LAS float* car, int jt, int hi) {
#pragma unroll
    for (int a = 0; a < 4; ++a) {
        const int j0 = jt + 2 * a + hi, j1 = jt + 8 + 2 * a + hi;
        own[j0] = (p0[4 * a] + p0[4 * a + 1]) + (p0[4 * a + 2] + 0.5f * p0[4 * a + 3]); car[j0 + 1] = 0.5f * p0[4 * a + 3];
        own[j1] = (p1[4 * a] + p1[4 * a + 1]) + (p1[4 * a + 2] + 0.5f * p1[4 * a + 3]); if (j1 + 1 < 32) car[j1 + 1] = 0.5f * p1[4 * a + 3];
    }
}
__device__ __forceinline__ bf16x8 pk8(const f32x16& p, int o) { v4u w = (v4u){cvtpk_s(p[o], p[o + 1]), cvtpk_s(p[o + 2], p[o + 3]), cvtpk_s(p[o + 4], p[o + 5]), cvtpk_s(p[o + 6], p[o + 7])}; return __builtin_bit_cast(bf16x8, w); }
__device__ __forceinline__ void cmp_unit(LAS unsigned char* shm, int b, int g, int tb, const bf16* PROJ, const bf16* KCB, float* OACC, unsigned* SELM) {
    const int tid = tid_opaque(), lane = tid & 63, r32 = lane & 31, hi = lane >> 5; const int wid = __builtin_amdgcn_readfirstlane(tid >> 6);
    const int hh = wid & 3, th = wid >> 2, head = g * 4 + hh, tq = th * 32 + r32, t = tb * 64 + tq; const size_t row = (size_t)b * SEQ + t;
    const unsigned lds0 = (unsigned)(uintptr_t)shm;
    LAS float* wsf = (LAS float*)(shm + C_WS) + wid * 64;
    const int ntile = (tb >= 16) ? 2 : 1;
    const bf16* kc = KCB + (size_t)((0 * 8 + b) * 4 + g) * 8192; const bf16* vc = KCB + (size_t)((1 * 8 + b) * 4 + g) * 8192;
    for (int tau = 0; tau < ntile; ++tau) {
        glds16(kc + (size_t)(64 * tau + lane) * 64 + wid * 8, (unsigned)__builtin_amdgcn_readfirstlane(lds0 + C_K + tau * 8192 + wid * 1024));
        glds16(vc + (size_t)(64 * tau + 16 * (wid & 3) + (lane >> 2)) * 64 + (wid >> 2) * 32 + (lane & 3) * 8, (unsigned)__builtin_amdgcn_readfirstlane(lds0 + C_V + tau * 8192 + wid * 1024));
    }
    const bf16* prow = PROJ + row * PLD;
    bf16x8 qr[4];
#pragma unroll
    for (int d0 = 0; d0 < 4; ++d0) qr[d0] = *(const bf16x8*)(prow + PC_Q + head * 64 + d0 * 16 + hi * 8);
    const float g0 = sigm(bf2f(prow[PC_G3 + head * 3 + 0]));
    const int nvalid = (t >= 31) ? (((t - 31) >> 4) + 1) : 0;
    asm volatile("s_waitcnt vmcnt(0) lgkmcnt(0)\n\ts_barrier" ::: "memory");
    const LAS char* kp0 = (const LAS char*)shm + C_K + hi * 1024 + r32 * 16;
    const int vb0 = (int)(lds0 + C_V) + ((lane >> 4) & 1) * 32 + (lane & 3) * 8 + (4 * hi + ((lane & 15) >> 2)) * 64;
    const f32x16 zero = f32x16{};
    f32x16 p0, p1, p2, p3;
    qkt(p0, p1, kp0, qr, zero); mask_nv(p0, p1, 0, nvalid, hi);
    float m = rowmax(p0, p1);
    if (ntile == 2) { qkt(p2, p3, kp0 + 8192, qr, zero); mask_nv(p2, p3, 64, nvalid, hi); m = fmaxf(m, rowmax(p2, p3)); }
    m = fmaxf(m, -1e30f);
    float l = 0.f;
#pragma unroll
    for (int r = 0; r < 16; ++r) { p0[r] = exp2f(p0[r] - m); p1[r] = exp2f(p1[r] - m); l += p0[r] + p1[r]; }
    if (ntile == 2) {
#pragma unroll
        for (int r = 0; r < 16; ++r) { p2[r] = exp2f(p2[r] - m); p3[r] = exp2f(p3[r] - m); l += p2[r] + p3[r]; } }
    const float lt = swap_add(l); const float inv = (lt > 0.f) ? 1.f / lt : 0.f;
#pragma unroll
    for (int r = 0; r < 16; ++r) { p0[r] *= inv; p1[r] *= inv; }
    f32x16 o[2]; o[0] = f32x16{}; o[1] = f32x16{};
    pv(o, vb0, pk8(p0, 0), pk8(p0, 8), pk8(p1, 0), pk8(p1, 8));
    LAS float* own = (LAS float*)(shm + C_OWN) + wid * TBW + r32 * 33; LAS float* car = (LAS float*)(shm + C_CAR) + wid * TBW + r32 * 33;
    imp_tile(p0, p1, own, car, 0, hi);
    if (ntile == 2) {
#pragma unroll
        for (int r = 0; r < 16; ++r) { p2[r] *= inv; p3[r] *= inv; }
        pv(o, vb0 + 8192, pk8(p2, 0), pk8(p2, 8), pk8(p3, 0), pk8(p3, 8));
        imp_tile(p2, p3, own, car, 16, hi);
    }
    if (hi == 0) wsf[r32] = g0;
    LDS_WAIT(); asm volatile("" ::: "memory");
    const size_t rowbase = (size_t)b * SEQ + tb * 64 + th * 32;
#pragma unroll
    for (int r = 0; r < 16; ++r) { const float gq = wsf[crow(r, hi)]; float* oa = OACC + (rowbase + crow(r, hi)) * 1024 + head * 64 + r32; oa[0] = o[0][r] * gq; oa[32] = o[1][r] * gq; }
    asm volatile("s_waitcnt lgkmcnt(0)\n\ts_barrier" ::: "memory");
    LAS float* IMPS = (LAS float*)(shm + C_IMP);
#pragma unroll
    for (int pass = 0; pass < 4; ++pass) { const int tok = pass * 16 + (tid >> 5), j = tid & 31, q = tok & 31, w0 = (tok >> 5) * 4; float v = 0.f;
        if (j < 16 * ntile) {
#pragma unroll
            for (int k = 0; k < 4; ++k) { v += ((LAS float*)(shm + C_OWN))[(w0 + k) * TBW + q * 33 + j]; if (j > 0) v += ((LAS float*)(shm + C_CAR))[(w0 + k) * TBW + q * 33 + j]; } }
        IMPS[tok * 33 + j] = v; }
    asm volatile("s_waitcnt lgkmcnt(0)\n\ts_barrier" ::: "memory");
#pragma unroll
    for (int pass = 0; pass < 4; ++pass) { const int tok = pass * 16 + (tid >> 5), j = tid & 31, cur = tb;
        const bool forced = (j == 0) || (j == cur) || (j == cur - 1);
        const float score = (j <= cur) ? IMPS[tok * 33 + j] + (forced ? 1000.f : 0.f) : -1e9f;
        int rank = 0;
        for (int i = 0; i < 32; ++i) { const bool fi = (i == 0) || (i == cur) || (i == cur - 1); const float si = (i <= cur) ? IMPS[tok * 33 + i] + (fi ? 1000.f : 0.f) : -1e9f; rank += ((si > score) || (si == score && i < j)) ? 1 : 0; }
        const bool sel = (rank < 16) && (score > -5e8f);
        const unsigned long long bal = __ballot(sel);
        if ((lane & 31) == 0) SELM[(size_t)(b * 4 + g) * SEQ + tb * 64 + tok] = (unsigned)(bal >> (lane & 32)); }
    asm volatile("s_waitcnt vmcnt(0) lgkmcnt(0)\n\ts_barrier" ::: "memory");
}
}
__device__ __forceinline__ void p5_cmp_select(Frame& F) {
    const int tid_ = tid_opaque(), lane_ = tid_ & 63; (void)lane_;
    const bf16* PROJ = WSP(bf16, WS_PROJ); const bf16* KCB = WSP(bf16, WS_KCV); float* OACC = WSP(float, WS_OACC); unsigned* SELM = WSP(unsigned, WS_SELM);
    for (int u = blockIdx.x; u < 1024; u += F.G) { const int bg = u >> 5, tb = u & 31; cs::cmp_unit(F.lds, bg >> 2, bg & 3, tb, PROJ, KCB, OACC, SELM); }
}
namespace ml {
using fa::f32x16; using fa::crow; using fa::glds16; using fa::cvtpk_s; using fa::swap_add; using fa::vtr;
constexpr int NR = 4, KSL = 8192, VSL = 16384;
constexpr int L_K = 0, L_V = NR * KSL, L_W = L_V + NR * VSL, L_WS = L_W + 8192, L_UT = L_WS + 8 * 256, L_END = L_UT + 8192;
static_assert(L_END <= RING_BYTES, "mlstm lds");
__device__ __forceinline__ void mlstm_unit(LAS unsigned char* shm, int b, int h, int tb, const bf16* PROJ, const bf16* QKC, const float* GA2, const float* GU2, const float* GM2, const float* mhg, bf16* OML) {
    const int tid = tid_opaque(), lane = tid & 63, r32 = lane & 31, hi = lane >> 5; const int wid = __builtin_amdgcn_readfirstlane(tid >> 6);
    const int vq = wid & 3, th = wid >> 2, tq = th * 32 + r32, t = tb * 64 + tq, bh = b * 4 + h; const size_t row = (size_t)b * SEQ + t;
    const unsigned lds0 = (unsigned)(uintptr_t)shm;
    LAS float* wsf = (LAS float*)(shm + L_WS) + wid * 64;
    LAS float* ut = (LAS float*)(shm + L_UT);
    const int n = 2 * (tb + 1);
    for (int i = tid; i < n * 32; i += 512) ut[i] = GU2[bh * SEQ + i];
    const bf16* kbase = QKC + (size_t)b * SEQ * 1024 + 512 + h * 128 + (size_t)(lane & 31) * 1024 + (2 * wid + (lane >> 5)) * 8;
    const bf16* vb0 = PROJ + (size_t)b * SEQ * PLD + PC_VM + h * 256 + (size_t)(lane >> 2) * PLD + (lane & 3) * 8;
    const int pa = 2 * wid, pb = 2 * wid + 1;
    const bf16* vbaseA = vb0 + (size_t)(16 * (pa & 1)) * PLD + (pa >> 2) * 64 + ((pa >> 1) & 1) * 32;
    const bf16* vbaseB = vb0 + (size_t)(16 * (pb & 1)) * PLD + (pb >> 2) * 64 + ((pb >> 1) & 1) * 32;
    const unsigned kdst = lds0 + L_K + wid * 1024, vdst = lds0 + L_V + wid * 2048;
#define ML_ISSUE_K(i) do { const int i_ = (i); if (i_ < n) glds16(kbase + (size_t)(i_ * 32) * 1024, (unsigned)__builtin_amdgcn_readfirstlane(kdst + (unsigned)((i_ & 3) * KSL))); } while (0)
#define ML_ISSUE_V(i) do { const int i_ = (i); if (i_ >= 0 && i_ < n) { const unsigned d_ = (unsigned)__builtin_amdgcn_readfirstlane(vdst + (unsigned)((i_ & 3) * VSL)); \
        glds16(vbaseA + (size_t)(i_ * 32) * PLD, d_); glds16(vbaseB + (size_t)(i_ * 32) * PLD, d_ + 1024u); } } while (0)
    bf16x8 qr[8];
#pragma unroll
    for (int d0 = 0; d0 < 8; ++d0) qr[d0] = *(const bf16x8*)(QKC + row * 1024 + h * 128 + d0 * 16 + hi * 8);
    const float M2 = GM2[bh * SEQ + t], A2 = GA2[bh * SEQ + t];
    ML_ISSUE_K(0); ML_ISSUE_K(1); ML_ISSUE_V(0); ML_ISSUE_K(2); ML_ISSUE_V(1);
    f32x16 o[2]; o[0] = f32x16{}; o[1] = f32x16{}; float den = 0.f;
    const f32x16 zero = f32x16{};
    const int vbl = ((lane >> 4) & 1) * 32 + (lane & 3) * 8 + (4 * hi + ((lane & 15) >> 2)) * 64;
    LAS unsigned char* wbase = shm + L_W + th * 2048 + lane * 16;
    for (int s = 0; s <= n; ++s) {
        if (s + 2 < n) asm volatile("s_waitcnt vmcnt(6) lgkmcnt(0)\n\ts_barrier" ::: "memory");
        else if (s + 2 == n) asm volatile("s_waitcnt vmcnt(5) lgkmcnt(0)\n\ts_barrier" ::: "memory");
        else if (s + 1 == n) asm volatile("s_waitcnt vmcnt(2) lgkmcnt(0)\n\ts_barrier" ::: "memory");
        else asm volatile("s_waitcnt vmcnt(0) lgkmcnt(0)\n\ts_barrier" ::: "memory");
        ML_ISSUE_K(s + 3); ML_ISSUE_V(s + 2);
        if (s < n && vq == (s & 3)) {
            const LAS char* kb = (const LAS char*)shm + L_K + (s & 3) * KSL + hi * 512 + r32 * 16;
            f32x16 p0;
#pragma unroll
            for (int d0 = 0; d0 < 8; ++d0) { const bf16x8 b0 = *(const LAS bf16x8*)(kb + d0 * 1024); p0 = __builtin_amdgcn_mfma_f32_32x32x16_bf16(b0, qr[d0], d0 == 0 ? zero : p0, 0, 0, 0); }
            const LAS float* up = ut + s * 32 + 4 * hi;
            fa::P8 q0 = __builtin_bit_cast(fa::P8, p0);
            const f32x2 m2 = {M2, M2};
#pragma unroll
            for (int a = 0; a < 4; ++a) { const f32x4 u0 = *(const LAS f32x4*)(up + 8 * a);
                f32x2 e0 = (f32x2){u0.x, u0.y} - m2, e1 = (f32x2){u0.z, u0.w} - m2;
                e0.x = __builtin_amdgcn_exp2f(e0.x); e0.y = __builtin_amdgcn_exp2f(e0.y); e1.x = __builtin_amdgcn_exp2f(e1.x); e1.y = __builtin_amdgcn_exp2f(e1.y);
                q0.v[2 * a] *= e0; q0.v[2 * a + 1] *= e1; }
            if (s >= 2 * tb) {
                const int kb32 = 32 * (s & 1);
#pragma unroll
                for (int r = 0; r < 16; ++r) { if (kb32 + fa::crow(r, hi) > tq) q0.v[r >> 1][r & 1] = 0.f; } }
            { f32x2 d2 = (q0.v[0] + q0.v[1]) + (q0.v[2] + q0.v[3]); d2 += (q0.v[4] + q0.v[5]) + (q0.v[6] + q0.v[7]); den += d2.x + d2.y; }
            LAS unsigned char* wp = wbase + (s & 1) * 4096;
            *(LAS v4u*)(wp) = (v4u){cvtpk_s(q0.v[0].x, q0.v[0].y), cvtpk_s(q0.v[1].x, q0.v[1].y), cvtpk_s(q0.v[2].x, q0.v[2].y), cvtpk_s(q0.v[3].x, q0.v[3].y)};
            *(LAS v4u*)(wp + 1024) = (v4u){cvtpk_s(q0.v[4].x, q0.v[4].y), cvtpk_s(q0.v[5].x, q0.v[5].y), cvtpk_s(q0.v[6].x, q0.v[6].y), cvtpk_s(q0.v[7].x, q0.v[7].y)};
        }
        if (s >= 1) {
            const LAS unsigned char* wp = wbase + ((s - 1) & 1) * 4096;
            const v4u pw0 = *(const LAS v4u*)(wp), pw1 = *(const LAS v4u*)(wp + 1024);
            const LAS char* vp = (const LAS char*)shm + L_V + ((s - 1) & 3) * VSL + vq * 4096 + vbl;
#pragma unroll
            for (int d0 = 0; d0 < 2; ++d0) {
                const fa::s16x4 l0 = vtr(vp + d0 * 2048), h0 = vtr(vp + d0 * 2048 + 512), l1 = vtr(vp + d0 * 2048 + 1024), h1 = vtr(vp + d0 * 2048 + 1536);
                o[d0] = __builtin_amdgcn_mfma_f32_32x32x16_bf16(__builtin_bit_cast(bf16x8, pw0), (bf16x8){l0[0], l0[1], l0[2], l0[3], h0[0], h0[1], h0[2], h0[3]}, o[d0], 0, 0, 0);
                o[d0] = __builtin_amdgcn_mfma_f32_32x32x16_bf16(__builtin_bit_cast(bf16x8, pw1), (bf16x8){l1[0], l1[1], l1[2], l1[3], h1[0], h1[1], h1[2], h1[3]}, o[d0], 0, 0, 0);
            }
        }
    }
    { const float dt = swap_add(den); if (hi == 0) wsf[r32] = dt; }
    asm volatile("s_waitcnt lgkmcnt(0)\n\ts_barrier" ::: "memory");
    { const LAS float* wd = (const LAS float*)(shm + L_WS) + th * 4 * 64; const float dt = (wd[r32] + wd[64 + r32]) + (wd[128 + r32] + wd[192 + r32]);
      const float dd = fmaxf(fabsf(dt), __builtin_amdgcn_exp2f(-(A2 + M2))); if (hi == 0) wsf[32 + r32] = 1.f / dd; }
    LDS_WAIT(); asm volatile("" ::: "memory");
    LAS float* Hst = (LAS float*)shm;
#pragma unroll
    for (int r = 0; r < 16; ++r) { const float f = wsf[32 + crow(r, hi)]; LAS float* hp = Hst + (th * 32 + crow(r, hi)) * 256 + vq * 64 + r32; hp[0] = o[0][r] * f; hp[32] = o[1][r] * f; }
    asm volatile("s_waitcnt lgkmcnt(0)\n\ts_barrier" ::: "memory");
#pragma unroll
    for (int k = 0; k < 8; ++k) { const int tr = wid * 8 + k; const f32x4 hv = *(const LAS f32x4*)(Hst + tr * 256 + 4 * lane);
        const float ssq = wave_sum((hv.x * hv.x + hv.y * hv.y) + (hv.z * hv.z + hv.w * hv.w)); const float rs = rsqrtf(ssq * (1.f / 256.f) + EPS);
        const size_t orow = (size_t)b * SEQ + tb * 64 + tr; const v2u om = *(const v2u*)(PROJ + orow * PLD + PC_OM + h * 256 + 4 * lane); const f32x4 gg = *(const f32x4*)(mhg + h * 256 + 4 * lane);
        v2u ov; ov.x = pk2(sigm(bflo(om.x)) * hv.x * rs * gg.x, sigm(bfhi(om.x)) * hv.y * rs * gg.y); ov.y = pk2(sigm(bflo(om.y)) * hv.z * rs * gg.z, sigm(bfhi(om.y)) * hv.w * rs * gg.w);
        *(v2u*)(OML + orow * 2048 + h * 256 + 4 * lane) = ov; }
    asm volatile("s_waitcnt lgkmcnt(0)\n\ts_barrier" ::: "memory");
#undef ML_ISSUE_K
#undef ML_ISSUE_V
}
}
__device__ __forceinline__ void p5_mlstm(Frame& F, int& chunk) {
    const int tid_ = tid_opaque(), lane_ = tid_ & 63; (void)lane_;
    const bf16* PROJ = WSP(bf16, WS_PROJ); const bf16* QKC = WSP(bf16, WS_QKC); bf16* OML = WSP(bf16, WS_OMIX) + 1024;
    const float* GA = WSP(float, WS_GA); const float* GU = WSP(float, WS_GU); const float* GM = WSP(float, WS_GM); const float* mhg = INP(13);
    unsigned* ctr = WSP(unsigned, WS_CTL) + CW_MLQ; LAS int* tk = (LAS int*)(F.lds + LDSCTL_OFF + 64);
    __syncthreads();
    if (tid_ == 0) tk[0] = (int)__hip_atomic_fetch_add(ctr, 1u, RLX_AGENT);
    __syncthreads();
    int u = tk[0];
    while (u < 1024) {
        int nxt = 0; if (tid_ == 0) nxt = (int)__hip_atomic_fetch_add(ctr, 1u, RLX_AGENT);
        const int bh = u & 31, tb = 31 - (u >> 5);
        ml::mlstm_unit(F.lds, bh >> 2, bh & 3, tb, PROJ, QKC, GA, GU, GM, mhg, OML);
        convert_chunk(F, chunk);
        if (tid_ == 0) tk[0] = nxt;
        __syncthreads();
        u = tk[0];
        __syncthreads();
    }
}
__device__ __forceinline__ void p6_sel_win(Frame& F, int& chunk) {
    const int tid_ = tid_opaque(), lane_ = tid_ & 63; (void)lane_;
    const bf16* PROJ = WSP(bf16, WS_PROJ); float* OACC = WSP(float, WS_OACC); unsigned* SELM = WSP(unsigned, WS_SELM); bf16* ONSA = WSP(bf16, WS_OMIX); const bf16* KCB = WSP(bf16, WS_KCV);
    __syncthreads();
    if (F.G == 256) {
        const int bx = blockIdx.x, xcd = bx % 8, w = bx / 8, s = w & 15;
        for (int i = 0; i < 4; ++i) { const int bg = 4 * xcd + 2 * (i >> 1) + (w >> 4); const int tb = (i & 1) ? 31 - s : s;
            cs::cmp_unit(F.lds, bg >> 2, bg & 3, tb, PROJ, KCB, OACC, SELM); fa::sel_win_unit(F.lds, bg >> 2, bg & 3, tb, PROJ, SELM, OACC, ONSA); convert_chunk(F, chunk); }
    } else {
        for (int u = blockIdx.x; u < 1024; u += F.G) { const int bg = u >> 5, tb = u & 31;
            cs::cmp_unit(F.lds, bg >> 2, bg & 3, tb, PROJ, KCB, OACC, SELM); fa::sel_win_unit(F.lds, bg >> 2, bg & 3, tb, PROJ, SELM, OACC, ONSA); convert_chunk(F, chunk); }
    }
    while (chunk < NCHUNK) convert_chunk(F, chunk);
}
__device__ __forceinline__ void p10_rows(Frame& F) {
    const int tid_ = tid_opaque(), lane_ = tid_ & 63; (void)lane_;
    const float* x = INP(0); const float* gpost = INP(5); const float* gpre = INP(17); const float* mod = WSP(float, WS_MOD); const bf16* Y = WSP(bf16, WS_Y); bf16* H2 = WSP(bf16, WS_H2); unsigned char* H2Q = WSP(unsigned char, WS_H2Q);
    LAS float* A1 = (LAS float*)F.lds; LAS float* A2 = A1 + 2048; LAS float* C2 = A1 + 4096;
    int cur_b = -1;
    for (int blk = blockIdx.x; blk < NTOK / 64; blk += F.G) {
        const int b = blk >> 5;
        if (b != cur_b) { __syncthreads(); const float* mb = mod + b * 12288;
            const f32x4 g = *(const f32x4*)(gpost + 4 * tid_), gt = *(const f32x4*)(mb + 4096 + 4 * tid_), gp = *(const f32x4*)(gpre + 4 * tid_), a = *(const f32x4*)(mb + 8192 + 4 * tid_), c = *(const f32x4*)(mb + 6144 + 4 * tid_);
            *(LAS f32x4*)(A1 + 4 * tid_) = g * gt; *(LAS f32x4*)(A2 + 4 * tid_) = gp * (1.f + a); *(LAS f32x4*)(C2 + 4 * tid_) = c; __syncthreads(); cur_b = b; }
        const int row0 = blk * 64 + F.wave * 8;
        v2u yq[8]; f32x4 xx[8];
        { const GAS v2u* yr = UPTR(const v2u, Y + (size_t)row0 * DM) + lane_; const GAS f32x4* xr = UPTR(const f32x4, x + (size_t)row0 * DM) + lane_;
#pragma unroll
          for (int j = 0; j < 8; ++j) { yq[j] = yr[64 * j]; xx[j] = xr[64 * j]; } }
#pragma unroll
        for (int k = 0; k < 8; ++k) {
            const int row = row0 + k;
            v2u yn[8]; f32x4 xn[8];
            if (k + 1 < 8) { const GAS v2u* yr = UPTR(const v2u, Y + (size_t)(row + 1) * DM) + lane_; const GAS f32x4* xr = UPTR(const f32x4, x + (size_t)(row + 1) * DM) + lane_;
#pragma unroll
                for (int j = 0; j < 8; ++j) { yn[j] = yr[64 * j]; xn[j] = xr[64 * j]; } }
            GAS v2u* orow = UPTR(v2u, WSP(bf16, WS_X1B) + (size_t)row * DM) + lane_;
            f32x4 v[8]; float s = 0.f;
#pragma unroll
            for (int j = 0; j < 8; ++j) { const v2u q = yq[j]; v[j] = (f32x4){bflo(q.x), bfhi(q.x), bflo(q.y), bfhi(q.y)}; s += (v[j].x * v[j].x + v[j].y * v[j].y) + (v[j].z * v[j].z + v[j].w * v[j].w); }
            const float rstd = rsqrtf(wave_sum(s) * (1.f / DM) + EPS);
            float s1 = 0.f;
#pragma unroll
            for (int j = 0; j < 8; ++j) { const f32x4 a1 = *(LAS f32x4*)(A1 + 4 * lane_ + 256 * j);
                v[j] = xx[j] + a1 * (v[j] * rstd); orow[64 * j] = (v2u){pk2(v[j].x, v[j].y), pk2(v[j].z, v[j].w)}; s1 += (v[j].x * v[j].x + v[j].y * v[j].y) + (v[j].z * v[j].z + v[j].w * v[j].w); }
            const float rstd1 = rsqrtf(wave_sum(s1) * (1.f / DM) + EPS);
            GAS unsigned long long* o8 = UPTR(unsigned long long, H2 + (size_t)row * DM) + lane_; GAS int* o4 = UPTR(int, H2Q + (size_t)row * DM) + lane_;
#pragma unroll
            for (int j = 0; j < 8; ++j) { const int col = 4 * lane_ + 256 * j; const f32x4 a2 = *(LAS f32x4*)(A2 + col), c2 = *(LAS f32x4*)(C2 + col);
                const f32x4 r = v[j] * rstd1 * a2 + c2;
                o8[64 * j] = (unsigned long long)pk2(r.x, r.y) | ((unsigned long long)pk2(r.z, r.w) << 32);
                int q8 = 0; q8 = __builtin_amdgcn_cvt_pk_fp8_f32(fminf(fmaxf(r.x, -448.f), 448.f), fminf(fmaxf(r.y, -448.f), 448.f), q8, false); q8 = __builtin_amdgcn_cvt_pk_fp8_f32(fminf(fmaxf(r.z, -448.f), 448.f), fminf(fmaxf(r.w, -448.f), 448.f), q8, true);
                o4[64 * j] = q8; }
            if (k + 1 < 8) {
#pragma unroll
                for (int j = 0; j < 8; ++j) { yq[j] = yn[j]; xx[j] = xn[j]; } }
        }
    }
    __syncthreads();
}
__device__ __forceinline__ void p12_route(Frame& F, int cbase = CW_CNT) {
    const int tid_ = tid_opaque(), lane_ = tid_ & 63; (void)lane_;
    const float* LG = WSP(float, WS_LOGITS); const float* br = INP(20); unsigned* cnt = WSP(unsigned, WS_CTL) + cbase;
    int* TE = WSP(int, WS_TE); int* TP = WSP(int, WS_TP); float* TW = WSP(float, WS_TW);
    LAS int* cw = (LAS int*)F.lds; LAS int* basee = cw + 512;
    const int lane = lane_; const float brl = br[lane];
    for (int tblk = blockIdx.x; tblk < NTOK / 64; tblk += F.G) {
        __syncthreads();
        int c = 0; unsigned selm = 0u, posb = 0u, kb = 0u; float wv[8];
#pragma unroll
        for (int k = 0; k < 8; ++k) { const int t = tblk * 64 + F.wave * 8 + k;
            const float s = sigm_ieee(LG[(size_t)t * 64 + lane]); const float sb = s + brl;
            const int grp = lane >> 3; float m1 = -INFINITY, m2 = -INFINITY;
#pragma unroll
            for (int i = 0; i < 8; ++i) { const float v = __shfl(sb, grp * 8 + i); if (v > m1) { m2 = m1; m1 = v; } else if (v > m2) { m2 = v; } }
            const float gs = m1 + m2; int grank = 0;
#pragma unroll
            for (int gi = 0; gi < 8; ++gi) { const float o = __shfl(gs, gi * 8); grank += ((o > gs) || (o == gs && gi < grp)) ? 1 : 0; }
            const float ms = (grank < 4) ? sb : -1e9f; int rank = 0;
            for (int i = 0; i < 64; ++i) { const float o = rdlane(ms, i); rank += ((o > ms) || (o == ms && i < lane)) ? 1 : 0; }
            const bool sel = rank < 8;
            const float wsum = wave_sum(sel ? s : 0.f);
            const unsigned long long bal = __ballot(sel);
            wv[k] = s / wsum * 2.5f;
            if (sel) { selm |= 1u << k; posb |= (unsigned)c << (3 * k); kb |= (unsigned)(__popcll(bal & ((1ull << lane) - 1ull)) & 7) << (3 * k); ++c; } }
        cw[F.wave * 64 + lane] = c;
        __syncthreads();
        if (F.wave == 0) { int tot = 0;
#pragma unroll
            for (int w = 0; w < 8; ++w) tot += cw[w * 64 + lane];
            basee[lane] = tot ? (int)atomicAdd(&cnt[lane], (unsigned)tot) : 0; }
        __syncthreads();
        int off = basee[lane];
        for (int w = 0; w < F.wave; ++w) off += cw[w * 64 + lane];
#pragma unroll
        for (int k = 0; k < 8; ++k) if ((selm >> k) & 1u) { const int t = tblk * 64 + F.wave * 8 + k; const int idx = t * 8 + (int)((kb >> (3 * k)) & 7u);
            TE[idx] = lane; TP[idx] = off + (int)((posb >> (3 * k)) & 7u); TW[idx] = wv[k]; }
    }
    __syncthreads();
}
__device__ __forceinline__ void p13_slots(Frame& F) {
    const int tid_ = tid_opaque(), lane_ = tid_ & 63; (void)lane_;
    unsigned* cnt = WSP(unsigned, WS_CTL) + CW_CNT; LAS int* rs = (LAS int*)F.lds;
    const int* TE = WSP(int, WS_TE); const int* TP = WSP(int, WS_TP); const float* TW = WSP(float, WS_TW);
    int* TOKSLOT = WSP(int, WS_TOKSLOT); int* SLOTTOK = WSP(int, WS_SLOTTOK); float* SLOTW = WSP(float, WS_SLOTW); int* RT = WSP(int, WS_RT);
    LAS int* ts = rs + 80;
    if (tid_ < 64) { const int c = (int)__hip_atomic_load(cnt + tid_, RLX_AGENT); const int nt_ = (c + 255) >> 8; int a = c, tt = nt_;
#pragma unroll
        for (int o = 1; o < 64; o <<= 1) { const int n = __shfl_up(a, o), n2 = __shfl_up(tt, o); if (lane_ >= o) { a += n; tt += n2; } }
        rs[tid_ + 1] = a; ts[tid_ + 1] = tt; if (tid_ == 0) { rs[0] = 0; ts[0] = 0; } }
    __syncthreads();
    const int gt = blockIdx.x * 512 + tid_, ngt = F.G * 512;
    for (int idx = gt; idx < NSLOT; idx += ngt) { const int e = TE[idx], slot = rs[e] + TP[idx]; SLOTTOK[slot] = idx >> 3; SLOTW[slot] = TW[idx]; TOKSLOT[idx] = slot; }
    for (int idx = gt; idx < NTOK; idx += ngt) { SLOTTOK[NSLOT + idx] = idx; SLOTW[NSLOT + idx] = 1.f; }
    if (blockIdx.x == 0) {
        if (tid_ < 64) { const int e = tid_, c = rs[e + 1] - rs[e]; int j = ts[e]; for (int r = 0; r * 256 < c; ++r, ++j) { RT[3 * j] = e; RT[3 * j + 1] = rs[e] + 256 * r; RT[3 * j + 2] = (c - 256 * r) < 256 ? (c - 256 * r) : 256; } }
        else if (tid_ < 128) { const int r = tid_ - 64, j = ts[64] + r; RT[3 * j] = 64; RT[3 * j + 1] = NSLOT + 256 * r; RT[3 * j + 2] = 256; }
        if (tid_ == 0) __hip_atomic_store(WSP(unsigned, WS_CTL) + CW_NTILES, (unsigned)(ts[64] + 64), RLX_AGENT);
    }
    __syncthreads();
}
__device__ __forceinline__ void p16_final(Frame& F, bool do_store = true) {
    const int tid_ = tid_opaque(), lane_ = tid_ & 63; (void)lane_;
    const unsigned char* YS = WSP(unsigned char, WS_YSLOT); const int* TOKSLOT = WSP(int, WS_TOKSLOT); const float* gpost = INP(18); const float* mod = WSP(float, WS_MOD);
    LAS float* A = (LAS float*)F.lds;
    int cur_b = -1;
    for (int blk = blockIdx.x; blk < NTOK / 64; blk += F.G) {
        const int b = blk >> 5;
        if (b != cur_b) { __syncthreads();
            const f32x4 g = *(const f32x4*)(gpost + 4 * tid_), gt = *(const f32x4*)(mod + b * 12288 + 10240 + 4 * tid_);
            *(LAS f32x4*)(A + 4 * tid_) = g * gt * (1.f / 64.f); __syncthreads(); cur_b = b; }
        const int row0 = blk * 64 + F.wave * 8;
        const int myslot = TOKSLOT[row0 * 8 + lane_];
        int q[3][24]; v2u xx[8];
#define P16_ISSUE(kk, gg) do { _Pragma("unroll") for (int r = 0; r < 3; ++r) { const int k9 = 3 * (gg) + r; \
            const int slot = (k9 < 8) ? __builtin_amdgcn_readlane(myslot, (kk) * 8 + k9) : NSLOT + row0 + (kk); \
            const GAS int* yr = UPTR(const int, YS + (size_t)slot * DM) + lane_; \
            _Pragma("unroll") for (int j = 0; j < 8; ++j) q[gg][8 * r + j] = yr[64 * j]; } } while (0)
        P16_ISSUE(0, 0); P16_ISSUE(0, 1); P16_ISSUE(0, 2);
#pragma unroll 1
        for (int k = 0; k < 8; ++k) {
            const int row = row0 + k;
            { const GAS v2u* xr = UPTR(const v2u, WSP(bf16, WS_X1B) + (size_t)row * DM) + lane_;
#pragma unroll
              for (int j = 0; j < 8; ++j) xx[j] = xr[64 * j]; }
            f32x4 acc[8];
#pragma unroll
            for (int j = 0; j < 8; ++j) acc[j] = (f32x4){0.f, 0.f, 0.f, 0.f};
#pragma unroll
            for (int g = 0; g < 3; ++g) {
#pragma unroll
                for (int r = 0; r < 3; ++r)
#pragma unroll
                    for (int j = 0; j < 8; ++j) { const int w = q[g][8 * r + j]; const f32x2 lo = __builtin_amdgcn_cvt_pk_f32_fp8(w, false), hi = __builtin_amdgcn_cvt_pk_f32_fp8(w, true);
                        acc[j].x += lo.x; acc[j].y += lo.y; acc[j].z += hi.x; acc[j].w += hi.y; }
                if (k + 1 < 8) P16_ISSUE(k + 1, g);
            }
            float s = 0.f;
#pragma unroll
            for (int j = 0; j < 8; ++j) s += (acc[j].x * acc[j].x + acc[j].y * acc[j].y) + (acc[j].z * acc[j].z + acc[j].w * acc[j].w);
            const float rstd = rsqrtf(wave_sum(s) * (1.f / (4096.f * DM)) + EPS);
            GAS f32x4* orow = UPTR(f32x4, F.out + (size_t)row * DM) + lane_;
            unsigned aoff = 16u * (unsigned)lane_; asm volatile("" : "+v"(aoff));
#pragma unroll
            for (int j = 0; j < 8; ++j) { const f32x4 a = *(LAS f32x4*)((LAS unsigned char*)A + aoff + 1024 * j);
                const f32x4 x1 = {bflo(xx[j].x), bfhi(xx[j].x), bflo(xx[j].y), bfhi(xx[j].y)};
                if (do_store || F.G == 12345) orow[64 * j] = x1 + a * (acc[j] * rstd); }
        }
#undef P16_ISSUE
    }
}

constexpr int NPHASE = 17;
struct Args { const float* in[27]; float* out; unsigned char* ws; int ph_lo, ph_hi, li, pad; };
__global__ void __launch_bounds__(512, 2) mega_fwd(Args args) {
    extern __shared__ __attribute__((aligned(16))) unsigned char lds[];
    Frame F;
    F.lds = (LAS unsigned char*)lds; F.ws = args.ws; F.in = args.in; F.out = args.out;
    F.tid = threadIdx.x; F.lane = F.tid & 63; F.wave = __builtin_amdgcn_readfirstlane(F.tid >> 6); F.G = gridDim.x;
    F.gw = blockIdx.x * 8 + F.wave; F.ngw = F.G * 8;
    volatile LAS unsigned* MISC = (volatile LAS unsigned*)(F.lds + MISC_OFF);
    for (int u = F.tid; u < (LDS_BYTES - LDSCTL_OFF) / 4; u += 512) ((LAS unsigned*)(F.lds + LDSCTL_OFF))[u] = 0u;
    __syncthreads();
    unsigned* ctl = (unsigned*)(args.ws + WS_CTL);
    XcdBarrier bar; bar.bar = ctl + CW_BAR; bar.x = 0; bar.st = nullptr;
    if (!MK_PER_PHASE) bar = xcd_barrier_post(ctl + CW_BAR, MISC + 8);
    const int lo = args.ph_lo, hi = args.ph_hi;
#define IN(k) (lo <= (k) && (k) < hi)
#define SEAM(k) do { if (IN(k) && IN((k) + 1)) xcd_barrier(bar); } while (0)
    bf16* PROJ = WSP(bf16, WS_PROJ);
    int chunk = 0;
    const int vcu_ = (F.G % 8 == 0) ? (int)(blockIdx.x % 8) * (F.G / 8) + (int)(blockIdx.x / 8) : (int)blockIdx.x;

    if (IN(0)) { p0_bias1(F); p0_early(F); } SEAM(0);
    if (IN(1)) REP(1, { p1_h1(F); }); SEAM(1);
    if (IN(2)) REP(2, {
        if constexpr (PROJ_MODE == 0) {
        { pg8::Gemm g{WSP(bf16, WS_H1), WSP(bf16, WS_WIN), DM, 128, 0, 0}; pg8::StaticOrder S; S.init(NTOK, PN_BF, F.G, (int)blockIdx.x, PRB(2));
          pg8::EpiBf16 E{PROJ, PLD, 4, QC2};
          pg8::gemm_phase<pg8::EpiBf16, pg8::StaticOrder, false, true>(F.lds, g, S, E); }
        { pg8::Gemm g{WSP(unsigned char, WS_H1Q), WSP(unsigned char, WS_WIN8), DM, 128, 127 - 6, 127}; pg8::StaticOrder S; S.init(NTOK, PN_F8, F.G, (int)blockIdx.x, PRB(3));
          pg8::EpiBf16 E{PROJ + PN_BF, PLD, 1 << 20, 1.f / 64.f};
          pg8::gemm_phase<pg8::EpiBf16, pg8::StaticOrder, false, true, true>(F.lds, g, S, E); }
        } else {
          pg8::Gemm g{WSP(unsigned char, WS_H1Q), WSP(unsigned char, WS_WIN8), DM, 128, 127 - 6, 127}; pg8::StaticOrder S; S.init(NTOK, PLD, F.G, (int)blockIdx.x, PRB(3));
          pg8::EpiBf16 E{PROJ, PLD, 4, QC2 / 64.f, 1.f / 64.f};
          pg8::gemm_phase<pg8::EpiBf16, pg8::StaticOrder, false, true, true>(F.lds, g, S, E); }
    }); SEAM(2);
    if (IN(3)) REP(3, { p3_conv(F); p3_gates(F); }); SEAM(3);
    if (IN(4)) {
        { pg8::Gemm g{PROJ, WSP(bf16, WS_CW1), DM, PLD * 2, 0, 0}; pg8::CmpOrder S{F.G, (int)blockIdx.x}; pg8::EpiCmpHid E{WSP(bf16, WS_HIDC), WSP(float, WS_BIAS1)};
          pg8::gemm_phase<pg8::EpiCmpHid, pg8::CmpOrder, true, true>(F.lds, g, S, E);
          if ((int)blockIdx.x < 32) kcv_unit(F, (int)blockIdx.x >> 4, (int)blockIdx.x & 15); }
        p5_mlstm(F, chunk); } SEAM(4);
    if (IN(6)) { p6_sel_win(F, chunk); } SEAM(6);
    if (IN(7)) REP(7, {
        pg8::Gemm g{WSP(bf16, WS_OMIX), WSP(bf16, WS_WUP), DM, 128, 0, 0}; pg8::StaticOrder S; S.init(NTOK, DM, F.G, (int)blockIdx.x);
        pg8::EpiGate E{WSP(bf16, WS_MERGED), PROJ + PC_GB, PLD, nullptr}; pg8::MidGate MH{PROJ + PC_GA, PROJ + PC_GB, PLD};
        pg8::gemm_phase<pg8::EpiGate, pg8::StaticOrder, false, true, false, false, pg8::MidGate>(F.lds, g, S, E, MH);
    }); SEAM(7);
    if (IN(9)) REP(9, {
        pg8::Gemm g{WSP(bf16, WS_MERGED), WSP(bf16, WS_WOUT), DM, 128, 0, 0}; pg8::StaticOrder S; S.init(NTOK, DM, F.G, (int)blockIdx.x);
        pg8::EpiBf16 E{WSP(bf16, WS_Y), DM, 0, 1.f};
        pg8::gemm_phase<pg8::EpiBf16, pg8::StaticOrder, false, true>(F.lds, g, S, E);
    }); SEAM(9);
    if (IN(10)) REP(10, { p10_rows(F); }); SEAM(10);
    if (IN(11)) REP(11, {
        pg8::Gemm g{WSP(bf16, WS_H2), WSP(bf16, WS_WR), DM, 128, 0, 0}; pg8::StaticOrder S; S.init(NTOK, 256, F.G, (int)blockIdx.x);
        pg8::EpiF32 E{WSP(float, WS_LOGITS), 64, 64};
        pg8::gemm_phase<pg8::EpiF32, pg8::StaticOrder, false, true>(F.lds, g, S, E);
    }); SEAM(11);
    if (IN(12)) { if ((PROBE_DUP >> 12) & 1) p12_route(F, 256); p12_route(F); } SEAM(12);
    if (IN(13)) REP(13, { p13_slots(F); }); SEAM(13);
    if (IN(14)) REP(14, {
        const int ntiles = (int)__hip_atomic_load(ctl + CW_NTILES, RLX_AGENT);
        LAS int* rtc = (LAS int*)(F.lds + RT_LDS_OFF); for (int i = threadIdx.x; i < 3 * ntiles; i += 512) rtc[i] = WSP(int, WS_RT)[i]; __syncthreads();
        pg8::Gemm g{WSP(unsigned char, WS_H2Q), WSP(unsigned char, WS_WEGU), DM, 128, 127 - 6, 127}; pg8::MoeOrder S{rtc, ntiles, 4, F.G, vcu_, WSP(int, WS_SLOTTOK), 2048u, PRB(14)};
        pg8::EpiSwiglu E{WSP(unsigned char, WS_HID), WSP(float, WS_SLOTW)};
        pg8::gemm_phase<pg8::EpiSwiglu, pg8::MoeOrder, true, true, true, false>(F.lds, g, S, E);
    }); SEAM(14);
    if (IN(15)) REP(15, {
        const int ntiles = (int)__hip_atomic_load(ctl + CW_NTILES, RLX_AGENT);
        LAS int* rtc = (LAS int*)(F.lds + RT_LDS_OFF); for (int i = threadIdx.x; i < 3 * ntiles; i += 512) rtc[i] = WSP(int, WS_RT)[i]; __syncthreads();
        pg8::Gemm g{WSP(unsigned char, WS_HID), WSP(unsigned char, WS_WED), EFF, 128, 127 - 6, 127 - 4}; pg8::MoeOrder S{rtc, ntiles, 8, F.G, vcu_, nullptr, 512u, PRB(15)};
        pg8::EpiFp8 E{WSP(unsigned char, WS_YSLOT), DM, 64.f / 1024.f};
        pg8::gemm_phase<pg8::EpiFp8, pg8::MoeOrder, false, true, true>(F.lds, g, S, E);
    }); SEAM(15);
    if (IN(16)) { if ((PROBE_DUP >> 16) & 1) p16_final(F, false); p16_final(F); }
#undef IN
#undef SEAM
}

extern "C" void kernel_launch(void* const* d_in, const int* in_sizes, int n_in, void* d_out, int out_size, void* d_ws, size_t ws_size, hipStream_t stream) {
    static int grid = 0;
    if (grid == 0) {
        if (n_in != 27 || out_size != NTOK * DM || ws_size < WS_END) { fprintf(stderr, "kernel_launch: unexpected shapes (n_in %d out %d ws %zu)\n", n_in, out_size, ws_size); grid = -1; return; }
        int dev = 0, cus = 0, per_cu = 0;
        if (hipGetDevice(&dev) != hipSuccess || hipDeviceGetAttribute(&cus, hipDeviceAttributeMultiprocessorCount, dev) != hipSuccess) { grid = -1; return; }
        if (hipFuncSetAttribute((const void*)mega_fwd, hipFuncAttributeMaxDynamicSharedMemorySize, LDS_BYTES) != hipSuccess) { fprintf(stderr, "kernel_launch: hipFuncSetAttribute failed\n"); grid = -1; return; }
        if (hipOccupancyMaxActiveBlocksPerMultiprocessor(&per_cu, (const void*)mega_fwd, 512, LDS_BYTES) != hipSuccess || per_cu < 1) fprintf(stderr, "kernel_launch: occupancy query says %d\n", per_cu);
        (void)hipGetLastError();
        grid = cus;
    }
    if (grid < 0) return;
    (void)hipMemsetAsync((char*)d_ws + WS_CTL, 0, CTL_ZERO_BYTES, stream);
    Args a{};
    for (int i = 0; i < 27; ++i) a.in[i] = (const float*)d_in[i];
    a.out = (float*)d_out; a.ws = (unsigned char*)d_ws;
#if MK_PER_PHASE
    for (int p = 0; p < NPHASE; ++p) { a.ph_lo = p; a.ph_hi = p + 1; a.li = p; hipLaunchKernelGGL(mega_fwd, dim3(grid), dim3(512), LDS_BYTES, stream, a); }
#else
    a.ph_lo = 0; a.ph_hi = NPHASE; a.li = 0;
    hipLaunchKernelGGL(mega_fwd, dim3(grid), dim3(512), LDS_BYTES, stream, a);
#endif
}
```
